# Optimizing an MI355X kernel written in HIP

```python
import math
import jax
import jax.numpy as jnp
from jax import lax
import numpy as np

D_MODEL = 2048
BATCH = 2
SEQ = 8192
DEPTH = 4

GRID_W = 64
CTX_LEN = 256
A_HEADS = 8
A_HEAD_DIM = 128
A_WIDTH = A_HEADS * A_HEAD_DIM
B_HEADS = 8
B_HEAD_DIM = 128
B_WIDTH = B_HEADS * B_HEAD_DIM
SHORT_CONV = 4
CHUNK = 64
RNN_WIDTH = D_MODEL
RNN_BLOCKS = 8
RNN_BLOCK = RNN_WIDTH // RNN_BLOCKS
RNN_CONV = 4
RG_C = 8.0
FFN_HIDDEN = ((8 * D_MODEL + 3 * 256 - 1) // (3 * 256)) * 256
N_EVEN = (DEPTH + 1) // 2
N_ODD = DEPTH // 2
DN_ALPHA = (2 * DEPTH) ** 0.25
DN_BETA = (8 * DEPTH) ** -0.25
EPS = 1e-6
EVEN_SPLIT_SIZES = (A_WIDTH, A_WIDTH, A_WIDTH, A_WIDTH, A_WIDTH, B_WIDTH, B_WIDTH, B_WIDTH, B_WIDTH, 2 * B_HEADS, 2 * B_HEADS)
EVEN_IN = 5 * A_WIDTH + 4 * B_WIDTH + 4 * B_HEADS

kernel_name = 'hybrid_hgrn2_gdn_rglru_diffusion_block'


def _layer_norm(x, g, b):
    xf = x.astype(jnp.float32)
    mu = jnp.mean(xf, axis=-1, keepdims=True)
    var = jnp.mean(jnp.square(xf - mu), axis=-1, keepdims=True)
    return ((xf - mu) * lax.rsqrt(var + EPS) * g + b).astype(x.dtype)


def _rms_heads(o, w):
    of = o.astype(jnp.float32)
    of = of * lax.rsqrt(jnp.mean(jnp.square(of), axis=-1, keepdims=True) + EPS)
    return (of.reshape(o.shape[:2] + (-1,)) * w).astype(o.dtype)


def _l2norm(t):
    tf = t.astype(jnp.float32)
    return (tf * lax.rsqrt(jnp.sum(jnp.square(tf), axis=-1, keepdims=True) + EPS)).astype(t.dtype)


def _dwconv(x, w):
    k_w = w.shape[0]
    t_len = x.shape[1]
    left = k_w // 2
    xp = jnp.pad(x, ((0, 0), (left, k_w - 1 - left), (0, 0)))
    out = xp[:, 0:t_len] * w[0]
    for k in range(1, k_w):
        out = out + xp[:, k:k + t_len] * w[k]
    return out


def _split_cols(p, sizes):
    out, start = [], 0
    for s in sizes:
        out.append(p[..., start:start + s])
        start += s
    return out


def _to_chunks(t):
    bsz, t_len = t.shape[:2]
    t = t.reshape((bsz, t_len // CHUNK, CHUNK) + t.shape[2:])
    return jnp.swapaxes(jnp.moveaxis(t, 1, 0), 2, 3)


def _from_chunks(o):
    o = jnp.moveaxis(jnp.swapaxes(o, 2, 3), 0, 1)
    return o.reshape((o.shape[0], -1) + o.shape[3:])


def _hgrn2_scan(q, k, log_f, v, s0):
    dt = v.dtype
    q, k, log_f, v = (_to_chunks(t.astype(jnp.float32)) for t in (q, k, log_f, v))
    g_cum = jnp.cumsum(log_f, axis=-2)
    causal = jnp.tril(jnp.ones((CHUNK, CHUNK), dtype=bool))

    def step(s, inp):
        qc, kc, gc, vc = inp
        diff = gc[..., :, None, :] - gc[..., None, :, :]
        decay = jnp.exp(jnp.where(causal[:, :, None], diff, -jnp.inf))
        scores = jnp.einsum('bhtc,bhsc,bhtsc->bhts', qc, kc, decay)
        o = jnp.einsum('bhtc,bhcv->bhtv', qc * jnp.exp(gc), s) + jnp.einsum('bhts,bhsv->bhtv', scores, vc)
        g_last = gc[..., -1:, :]
        s = jnp.exp(g_last[..., 0, :])[..., None] * s + jnp.einsum('bhsc,bhsv->bhcv', kc * jnp.exp(g_last - gc), vc)
        return s, o

    s_final, o = lax.scan(step, s0, (q, k, g_cum, v))
    return _from_chunks(o).astype(dt), s_final


def _gdn_scan(q, k, v, g, beta, s0):
    dt = v.dtype
    dv = v.shape[-1]
    q, k, v, g, beta = (_to_chunks(t.astype(jnp.float32)) for t in (q, k, v, g, beta))
    g_cum = jnp.cumsum(g, axis=-1)
    causal = jnp.tril(jnp.ones((CHUNK, CHUNK), dtype=bool))
    strict = jnp.tril(jnp.ones((CHUNK, CHUNK), dtype=bool), -1)
    decay = jnp.exp(jnp.where(causal, g_cum[..., :, None] - g_cum[..., None, :], -jnp.inf))
    kb = k * beta[..., None]
    a_mat = jnp.where(strict, jnp.einsum('nbhtd,nbhsd->nbhts', kb, k) * decay, 0.0)
    rhs = jnp.concatenate([v * beta[..., None], kb * jnp.exp(g_cum)[..., None]], axis=-1)
    sol = lax.linalg.triangular_solve(jnp.eye(CHUNK, dtype=jnp.float32) + a_mat, rhs, left_side=True, lower=True)
    u, w = sol[..., :dv], sol[..., dv:]
    attn = jnp.einsum('nbhtd,nbhsd->nbhts', q, k) * decay

    def step(s, inp):
        qc, kc, gc, uc, wc, ac = inp
        v_new = uc - jnp.einsum('bhtc,bhcv->bhtv', wc, s)
        o = jnp.einsum('bhtc,bhcv->bhtv', qc * jnp.exp(gc)[..., None], s) + jnp.einsum('bhts,bhsv->bhtv', ac, v_new)
        g_last = gc[..., -1:]
        s = jnp.exp(g_last)[..., None] * s + jnp.einsum('bhsc,bhsv->bhcv', kc * jnp.exp(g_last - gc)[..., None], v_new)
        return s, o

    s_final, o = lax.scan(step, s0, (q, k, g_cum, u, w, attn))
    return _from_chunks(o).astype(dt), s_final


def _linear_scan(log_a, b, h0):
    dt = b.dtype
    a = jnp.exp(log_a.astype(jnp.float32))
    b = b.astype(jnp.float32)
    b = b.at[:, 0].add(a[:, 0] * h0)

    def combine(left, right):
        return left[0] * right[0], right[0] * left[1] + right[1]

    _, h = lax.associative_scan(combine, (a, b), axis=1)
    return h.astype(dt), h[:, -1]


def _bidir(scan_fn, ctx_fwd, ctx_bwd, lat_fwd, lat_bwd, s0):
    rev = lambda args: tuple(jnp.flip(t, axis=1) for t in args)
    oc_f, sc_f = scan_fn(*ctx_fwd, s0)
    ol_f, _ = scan_fn(*lat_fwd, sc_f)
    oc_b, sc_b = scan_fn(*rev(ctx_bwd), s0)
    ol_b, _ = scan_fn(*rev(lat_bwd), sc_b)
    return oc_f + jnp.flip(oc_b, axis=1), ol_f + jnp.flip(ol_b, axis=1)


def _even_prep(h, w_in, conv_w, a_log, dt_bias, lb):
    bsz, t_len = h.shape[:2]
    heads = lambda t, n: t.reshape(bsz, t_len, n, -1)
    aq, ai, af_fwd, af_bwd, ag, bq, bk, bv, bz, ba, bb = _split_cols(h @ w_in, EVEN_SPLIT_SIZES)
    a_q = heads(jax.nn.silu(aq), A_HEADS) * A_HEAD_DIM ** -0.5
    a_v = heads(ai, A_HEADS)
    hgrn = []
    for f_pre in (af_fwd, af_bwd):
        log_f = heads(jnp.log(lb + (1.0 - lb) * jax.nn.sigmoid(f_pre)), A_HEADS)
        hgrn.append((a_q, -jnp.expm1(log_f), log_f, a_v))
    qkv = jax.nn.silu(_dwconv(jnp.concatenate([bq, bk, bv], axis=-1), conv_w))
    bq, bk, bv = jnp.split(qkv, 3, axis=-1)
    b_q = _l2norm(heads(bq, B_HEADS)) * B_HEAD_DIM ** -0.5
    b_k = _l2norm(heads(bk, B_HEADS))
    b_v = heads(bv, B_HEADS)
    g = -jnp.exp(a_log) * jax.nn.softplus(ba.reshape(bsz, t_len, 2, B_HEADS) + dt_bias)
    beta = jax.nn.sigmoid(bb.reshape(bsz, t_len, 2, B_HEADS))
    gdn = [(b_q, b_k, b_v, g[:, :, d], beta[:, :, d]) for d in range(2)]
    return hgrn, gdn, ag, bz


def _even_mixer(hx, hc, w_in, conv_w, a_log, dt_bias, lb, norm_a, norm_b, w_out, need_ctx):
    bsz = hx.shape[0]
    hgrn_x, gdn_x, ag_x, bz_x = _even_prep(hx, w_in, conv_w, a_log, dt_bias, lb)
    hgrn_c, gdn_c, ag_c, bz_c = _even_prep(hc, w_in, conv_w, a_log, dt_bias, lb)
    s0_a = jnp.zeros((bsz, A_HEADS, A_HEAD_DIM, A_HEAD_DIM), jnp.float32)
    s0_b = jnp.zeros((bsz, B_HEADS, B_HEAD_DIM, B_HEAD_DIM), jnp.float32)
    oa_c, oa_x = _bidir(_hgrn2_scan, hgrn_c[0], hgrn_c[1], hgrn_x[0], hgrn_x[1], s0_a)
    ob_c, ob_x = _bidir(_gdn_scan, gdn_c[0], gdn_c[1], gdn_x[0], gdn_x[1], s0_b)

    def merge(oa, ob, ag, bz):
        ya = _rms_heads(oa, norm_a) * jax.nn.silu(ag)
        yb = _rms_heads(ob, norm_b) * jax.nn.silu(bz)
        return jnp.concatenate([ya, yb], axis=-1) @ w_out

    yx = merge(oa_x, ob_x, ag_x, bz_x)
    yc = merge(oa_c, ob_c, ag_c, bz_c) if need_ctx else None
    return yx, yc


def _odd_prep(h, w_in, conv_w, conv_b, gate_w, gate_b, lam):
    bsz, t_len = h.shape[:2]
    y_br, x_br = jnp.split(h @ w_in, 2, axis=-1)
    xc = _dwconv(x_br, conv_w) + conv_b
    gates = jnp.einsum('btnk,dgnkj->dgbtnj', xc.reshape(bsz, t_len, RNN_BLOCKS, RNN_BLOCK), gate_w)
    gates = gates.reshape(2, 2, bsz, t_len, RNN_WIDTH) + gate_b[:, :, None, None, :]
    r = jax.nn.sigmoid(gates[:, 0])
    i = jax.nn.sigmoid(gates[:, 1])
    log_a = -RG_C * r * jax.nn.softplus(-lam)[:, None, None, :]
    b = jnp.sqrt(-jnp.expm1(2.0 * log_a)) * (i * xc)
    return jax.nn.gelu(y_br), [(log_a[d], b[d]) for d in range(2)]


def _odd_mixer(hx, hc, w_in, conv_w, conv_b, gate_w, gate_b, lam, w_out, need_ctx):
    bsz, n_tok = hx.shape[:2]
    rows = n_tok // GRID_W
    hx_col = hx.reshape(bsz, rows, GRID_W, -1).transpose(0, 2, 1, 3).reshape(bsz, n_tok, -1)
    gx, dx = _odd_prep(hx_col, w_in, conv_w, conv_b, gate_w, gate_b, lam)
    gc, dc = _odd_prep(hc, w_in, conv_w, conv_b, gate_w, gate_b, lam)
    h0 = jnp.zeros((bsz, RNN_WIDTH), jnp.float32)
    rc, rx = _bidir(_linear_scan, dc[0], dc[1], dx[0], dx[1], h0)
    yx = ((gx * rx) @ w_out).reshape(bsz, GRID_W, rows, -1).transpose(0, 2, 1, 3).reshape(bsz, n_tok, -1)
    yc = (gc * rc) @ w_out if need_ctx else None
    return yx, yc


def _ffn(h, w_gu, w_down):
    gte, up = jnp.split(h @ w_gu, 2, axis=-1)
    return (jax.nn.silu(gte) * up) @ w_down


def _modulation(cond, w, b):
    return jnp.split(jax.nn.silu(cond) @ w + b, 6, axis=-1)


def setup_inputs(seed: int = 0) -> dict:
    key = jax.random.key(seed)
    ks = jax.random.split(key, 32)
    f32 = jnp.float32
    nrm = lambda i, shape, s: jax.random.normal(ks[i], shape, f32) * s
    a_log = jnp.log(jax.random.uniform(ks[20], (N_EVEN, 2, B_HEADS), f32, 1.0, 16.0))
    dt = jnp.exp(jax.random.uniform(ks[21], (N_EVEN, 2, B_HEADS), f32, math.log(1e-3), math.log(1e-1)))
    dt_bias = dt + jnp.log(-jnp.expm1(-dt))
    a_pow = jax.random.uniform(ks[22], (N_ODD, 2, RNN_WIDTH), f32, 0.9, 0.999) ** (1.0 / RG_C)
    lam = jnp.log(a_pow) - jnp.log1p(-a_pow)
    return {
        'x': nrm(0, (BATCH, SEQ, D_MODEL), 1.0),
        'c': nrm(1, (BATCH, D_MODEL), 1.0),
        'ctx': nrm(2, (BATCH, CTX_LEN, D_MODEL), 1.0),
        'c_ctx': nrm(3, (D_MODEL,), 1.0),
        'ada_w': nrm(4, (DEPTH, D_MODEL, 6 * D_MODEL), 0.5 * D_MODEL ** -0.5),
        'ada_b': nrm(5, (DEPTH, 6 * D_MODEL), 0.02),
        'ln_g': 1.0 + nrm(6, (DEPTH, 2, D_MODEL), 0.02),
        'ln_b': nrm(7, (DEPTH, 2, D_MODEL), 0.02),
        'ffn_w_gu': nrm(8, (DEPTH, D_MODEL, 2 * FFN_HIDDEN), D_MODEL ** -0.5),
        'ffn_w_down': nrm(9, (DEPTH, FFN_HIDDEN, D_MODEL), DN_BETA * FFN_HIDDEN ** -0.5),
        'ev_w_in': nrm(10, (N_EVEN, D_MODEL, EVEN_IN), D_MODEL ** -0.5),
        'ev_conv_w': nrm(11, (N_EVEN, SHORT_CONV, 3 * B_WIDTH), SHORT_CONV ** -0.5),
        'ev_a_log': a_log,
        'ev_dt_bias': dt_bias,
        'ev_lb_logits': nrm(12, (N_EVEN, A_WIDTH), 0.5),
        'ev_norm_a': 1.0 + nrm(13, (N_EVEN, A_WIDTH), 0.02),
        'ev_norm_b': 1.0 + nrm(14, (N_EVEN, B_WIDTH), 0.02),
        'ev_w_out': nrm(15, (N_EVEN, A_WIDTH + B_WIDTH, D_MODEL), DN_BETA * (A_WIDTH + B_WIDTH) ** -0.5),
        'od_w_in': nrm(16, (N_ODD, D_MODEL, 2 * RNN_WIDTH), D_MODEL ** -0.5),
        'od_conv_w': nrm(17, (N_ODD, RNN_CONV, RNN_WIDTH), RNN_CONV ** -0.5),
        'od_conv_b': nrm(18, (N_ODD, RNN_WIDTH), 0.02),
        'od_gate_w': nrm(19, (N_ODD, 2, 2, RNN_BLOCKS, RNN_BLOCK, RNN_BLOCK), RNN_BLOCK ** -0.5),
        'od_gate_b': nrm(23, (N_ODD, 2, 2, RNN_WIDTH), 0.02),
        'od_lambda': lam,
        'od_w_out': nrm(24, (N_ODD, RNN_WIDTH, D_MODEL), DN_BETA * RNN_WIDTH ** -0.5),
    }


def reference(x, c, ctx, c_ctx, ada_w, ada_b, ln_g, ln_b, ffn_w_gu, ffn_w_down, ev_w_in, ev_conv_w, ev_a_log, ev_dt_bias, ev_lb_logits, ev_norm_a, ev_norm_b, ev_w_out, od_w_in, od_conv_w, od_conv_b, od_gate_w, od_gate_b, od_lambda, od_w_out):
    lb_p = jax.nn.softmax(ev_lb_logits.astype(jnp.float32), axis=0)
    lower_bounds = jnp.cumsum(lb_p, axis=0) - lb_p[0]
    for l in range(DEPTH):
        need_ctx = l < DEPTH - 1
        sh_m, sc_m, gt_m, sh_f, sc_f, gt_f = (t[:, None, :] for t in _modulation(c, ada_w[l], ada_b[l]))
        csh_m, csc_m, cgt_m, csh_f, csc_f, cgt_f = _modulation(c_ctx, ada_w[l], ada_b[l])
        hx = x * (1.0 + sc_m) + sh_m
        hc = ctx * (1.0 + csc_m) + csh_m
        j = l // 2
        if l % 2 == 0:
            yx, yc = _even_mixer(hx, hc, ev_w_in[j], ev_conv_w[j], ev_a_log[j], ev_dt_bias[j], lower_bounds[j], ev_norm_a[j], ev_norm_b[j], ev_w_out[j], need_ctx)
        else:
            yx, yc = _odd_mixer(hx, hc, od_w_in[j], od_conv_w[j], od_conv_b[j], od_gate_w[j], od_gate_b[j], od_lambda[j], od_w_out[j], need_ctx)
        x = _layer_norm(DN_ALPHA * x + (1.0 + gt_m) * yx, ln_g[l, 0], ln_b[l, 0])
        x = _layer_norm(DN_ALPHA * x + (1.0 + gt_f) * _ffn(x * (1.0 + sc_f) + sh_f, ffn_w_gu[l], ffn_w_down[l]), ln_g[l, 1], ln_b[l, 1])
        if need_ctx:
            ctx = _layer_norm(DN_ALPHA * ctx + (1.0 + cgt_m) * yc, ln_g[l, 0], ln_b[l, 0])
            ctx = _layer_norm(DN_ALPHA * ctx + (1.0 + cgt_f) * _ffn(ctx * (1.0 + csc_f) + csh_f, ffn_w_gu[l], ffn_w_down[l]), ln_g[l, 1], ln_b[l, 1])
    return x
```

```cpp
#include <hip/hip_runtime.h>
#include <cstdio>
#include <cstdint>
#ifndef MK_ONE_LAUNCH
#define MK_ONE_LAUNCH 0
#endif
namespace pg8 {
#define PG8_LAS __attribute__((address_space(3)))
typedef unsigned short bf16_t;
typedef short bf16x8 __attribute__((ext_vector_type(8)));
typedef float f32x4 __attribute__((ext_vector_type(4)));
typedef unsigned u32x4 __attribute__((ext_vector_type(4)));
typedef unsigned u32x2 __attribute__((ext_vector_type(2)));
constexpr int BM = 256, BK = 64, HALF = 128, HTB = HALF * BK * 2  , STAGE_BYTES = 8 * HTB, NXCD = 8, WGM = 8;
__host__ __device__ __forceinline__ int lds_byte(int r, int c) { const int st = (r >> 4) * 2 + (c >> 5), rr = r & 15, cc = c & 31, ob = rr * 64 + cc * 2; return st * 1024 + (ob ^ (((ob >> 9) & 1) << 5)); }
__host__ __device__ __forceinline__ void stage_rc(int b, int& R, int& C) { const int st = b / 1024, sb = b % 1024, swz = sb ^ (((sb >> 9) & 1) << 5); R = (st >> 1) * 16 + swz / 64; C = (st & 1) * 32 + (swz % 64) / 2; }
__host__ __device__ __forceinline__ int perm32(int rho) { const int n = rho >> 4, i = rho & 15; return 8 * (i >> 2) + 4 * n + (i & 3); }

struct Unit { int pm, pn, ka; };
struct Gemm { const bf16_t* A; const bf16_t* Bt; int M, N, K, lda, ldb; };

struct StaticOrder {
    int nM, nN, nwg, G, c;
    __host__ __device__ void init(int M, int N, int G_, int c_) { nM = M / BM; nN = N / BM; nwg = nM * nN; G = G_; c = c_; }
    __host__ __device__ bool next(int i, Unit& u) const {
        const long L = (long)i * G + c; if (L >= nwg) return false;
        int wgid = (int)L; { const int q = nwg / NXCD, r = nwg % NXCD, xcd = wgid % NXCD, off = wgid / NXCD; wgid = (xcd < r ? xcd * (q + 1) : r * (q + 1) + (xcd - r) * q) + off; }
        const int nig = WGM * nN, gid = wgid / nig, fm = gid * WGM, gsz = (nM - fm) < WGM ? (nM - fm) : WGM;
        u.pm = fm + ((wgid % nig) % gsz); u.pn = (wgid % nig) / gsz; u.ka = 0; return true;
    }
    __device__ __forceinline__ void a_ready(const Unit&) const {}
    __device__ __forceinline__ void done(const Unit&) const {}
};
struct GateOrder {
    int nM, nwg, G, c;
    __host__ __device__ void init(int M, int G_, int c_) { nM = M / BM; nwg = nM * 32; G = G_; c = c_; }
    __host__ __device__ bool next(int i, Unit& u) const {
        const long L = (long)i * G + c; if (L >= nwg) return false;
        const int l = (int)L, pn4 = l & 3, pm = (l >> 2) % nM, nb = (l >> 2) / nM;
        u.pm = pm; u.pn = nb * 4 + pn4; u.ka = nb * 256; return true;
    }
    __device__ __forceinline__ void a_ready(const Unit&) const {}
    __device__ __forceinline__ void done(const Unit&) const {}
};
__device__ __forceinline__ unsigned cvt_pk_bf16(float lo, float hi) { unsigned r; asm volatile("v_cvt_pk_bf16_f32 %0, %1, %2" : "=v"(r) : "v"(lo), "v"(hi)); return r; }
template <class Epi, class Sched, bool ALIGN_EPI = false, bool SP2 = false>
__device__ __forceinline__ void gemm_phase(PG8_LAS unsigned char* lds, const Gemm g, const Sched& S, const Epi& E) {
    int tid = threadIdx.x; asm volatile("" : "+v"(tid)); const int wid = __builtin_amdgcn_readfirstlane(tid >> 6), lane = tid & 63, wr = wid >> 2, wc = wid & 3, fr = lane & 15, fq = lane >> 4;
    int nt = g.K / BK; asm volatile("" : "+s"(nt));
    unsigned voffA[2], voffB[2];
#pragma unroll
    for (int i = 0; i < 2; ++i) { int R, C; stage_rc(tid * 16 + i * 8192, R, C); const int Rb = Epi::PERM ? ((R & ~31) + perm32(R & 31)) : R;
        voffA[i] = (unsigned)(R * g.lda + C) * 2u; voffB[i] = (unsigned)(Rb * g.ldb + C) * 2u; }
    const size_t kstep = (size_t)(BK * 2);
    const size_t hstepA = (size_t)HALF * g.lda * 2, hstepB = (size_t)HALF * g.ldb * 2;
    const size_t tstepA = 2 * hstepA, tstepB = 2 * hstepB;
    const unsigned ldsw = (unsigned)wid * 1024u;
    const int aoff = lds_byte(wr * 64 + fr, fq * 8), boff = lds_byte(wc * 32 + fr, fq * 8);
#define PG8_SA(b, h) (((b) * 2 + (h)) * HTB)
#define PG8_SB(b, h) ((4 + (b) * 2 + (h)) * HTB)
#define PG8_STAGE(bufoff, gbase, voff) do { _Pragma("unroll") for (int _i = 0; _i < 2; ++_i) \
        __builtin_amdgcn_global_load_lds((const unsigned*)((const char*)(gbase) + (voff)[_i]), (PG8_LAS unsigned*)(lds + (bufoff) + ldsw + _i * 8192), 16, 0, 0); } while (0)
#define PG8_LDA(dst, b, h) do { _Pragma("unroll") for (int m = 0; m < 4; ++m) _Pragma("unroll") for (int k = 0; k < 2; ++k) dst[m][k] = *(const PG8_LAS bf16x8*)(lds + PG8_SA(b, h) + aoff + m * 2048 + k * 1024); } while (0)
#define PG8_LDB(dst, b, h) do { _Pragma("unroll") for (int n = 0; n < 2; ++n) _Pragma("unroll") for (int k = 0; k < 2; ++k) dst[n][k] = *(const PG8_LAS bf16x8*)(lds + PG8_SB(b, h) + boff + n * 2048 + k * 1024); } while (0)
#define PG8_MMA(ai, bj, At, Bt) do { __builtin_amdgcn_s_setprio(1); _Pragma("unroll") for (int m = 0; m < 4; ++m) _Pragma("unroll") for (int n = 0; n < 2; ++n) _Pragma("unroll") for (int k = 0; k < 2; ++k) \
        acc[ai][bj][m][n] = __builtin_amdgcn_mfma_f32_16x16x32_bf16(Bt[n][k], At[m][k], acc[ai][bj][m][n], 0, 0, 0); __builtin_amdgcn_s_setprio(0); } while (0)
#define PG8_WAIT_V(n) asm volatile("s_waitcnt vmcnt(" #n ")" ::: "memory")
#define PG8_WAIT_L(n) asm volatile("s_waitcnt lgkmcnt(" #n ")" ::: "memory")
#define PG8_BAR __builtin_amdgcn_s_barrier()
#define PG8_SCHED __builtin_amdgcn_sched_barrier(0)
    Unit cur, nxt; int ui = 0;
    if (!S.next(0, cur)) return;
    f32x4 acc[2][2][4][2];
#pragma unroll
    for (int a = 0; a < 2; ++a)
#pragma unroll
        for (int b = 0; b < 2; ++b)
#pragma unroll
            for (int m = 0; m < 4; ++m)
#pragma unroll
                for (int n = 0; n < 2; ++n) acc[a][b][m][n] = (f32x4){0.f, 0.f, 0.f, 0.f};
    bf16x8 At[4][2], B0[2][2], B1[2][2];
    const char* cA = (const char*)g.A + (size_t)cur.pm * tstepA + (size_t)cur.ka * 2; const char* cB = (const char*)g.Bt + (size_t)cur.pn * tstepB;
    S.a_ready(cur);
    if constexpr (SP2) {
        PG8_STAGE(PG8_SB(0, 0), cB, voffB); PG8_STAGE(PG8_SB(0, 1), cB + hstepB, voffB); PG8_STAGE(PG8_SA(0, 0), cA, voffA); PG8_STAGE(PG8_SA(0, 1), cA + hstepA, voffA);
        if (wr == 1) PG8_BAR;
        PG8_WAIT_V(2); PG8_BAR;
        PG8_STAGE(PG8_SB(1, 0), cB + kstep, voffB); PG8_STAGE(PG8_SA(1, 0), cA + kstep, voffA); PG8_STAGE(PG8_SB(1, 1), cB + hstepB + kstep, voffB);
        PG8_WAIT_V(6); PG8_BAR;
    } else {
        PG8_STAGE(PG8_SB(0, 0), cB, voffB); PG8_STAGE(PG8_SA(0, 0), cA, voffA); PG8_STAGE(PG8_SB(0, 1), cB + hstepB, voffB); PG8_STAGE(PG8_SA(0, 1), cA + hstepA, voffA);
        if (wr == 1) PG8_BAR;
        PG8_WAIT_V(4); PG8_BAR;
        PG8_STAGE(PG8_SB(1, 0), cB + kstep, voffB); PG8_STAGE(PG8_SA(1, 0), cA + kstep, voffA); PG8_STAGE(PG8_SB(1, 1), cB + hstepB + kstep, voffB);
        PG8_WAIT_V(6); PG8_BAR;
    }
    for (;;) {
        const bool has_next = S.next(ui + 1, nxt);
        const char* nA = has_next ? (const char*)g.A + (size_t)nxt.pm * tstepA + (size_t)nxt.ka * 2 : cA; const char* nB = has_next ? (const char*)g.Bt + (size_t)nxt.pn * tstepB : cB;
        for (int t = 0; t < nt; t += 2) {
            const bool last = (t == nt - 2);
            const char* a1 = cA + (size_t)(t + 1) * kstep;
            const char* a2 = last ? nA : cA + (size_t)(t + 2) * kstep; const char* b2 = last ? nB : cB + (size_t)(t + 2) * kstep;
            const char* a3 = a2 + kstep; const char* b3 = b2 + kstep;
            if (last && has_next) S.a_ready(nxt);
            if constexpr (SP2) {
            PG8_LDB(B0, 0, 0); PG8_LDB(B1, 0, 1); PG8_SCHED; PG8_LDA(At, 0, 0); PG8_STAGE(PG8_SA(1, 1), a1 + hstepA, voffA);
            PG8_WAIT_V(8); PG8_WAIT_L(0); PG8_BAR; PG8_MMA(0, 0, At, B0); PG8_MMA(0, 1, At, B1); PG8_BAR; PG8_SCHED;
            PG8_LDA(At, 0, 1); PG8_STAGE(PG8_SB(0, 0), b2, voffB); PG8_STAGE(PG8_SB(0, 1), b2 + hstepB, voffB); PG8_STAGE(PG8_SA(0, 0), a2, voffA);
            PG8_WAIT_V(8); PG8_WAIT_L(0); PG8_BAR; PG8_MMA(1, 0, At, B0); PG8_MMA(1, 1, At, B1); PG8_BAR; PG8_SCHED;
            PG8_LDB(B0, 1, 0); PG8_LDB(B1, 1, 1); PG8_SCHED; PG8_LDA(At, 1, 0); PG8_STAGE(PG8_SA(0, 1), a2 + hstepA, voffA);
            PG8_WAIT_V(8); PG8_WAIT_L(0); PG8_BAR; PG8_MMA(0, 0, At, B0); PG8_MMA(0, 1, At, B1); PG8_BAR; PG8_SCHED;
            PG8_LDA(At, 1, 1); PG8_STAGE(PG8_SB(1, 0), b3, voffB); PG8_STAGE(PG8_SB(1, 1), b3 + hstepB, voffB); PG8_STAGE(PG8_SA(1, 0), a3, voffA);
            PG8_WAIT_V(8); PG8_WAIT_L(0); PG8_BAR; PG8_MMA(1, 0, At, B0); PG8_MMA(1, 1, At, B1); PG8_BAR; PG8_SCHED;
            } else {
            PG8_LDB(B0, 0, 0); PG8_SCHED; PG8_LDA(At, 0, 0); PG8_STAGE(PG8_SA(1, 1), a1 + hstepA, voffA);
            PG8_WAIT_L(8); PG8_BAR; PG8_WAIT_L(0); PG8_MMA(0, 0, At, B0); PG8_BAR; PG8_SCHED;
            PG8_LDB(B1, 0, 1); PG8_STAGE(PG8_SB(0, 0), b2, voffB);
            PG8_BAR; PG8_WAIT_L(0); PG8_MMA(0, 1, At, B1); PG8_BAR;
            PG8_LDA(At, 0, 1); PG8_STAGE(PG8_SA(0, 0), a2, voffA);
            PG8_BAR; PG8_WAIT_L(0); PG8_MMA(1, 0, At, B0); PG8_BAR; PG8_SCHED;
            PG8_STAGE(PG8_SB(0, 1), b2 + hstepB, voffB);
            PG8_WAIT_V(6); PG8_BAR; PG8_MMA(1, 1, At, B1); PG8_BAR;
            PG8_LDB(B0, 1, 0); PG8_SCHED; PG8_LDA(At, 1, 0); PG8_STAGE(PG8_SA(0, 1), a2 + hstepA, voffA);
            PG8_WAIT_L(8); PG8_BAR; PG8_WAIT_L(0); PG8_MMA(0, 0, At, B0); PG8_BAR; PG8_SCHED;
            PG8_LDB(B1, 1, 1); PG8_STAGE(PG8_SB(1, 0), b3, voffB);
            PG8_BAR; PG8_WAIT_L(0); PG8_MMA(0, 1, At, B1); PG8_BAR;
            PG8_LDA(At, 1, 1); PG8_STAGE(PG8_SA(1, 0), a3, voffA);
            PG8_BAR; PG8_WAIT_L(0); PG8_MMA(1, 0, At, B0); PG8_BAR; PG8_SCHED;
            PG8_STAGE(PG8_SB(1, 1), b3 + hstepB, voffB);
            PG8_WAIT_V(6); PG8_BAR; PG8_MMA(1, 1, At, B1); PG8_BAR;
            }
        }
        if constexpr (ALIGN_EPI) { if (wr == 0) PG8_BAR; }
        if constexpr (!Epi::AFTER_DRAIN) { E(acc, cur, wr, wc, fr, fq); S.done(cur); }
        if (!has_next) break;
#pragma unroll
        for (int a = 0; a < 2; ++a)
#pragma unroll
            for (int b = 0; b < 2; ++b)
#pragma unroll
                for (int m = 0; m < 4; ++m)
#pragma unroll
                    for (int n = 0; n < 2; ++n) acc[a][b][m][n] = (f32x4){0.f, 0.f, 0.f, 0.f};
        cur = nxt; cA = nA; cB = nB; ++ui;
        if constexpr (ALIGN_EPI) { if (wr == 1) PG8_BAR; }
    }
    PG8_WAIT_V(0);
    if constexpr (!ALIGN_EPI) { if (wr == 0) PG8_BAR; }
    PG8_BAR;
    if constexpr (Epi::AFTER_DRAIN) { E.fused(acc, cur, wr, wc, fr, fq, lds, wid, lane); S.done(cur); }
#undef PG8_SA
#undef PG8_SB
#undef PG8_STAGE
#undef PG8_LDA
#undef PG8_LDB
#undef PG8_MMA
#undef PG8_WAIT_V
#undef PG8_WAIT_L
#undef PG8_BAR
#undef PG8_SCHED
}
}
using pg8::bf16_t; using pg8::f32x4; using pg8::u32x4; using pg8::u32x2; using pg8::Unit; using pg8::cvt_pk_bf16;

constexpr int D = 2048, NBATCH = 2, SEQ = 8192, CTXL = 256, DEPTH = 4;
constexpr int MX = NBATCH * SEQ;
constexpr int MC = NBATCH * CTXL;
constexpr int M = MX + MC;
constexpr int NE_IN = 9248, NE_INP = 9472, FF = 5632, AW = 1024;
constexpr int NWAVES = 8, NTHREADS = 512;
constexpr float LN_EPS = 1e-6f, DN_ALPHA = 1.681792830507429f;
constexpr float QSCALE = 0.08838834764831845f;

constexpr size_t MiB = 1u << 20;
constexpr size_t al256(size_t x) { return (x + 255) & ~(size_t)255; }
constexpr size_t WS_CTL = 0, CTL_ZERO_BYTES = 1 * MiB;
constexpr size_t WS_MOD = 1 * MiB;
constexpr size_t WS_LB = 2 * MiB;
constexpr size_t WS_PART = 3 * MiB;
constexpr size_t WS_W0 = 8 * MiB;
constexpr size_t SZ_WINE = (size_t)NE_INP * D * 2, SZ_WSQ = (size_t)D * D * 2, SZ_WINO = (size_t)2 * D * D * 2, SZ_WGATE = (size_t)8192 * 256 * 2, SZ_WGU = (size_t)2 * FF * D * 2, SZ_WDN = (size_t)D * FF * 2;
constexpr size_t WS_WINE = WS_W0;
constexpr size_t WS_WOUTE = WS_WINE + 2 * SZ_WINE;
constexpr size_t WS_WINO = WS_WOUTE + 2 * SZ_WSQ;
constexpr size_t WS_WGATE = WS_WINO + 2 * SZ_WINO;
constexpr size_t WS_WOUTO = WS_WGATE + 2 * SZ_WGATE;
constexpr size_t WS_WGU = WS_WOUTO + 2 * SZ_WSQ;
constexpr size_t WS_WDN = WS_WGU + 4 * SZ_WGU;
constexpr size_t WS_XA = al256(WS_WDN + 4 * SZ_WDN);
constexpr size_t SZ_F32ROW = (size_t)M * D * 4, SZ_BF16ROW = (size_t)M * D * 2, SZ_BF16HALF = (size_t)M * AW * 2;
constexpr size_t WS_Z = WS_XA + SZ_F32ROW;
constexpr size_t WS_HX = WS_Z + SZ_F32ROW;
constexpr size_t WS_MIX = WS_HX + SZ_BF16ROW;
constexpr size_t WS_MR = WS_MIX + SZ_BF16ROW;
constexpr size_t WS_QA = WS_MR, WS_VA = WS_QA + SZ_BF16HALF, WS_GA = WS_VA + SZ_BF16HALF, WS_ZB = WS_GA + SZ_BF16HALF;
constexpr size_t WS_LF = WS_ZB + SZ_BF16HALF;
constexpr size_t WS_QKVB = WS_LF + 2 * (size_t)M * AW * 4;
constexpr size_t WS_GB = WS_QKVB + (size_t)M * 3072 * 2;
constexpr size_t WS_QB = WS_GB + (size_t)M * 32 * 4, WS_KB = WS_QB + SZ_BF16HALF, WS_VB = WS_KB + SZ_BF16HALF;
constexpr size_t WS_OA = WS_VB + SZ_BF16HALF;
constexpr size_t WS_OB = WS_OA + 2 * SZ_BF16HALF;
constexpr size_t WS_EVEN_END = WS_OB + 2 * SZ_BF16HALF;
constexpr size_t WS_GY = WS_MR, WS_XBR = WS_GY + SZ_BF16ROW, WS_XC = WS_XBR + SZ_BF16ROW;
constexpr size_t WS_AB = WS_XC + SZ_BF16ROW;
constexpr size_t WS_R = WS_AB + 2 * (size_t)M * D * 4;
constexpr size_t WS_ODD_END = WS_R + 2 * SZ_BF16ROW;
constexpr size_t WS_ACT = WS_MR;
constexpr size_t WS_END = (WS_EVEN_END > WS_ODD_END ? WS_EVEN_END : WS_ODD_END);
static_assert(WS_ACT + (size_t)M * FF * 2 <= WS_END, "ACT fits the mixer region");
static_assert(WS_END <= (size_t)1560 * MiB, "workspace budget");
constexpr int CW_BAR = 4096;

constexpr int RING_OFF = 0, RING_BYTES = 131072;
constexpr int LDSCTL_OFF = RING_BYTES, MISC_OFF = LDSCTL_OFF + 320;
constexpr int LDS_BYTES = 147456;

#define GAS __attribute__((address_space(1)))
#define LAS __attribute__((address_space(3)))
typedef unsigned short bf16;
#define LDS_WAIT() asm volatile("s_waitcnt lgkmcnt(0)" ::: "memory")
#define VM_WAIT() asm volatile("s_waitcnt vmcnt(0)" ::: "memory")
__device__ __forceinline__ unsigned f2bf(float f) { unsigned u = __builtin_bit_cast(unsigned, f); return (u + 0x7fffu + ((u >> 16) & 1u)) >> 16; }
__device__ __forceinline__ unsigned pk2(float lo, float hi) { return f2bf(lo) | (f2bf(hi) << 16); }
__device__ __forceinline__ float bflo(unsigned u) { return __builtin_bit_cast(float, u << 16); }
__device__ __forceinline__ float bfhi(unsigned u) { return __builtin_bit_cast(float, u & 0xffff0000u); }
__device__ __forceinline__ float bf2f(bf16 h) { return __builtin_bit_cast(float, (unsigned)h << 16); }
__device__ __forceinline__ float sigm(float x) { return 1.f / (1.f + __expf(-x)); }
__device__ __forceinline__ float siluf(float x) { return x / (1.f + __expf(-x)); }
__device__ __forceinline__ float log1p_fast(float t) { const float p = t * (1.f + t * (-0.5f + t * (0.33333333f + t * (-0.25f + t * 0.2f)))); return t < 0.03f ? p : __logf(1.f + t); }
__device__ __forceinline__ float softplusf(float x) { return fmaxf(x, 0.f) + log1p_fast(__expf(-fabsf(x))); }
__device__ __forceinline__ float neg_expm1_fast(float x) { const float p = -x * (1.f + x * (0.5f + x * (0.16666667f + x * (0.041666668f + x * 0.0083333338f)))); return x > -0.25f ? p : 1.f - __expf(x); }
__device__ __forceinline__ float gelu_tanh(float x) { const float u = 0.7978845608028654f * (x + 0.044715f * x * x * x); return x / (1.f + __expf(-2.f * u)); }
__device__ __forceinline__ float wave_sum(float v) {
#pragma unroll
    for (int o = 1; o < 64; o <<= 1) v += __shfl_xor(v, o);
    return v;
}
__device__ __forceinline__ int mod_index(int row) { return row < SEQ ? 0 : (row < MX ? 1 : 2); }
__device__ __forceinline__ int perm_row(int r) { if (r >= MX) return r; const int b = r >> 13, t = r & 8191; return (b << 13) + ((t & 63) << 7) + (t >> 6); }
__device__ __forceinline__ int unperm_row(int r) { if (r >= MX) return r; const int b = r >> 13, i = r & 8191; return (b << 13) + ((i & 127) << 6) + (i >> 7); }
__device__ __forceinline__ int seq_row(int b, int dir, int s) {
    if (s < CTXL) { const int pos = dir ? (CTXL - 1 - s) : s; return MX + b * CTXL + pos; }
    const int p = s - CTXL, pos = dir ? (SEQ - 1 - p) : p; return b * SEQ + pos;
}
#define XB_TMO      128
#define XB_XCNT(j)  (256  + 64 * (j))
#define XB_XSUB(j)  (1280 + 64 * (j))
#define XB_XGEN(j)  (2304 + 64 * (j))
#define XB_TOP      3328
#define XB_TOPGEN   3392
#define XCD_BAR_WORDS 3456
#define XB_SPIN_CAP (1u << 18)

__device__ __forceinline__ unsigned xb_ld(unsigned* p)              { return __hip_atomic_load(p, __ATOMIC_RELAXED, __HIP_MEMORY_SCOPE_AGENT); }
__device__ __forceinline__ unsigned xb_add(unsigned* p, unsigned v) { return __hip_atomic_fetch_add(p, v, __ATOMIC_RELAXED, __HIP_MEMORY_SCOPE_AGENT); }
__device__ __forceinline__ unsigned xb_xcc_id() { return (unsigned)__builtin_amdgcn_s_getreg((3 << 11) | 20) & 0xFu; }
#define XB_SPIN(cond, bar) do { unsigned _sp = 0; while (cond) { __builtin_amdgcn_s_sleep(1); \
    if ((++_sp & 255u) == 0u) { if (xb_ld(&(bar)[XB_TMO])) break; if (_sp > XB_SPIN_CAP) { atomicAdd(&(bar)[XB_TMO], 1u); break; } } } } while (0)

struct XcdBarrier {
    unsigned* bar; unsigned x;
    volatile LAS unsigned* st;
};

__device__ __forceinline__ XcdBarrier xcd_barrier_post(unsigned* bar, volatile LAS unsigned* st) {
    XcdBarrier b; b.bar = bar; b.x = xb_xcc_id(); b.st = st;
    if (threadIdx.x == 0) (void)xb_add(&bar[XB_XCNT(b.x)], 1u);
    return b;
}
__device__ __forceinline__ void xcd_barrier_complete(unsigned* bar, unsigned x, unsigned& nloc, unsigned& nx) {
    const unsigned G = gridDim.x * gridDim.y * gridDim.z;
    unsigned sum, cnt, mine, sp = 0u;
    for (;;) {
        sum = 0u; cnt = 0u; mine = 0u;
#pragma unroll
        for (unsigned j = 0; j < 16; ++j) { const unsigned c = xb_ld(&bar[XB_XCNT(j)]); sum += c; cnt += (c > 0u) ? 1u : 0u; mine = (j == x) ? c : mine; }
        if (sum == G) break;
        __builtin_amdgcn_s_sleep(1);
        if ((++sp & 255u) == 0u) { if (xb_ld(&bar[XB_TMO])) break; if (sp > XB_SPIN_CAP) { atomicAdd(&bar[XB_TMO], 1u); break; } }
    }
    nloc = mine > 0u ? mine : 1u; nx = cnt > 0u ? cnt : 1u;
}

__device__ __forceinline__ void xcd_barrier(const XcdBarrier& b) {
    asm volatile("s_waitcnt vmcnt(0)" ::: "memory");
    __syncthreads();
    if (threadIdx.x == 0) {
        unsigned* bar = b.bar;
        __builtin_amdgcn_s_waitcnt(0);
        unsigned nloc = b.st[0], nx = b.st[1];
        if (nloc == 0u) { xcd_barrier_complete(bar, b.x, nloc, nx); b.st[0] = nloc; b.st[1] = nx; }
        const unsigned old = xb_add(&bar[XB_XSUB(b.x)], 1u);
        const unsigned gen = old / nloc;
        if (old + 1u == (gen + 1u) * nloc) {
            __builtin_amdgcn_fence(__ATOMIC_RELEASE, "agent");
            asm volatile("s_waitcnt vmcnt(0)" ::: "memory");
            const unsigned og = xb_add(&bar[XB_TOP], 1u);
            const unsigned tg = og / nx;
            if (og + 1u == (tg + 1u) * nx) xb_add(&bar[XB_TOPGEN], 1u);
            else XB_SPIN(xb_ld(&bar[XB_TOPGEN]) == tg, bar);
            __builtin_amdgcn_fence(__ATOMIC_ACQUIRE, "agent");
            xb_add(&bar[XB_XGEN(b.x)], 1u);
            asm volatile("s_waitcnt vmcnt(0)" ::: "memory");
        } else {
            XB_SPIN(xb_ld(&bar[XB_XGEN(b.x)]) == gen, bar);
            __builtin_amdgcn_fence(__ATOMIC_ACQUIRE, "agent");
            asm volatile("s_waitcnt vmcnt(0)" ::: "memory");
        }
    }
    __syncthreads();
}

struct EpiEven1 {
    static constexpr bool PERM = true, AFTER_DRAIN = false;
    bf16_t *QA, *VA, *GA, *ZB, *QKVB; float *LF, *GB; const float *lb, *a_log, *dt_bias;
    __device__ __forceinline__ void operator()(const f32x4 (&acc)[2][2][4][2], const Unit& u, int wr, int wc, int fr_, int fq_) const {
        int fr = fr_, fq = fq_; asm volatile("" : "+v"(fr), "+v"(fq));
        const int grp = u.pn >> 2, row0 = u.pm * 256 + wr * 64 + fr;
        if (grp == 9) {
            if (wc != 0) return;
            float al[8], db[8];
#pragma unroll
            for (int i = 0; i < 8; ++i) { const int c = (8 * fq + i) & 15; al[i] = -__expf(a_log[c]); db[i] = dt_bias[c]; }
#pragma unroll
            for (int ai = 0; ai < 2; ++ai)
#pragma unroll
                for (int m = 0; m < 4; ++m) { float* rowp = GB + (size_t)(row0 + ai * 128 + m * 16) * 32 + 8 * fq;
#pragma unroll
                    for (int n = 0; n < 2; ++n) { const f32x4 v = acc[ai][0][m][n]; f32x4 o;
#pragma unroll
                        for (int j = 0; j < 4; ++j) o[j] = (fq < 2) ? al[4 * n + j] * softplusf(v[j] + db[4 * n + j]) : sigm(v[j]);
                        *(f32x4*)(rowp + 4 * n) = o; } }
            return;
        }
        const int col0 = (u.pn & 3) * 256 + wc * 32 + 8 * fq;
        int op = 0, ld = 1024; bf16_t* dstb = VA; float* dstf = LF;
        switch (grp) {
            case 0: op = 2; dstb = QA; break;
            case 1: op = 0; dstb = VA; break;
            case 2: op = 3; dstf = LF; break;
            case 3: op = 3; dstf = LF + (size_t)M * 1024; break;
            case 4: op = 1; dstb = GA; break;
            case 5: case 6: case 7: op = 0; dstb = QKVB + (grp - 5) * 1024; ld = 3072; break;
            default: op = 1; dstb = ZB; break;
        }
        if (op == 3) {
#pragma unroll
            for (int bj = 0; bj < 2; ++bj) { float lbv[8];
#pragma unroll
                for (int i = 0; i < 8; ++i) lbv[i] = lb[col0 + bj * 128 + i];
#pragma unroll
                for (int ai = 0; ai < 2; ++ai)
#pragma unroll
                    for (int m = 0; m < 4; ++m) { float* rowp = dstf + (size_t)(row0 + ai * 128 + m * 16) * 1024 + col0 + bj * 128;
#pragma unroll
                        for (int n = 0; n < 2; ++n) { const f32x4 v = acc[ai][bj][m][n]; f32x4 o;
#pragma unroll
                            for (int j = 0; j < 4; ++j) { const float l = lbv[4 * n + j]; o[j] = __logf(l + (1.f - l) * sigm(v[j])); }
                            *(f32x4*)(rowp + 4 * n) = o; } } }
            return;
        }
#pragma unroll
        for (int ai = 0; ai < 2; ++ai)
#pragma unroll
            for (int m = 0; m < 4; ++m) { bf16_t* rowp = dstb + (size_t)(row0 + ai * 128 + m * 16) * ld + col0;
#pragma unroll
                for (int bj = 0; bj < 2; ++bj) { f32x4 v0 = acc[ai][bj][m][0], v1 = acc[ai][bj][m][1];
                    if (op >= 1) {
#pragma unroll
                        for (int j = 0; j < 4; ++j) { v0[j] = siluf(v0[j]); v1[j] = siluf(v1[j]); }
                        if (op == 2) { v0 = v0 * QSCALE; v1 = v1 * QSCALE; } }
                    u32x4 w; w.x = cvt_pk_bf16(v0[0], v0[1]); w.y = cvt_pk_bf16(v0[2], v0[3]); w.z = cvt_pk_bf16(v1[0], v1[1]); w.w = cvt_pk_bf16(v1[2], v1[3]);
                    *(u32x4*)(rowp + bj * 128) = w; } }
    }
};
struct EpiOdd1 {
    static constexpr bool PERM = true, AFTER_DRAIN = false;
    bf16_t *GY, *XBR;
    __device__ __forceinline__ void operator()(const f32x4 (&acc)[2][2][4][2], const Unit& u, int wr, int wc, int fr_, int fq_) const {
        int fr = fr_, fq = fq_; asm volatile("" : "+v"(fr), "+v"(fq));
        const int row0 = u.pm * 256 + wr * 64 + fr; const bool isy = u.pn < 8;
        bf16_t* dst = isy ? GY : XBR; const int col0 = (u.pn & 7) * 256 + wc * 32 + 8 * fq;
#pragma unroll
        for (int ai = 0; ai < 2; ++ai)
#pragma unroll
            for (int m = 0; m < 4; ++m) { bf16_t* rowp = dst + (size_t)(row0 + ai * 128 + m * 16) * D + col0;
#pragma unroll
                for (int bj = 0; bj < 2; ++bj) { f32x4 v0 = acc[ai][bj][m][0], v1 = acc[ai][bj][m][1];
                    if (isy) {
#pragma unroll
                        for (int j = 0; j < 4; ++j) { v0[j] = gelu_tanh(v0[j]); v1[j] = gelu_tanh(v1[j]); } }
                    u32x4 w; w.x = cvt_pk_bf16(v0[0], v0[1]); w.y = cvt_pk_bf16(v0[2], v0[3]); w.z = cvt_pk_bf16(v1[0], v1[1]); w.w = cvt_pk_bf16(v1[2], v1[3]);
                    *(u32x4*)(rowp + bj * 128) = w; } }
    }
};
struct EpiGates {
    static constexpr bool PERM = true, AFTER_DRAIN = false;
    const bf16_t* XC; unsigned* AB; const float *gate_b  , *lam  ;
    __device__ __forceinline__ void operator()(const f32x4 (&acc)[2][2][4][2], const Unit& u, int wr, int wc, int fr_, int fq_) const {
        int fr = fr_, fq = fq_; asm volatile("" : "+v"(fr), "+v"(fq));
        const int nb = u.pn >> 2, pn4 = u.pn & 3, d = pn4 >> 1, half = pn4 & 1;
        const int row0 = u.pm * 256 + wr * 64 + fr, ch0 = nb * 256 + half * 128 + wc * 32 + 8 * fq;
        unsigned* ab = AB + (size_t)d * M * D;
#pragma unroll
        for (int n = 0; n < 2; ++n) {
            const int ch = ch0 + 4 * n;
            const f32x4 gr = *(const f32x4*)(gate_b + (d * 2 + 0) * D + ch), gi = *(const f32x4*)(gate_b + (d * 2 + 1) * D + ch), lm = *(const f32x4*)(lam + d * D + ch);
            f32x4 sp;
#pragma unroll
            for (int j = 0; j < 4; ++j) sp[j] = -8.0f * softplusf(-lm[j]);
#pragma unroll
            for (int ai = 0; ai < 2; ++ai)
#pragma unroll
                for (int m = 0; m < 4; ++m) { const size_t ro = (size_t)(row0 + ai * 128 + m * 16) * D + ch;
                    const u32x2 xr = *(const u32x2*)(XC + ro); const float xc[4] = {bflo(xr.x), bfhi(xr.x), bflo(xr.y), bfhi(xr.y)};
                    u32x4 o;
#pragma unroll
                    for (int j = 0; j < 4; ++j) { const float r = sigm(acc[ai][0][m][n][j] + gr[j]), ig = sigm(acc[ai][1][m][n][j] + gi[j]);
                        const float la = r * sp[j], bb = __builtin_sqrtf(neg_expm1_fast(2.f * la)) * (ig * xc[j]); o[j] = pk2(la, bb); }
                    *(u32x4*)(ab + ro) = o; }
        }
    }
};
struct EpiResid {
    static constexpr bool PERM = false, AFTER_DRAIN = false;
    const float *r0, *r1; float* out; const float* gt; int permute;
    __device__ __forceinline__ void operator()(const f32x4 (&acc)[2][2][4][2], const Unit& u, int wr, int wc, int fr_, int fq_) const {
        int fr = fr_, fq = fq_; asm volatile("" : "+v"(fr), "+v"(fq));
        const int rowt = u.pm * 256, mi = mod_index(rowt), col0 = u.pn * 256 + wc * 32 + 4 * fq;
        f32x4 gv[2][2];
#pragma unroll
        for (int bj = 0; bj < 2; ++bj)
#pragma unroll
            for (int n = 0; n < 2; ++n) gv[bj][n] = *(const f32x4*)(gt + (size_t)mi * 12288 + col0 + bj * 128 + n * 16) + 1.0f;
#pragma unroll
        for (int ai = 0; ai < 2; ++ai)
#pragma unroll
            for (int m = 0; m < 4; ++m) { const int rr = rowt + ai * 128 + wr * 64 + m * 16 + fr, tok = permute ? unperm_row(rr) : rr;
                const float* rp = (tok < MX ? r0 + (size_t)tok * D : r1 + (size_t)(tok - MX) * D) + col0; float* op = out + (size_t)tok * D + col0;
#pragma unroll
                for (int bj = 0; bj < 2; ++bj)
#pragma unroll
                    for (int n = 0; n < 2; ++n) { const f32x4 rs = *(const f32x4*)(rp + bj * 128 + n * 16); *(f32x4*)(op + bj * 128 + n * 16) = rs * DN_ALPHA + gv[bj][n] * acc[ai][bj][m][n]; }
                asm volatile("" ::: "memory"); }
    }
};
struct EpiSwiGLU {
    static constexpr bool PERM = true, AFTER_DRAIN = false;
    bf16_t* ACT;
    __device__ __forceinline__ void operator()(const f32x4 (&acc)[2][2][4][2], const Unit& u, int wr, int wc, int fr_, int fq_) const {
        int fr = fr_, fq = fq_; asm volatile("" : "+v"(fr), "+v"(fq));
        const int row0 = u.pm * 256 + wr * 64 + fr, col0 = u.pn * 128 + wc * 32 + 8 * fq;
#pragma unroll
        for (int ai = 0; ai < 2; ++ai)
#pragma unroll
            for (int m = 0; m < 4; ++m) { f32x4 v0 = acc[ai][0][m][0], v1 = acc[ai][0][m][1]; const f32x4 u0 = acc[ai][1][m][0], u1 = acc[ai][1][m][1];
#pragma unroll
                for (int j = 0; j < 4; ++j) { v0[j] = siluf(v0[j]) * u0[j]; v1[j] = siluf(v1[j]) * u1[j]; }
                u32x4 w; w.x = cvt_pk_bf16(v0[0], v0[1]); w.y = cvt_pk_bf16(v0[2], v0[3]); w.z = cvt_pk_bf16(v1[0], v1[1]); w.w = cvt_pk_bf16(v1[2], v1[3]);
                *(u32x4*)(ACT + (size_t)(row0 + ai * 128 + m * 16) * FF + col0) = w; }
    }
};
struct Frame {
    LAS unsigned char* lds;
    int tid, lane, wave, G, gw, NGW;
};
struct Args { const float* in[25]; float* out; unsigned char* ws; int ph_lo, ph_hi; };

template <int MODE> __device__ __forceinline__ long src_off(int n, int nsrc) {
    if (MODE == 0) return n < nsrc ? (long)n : -1L;
    if (MODE == 1) { const int pn = n >> 8, bj = (n >> 7) & 1, jj = n & 127; return (long)bj * FF + pn * 128 + jj; }
    const int nb = n >> 10, c = n & 1023, pn4 = c >> 8, g = (c >> 7) & 1, jj = c & 127, d = pn4 >> 1, half = pn4 & 1;
    return (long)(((d * 2 + g) * 8 + nb) * 256) * 256 + half * 128 + jj;
}
template <int MODE> __device__ __forceinline__ void tr_item(const float* W, int ldin, int K, bf16* WT, int nout, int nsrc, LAS float* scr, int item, int lane) {
    const int nblk = nout / 32, kb = item / nblk, nb = item % nblk, k0 = 64 * kb, n0 = 32 * nb;
    const long off = src_off<MODE>(n0 + (lane & 31), nsrc);
#pragma unroll 8
    for (int i = 0; i < 32; ++i) { const int kk = 2 * i + (lane >> 5); scr[kk * 33 + (lane & 31)] = off >= 0 ? W[off + (size_t)(k0 + kk) * ldin] : 0.f; }
    LDS_WAIT(); asm volatile("" ::: "memory");
    const int c = lane & 7;
#pragma unroll
    for (int j = 0; j < 4; ++j) { const int n = (lane >> 3) + 8 * j; const LAS float* s = scr + (8 * c) * 33 + n;
        u32x4 o; o.x = pk2(s[0 * 33], s[1 * 33]); o.y = pk2(s[2 * 33], s[3 * 33]); o.z = pk2(s[4 * 33], s[5 * 33]); o.w = pk2(s[6 * 33], s[7 * 33]);
        *(u32x4*)(WT + (size_t)(n0 + n) * K + k0 + 8 * c) = o; }
    LDS_WAIT(); asm volatile("" ::: "memory");
}
__device__ __forceinline__ void gemv_item(const Args& a, int gi, int lane, float* PART) {
    const int l = gi / 384, c48 = (gi >> 3) % 48, kp = gi & 7, col = c48 * 256 + lane * 4;
    const float* W = a.in[4] + ((size_t)l * D + kp * 256) * 12288 + col;
    const float* c0 = a.in[1] + kp * 256; const float* c1 = c0 + D; const float* c2 = a.in[3] + kp * 256;
    f32x4 s0 = {0.f, 0.f, 0.f, 0.f}, s1 = s0, s2 = s0;
#pragma unroll 8
    for (int k = 0; k < 256; ++k) { const f32x4 w = *(const f32x4*)(W + (size_t)k * 12288); s0 += w * siluf(c0[k]); s1 += w * siluf(c1[k]); s2 += w * siluf(c2[k]); }
    float* p = PART + ((size_t)(kp * 4 + l) * 3) * 12288 + col;
    *(f32x4*)p = s0; *(f32x4*)(p + 12288) = s1; *(f32x4*)(p + 2 * 12288) = s2;
}
__device__ __forceinline__ void ph_prologue(Frame& F, const Args& a) {
    LAS float* scr = (LAS float*)(F.lds + RING_OFF + F.wave * 16384);
    unsigned char* ws = a.ws;
    constexpr int I_INE = (D / 64) * (NE_INP / 32), I_SQ = (D / 64) * (D / 32), I_INO = (D / 64) * (2 * D / 32), I_GATE = (256 / 64) * (8192 / 32), I_GU = (D / 64) * (2 * FF / 32), I_DN = (FF / 64) * (D / 32);
    constexpr int NGEMV = 4 * 48 * 8;
    constexpr int NITEMS = NGEMV + 2 * (I_INE + I_SQ + I_INO + I_GATE + I_SQ) + 4 * (I_GU + I_DN);
    for (int it = F.gw; it < NITEMS; it += F.NGW) {
        int r = it;
        if (r < NGEMV) { gemv_item(a, r, F.lane, (float*)(ws + WS_PART)); continue; } r -= NGEMV;
        bool done = false;
#pragma unroll 1
        for (int j = 0; j < 2 && !done; ++j) {
            if (r < I_INE) { tr_item<0>(a.in[10] + (size_t)j * D * NE_IN, NE_IN, D, (bf16*)(ws + WS_WINE + j * SZ_WINE), NE_INP, NE_IN, scr, r, F.lane); done = true; break; } r -= I_INE;
            if (r < I_SQ) { tr_item<0>(a.in[17] + (size_t)j * D * D, D, D, (bf16*)(ws + WS_WOUTE + j * SZ_WSQ), D, D, scr, r, F.lane); done = true; break; } r -= I_SQ;
            if (r < I_INO) { tr_item<0>(a.in[18] + (size_t)j * D * 2 * D, 2 * D, D, (bf16*)(ws + WS_WINO + j * SZ_WINO), 2 * D, 2 * D, scr, r, F.lane); done = true; break; } r -= I_INO;
            if (r < I_GATE) { tr_item<2>(a.in[21] + (size_t)j * 4 * 8 * 256 * 256, 256, 256, (bf16*)(ws + WS_WGATE + j * SZ_WGATE), 8192, 8192, scr, r, F.lane); done = true; break; } r -= I_GATE;
            if (r < I_SQ) { tr_item<0>(a.in[24] + (size_t)j * D * D, D, D, (bf16*)(ws + WS_WOUTO + j * SZ_WSQ), D, D, scr, r, F.lane); done = true; break; } r -= I_SQ;
        }
        if (done) continue;
#pragma unroll 1
        for (int l = 0; l < 4; ++l) {
            if (r < I_GU) { tr_item<1>(a.in[8] + (size_t)l * D * 2 * FF, 2 * FF, D, (bf16*)(ws + WS_WGU + l * SZ_WGU), 2 * FF, 2 * FF, scr, r, F.lane); break; } r -= I_GU;
            if (r < I_DN) { tr_item<0>(a.in[9] + (size_t)l * FF * D, D, FF, (bf16*)(ws + WS_WDN + l * SZ_WDN), D, D, scr, r, F.lane); break; } r -= I_DN;
        }
    }
}
__device__ __forceinline__ void ph_modreduce(Frame& F, const Args& a) {
    float* MOD = (float*)(a.ws + WS_MOD); const float* PART = (const float*)(a.ws + WS_PART); float* LB = (float*)(a.ws + WS_LB);
    const int gt = blockIdx.x * NTHREADS + F.tid, NT = F.G * NTHREADS;
    for (int i = gt; i < 4 * 3 * 12288; i += NT) { const int l = i / 36864, n = i % 12288; float s = a.in[5][l * 12288 + n];
#pragma unroll
        for (int kp = 0; kp < 8; ++kp) s += PART[(size_t)kp * 147456 + i];
        MOD[i] = s; }
    for (int i = gt; i < 2048; i += NT) { const int c = i & 1023; LB[i] = i < 1024 ? 0.f : sigm(a.in[14][1024 + c] - a.in[14][c]); }
}
__device__ __forceinline__ void store_hx(bf16* HX, int orow, const f32x4 (&v)[8], const float* sh, const float* sc, int lane) {
    unsigned long long* o8 = (unsigned long long*)(HX + (size_t)orow * D) + lane;
#pragma unroll
    for (int j = 0; j < 8; ++j) { const f32x4 s = *(const f32x4*)(sc + 4 * (lane + 64 * j)), h = *(const f32x4*)(sh + 4 * (lane + 64 * j)); const f32x4 y = v[j] * (s + 1.0f) + h;
        o8[64 * j] = (unsigned long long)pk2(y[0], y[1]) | ((unsigned long long)pk2(y[2], y[3]) << 32); }
}
__device__ __forceinline__ void ph_mod0(Frame& F, const Args& a) {
    const float* MOD = (const float*)(a.ws + WS_MOD); bf16* HX = (bf16*)(a.ws + WS_HX);
    for (int row = F.gw; row < M; row += F.NGW) {
        const float* p = row < MX ? a.in[0] + (size_t)row * D : a.in[2] + (size_t)(row - MX) * D; f32x4 v[8];
#pragma unroll
        for (int j = 0; j < 8; ++j) v[j] = *(const f32x4*)(p + 4 * (F.lane + 64 * j));
        const float* md = MOD + (size_t)mod_index(row) * 12288;
        store_hx(HX, row, v, md, md + D, F.lane);
    }
}
__device__ __forceinline__ void ph_ln(Frame& F, float* buf, int nrows, const float* g, const float* b, float* dout, bf16* HX, const float* modsh, const float* modsc, int permute) {
    for (int row = F.gw; row < nrows; row += F.NGW) {
        float* p = buf + (size_t)row * D; f32x4 v[8]; float s = 0.f;
#pragma unroll
        for (int j = 0; j < 8; ++j) { v[j] = *(const f32x4*)(p + 4 * (F.lane + 64 * j)); s += (v[j][0] + v[j][1]) + (v[j][2] + v[j][3]); }
        const float mean = wave_sum(s) * (1.f / D); float q = 0.f;
#pragma unroll
        for (int j = 0; j < 8; ++j) { v[j] = v[j] - mean; q += (v[j][0] * v[j][0] + v[j][1] * v[j][1]) + (v[j][2] * v[j][2] + v[j][3] * v[j][3]); }
        const float rstd = 1.f / sqrtf(wave_sum(q) * (1.f / D) + LN_EPS);
        float* o = dout ? dout + (size_t)row * D : p;
#pragma unroll
        for (int j = 0; j < 8; ++j) { const f32x4 gg = *(const f32x4*)(g + 4 * (F.lane + 64 * j)), bb = *(const f32x4*)(b + 4 * (F.lane + 64 * j)); v[j] = v[j] * rstd * gg + bb; *(f32x4*)(o + 4 * (F.lane + 64 * j)) = v[j]; }
        if (HX) { const int mi = mod_index(row); store_hx(HX, permute ? perm_row(row) : row, v, modsh + (size_t)mi * 12288, modsc + (size_t)mi * 12288, F.lane); }
    }
}
__device__ __forceinline__ void seg_bounds(int r, int& lo, int& hi) { if (r < MX) { lo = r & ~(SEQ - 1); hi = lo + SEQ; } else { lo = MX + ((r - MX) & ~(CTXL - 1)); hi = lo + CTXL; } }
__device__ __forceinline__ void ph_gdn_prep(Frame& F, const Args& a, int j) {
    const bf16* QKVB = (const bf16*)(a.ws + WS_QKVB); bf16* QB = (bf16*)(a.ws + WS_QB); bf16* KB = (bf16*)(a.ws + WS_KB); bf16* VB = (bf16*)(a.ws + WS_VB);
    const float* cw = a.in[11] + (size_t)j * 4 * 3072;
    for (int row = F.gw; row < M; row += F.NGW) {
        int lo, hi; seg_bounds(row, lo, hi);
#pragma unroll 2
        for (int it = 0; it < 24; ++it) { const int s = it >> 3, h = it & 7, ch = s * 1024 + h * 128 + F.lane * 2; float y0 = 0.f, y1 = 0.f;
#pragma unroll
            for (int k = 0; k < 4; ++k) { const int rr = row + k - 2; if (rr >= lo && rr < hi) { const unsigned x = *(const unsigned*)(QKVB + (size_t)rr * 3072 + ch); y0 += cw[k * 3072 + ch] * bflo(x); y1 += cw[k * 3072 + ch + 1] * bfhi(x); } }
            y0 = siluf(y0); y1 = siluf(y1);
            if (s < 2) { const float sc = rsqrtf(wave_sum(y0 * y0 + y1 * y1) + 1e-6f) * (s == 0 ? QSCALE : 1.f); y0 *= sc; y1 *= sc; }
            bf16* dst = s == 0 ? QB : (s == 1 ? KB : VB);
            *(unsigned*)(dst + (size_t)row * AW + h * 128 + F.lane * 2) = pk2(y0, y1); }
    }
}
__device__ __forceinline__ void ph_merge(Frame& F, const Args& a, int j) {
    const bf16* OA = (const bf16*)(a.ws + WS_OA); const bf16* OB = (const bf16*)(a.ws + WS_OB); const bf16* GA = (const bf16*)(a.ws + WS_GA); const bf16* ZB = (const bf16*)(a.ws + WS_ZB);
    bf16* MIX = (bf16*)(a.ws + WS_MIX); const float* na = a.in[15] + (size_t)j * AW; const float* nb = a.in[16] + (size_t)j * AW;
    for (int row = F.gw; row < M; row += F.NGW) {
#pragma unroll 2
        for (int it = 0; it < 16; ++it) { const int part = it >> 3, c = (it & 7) * 128 + F.lane * 2; const bf16* O = part ? OB : OA; const size_t o = (size_t)row * AW + c;
            const unsigned x0 = *(const unsigned*)(O + o), x1 = *(const unsigned*)(O + (size_t)M * AW + o), gg = *(const unsigned*)((part ? ZB : GA) + o);
            float y0 = bflo(x0) + bflo(x1), y1 = bfhi(x0) + bfhi(x1);
            const float sc = rsqrtf(wave_sum(y0 * y0 + y1 * y1) * (1.f / 128.f) + 1e-6f); const float* nw = part ? nb : na;
            y0 = y0 * sc * nw[c] * bflo(gg); y1 = y1 * sc * nw[c + 1] * bfhi(gg);
            *(unsigned*)(MIX + (size_t)row * D + part * AW + c) = pk2(y0, y1); }
    }
}
__device__ __forceinline__ void ph_odd_conv(Frame& F, const Args& a, int j) {
    const bf16* XBR = (const bf16*)(a.ws + WS_XBR); bf16* XC = (bf16*)(a.ws + WS_XC); const float* cw = a.in[19] + (size_t)j * 4 * D; const float* cb = a.in[20] + (size_t)j * D;
    for (int row = F.gw; row < M; row += F.NGW) {
        int lo, hi; seg_bounds(row, lo, hi);
#pragma unroll 2
        for (int it = 0; it < 16; ++it) { const int ch = it * 128 + F.lane * 2; float y0 = cb[ch], y1 = cb[ch + 1];
#pragma unroll
            for (int k = 0; k < 4; ++k) { const int rr = row + k - 2; if (rr >= lo && rr < hi) { const unsigned x = *(const unsigned*)(XBR + (size_t)rr * D + ch); y0 += cw[k * D + ch] * bflo(x); y1 += cw[k * D + ch + 1] * bfhi(x); } }
            *(unsigned*)(XC + (size_t)row * D + ch) = pk2(y0, y1); }
    }
}
__device__ __forceinline__ void ph_odd_mix(Frame& F, const Args& a) {
    const u32x4* GY = (const u32x4*)(a.ws + WS_GY); const u32x4* R0 = (const u32x4*)(a.ws + WS_R); const u32x4* R1 = (const u32x4*)(a.ws + WS_R + SZ_BF16ROW); u32x4* MIX = (u32x4*)(a.ws + WS_MIX);
    const size_t n = (size_t)M * D / 8;
    for (size_t i = (size_t)blockIdx.x * NTHREADS + F.tid; i < n; i += (size_t)F.G * NTHREADS) { const u32x4 g = GY[i], r0 = R0[i], r1 = R1[i]; u32x4 o;
#pragma unroll
        for (int k = 0; k < 4; ++k) o[k] = pk2(bflo(g[k]) * (bflo(r0[k]) + bflo(r1[k])), bfhi(g[k]) * (bfhi(r0[k]) + bfhi(r1[k])));
        MIX[i] = o; }
}
__device__ __forceinline__ void ph_odd_scan(Frame& F, const Args& a) {
    const unsigned* AB = (const unsigned*)(a.ws + WS_AB); bf16* R = (bf16*)(a.ws + WS_R);
    for (int it = F.gw; it < 128; it += F.NGW) {
        const int c = it * 64 + F.lane, ch = c & 2047, d = (c >> 11) & 1, b = c >> 12;
        const unsigned* ab = AB + (size_t)d * M * D + ch; bf16* r = R + (size_t)d * M * D + ch; float h = 0.f;
        for (int s0 = 0; s0 < CTXL + SEQ; s0 += 8) { unsigned x[8]; int rows[8];
#pragma unroll
            for (int k = 0; k < 8; ++k) { rows[k] = seq_row(b, d, s0 + k); x[k] = ab[(size_t)rows[k] * D]; }
#pragma unroll
            for (int k = 0; k < 8; ++k) { h = __expf(bflo(x[k])) * h + bfhi(x[k]); r[(size_t)rows[k] * D] = (bf16)f2bf(h); } }
    }
}
__device__ __forceinline__ void hgrn_wave(int wi, int lane, const bf16* QA, const float* LF, const bf16* VA, bf16* OA) {
    const int chain = wi >> 3, cg = wi & 7, b = chain >> 4, h = (chain >> 1) & 7, dir = chain & 1, kq = lane >> 4, col = cg * 16 + (lane & 15);
    const float* lf = LF + (size_t)dir * M * AW + h * 128 + kq * 32; const bf16* qa = QA + h * 128 + kq * 32; const bf16* va = VA + h * 128 + col; bf16* oa = OA + (size_t)dir * M * AW + h * 128 + col;
    float S[32];
#pragma unroll
    for (int i = 0; i < 32; ++i) S[i] = 0.f;
    u32x4 qn[4]; f32x4 fn[8]; float vn; int rown = seq_row(b, dir, 0);
#pragma unroll
    for (int i = 0; i < 4; ++i) qn[i] = *(const u32x4*)(qa + (size_t)rown * AW + 8 * i);
#pragma unroll
    for (int i = 0; i < 8; ++i) fn[i] = *(const f32x4*)(lf + (size_t)rown * AW + 4 * i);
    vn = bf2f(va[(size_t)rown * AW]);
    for (int s = 0; s < CTXL + SEQ; ++s) {
        u32x4 qc[4]; f32x4 fc[8]; const float vc = vn; const int row = rown;
#pragma unroll
        for (int i = 0; i < 4; ++i) qc[i] = qn[i];
#pragma unroll
        for (int i = 0; i < 8; ++i) fc[i] = fn[i];
        if (s + 1 < CTXL + SEQ) { rown = seq_row(b, dir, s + 1);
#pragma unroll
            for (int i = 0; i < 4; ++i) qn[i] = *(const u32x4*)(qa + (size_t)rown * AW + 8 * i);
#pragma unroll
            for (int i = 0; i < 8; ++i) fn[i] = *(const f32x4*)(lf + (size_t)rown * AW + 4 * i);
            vn = bf2f(va[(size_t)rown * AW]); }
        float o = 0.f;
#pragma unroll
        for (int i = 0; i < 32; ++i) { const float f = __expf(fc[i >> 2][i & 3]); const unsigned qw = qc[i >> 3][(i >> 1) & 3]; const float q = (i & 1) ? bfhi(qw) : bflo(qw);
            S[i] = f * (S[i] - vc) + vc; o += S[i] * q; }
        o += __shfl_xor(o, 16); o += __shfl_xor(o, 32);
        if (kq == 0) oa[(size_t)row * AW] = (bf16)f2bf(o);
    }
}
__device__ __forceinline__ void gdn_wave(int wi, int lane, const bf16* QB, const bf16* KB, const bf16* VB, const float* GB, bf16* OB) {
    const int chain = wi >> 3, cg = wi & 7, b = chain >> 4, h = (chain >> 1) & 7, dir = chain & 1, kq = lane >> 4, col = cg * 16 + (lane & 15);
    const bf16* qb = QB + h * 128 + kq * 32; const bf16* kb = KB + h * 128 + kq * 32; const bf16* vb = VB + h * 128 + col; const float* gb = GB + dir * 8 + h; bf16* ob = OB + (size_t)dir * M * AW + h * 128 + col;
    float S[32];
#pragma unroll
    for (int i = 0; i < 32; ++i) S[i] = 0.f;
    u32x4 qn[4], kn[4]; float vn, gn, bn; int rown = seq_row(b, dir, 0);
#pragma unroll
    for (int i = 0; i < 4; ++i) { qn[i] = *(const u32x4*)(qb + (size_t)rown * AW + 8 * i); kn[i] = *(const u32x4*)(kb + (size_t)rown * AW + 8 * i); }
    vn = bf2f(vb[(size_t)rown * AW]); gn = gb[(size_t)rown * 32]; bn = gb[(size_t)rown * 32 + 16];
    for (int s = 0; s < CTXL + SEQ; ++s) {
        u32x4 qc[4], kc[4]; const float vc = vn, gc = gn, bc = bn; const int row = rown;
#pragma unroll
        for (int i = 0; i < 4; ++i) { qc[i] = qn[i]; kc[i] = kn[i]; }
        if (s + 1 < CTXL + SEQ) { rown = seq_row(b, dir, s + 1);
#pragma unroll
            for (int i = 0; i < 4; ++i) { qn[i] = *(const u32x4*)(qb + (size_t)rown * AW + 8 * i); kn[i] = *(const u32x4*)(kb + (size_t)rown * AW + 8 * i); }
            vn = bf2f(vb[(size_t)rown * AW]); gn = gb[(size_t)rown * 32]; bn = gb[(size_t)rown * 32 + 16]; }
        const float al = __expf(gc); float ks = 0.f; float kk[32];
#pragma unroll
        for (int i = 0; i < 32; ++i) { const unsigned kw = kc[i >> 3][(i >> 1) & 3]; kk[i] = (i & 1) ? bfhi(kw) : bflo(kw); ks += kk[i] * S[i]; }
        ks += __shfl_xor(ks, 16); ks += __shfl_xor(ks, 32);
        const float dl = bc * (vc - al * ks); float o = 0.f;
#pragma unroll
        for (int i = 0; i < 32; ++i) { const unsigned qw = qc[i >> 3][(i >> 1) & 3]; const float q = (i & 1) ? bfhi(qw) : bflo(qw); S[i] = al * S[i] + kk[i] * dl; o += S[i] * q; }
        o += __shfl_xor(o, 16); o += __shfl_xor(o, 32);
        if (kq == 0) ob[(size_t)row * AW] = (bf16)f2bf(o);
    }
}
__device__ __forceinline__ void ph_even_scan(Frame& F, const Args& a) {
    unsigned char* ws = a.ws;
    if (F.wave == 0) { for (int wi = blockIdx.x; wi < 256; wi += F.G) hgrn_wave(wi, F.lane, (const bf16*)(ws + WS_QA), (const float*)(ws + WS_LF), (const bf16*)(ws + WS_VA), (bf16*)(ws + WS_OA)); }
    else if (F.wave == 1) { for (int wi = blockIdx.x; wi < 256; wi += F.G) gdn_wave(wi, F.lane, (const bf16*)(ws + WS_QB), (const bf16*)(ws + WS_KB), (const bf16*)(ws + WS_VB), (const float*)(ws + WS_GB), (bf16*)(ws + WS_OB)); }
}
constexpr int N_PHASES = 3 + 10 * DEPTH;
__host__ __device__ constexpr bool phase_used(int ph) { return ph < 3 ? true : !((((ph - 3) / 10) & 1) == 0 && ((ph - 3) % 10) == 4); }

__global__ void __launch_bounds__(NTHREADS, 2) fwd(Args args) {
    extern __shared__ __attribute__((aligned(16))) unsigned char lds[];
    Frame F;
    F.lds = (LAS unsigned char*)lds; F.tid = threadIdx.x; F.lane = F.tid & 63; F.wave = __builtin_amdgcn_readfirstlane(F.tid >> 6);
    F.G = gridDim.x; F.gw = F.wave * F.G + blockIdx.x; F.NGW = F.G * NWAVES;
    for (int u = F.tid; u < (LDS_BYTES - LDSCTL_OFF) / 4; u += NTHREADS) ((LAS unsigned*)(F.lds + LDSCTL_OFF))[u] = 0u;
    __syncthreads();
    const int lo = args.ph_lo, hi = args.ph_hi; const bool multi = (hi - lo) > 1;
    unsigned char* ws = args.ws;
    XcdBarrier bar; bar.bar = (unsigned*)(ws + WS_CTL) + CW_BAR; bar.x = 0; bar.st = nullptr;
    if (multi) bar = xcd_barrier_post((unsigned*)(ws + WS_CTL) + CW_BAR, (volatile LAS unsigned*)(F.lds + MISC_OFF) + 8);
#ifndef PH_SITES
#define PH_SITES 0x1ffff
#endif
#define SITE(n) ((PH_SITES >> (n)) & 1)
#define IN(k) (lo <= (k) && (k) < hi)
#define LAUNDER() do { asm volatile("" : "+v"(F.tid), "+v"(F.lane)); } while (0)
#define SEAM() do { if (multi) xcd_barrier(bar); } while (0)
    bf16* HX = (bf16*)(ws + WS_HX); bf16* MIX = (bf16*)(ws + WS_MIX); float* XA = (float*)(ws + WS_XA); float* Z = (float*)(ws + WS_Z); bf16* ACT = (bf16*)(ws + WS_ACT);
    LAS unsigned char* ring = F.lds + RING_OFF;

    if (SITE(0) && IN(0)) { LAUNDER(); ph_prologue(F, args); SEAM(); }
    if (SITE(1) && IN(1)) { LAUNDER(); ph_modreduce(F, args); SEAM(); }
    if (SITE(2) && IN(2)) { LAUNDER(); ph_mod0(F, args); SEAM(); }
#pragma unroll 1
    for (int l = 0; l < DEPTH; ++l) {
        const int base = 3 + 10 * l, j = l >> 1; const bool last = (l == DEPTH - 1); const int Mo = last ? MX : M;
        const float* MODL = (const float*)(ws + WS_MOD) + (size_t)l * 3 * 12288;
        if ((l & 1) == 0) {
            if (SITE(3) && IN(base + 0)) {
                pg8::Gemm g{HX, (const bf16*)(ws + WS_WINE + j * SZ_WINE), M, NE_INP, D, D, D}; pg8::StaticOrder S; S.init(M, NE_INP, F.G, (int)blockIdx.x);
                EpiEven1 E{(bf16*)(ws + WS_QA), (bf16*)(ws + WS_VA), (bf16*)(ws + WS_GA), (bf16*)(ws + WS_ZB), (bf16*)(ws + WS_QKVB), (float*)(ws + WS_LF), (float*)(ws + WS_GB),
                           (const float*)(ws + WS_LB) + j * AW, args.in[12] + j * 16, args.in[13] + j * 16};
                pg8::gemm_phase<EpiEven1, pg8::StaticOrder, true, true>(ring, g, S, E); SEAM(); }
            if (SITE(4) && IN(base + 1)) { LAUNDER(); ph_gdn_prep(F, args, j); SEAM(); }
            if (SITE(5) && IN(base + 2)) { LAUNDER(); ph_even_scan(F, args); SEAM(); }
            if (SITE(6) && IN(base + 3)) { LAUNDER(); ph_merge(F, args, j); SEAM(); }
        } else {
            if (SITE(7) && IN(base + 0)) {
                pg8::Gemm g{HX, (const bf16*)(ws + WS_WINO + j * SZ_WINO), M, 2 * D, D, D, D}; pg8::StaticOrder S; S.init(M, 2 * D, F.G, (int)blockIdx.x);
                EpiOdd1 E{(bf16*)(ws + WS_GY), (bf16*)(ws + WS_XBR)};
                pg8::gemm_phase<EpiOdd1, pg8::StaticOrder, true, true>(ring, g, S, E); SEAM(); }
            if (SITE(8) && IN(base + 1)) { LAUNDER(); ph_odd_conv(F, args, j); SEAM(); }
            if (SITE(9) && IN(base + 2)) {
                pg8::Gemm g{(const bf16*)(ws + WS_XC), (const bf16*)(ws + WS_WGATE + j * SZ_WGATE), M, 8192, 256, D, 256}; pg8::GateOrder S; S.init(M, F.G, (int)blockIdx.x);
                EpiGates E{(const bf16*)(ws + WS_XC), (unsigned*)(ws + WS_AB), args.in[22] + (size_t)j * 4 * D, args.in[23] + (size_t)j * 2 * D};
                pg8::gemm_phase<EpiGates, pg8::GateOrder, true, true>(ring, g, S, E); SEAM(); }
            if (SITE(10) && IN(base + 3)) { LAUNDER(); ph_odd_scan(F, args); SEAM(); }
            if (SITE(11) && IN(base + 4)) { LAUNDER(); ph_odd_mix(F, args); SEAM(); }
        }
        if (SITE(12) && IN(base + 5)) {
            pg8::Gemm g{MIX, (const bf16*)((l & 1) ? ws + WS_WOUTO + j * SZ_WSQ : ws + WS_WOUTE + j * SZ_WSQ), Mo, D, D, D, D}; pg8::StaticOrder S; S.init(Mo, D, F.G, (int)blockIdx.x);
            EpiResid E{l == 0 ? args.in[0] : XA, l == 0 ? args.in[2] : XA + (size_t)MX * D, Z, MODL + 2 * D, l & 1};
            pg8::gemm_phase<EpiResid, pg8::StaticOrder, true, true>(ring, g, S, E); SEAM(); }
        if (SITE(13) && IN(base + 6)) { LAUNDER(); ph_ln(F, Z, Mo, args.in[6] + (size_t)(l * 2) * D, args.in[7] + (size_t)(l * 2) * D, nullptr, HX, MODL + 3 * D, MODL + 4 * D, 0); SEAM(); }
        if (SITE(14) && IN(base + 7)) {
            pg8::Gemm g{HX, (const bf16*)(ws + WS_WGU + l * SZ_WGU), Mo, 2 * FF, D, D, D}; pg8::StaticOrder S; S.init(Mo, 2 * FF, F.G, (int)blockIdx.x);
            EpiSwiGLU E{ACT};
            pg8::gemm_phase<EpiSwiGLU, pg8::StaticOrder, true, true>(ring, g, S, E); SEAM(); }
        if (SITE(15) && IN(base + 8)) {
            pg8::Gemm g{ACT, (const bf16*)(ws + WS_WDN + l * SZ_WDN), Mo, D, FF, FF, FF}; pg8::StaticOrder S; S.init(Mo, D, F.G, (int)blockIdx.x);
            EpiResid E{Z, Z + (size_t)MX * D, XA, MODL + 5 * D, 0};
            pg8::gemm_phase<EpiResid, pg8::StaticOrder, true, true>(ring, g, S, E); SEAM(); }
        if (SITE(16) && IN(base + 9)) {
            const float* g1 = args.in[6] + (size_t)(l * 2 + 1) * D; const float* b1 = args.in[7] + (size_t)(l * 2 + 1) * D;
            LAUNDER(); if (last) ph_ln(F, XA, MX, g1, b1, args.out, nullptr, nullptr, nullptr, 0);
            else { LAUNDER(); ph_ln(F, XA, M, g1, b1, nullptr, HX, MODL + 3 * 12288, MODL + 3 * 12288 + D, (l + 1) & 1); SEAM(); } }
    }
#undef IN
#undef SEAM
}

extern "C" void kernel_launch(void* const* d_in, const int* in_sizes, int n_in, void* d_out, int out_size, void* d_ws, size_t ws_size, hipStream_t stream) {
    static int grid = 0;
    if (grid == 0) {
        if (n_in != 25 || in_sizes[0] != MX * D || out_size != MX * D || ws_size < WS_END) { fprintf(stderr, "kernel_launch: unexpected shapes (n_in %d, in0 %d, out %d, ws %zu < %zu); nothing launched\n", n_in, n_in > 0 ? in_sizes[0] : -1, out_size, ws_size, (size_t)WS_END); grid = -1; return; }
        int dev = 0, cus = 0, per_cu = 0;
        if (hipGetDevice(&dev) != hipSuccess || hipDeviceGetAttribute(&cus, hipDeviceAttributeMultiprocessorCount, dev) != hipSuccess) { grid = -1; return; }
        if (hipFuncSetAttribute((const void*)fwd, hipFuncAttributeMaxDynamicSharedMemorySize, LDS_BYTES) != hipSuccess) { fprintf(stderr, "kernel_launch: hipFuncSetAttribute failed\n"); grid = -1; return; }
        if (hipOccupancyMaxActiveBlocksPerMultiprocessor(&per_cu, (const void*)fwd, NTHREADS, LDS_BYTES) != hipSuccess || per_cu < 1) { fprintf(stderr, "kernel_launch: occupancy query says %d\n", per_cu); }
        (void)hipGetLastError();
        grid = cus;
    }
    if (grid < 0) return;
    if (hipMemsetAsync((char*)d_ws + WS_CTL, 0, CTL_ZERO_BYTES, stream) != hipSuccess) return;
    Args a{};
    for (int i = 0; i < 25; ++i) a.in[i] = (const float*)d_in[i];
    a.out = (float*)d_out; a.ws = (unsigned char*)d_ws;
#if MK_ONE_LAUNCH
    a.ph_lo = 0; a.ph_hi = N_PHASES;
    hipLaunchKernelGGL(fwd, dim3(grid), dim3(NTHREADS), LDS_BYTES, stream, a);
#else
    for (int ph = 0; ph < N_PHASES; ++ph) { if (!phase_used(ph)) continue; a.ph_lo = ph; a.ph_hi = ph + 1;
        hipLaunchKernelGGL(fwd, dim3(grid), dim3(NTHREADS), LDS_BYTES, stream, a); }
#endif
}
```

```cpp
#include <hip/hip_runtime.h>
#include <cstdio>
#include <cstdint>
#ifndef MK_ONE_LAUNCH
#define MK_ONE_LAUNCH 1
#endif
namespace pg8 {
#define PG8_LAS __attribute__((address_space(3)))
typedef unsigned short bf16_t;
typedef short bf16x8 __attribute__((ext_vector_type(8)));
typedef float f32x4 __attribute__((ext_vector_type(4)));
typedef unsigned u32x4 __attribute__((ext_vector_type(4)));
typedef unsigned u32x2 __attribute__((ext_vector_type(2)));
constexpr int BM = 256, BK = 64, HALF = 128, HTB = HALF * BK * 2  , STAGE_BYTES = 8 * HTB, NXCD = 8, WGM = 8;
__host__ __device__ __forceinline__ int lds_byte(int r, int c) { const int st = (r >> 4) * 2 + (c >> 5), rr = r & 15, cc = c & 31, ob = rr * 64 + cc * 2; return st * 1024 + (ob ^ (((ob >> 9) & 1) << 5)); }
__host__ __device__ __forceinline__ void stage_rc(int b, int& R, int& C) { const int st = b / 1024, sb = b % 1024, swz = sb ^ (((sb >> 9) & 1) << 5); R = (st >> 1) * 16 + swz / 64; C = (st & 1) * 32 + (swz % 64) / 2; }
__host__ __device__ __forceinline__ int perm32(int rho) { const int n = rho >> 4, i = rho & 15; return 8 * (i >> 2) + 4 * n + (i & 3); }

struct Unit { int pm, pn, ka; };
struct Gemm { const bf16_t* A; const bf16_t* Bt; int M, N, K, lda, ldb; };

struct StaticOrder {
    int nM, nN, nwg, G, c;
    __host__ __device__ void init(int M, int N, int G_, int c_) { nM = M / BM; nN = N / BM; nwg = nM * nN; G = G_; c = c_; }
    __host__ __device__ bool next(int i, Unit& u) const {
        const long L = (long)i * G + c; if (L >= nwg) return false;
        int wgid = (int)L; { const int q = nwg / NXCD, r = nwg % NXCD, xcd = wgid % NXCD, off = wgid / NXCD; wgid = (xcd < r ? xcd * (q + 1) : r * (q + 1) + (xcd - r) * q) + off; }
        const int nig = WGM * nN, gid = wgid / nig, fm = gid * WGM, gsz = (nM - fm) < WGM ? (nM - fm) : WGM;
        u.pm = fm + ((wgid % nig) % gsz); u.pn = (wgid % nig) / gsz; u.ka = 0; return true;
    }
    __device__ __forceinline__ void a_ready(const Unit&) const {}
    __device__ __forceinline__ void done(const Unit&) const {}
};
struct GateOrder {
    int nM, nwg, G, c;
    __host__ __device__ void init(int M, int G_, int c_) { nM = M / BM; nwg = nM * 32; G = G_; c = c_; }
    __host__ __device__ bool next(int i, Unit& u) const {
        const long L = (long)i * G + c; if (L >= nwg) return false;
        const int l = (int)L, pn4 = l & 3, pm = (l >> 2) % nM, nb = (l >> 2) / nM;
        u.pm = pm; u.pn = nb * 4 + pn4; u.ka = nb * 256; return true;
    }
    __device__ __forceinline__ void a_ready(const Unit&) const {}
    __device__ __forceinline__ void done(const Unit&) const {}
};
__device__ __forceinline__ unsigned cvt_pk_bf16(float lo, float hi) { unsigned r; asm volatile("v_cvt_pk_bf16_f32 %0, %1, %2" : "=v"(r) : "v"(lo), "v"(hi)); return r; }
template <class Epi, class Sched, bool ALIGN_EPI = false, bool SP2 = false>
__device__ __forceinline__ void gemm_phase(PG8_LAS unsigned char* lds, const Gemm g, const Sched& S, const Epi& E) {
    int tid = threadIdx.x; asm volatile("" : "+v"(tid)); const int wid = __builtin_amdgcn_readfirstlane(tid >> 6), lane = tid & 63, wr = wid >> 2, wc = wid & 3, fr = lane & 15, fq = lane >> 4;
    int nt = g.K / BK; asm volatile("" : "+s"(nt));
    unsigned voffA[2], voffB[2];
#pragma unroll
    for (int i = 0; i < 2; ++i) { int R, C; stage_rc(tid * 16 + i * 8192, R, C); const int Rb = Epi::PERM ? ((R & ~31) + perm32(R & 31)) : R;
        voffA[i] = (unsigned)(R * g.lda + C) * 2u; voffB[i] = (unsigned)(Rb * g.ldb + C) * 2u; }
    const size_t kstep = (size_t)(BK * 2);
    const size_t hstepA = (size_t)HALF * g.lda * 2, hstepB = (size_t)HALF * g.ldb * 2;
    const size_t tstepA = 2 * hstepA, tstepB = 2 * hstepB;
    const unsigned ldsw = (unsigned)wid * 1024u;
    const int aoff = lds_byte(wr * 64 + fr, fq * 8), boff = lds_byte(wc * 32 + fr, fq * 8);
#define PG8_SA(b, h) (((b) * 2 + (h)) * HTB)
#define PG8_SB(b, h) ((4 + (b) * 2 + (h)) * HTB)
#define PG8_STAGE(bufoff, gbase, voff) do { _Pragma("unroll") for (int _i = 0; _i < 2; ++_i) \
        __builtin_amdgcn_global_load_lds((const unsigned*)((const char*)(gbase) + (voff)[_i]), (PG8_LAS unsigned*)(lds + (bufoff) + ldsw + _i * 8192), 16, 0, 0); } while (0)
#define PG8_LDA(dst, b, h) do { _Pragma("unroll") for (int m = 0; m < 4; ++m) _Pragma("unroll") for (int k = 0; k < 2; ++k) dst[m][k] = *(const PG8_LAS bf16x8*)(lds + PG8_SA(b, h) + aoff + m * 2048 + k * 1024); } while (0)
#define PG8_LDB(dst, b, h) do { _Pragma("unroll") for (int n = 0; n < 2; ++n) _Pragma("unroll") for (int k = 0; k < 2; ++k) dst[n][k] = *(const PG8_LAS bf16x8*)(lds + PG8_SB(b, h) + boff + n * 2048 + k * 1024); } while (0)
#define PG8_MMA(ai, bj, At, Bt) do { __builtin_amdgcn_s_setprio(1); _Pragma("unroll") for (int m = 0; m < 4; ++m) _Pragma("unroll") for (int n = 0; n < 2; ++n) _Pragma("unroll") for (int k = 0; k < 2; ++k) \
        acc[ai][bj][m][n] = __builtin_amdgcn_mfma_f32_16x16x32_bf16(Bt[n][k], At[m][k], acc[ai][bj][m][n], 0, 0, 0); __builtin_amdgcn_s_setprio(0); } while (0)
#define PG8_WAIT_V(n) asm volatile("s_waitcnt vmcnt(" #n ")" ::: "memory")
#define PG8_WAIT_L(n) asm volatile("s_waitcnt lgkmcnt(" #n ")" ::: "memory")
#define PG8_BAR __builtin_amdgcn_s_barrier()
#define PG8_SCHED __builtin_amdgcn_sched_barrier(0)
    Unit cur, nxt; int ui = 0;
    if (!S.next(0, cur)) return;
    f32x4 acc[2][2][4][2];
#pragma unroll
    for (int a = 0; a < 2; ++a)
#pragma unroll
        for (int b = 0; b < 2; ++b)
#pragma unroll
            for (int m = 0; m < 4; ++m)
#pragma unroll
                for (int n = 0; n < 2; ++n) acc[a][b][m][n] = (f32x4){0.f, 0.f, 0.f, 0.f};
    bf16x8 At[4][2], B0[2][2], B1[2][2];
    const char* cA = (const char*)g.A + (size_t)cur.pm * tstepA + (size_t)cur.ka * 2; const char* cB = (const char*)g.Bt + (size_t)cur.pn * tstepB;
    S.a_ready(cur);
    if constexpr (SP2) {
        PG8_STAGE(PG8_SB(0, 0), cB, voffB); PG8_STAGE(PG8_SB(0, 1), cB + hstepB, voffB); PG8_STAGE(PG8_SA(0, 0), cA, voffA); PG8_STAGE(PG8_SA(0, 1), cA + hstepA, voffA);
        if (wr == 1) PG8_BAR;
        PG8_WAIT_V(2); PG8_BAR;
        PG8_STAGE(PG8_SB(1, 0), cB + kstep, voffB); PG8_STAGE(PG8_SA(1, 0), cA + kstep, voffA); PG8_STAGE(PG8_SB(1, 1), cB + hstepB + kstep, voffB);
        PG8_WAIT_V(6); PG8_BAR;
    } else {
        PG8_STAGE(PG8_SB(0, 0), cB, voffB); PG8_STAGE(PG8_SA(0, 0), cA, voffA); PG8_STAGE(PG8_SB(0, 1), cB + hstepB, voffB); PG8_STAGE(PG8_SA(0, 1), cA + hstepA, voffA);
        if (wr == 1) PG8_BAR;
        PG8_WAIT_V(4); PG8_BAR;
        PG8_STAGE(PG8_SB(1, 0), cB + kstep, voffB); PG8_STAGE(PG8_SA(1, 0), cA + kstep, voffA); PG8_STAGE(PG8_SB(1, 1), cB + hstepB + kstep, voffB);
        PG8_WAIT_V(6); PG8_BAR;
    }
    for (;;) {
        const bool has_next = S.next(ui + 1, nxt);
        const char* nA = has_next ? (const char*)g.A + (size_t)nxt.pm * tstepA + (size_t)nxt.ka * 2 : cA; const char* nB = has_next ? (const char*)g.Bt + (size_t)nxt.pn * tstepB : cB;
        for (int t = 0; t < nt; t += 2) {
            const bool last = (t == nt - 2);
            const char* a1 = cA + (size_t)(t + 1) * kstep;
            const char* a2 = last ? nA : cA + (size_t)(t + 2) * kstep; const char* b2 = last ? nB : cB + (size_t)(t + 2) * kstep;
            const char* a3 = a2 + kstep; const char* b3 = b2 + kstep;
            if (last && has_next) S.a_ready(nxt);
            if constexpr (SP2) {
            PG8_LDB(B0, 0, 0); PG8_LDB(B1, 0, 1); PG8_SCHED; PG8_LDA(At, 0, 0); PG8_STAGE(PG8_SA(1, 1), a1 + hstepA, voffA);
            PG8_WAIT_V(8); PG8_WAIT_L(0); PG8_BAR; PG8_MMA(0, 0, At, B0); PG8_MMA(0, 1, At, B1); PG8_BAR; PG8_SCHED;
            PG8_LDA(At, 0, 1); PG8_STAGE(PG8_SB(0, 0), b2, voffB); PG8_STAGE(PG8_SB(0, 1), b2 + hstepB, voffB); PG8_STAGE(PG8_SA(0, 0), a2, voffA);
            PG8_WAIT_V(8); PG8_WAIT_L(0); PG8_BAR; PG8_MMA(1, 0, At, B0); PG8_MMA(1, 1, At, B1); PG8_BAR; PG8_SCHED;
            PG8_LDB(B0, 1, 0); PG8_LDB(B1, 1, 1); PG8_SCHED; PG8_LDA(At, 1, 0); PG8_STAGE(PG8_SA(0, 1), a2 + hstepA, voffA);
            PG8_WAIT_V(8); PG8_WAIT_L(0); PG8_BAR; PG8_MMA(0, 0, At, B0); PG8_MMA(0, 1, At, B1); PG8_BAR; PG8_SCHED;
            PG8_LDA(At, 1, 1); PG8_STAGE(PG8_SB(1, 0), b3, voffB); PG8_STAGE(PG8_SB(1, 1), b3 + hstepB, voffB); PG8_STAGE(PG8_SA(1, 0), a3, voffA);
            PG8_WAIT_V(8); PG8_WAIT_L(0); PG8_BAR; PG8_MMA(1, 0, At, B0); PG8_MMA(1, 1, At, B1); PG8_BAR; PG8_SCHED;
            } else {
            PG8_LDB(B0, 0, 0); PG8_SCHED; PG8_LDA(At, 0, 0); PG8_STAGE(PG8_SA(1, 1), a1 + hstepA, voffA);
            PG8_WAIT_L(8); PG8_BAR; PG8_WAIT_L(0); PG8_MMA(0, 0, At, B0); PG8_BAR; PG8_SCHED;
            PG8_LDB(B1, 0, 1); PG8_STAGE(PG8_SB(0, 0), b2, voffB);
            PG8_BAR; PG8_WAIT_L(0); PG8_MMA(0, 1, At, B1); PG8_BAR;
            PG8_LDA(At, 0, 1); PG8_STAGE(PG8_SA(0, 0), a2, voffA);
            PG8_BAR; PG8_WAIT_L(0); PG8_MMA(1, 0, At, B0); PG8_BAR; PG8_SCHED;
            PG8_STAGE(PG8_SB(0, 1), b2 + hstepB, voffB);
            PG8_WAIT_V(6); PG8_BAR; PG8_MMA(1, 1, At, B1); PG8_BAR;
            PG8_LDB(B0, 1, 0); PG8_SCHED; PG8_LDA(At, 1, 0); PG8_STAGE(PG8_SA(0, 1), a2 + hstepA, voffA);
            PG8_WAIT_L(8); PG8_BAR; PG8_WAIT_L(0); PG8_MMA(0, 0, At, B0); PG8_BAR; PG8_SCHED;
            PG8_LDB(B1, 1, 1); PG8_STAGE(PG8_SB(1, 0), b3, voffB);
            PG8_BAR; PG8_WAIT_L(0); PG8_MMA(0, 1, At, B1); PG8_BAR;
            PG8_LDA(At, 1, 1); PG8_STAGE(PG8_SA(1, 0), a3, voffA);
            PG8_BAR; PG8_WAIT_L(0); PG8_MMA(1, 0, At, B0); PG8_BAR; PG8_SCHED;
            PG8_STAGE(PG8_SB(1, 1), b3 + hstepB, voffB);
            PG8_WAIT_V(6); PG8_BAR; PG8_MMA(1, 1, At, B1); PG8_BAR;
            }
        }
        if constexpr (ALIGN_EPI) { if (wr == 0) PG8_BAR; }
        if constexpr (!Epi::AFTER_DRAIN) { E(acc, cur, wr, wc, fr, fq); S.done(cur); }
        if (!has_next) break;
#pragma unroll
        for (int a = 0; a < 2; ++a)
#pragma unroll
            for (int b = 0; b < 2; ++b)
#pragma unroll
                for (int m = 0; m < 4; ++m)
#pragma unroll
                    for (int n = 0; n < 2; ++n) acc[a][b][m][n] = (f32x4){0.f, 0.f, 0.f, 0.f};
        cur = nxt; cA = nA; cB = nB; ++ui;
        if constexpr (ALIGN_EPI) { if (wr == 1) PG8_BAR; }
    }
    PG8_WAIT_V(0);
    if constexpr (!ALIGN_EPI) { if (wr == 0) PG8_BAR; }
    PG8_BAR;
    if constexpr (Epi::AFTER_DRAIN) { E.fused(acc, cur, wr, wc, fr, fq, lds, wid, lane); S.done(cur); }
#undef PG8_SA
#undef PG8_SB
#undef PG8_STAGE
#undef PG8_LDA
#undef PG8_LDB
#undef PG8_MMA
#undef PG8_WAIT_V
#undef PG8_WAIT_L
#undef PG8_BAR
#undef PG8_SCHED
}
}
using pg8::bf16_t; using pg8::f32x4; using pg8::u32x4; using pg8::u32x2; using pg8::Unit; using pg8::cvt_pk_bf16;

constexpr int D = 2048, NBATCH = 2, SEQ = 8192, CTXL = 256, DEPTH = 4;
constexpr int MX = NBATCH * SEQ;
constexpr int MC = NBATCH * CTXL;
constexpr int M = MX + MC;
constexpr int NE_IN = 9248, NE_INP = 9472, FF = 5632, AW = 1024;
constexpr int NWAVES = 8, NTHREADS = 512;
constexpr float LN_EPS = 1e-6f, DN_ALPHA = 1.681792830507429f;
constexpr float QSCALE = 0.08838834764831845f;

constexpr size_t MiB = 1u << 20;
constexpr size_t al256(size_t x) { return (x + 255) & ~(size_t)255; }
constexpr size_t WS_CTL = 0, CTL_ZERO_BYTES = 1 * MiB;
constexpr size_t WS_MOD = 1 * MiB;
constexpr size_t WS_LB = 2 * MiB;
constexpr size_t WS_PART = 3 * MiB;
constexpr size_t WS_W0 = 8 * MiB;
constexpr size_t SZ_WINE = (size_t)NE_INP * D * 2, SZ_WSQ = (size_t)D * D * 2, SZ_WINO = (size_t)2 * D * D * 2, SZ_WGATE = (size_t)8192 * 256 * 2, SZ_WGU = (size_t)2 * FF * D * 2, SZ_WDN = (size_t)D * FF * 2;
constexpr size_t WS_WINE = WS_W0;
constexpr size_t WS_WOUTE = WS_WINE + 2 * SZ_WINE;
constexpr size_t WS_WINO = WS_WOUTE + 2 * SZ_WSQ;
constexpr size_t WS_WGATE = WS_WINO + 2 * SZ_WINO;
constexpr size_t WS_WOUTO = WS_WGATE + 2 * SZ_WGATE;
constexpr size_t WS_WGU = WS_WOUTO + 2 * SZ_WSQ;
constexpr size_t WS_WDN = WS_WGU + 4 * SZ_WGU;
constexpr size_t WS_XA = al256(WS_WDN + 4 * SZ_WDN);
constexpr size_t SZ_F32ROW = (size_t)M * D * 4, SZ_BF16ROW = (size_t)M * D * 2, SZ_BF16HALF = (size_t)M * AW * 2;
constexpr size_t WS_Z = WS_XA + SZ_F32ROW;
constexpr size_t WS_HX = WS_Z + SZ_F32ROW;
constexpr size_t WS_MIX = WS_HX + SZ_BF16ROW;
constexpr size_t WS_MR = WS_MIX + SZ_BF16ROW;
constexpr size_t WS_QA = WS_MR, WS_VA = WS_QA + SZ_BF16HALF, WS_GA = WS_VA + SZ_BF16HALF, WS_ZB = WS_GA + SZ_BF16HALF;
constexpr size_t WS_LF = WS_ZB + SZ_BF16HALF;
constexpr size_t WS_QKVB = WS_LF + 2 * (size_t)M * AW * 4;
constexpr size_t WS_GB = WS_QKVB + (size_t)M * 3072 * 2;
constexpr size_t WS_QB = WS_GB + (size_t)M * 32 * 4, WS_KB = WS_QB + SZ_BF16HALF, WS_VB = WS_KB + SZ_BF16HALF;
constexpr size_t WS_OA = WS_VB + SZ_BF16HALF;
constexpr size_t WS_OB = WS_OA + 2 * SZ_BF16HALF;
constexpr size_t WS_EVEN_END = WS_OB + 2 * SZ_BF16HALF;
constexpr size_t WS_GY = WS_MR, WS_XBR = WS_GY + SZ_BF16ROW, WS_XC = WS_XBR + SZ_BF16ROW;
constexpr size_t WS_AB = WS_XC + SZ_BF16ROW;
constexpr size_t WS_R = WS_AB + 2 * (size_t)M * D * 4;
constexpr size_t WS_ODD_END = WS_R + 2 * SZ_BF16ROW;
constexpr size_t WS_ACT = WS_MR;
constexpr size_t WS_END = (WS_EVEN_END > WS_ODD_END ? WS_EVEN_END : WS_ODD_END);
static_assert(WS_ACT + (size_t)M * FF * 2 <= WS_END, "ACT fits the mixer region");
static_assert(WS_END <= (size_t)1560 * MiB, "workspace budget");
constexpr int CW_BAR = 4096;

constexpr int RING_OFF = 0, RING_BYTES = 131072;
constexpr int LDSCTL_OFF = RING_BYTES, MISC_OFF = LDSCTL_OFF + 320;
constexpr int LDS_BYTES = 147456;

#define GAS __attribute__((address_space(1)))
#define LAS __attribute__((address_space(3)))
typedef unsigned short bf16;
#define LDS_WAIT() asm volatile("s_waitcnt lgkmcnt(0)" ::: "memory")
#define VM_WAIT() asm volatile("s_waitcnt vmcnt(0)" ::: "memory")
__device__ __forceinline__ unsigned f2bf(float f) { unsigned u = __builtin_bit_cast(unsigned, f); return (u + 0x7fffu + ((u >> 16) & 1u)) >> 16; }
__device__ __forceinline__ unsigned pk2(float lo, float hi) { return f2bf(lo) | (f2bf(hi) << 16); }
__device__ __forceinline__ float bflo(unsigned u) { return __builtin_bit_cast(float, u << 16); }
__device__ __forceinline__ float bfhi(unsigned u) { return __builtin_bit_cast(float, u & 0xffff0000u); }
__device__ __forceinline__ float bf2f(bf16 h) { return __builtin_bit_cast(float, (unsigned)h << 16); }
__device__ __forceinline__ float sigm(float x) { return 1.f / (1.f + __expf(-x)); }
__device__ __forceinline__ float siluf(float x) { return x / (1.f + __expf(-x)); }
__device__ __forceinline__ float log1p_fast(float t) { const float p = t * (1.f + t * (-0.5f + t * (0.33333333f + t * (-0.25f + t * 0.2f)))); return t < 0.03f ? p : __logf(1.f + t); }
__device__ __forceinline__ float softplusf(float x) { return fmaxf(x, 0.f) + log1p_fast(__expf(-fabsf(x))); }
__device__ __forceinline__ float neg_expm1_fast(float x) { const float p = -x * (1.f + x * (0.5f + x * (0.16666667f + x * (0.041666668f + x * 0.0083333338f)))); return x > -0.25f ? p : 1.f - __expf(x); }
__device__ __forceinline__ float gelu_tanh(float x) { const float u = 0.7978845608028654f * (x + 0.044715f * x * x * x); return x / (1.f + __expf(-2.f * u)); }
__device__ __forceinline__ float wave_sum(float v) {
#pragma unroll
    for (int o = 1; o < 64; o <<= 1) v += __shfl_xor(v, o);
    return v;
}
__device__ __forceinline__ int mod_index(int row) { return row < SEQ ? 0 : (row < MX ? 1 : 2); }
__device__ __forceinline__ int perm_row(int r) { if (r >= MX) return r; const int b = r >> 13, t = r & 8191; return (b << 13) + ((t & 63) << 7) + (t >> 6); }
__device__ __forceinline__ int unperm_row(int r) { if (r >= MX) return r; const int b = r >> 13, i = r & 8191; return (b << 13) + ((i & 127) << 6) + (i >> 7); }
__device__ __forceinline__ int seq_row(int b, int dir, int s) {
    if (s < CTXL) { const int pos = dir ? (CTXL - 1 - s) : s; return MX + b * CTXL + pos; }
    const int p = s - CTXL, pos = dir ? (SEQ - 1 - p) : p; return b * SEQ + pos;
}
#define XB_TMO      128
#define XB_XCNT(j)  (256  + 64 * (j))
#define XB_XSUB(j)  (1280 + 64 * (j))
#define XB_XGEN(j)  (2304 + 64 * (j))
#define XB_TOP      3328
#define XB_TOPGEN   3392
#define XCD_BAR_WORDS 3456
#define XB_SPIN_CAP (1u << 18)

__device__ __forceinline__ unsigned xb_ld(unsigned* p)              { return __hip_atomic_load(p, __ATOMIC_RELAXED, __HIP_MEMORY_SCOPE_AGENT); }
__device__ __forceinline__ unsigned xb_add(unsigned* p, unsigned v) { return __hip_atomic_fetch_add(p, v, __ATOMIC_RELAXED, __HIP_MEMORY_SCOPE_AGENT); }
__device__ __forceinline__ unsigned xb_xcc_id() { return (unsigned)__builtin_amdgcn_s_getreg((3 << 11) | 20) & 0xFu; }
#define XB_SPIN(cond, bar) do { unsigned _sp = 0; while (cond) { __builtin_amdgcn_s_sleep(1); \
    if ((++_sp & 255u) == 0u) { if (xb_ld(&(bar)[XB_TMO])) break; if (_sp > XB_SPIN_CAP) { atomicAdd(&(bar)[XB_TMO], 1u); break; } } } } while (0)

struct XcdBarrier {
    unsigned* bar; unsigned x;
    volatile LAS unsigned* st;
};

__device__ __forceinline__ XcdBarrier xcd_barrier_post(unsigned* bar, volatile LAS unsigned* st) {
    XcdBarrier b; b.bar = bar; b.x = xb_xcc_id(); b.st = st;
    if (threadIdx.x == 0) (void)xb_add(&bar[XB_XCNT(b.x)], 1u);
    return b;
}
__device__ __forceinline__ void xcd_barrier_complete(unsigned* bar, unsigned x, unsigned& nloc, unsigned& nx) {
    const unsigned G = gridDim.x * gridDim.y * gridDim.z;
    unsigned sum, cnt, mine, sp = 0u;
    for (;;) {
        sum = 0u; cnt = 0u; mine = 0u;
#pragma unroll
        for (unsigned j = 0; j < 16; ++j) { const unsigned c = xb_ld(&bar[XB_XCNT(j)]); sum += c; cnt += (c > 0u) ? 1u : 0u; mine = (j == x) ? c : mine; }
        if (sum == G) break;
        __builtin_amdgcn_s_sleep(1);
        if ((++sp & 255u) == 0u) { if (xb_ld(&bar[XB_TMO])) break; if (sp > XB_SPIN_CAP) { atomicAdd(&bar[XB_TMO], 1u); break; } }
    }
    nloc = mine > 0u ? mine : 1u; nx = cnt > 0u ? cnt : 1u;
}

__device__ __forceinline__ void xcd_barrier(const XcdBarrier& b) {
    asm volatile("s_waitcnt vmcnt(0)" ::: "memory");
    __syncthreads();
    if (threadIdx.x == 0) {
        unsigned* bar = b.bar;
        __builtin_amdgcn_s_waitcnt(0);
        unsigned nloc = b.st[0], nx = b.st[1];
        if (nloc == 0u) { xcd_barrier_complete(bar, b.x, nloc, nx); b.st[0] = nloc; b.st[1] = nx; }
        const unsigned old = xb_add(&bar[XB_XSUB(b.x)], 1u);
        const unsigned gen = old / nloc;
        if (old + 1u == (gen + 1u) * nloc) {
            __builtin_amdgcn_fence(__ATOMIC_RELEASE, "agent");
            asm volatile("s_waitcnt vmcnt(0)" ::: "memory");
            const unsigned og = xb_add(&bar[XB_TOP], 1u);
            const unsigned tg = og / nx;
            if (og + 1u == (tg + 1u) * nx) xb_add(&bar[XB_TOPGEN], 1u);
            else XB_SPIN(xb_ld(&bar[XB_TOPGEN]) == tg, bar);
            __builtin_amdgcn_fence(__ATOMIC_ACQUIRE, "agent");
            xb_add(&bar[XB_XGEN(b.x)], 1u);
            asm volatile("s_waitcnt vmcnt(0)" ::: "memory");
        } else {
            XB_SPIN(xb_ld(&bar[XB_XGEN(b.x)]) == gen, bar);
            __builtin_amdgcn_fence(__ATOMIC_ACQUIRE, "agent");
            asm volatile("s_waitcnt vmcnt(0)" ::: "memory");
        }
    }
    __syncthreads();
}

struct EpiEven1 {
    static constexpr bool PERM = true, AFTER_DRAIN = false;
    bf16_t *QA, *VA, *GA, *ZB, *QKVB; float *LF, *GB; const float *lb, *a_log, *dt_bias;
    __device__ __forceinline__ void operator()(const f32x4 (&acc)[2][2][4][2], const Unit& u, int wr, int wc, int fr_, int fq_) const {
        int fr = fr_, fq = fq_; asm volatile("" : "+v"(fr), "+v"(fq));
        const int grp = u.pn >> 2, row0 = u.pm * 256 + wr * 64 + fr;
        if (grp == 9) {
            if (wc != 0) return;
            float al[8], db[8];
#pragma unroll
            for (int i = 0; i < 8; ++i) { const int c = (8 * fq + i) & 15; al[i] = -__expf(a_log[c]); db[i] = dt_bias[c]; }
#pragma unroll
            for (int ai = 0; ai < 2; ++ai)
#pragma unroll
                for (int m = 0; m < 4; ++m) { float* rowp = GB + (size_t)(row0 + ai * 128 + m * 16) * 32 + 8 * fq;
#pragma unroll
                    for (int n = 0; n < 2; ++n) { const f32x4 v = acc[ai][0][m][n]; f32x4 o;
#pragma unroll
                        for (int j = 0; j < 4; ++j) o[j] = (fq < 2) ? al[4 * n + j] * softplusf(v[j] + db[4 * n + j]) : sigm(v[j]);
                        *(f32x4*)(rowp + 4 * n) = o; } }
            return;
        }
        const int col0 = (u.pn & 3) * 256 + wc * 32 + 8 * fq;
        int op = 0, ld = 1024; bf16_t* dstb = VA; float* dstf = LF;
        switch (grp) {
            case 0: op = 2; dstb = QA; break;
            case 1: op = 0; dstb = VA; break;
            case 2: op = 3; dstf = LF; break;
            case 3: op = 3; dstf = LF + (size_t)M * 1024; break;
            case 4: op = 1; dstb = GA; break;
            case 5: case 6: case 7: op = 0; dstb = QKVB + (grp - 5) * 1024; ld = 3072; break;
            default: op = 1; dstb = ZB; break;
        }
        if (op == 3) {
#pragma unroll
            for (int bj = 0; bj < 2; ++bj) { float lbv[8];
#pragma unroll
                for (int i = 0; i < 8; ++i) lbv[i] = lb[col0 + bj * 128 + i];
#pragma unroll
                for (int ai = 0; ai < 2; ++ai)
#pragma unroll
                    for (int m = 0; m < 4; ++m) { float* rowp = dstf + (size_t)(row0 + ai * 128 + m * 16) * 1024 + col0 + bj * 128;
#pragma unroll
                        for (int n = 0; n < 2; ++n) { const f32x4 v = acc[ai][bj][m][n]; f32x4 o;
#pragma unroll
                            for (int j = 0; j < 4; ++j) { const float l = lbv[4 * n + j]; o[j] = __logf(l + (1.f - l) * sigm(v[j])); }
                            *(f32x4*)(rowp + 4 * n) = o; } } }
            return;
        }
#pragma unroll
        for (int ai = 0; ai < 2; ++ai)
#pragma unroll
            for (int m = 0; m < 4; ++m) { bf16_t* rowp = dstb + (size_t)(row0 + ai * 128 + m * 16) * ld + col0;
#pragma unroll
                for (int bj = 0; bj < 2; ++bj) { f32x4 v0 = acc[ai][bj][m][0], v1 = acc[ai][bj][m][1];
                    if (op >= 1) {
#pragma unroll
                        for (int j = 0; j < 4; ++j) { v0[j] = siluf(v0[j]); v1[j] = siluf(v1[j]); }
                        if (op == 2) { v0 = v0 * QSCALE; v1 = v1 * QSCALE; } }
                    u32x4 w; w.x = cvt_pk_bf16(v0[0], v0[1]); w.y = cvt_pk_bf16(v0[2], v0[3]); w.z = cvt_pk_bf16(v1[0], v1[1]); w.w = cvt_pk_bf16(v1[2], v1[3]);
                    *(u32x4*)(rowp + bj * 128) = w; } }
    }
};
struct EpiOdd1 {
    static constexpr bool PERM = true, AFTER_DRAIN = false;
    bf16_t *GY, *XBR;
    __device__ __forceinline__ void operator()(const f32x4 (&acc)[2][2][4][2], const Unit& u, int wr, int wc, int fr_, int fq_) const {
        int fr = fr_, fq = fq_; asm volatile("" : "+v"(fr), "+v"(fq));
        const int row0 = u.pm * 256 + wr * 64 + fr; const bool isy = u.pn < 8;
        bf16_t* dst = isy ? GY : XBR; const int col0 = (u.pn & 7) * 256 + wc * 32 + 8 * fq;
#pragma unroll
        for (int ai = 0; ai < 2; ++ai)
#pragma unroll
            for (int m = 0; m < 4; ++m) { bf16_t* rowp = dst + (size_t)(row0 + ai * 128 + m * 16) * D + col0;
#pragma unroll
                for (int bj = 0; bj < 2; ++bj) { f32x4 v0 = acc[ai][bj][m][0], v1 = acc[ai][bj][m][1];
                    if (isy) {
#pragma unroll
                        for (int j = 0; j < 4; ++j) { v0[j] = gelu_tanh(v0[j]); v1[j] = gelu_tanh(v1[j]); } }
                    u32x4 w; w.x = cvt_pk_bf16(v0[0], v0[1]); w.y = cvt_pk_bf16(v0[2], v0[3]); w.z = cvt_pk_bf16(v1[0], v1[1]); w.w = cvt_pk_bf16(v1[2], v1[3]);
                    *(u32x4*)(rowp + bj * 128) = w; } }
    }
};
struct EpiGates {
    static constexpr bool PERM = true, AFTER_DRAIN = false;
    const bf16_t* XC; unsigned* AB; const float *gate_b  , *lam  ;
    __device__ __forceinline__ void operator()(const f32x4 (&acc)[2][2][4][2], const Unit& u, int wr, int wc, int fr_, int fq_) const {
        int fr = fr_, fq = fq_; asm volatile("" : "+v"(fr), "+v"(fq));
        const int nb = u.pn >> 2, pn4 = u.pn & 3, d = pn4 >> 1, half = pn4 & 1;
        const int row0 = u.pm * 256 + wr * 64 + fr, ch0 = nb * 256 + half * 128 + wc * 32 + 8 * fq;
        unsigned* ab = AB + (size_t)d * M * D;
#pragma unroll
        for (int n = 0; n < 2; ++n) {
            const int ch = ch0 + 4 * n;
            const f32x4 gr = *(const f32x4*)(gate_b + (d * 2 + 0) * D + ch), gi = *(const f32x4*)(gate_b + (d * 2 + 1) * D + ch), lm = *(const f32x4*)(lam + d * D + ch);
            f32x4 sp;
#pragma unroll
            for (int j = 0; j < 4; ++j) sp[j] = -8.0f * softplusf(-lm[j]);
#pragma unroll
            for (int ai = 0; ai < 2; ++ai)
#pragma unroll
                for (int m = 0; m < 4; ++m) { const size_t ro = (size_t)(row0 + ai * 128 + m * 16) * D + ch;
                    const u32x2 xr = *(const u32x2*)(XC + ro); const float xc[4] = {bflo(xr.x), bfhi(xr.x), bflo(xr.y), bfhi(xr.y)};
                    u32x4 o;
#pragma unroll
                    for (int j = 0; j < 4; ++j) { const float r = sigm(acc[ai][0][m][n][j] + gr[j]), ig = sigm(acc[ai][1][m][n][j] + gi[j]);
                        const float la = r * sp[j], bb = __builtin_sqrtf(neg_expm1_fast(2.f * la)) * (ig * xc[j]); o[j] = pk2(la, bb); }
                    *(u32x4*)(ab + ro) = o; }
        }
    }
};
struct EpiResid {
    static constexpr bool PERM = false, AFTER_DRAIN = false;
    const float *r0, *r1; float* out; const float* gt; int permute;
    __device__ __forceinline__ void operator()(const f32x4 (&acc)[2][2][4][2], const Unit& u, int wr, int wc, int fr_, int fq_) const {
        int fr = fr_, fq = fq_; asm volatile("" : "+v"(fr), "+v"(fq));
        const int rowt = u.pm * 256, mi = mod_index(rowt), col0 = u.pn * 256 + wc * 32 + 4 * fq;
        f32x4 gv[2][2];
#pragma unroll
        for (int bj = 0; bj < 2; ++bj)
#pragma unroll
            for (int n = 0; n < 2; ++n) gv[bj][n] = *(const f32x4*)(gt + (size_t)mi * 12288 + col0 + bj * 128 + n * 16) + 1.0f;
#pragma unroll
        for (int ai = 0; ai < 2; ++ai)
#pragma unroll
            for (int m = 0; m < 4; ++m) { const int rr = rowt + ai * 128 + wr * 64 + m * 16 + fr, tok = permute ? unperm_row(rr) : rr;
                const float* rp = (tok < MX ? r0 + (size_t)tok * D : r1 + (size_t)(tok - MX) * D) + col0; float* op = out + (size_t)tok * D + col0;
#pragma unroll
                for (int bj = 0; bj < 2; ++bj)
#pragma unroll
                    for (int n = 0; n < 2; ++n) { const f32x4 rs = *(const f32x4*)(rp + bj * 128 + n * 16); *(f32x4*)(op + bj * 128 + n * 16) = rs * DN_ALPHA + gv[bj][n] * acc[ai][bj][m][n]; }
                asm volatile("" ::: "memory"); }
    }
};
struct EpiSwiGLU {
    static constexpr bool PERM = true, AFTER_DRAIN = false;
    bf16_t* ACT;
    __device__ __forceinline__ void operator()(const f32x4 (&acc)[2][2][4][2], const Unit& u, int wr, int wc, int fr_, int fq_) const {
        int fr = fr_, fq = fq_; asm volatile("" : "+v"(fr), "+v"(fq));
        const int row0 = u.pm * 256 + wr * 64 + fr, col0 = u.pn * 128 + wc * 32 + 8 * fq;
#pragma unroll
        for (int ai = 0; ai < 2; ++ai)
#pragma unroll
            for (int m = 0; m < 4; ++m) { f32x4 v0 = acc[ai][0][m][0], v1 = acc[ai][0][m][1]; const f32x4 u0 = acc[ai][1][m][0], u1 = acc[ai][1][m][1];
#pragma unroll
                for (int j = 0; j < 4; ++j) { v0[j] = siluf(v0[j]) * u0[j]; v1[j] = siluf(v1[j]) * u1[j]; }
                u32x4 w; w.x = cvt_pk_bf16(v0[0], v0[1]); w.y = cvt_pk_bf16(v0[2], v0[3]); w.z = cvt_pk_bf16(v1[0], v1[1]); w.w = cvt_pk_bf16(v1[2], v1[3]);
                *(u32x4*)(ACT + (size_t)(row0 + ai * 128 + m * 16) * FF + col0) = w; }
    }
};
struct Frame {
    LAS unsigned char* lds;
    int tid, lane, wave, G, gw, NGW;
};
struct Args { const float* in[25]; float* out; unsigned char* ws; int ph_lo, ph_hi; };

template <int MODE> __device__ __forceinline__ long src_off(int n, int nsrc) {
    if (MODE == 0) return n < nsrc ? (long)n : -1L;
    if (MODE == 1) { const int pn = n >> 8, bj = (n >> 7) & 1, jj = n & 127; return (long)bj * FF + pn * 128 + jj; }
    const int nb = n >> 10, c = n & 1023, pn4 = c >> 8, g = (c >> 7) & 1, jj = c & 127, d = pn4 >> 1, half = pn4 & 1;
    return (long)(((d * 2 + g) * 8 + nb) * 256) * 256 + half * 128 + jj;
}
template <int MODE> __device__ __forceinline__ void tr_item(const float* W, int ldin, int K, bf16* WT, int nout, int nsrc, LAS float* scr, int item, int lane) {
    const int nblk = nout / 32, kb = item / nblk, nb = item % nblk, k0 = 64 * kb, n0 = 32 * nb;
    const long off = src_off<MODE>(n0 + (lane & 31), nsrc);
#pragma unroll 8
    for (int i = 0; i < 32; ++i) { const int kk = 2 * i + (lane >> 5); scr[kk * 33 + (lane & 31)] = off >= 0 ? W[off + (size_t)(k0 + kk) * ldin] : 0.f; }
    LDS_WAIT(); asm volatile("" ::: "memory");
    const int c = lane & 7;
#pragma unroll
    for (int j = 0; j < 4; ++j) { const int n = (lane >> 3) + 8 * j; const LAS float* s = scr + (8 * c) * 33 + n;
        u32x4 o; o.x = pk2(s[0 * 33], s[1 * 33]); o.y = pk2(s[2 * 33], s[3 * 33]); o.z = pk2(s[4 * 33], s[5 * 33]); o.w = pk2(s[6 * 33], s[7 * 33]);
        *(u32x4*)(WT + (size_t)(n0 + n) * K + k0 + 8 * c) = o; }
    LDS_WAIT(); asm volatile("" ::: "memory");
}
__device__ __forceinline__ void gemv_item(const Args& a, int gi, int lane, float* PART) {
    const int l = gi / 384, c48 = (gi >> 3) % 48, kp = gi & 7, col = c48 * 256 + lane * 4;
    const float* W = a.in[4] + ((size_t)l * D + kp * 256) * 12288 + col;
    const float* c0 = a.in[1] + kp * 256; const float* c1 = c0 + D; const float* c2 = a.in[3] + kp * 256;
    f32x4 s0 = {0.f, 0.f, 0.f, 0.f}, s1 = s0, s2 = s0;
#pragma unroll 8
    for (int k = 0; k < 256; ++k) { const f32x4 w = *(const f32x4*)(W + (size_t)k * 12288); s0 += w * siluf(c0[k]); s1 += w * siluf(c1[k]); s2 += w * siluf(c2[k]); }
    float* p = PART + ((size_t)(kp * 4 + l) * 3) * 12288 + col;
    *(f32x4*)p = s0; *(f32x4*)(p + 12288) = s1; *(f32x4*)(p + 2 * 12288) = s2;
}
__device__ __forceinline__ void ph_prologue(Frame& F, const Args& a) {
    LAS float* scr = (LAS float*)(F.lds + RING_OFF + F.wave * 16384);
    unsigned char* ws = a.ws;
    constexpr int I_INE = (D / 64) * (NE_INP / 32), I_SQ = (D / 64) * (D / 32), I_INO = (D / 64) * (2 * D / 32), I_GATE = (256 / 64) * (8192 / 32), I_GU = (D / 64) * (2 * FF / 32), I_DN = (FF / 64) * (D / 32);
    constexpr int NGEMV = 4 * 48 * 8;
    constexpr int NITEMS = NGEMV + 2 * (I_INE + I_SQ + I_INO + I_GATE + I_SQ) + 4 * (I_GU + I_DN);
    for (int it = F.gw; it < NITEMS; it += F.NGW) {
        int r = it;
        if (r < NGEMV) { gemv_item(a, r, F.lane, (float*)(ws + WS_PART)); continue; } r -= NGEMV;
        bool done = false;
#pragma unroll 1
        for (int j = 0; j < 2 && !done; ++j) {
            if (r < I_INE) { tr_item<0>(a.in[10] + (size_t)j * D * NE_IN, NE_IN, D, (bf16*)(ws + WS_WINE + j * SZ_WINE), NE_INP, NE_IN, scr, r, F.lane); done = true; break; } r -= I_INE;
            if (r < I_SQ) { tr_item<0>(a.in[17] + (size_t)j * D * D, D, D, (bf16*)(ws + WS_WOUTE + j * SZ_WSQ), D, D, scr, r, F.lane); done = true; break; } r -= I_SQ;
            if (r < I_INO) { tr_item<0>(a.in[18] + (size_t)j * D * 2 * D, 2 * D, D, (bf16*)(ws + WS_WINO + j * SZ_WINO), 2 * D, 2 * D, scr, r, F.lane); done = true; break; } r -= I_INO;
            if (r < I_GATE) { tr_item<2>(a.in[21] + (size_t)j * 4 * 8 * 256 * 256, 256, 256, (bf16*)(ws + WS_WGATE + j * SZ_WGATE), 8192, 8192, scr, r, F.lane); done = true; break; } r -= I_GATE;
            if (r < I_SQ) { tr_item<0>(a.in[24] + (size_t)j * D * D, D, D, (bf16*)(ws + WS_WOUTO + j * SZ_WSQ), D, D, scr, r, F.lane); done = true; break; } r -= I_SQ;
        }
        if (done) continue;
#pragma unroll 1
        for (int l = 0; l < 4; ++l) {
            if (r < I_GU) { tr_item<1>(a.in[8] + (size_t)l * D * 2 * FF, 2 * FF, D, (bf16*)(ws + WS_WGU + l * SZ_WGU), 2 * FF, 2 * FF, scr, r, F.lane); break; } r -= I_GU;
            if (r < I_DN) { tr_item<0>(a.in[9] + (size_t)l * FF * D, D, FF, (bf16*)(ws + WS_WDN + l * SZ_WDN), D, D, scr, r, F.lane); break; } r -= I_DN;
        }
    }
}
__device__ __forceinline__ void ph_modreduce(Frame& F, const Args& a) {
    float* MOD = (float*)(a.ws + WS_MOD); const float* PART = (const float*)(a.ws + WS_PART); float* LB = (float*)(a.ws + WS_LB);
    const int gt = blockIdx.x * NTHREADS + F.tid, NT = F.G * NTHREADS;
    for (int i = gt; i < 4 * 3 * 12288; i += NT) { const int l = i / 36864, n = i % 12288; float s = a.in[5][l * 12288 + n];
#pragma unroll
        for (int kp = 0; kp < 8; ++kp) s += PART[(size_t)kp * 147456 + i];
        MOD[i] = s; }
    for (int i = gt; i < 2048; i += NT) { const int c = i & 1023; LB[i] = i < 1024 ? 0.f : sigm(a.in[14][1024 + c] - a.in[14][c]); }
}
__device__ __forceinline__ void store_hx(bf16* HX, int orow, const f32x4 (&v)[8], const float* sh, const float* sc, int lane) {
    unsigned long long* o8 = (unsigned long long*)(HX + (size_t)orow * D) + lane;
#pragma unroll
    for (int j = 0; j < 8; ++j) { const f32x4 s = *(const f32x4*)(sc + 4 * (lane + 64 * j)), h = *(const f32x4*)(sh + 4 * (lane + 64 * j)); const f32x4 y = v[j] * (s + 1.0f) + h;
        o8[64 * j] = (unsigned long long)pk2(y[0], y[1]) | ((unsigned long long)pk2(y[2], y[3]) << 32); }
}
__device__ __forceinline__ void ph_mod0(Frame& F, const Args& a) {
    const float* MOD = (const float*)(a.ws + WS_MOD); bf16* HX = (bf16*)(a.ws + WS_HX);
    for (int row = F.gw; row < M; row += F.NGW) {
        const float* p = row < MX ? a.in[0] + (size_t)row * D : a.in[2] + (size_t)(row - MX) * D; f32x4 v[8];
#pragma unroll
        for (int j = 0; j < 8; ++j) v[j] = *(const f32x4*)(p + 4 * (F.lane + 64 * j));
        const float* md = MOD + (size_t)mod_index(row) * 12288;
        store_hx(HX, row, v, md, md + D, F.lane);
    }
}
__device__ __forceinline__ void ph_ln(Frame& F, float* buf, int nrows, const float* g, const float* b, float* dout, bf16* HX, const float* modsh, const float* modsc, int permute) {
    for (int row = F.gw; row < nrows; row += F.NGW) {
        float* p = buf + (size_t)row * D; f32x4 v[8]; float s = 0.f;
#pragma unroll
        for (int j = 0; j < 8; ++j) { v[j] = *(const f32x4*)(p + 4 * (F.lane + 64 * j)); s += (v[j][0] + v[j][1]) + (v[j][2] + v[j][3]); }
        const float mean = wave_sum(s) * (1.f / D); float q = 0.f;
#pragma unroll
        for (int j = 0; j < 8; ++j) { v[j] = v[j] - mean; q += (v[j][0] * v[j][0] + v[j][1] * v[j][1]) + (v[j][2] * v[j][2] + v[j][3] * v[j][3]); }
        const float rstd = 1.f / sqrtf(wave_sum(q) * (1.f / D) + LN_EPS);
        float* o = dout ? dout + (size_t)row * D : p;
#pragma unroll
        for (int j = 0; j < 8; ++j) { const f32x4 gg = *(const f32x4*)(g + 4 * (F.lane + 64 * j)), bb = *(const f32x4*)(b + 4 * (F.lane + 64 * j)); v[j] = v[j] * rstd * gg + bb; *(f32x4*)(o + 4 * (F.lane + 64 * j)) = v[j]; }
        if (HX) { const int mi = mod_index(row); store_hx(HX, permute ? perm_row(row) : row, v, modsh + (size_t)mi * 12288, modsc + (size_t)mi * 12288, F.lane); }
    }
}
__device__ __forceinline__ void seg_bounds(int r, int& lo, int& hi) { if (r < MX) { lo = r & ~(SEQ - 1); hi = lo + SEQ; } else { lo = MX + ((r - MX) & ~(CTXL - 1)); hi = lo + CTXL; } }
__device__ __forceinline__ void ph_gdn_prep(Frame& F, const Args& a, int j) {
    const bf16* QKVB = (const bf16*)(a.ws + WS_QKVB); bf16* QB = (bf16*)(a.ws + WS_QB); bf16* KB = (bf16*)(a.ws + WS_KB); bf16* VB = (bf16*)(a.ws + WS_VB);
    const float* cw = a.in[11] + (size_t)j * 4 * 3072;
    for (int row = F.gw; row < M; row += F.NGW) {
        int lo, hi; seg_bounds(row, lo, hi);
#pragma unroll 2
        for (int it = 0; it < 24; ++it) { const int s = it >> 3, h = it & 7, ch = s * 1024 + h * 128 + F.lane * 2; float y0 = 0.f, y1 = 0.f;
#pragma unroll
            for (int k = 0; k < 4; ++k) { const int rr = row + k - 2; if (rr >= lo && rr < hi) { const unsigned x = *(const unsigned*)(QKVB + (size_t)rr * 3072 + ch); y0 += cw[k * 3072 + ch] * bflo(x); y1 += cw[k * 3072 + ch + 1] * bfhi(x); } }
            y0 = siluf(y0); y1 = siluf(y1);
            if (s < 2) { const float sc = rsqrtf(wave_sum(y0 * y0 + y1 * y1) + 1e-6f) * (s == 0 ? QSCALE : 1.f); y0 *= sc; y1 *= sc; }
            bf16* dst = s == 0 ? QB : (s == 1 ? KB : VB);
            *(unsigned*)(dst + (size_t)row * AW + h * 128 + F.lane * 2) = pk2(y0, y1); }
    }
}
__device__ __forceinline__ void ph_merge(Frame& F, const Args& a, int j) {
    const bf16* OA = (const bf16*)(a.ws + WS_OA); const bf16* OB = (const bf16*)(a.ws + WS_OB); const bf16* GA = (const bf16*)(a.ws + WS_GA); const bf16* ZB = (const bf16*)(a.ws + WS_ZB);
    bf16* MIX = (bf16*)(a.ws + WS_MIX); const float* na = a.in[15] + (size_t)j * AW; const float* nb = a.in[16] + (size_t)j * AW;
    for (int row = F.gw; row < M; row += F.NGW) {
#pragma unroll 2
        for (int it = 0; it < 16; ++it) { const int part = it >> 3, c = (it & 7) * 128 + F.lane * 2; const bf16* O = part ? OB : OA; const size_t o = (size_t)row * AW + c;
            const unsigned x0 = *(const unsigned*)(O + o), x1 = *(const unsigned*)(O + (size_t)M * AW + o), gg = *(const unsigned*)((part ? ZB : GA) + o);
            float y0 = bflo(x0) + bflo(x1), y1 = bfhi(x0) + bfhi(x1);
            const float sc = rsqrtf(wave_sum(y0 * y0 + y1 * y1) * (1.f / 128.f) + 1e-6f); const float* nw = part ? nb : na;
            y0 = y0 * sc * nw[c] * bflo(gg); y1 = y1 * sc * nw[c + 1] * bfhi(gg);
            *(unsigned*)(MIX + (size_t)row * D + part * AW + c) = pk2(y0, y1); }
    }
}
__device__ __forceinline__ void ph_odd_conv(Frame& F, const Args& a, int j) {
    const bf16* XBR = (const bf16*)(a.ws + WS_XBR); bf16* XC = (bf16*)(a.ws + WS_XC); const float* cw = a.in[19] + (size_t)j * 4 * D; const float* cb = a.in[20] + (size_t)j * D;
    for (int row = F.gw; row < M; row += F.NGW) {
        int lo, hi; seg_bounds(row, lo, hi);
#pragma unroll 2
        for (int it = 0; it < 16; ++it) { const int ch = it * 128 + F.lane * 2; float y0 = cb[ch], y1 = cb[ch + 1];
#pragma unroll
            for (int k = 0; k < 4; ++k) { const int rr = row + k - 2; if (rr >= lo && rr < hi) { const unsigned x = *(const unsigned*)(XBR + (size_t)rr * D + ch); y0 += cw[k * D + ch] * bflo(x); y1 += cw[k * D + ch + 1] * bfhi(x); } }
            *(unsigned*)(XC + (size_t)row * D + ch) = pk2(y0, y1); }
    }
}
__device__ __forceinline__ void ph_odd_mix(Frame& F, const Args& a) {
    const u32x4* GY = (const u32x4*)(a.ws + WS_GY); const u32x4* R0 = (const u32x4*)(a.ws + WS_R); const u32x4* R1 = (const u32x4*)(a.ws + WS_R + SZ_BF16ROW); u32x4* MIX = (u32x4*)(a.ws + WS_MIX);
    const size_t n = (size_t)M * D / 8;
    for (size_t i = (size_t)blockIdx.x * NTHREADS + F.tid; i < n; i += (size_t)F.G * NTHREADS) { const u32x4 g = GY[i], r0 = R0[i], r1 = R1[i]; u32x4 o;
#pragma unroll
        for (int k = 0; k < 4; ++k) o[k] = pk2(bflo(g[k]) * (bflo(r0[k]) + bflo(r1[k])), bfhi(g[k]) * (bfhi(r0[k]) + bfhi(r1[k])));
        MIX[i] = o; }
}
__device__ __forceinline__ void ph_odd_scan(Frame& F, const Args& a) {
    const unsigned* AB = (const unsigned*)(a.ws + WS_AB); bf16* R = (bf16*)(a.ws + WS_R);
    for (int it = F.gw; it < 128; it += F.NGW) {
        const int c = it * 64 + F.lane, ch = c & 2047, d = (c >> 11) & 1, b = c >> 12;
        const unsigned* ab = AB + (size_t)d * M * D + ch; bf16* r = R + (size_t)d * M * D + ch; float h = 0.f;
        for (int s0 = 0; s0 < CTXL + SEQ; s0 += 8) { unsigned x[8]; int rows[8];
#pragma unroll
            for (int k = 0; k < 8; ++k) { rows[k] = seq_row(b, d, s0 + k); x[k] = ab[(size_t)rows[k] * D]; }
#pragma unroll
            for (int k = 0; k < 8; ++k) { h = __expf(bflo(x[k])) * h + bfhi(x[k]); r[(size_t)rows[k] * D] = (bf16)f2bf(h); } }
    }
}
__device__ __forceinline__ void hgrn_wave(int wi, int lane, const bf16* QA, const float* LF, const bf16* VA, bf16* OA) {
    const int chain = wi >> 3, cg = wi & 7, b = chain >> 4, h = (chain >> 1) & 7, dir = chain & 1, kq = lane >> 4, col = cg * 16 + (lane & 15);
    const float* lf = LF + (size_t)dir * M * AW + h * 128 + kq * 32; const bf16* qa = QA + h * 128 + kq * 32; const bf16* va = VA + h * 128 + col; bf16* oa = OA + (size_t)dir * M * AW + h * 128 + col;
    float S[32];
#pragma unroll
    for (int i = 0; i < 32; ++i) S[i] = 0.f;
    u32x4 qn[4]; f32x4 fn[8]; float vn; int rown = seq_row(b, dir, 0);
#pragma unroll
    for (int i = 0; i < 4; ++i) qn[i] = *(const u32x4*)(qa + (size_t)rown * AW + 8 * i);
#pragma unroll
    for (int i = 0; i < 8; ++i) fn[i] = *(const f32x4*)(lf + (size_t)rown * AW + 4 * i);
    vn = bf2f(va[(size_t)rown * AW]);
    for (int s = 0; s < CTXL + SEQ; ++s) {
        u32x4 qc[4]; f32x4 fc[8]; const float vc = vn; const int row = rown;
#pragma unroll
        for (int i = 0; i < 4; ++i) qc[i] = qn[i];
#pragma unroll
        for (int i = 0; i < 8; ++i) fc[i] = fn[i];
        if (s + 1 < CTXL + SEQ) { rown = seq_row(b, dir, s + 1);
#pragma unroll
            for (int i = 0; i < 4; ++i) qn[i] = *(const u32x4*)(qa + (size_t)rown * AW + 8 * i);
#pragma unroll
            for (int i = 0; i < 8; ++i) fn[i] = *(const f32x4*)(lf + (size_t)rown * AW + 4 * i);
            vn = bf2f(va[(size_t)rown * AW]); }
        float o = 0.f;
#pragma unroll
        for (int i = 0; i < 32; ++i) { const float f = __expf(fc[i >> 2][i & 3]); const unsigned qw = qc[i >> 3][(i >> 1) & 3]; const float q = (i & 1) ? bfhi(qw) : bflo(qw);
            S[i] = f * (S[i] - vc) + vc; o += S[i] * q; }
        o += __shfl_xor(o, 16); o += __shfl_xor(o, 32);
        if (kq == 0) oa[(size_t)row * AW] = (bf16)f2bf(o);
    }
}
__device__ __forceinline__ void gdn_wave(int wi, int lane, const bf16* QB, const bf16* KB, const bf16* VB, const float* GB, bf16* OB) {
    const int chain = wi >> 3, cg = wi & 7, b = chain >> 4, h = (chain >> 1) & 7, dir = chain & 1, kq = lane >> 4, col = cg * 16 + (lane & 15);
    const bf16* qb = QB + h * 128 + kq * 32; const bf16* kb = KB + h * 128 + kq * 32; const bf16* vb = VB + h * 128 + col; const float* gb = GB + dir * 8 + h; bf16* ob = OB + (size_t)dir * M * AW + h * 128 + col;
    float S[32];
#pragma unroll
    for (int i = 0; i < 32; ++i) S[i] = 0.f;
    u32x4 qn[4], kn[4]; float vn, gn, bn; int rown = seq_row(b, dir, 0);
#pragma unroll
    for (int i = 0; i < 4; ++i) { qn[i] = *(const u32x4*)(qb + (size_t)rown * AW + 8 * i); kn[i] = *(const u32x4*)(kb + (size_t)rown * AW + 8 * i); }
    vn = bf2f(vb[(size_t)rown * AW]); gn = gb[(size_t)rown * 32]; bn = gb[(size_t)rown * 32 + 16];
    for (int s = 0; s < CTXL + SEQ; ++s) {
        u32x4 qc[4], kc[4]; const float vc = vn, gc = gn, bc = bn; const int row = rown;
#pragma unroll
        for (int i = 0; i < 4; ++i) { qc[i] = qn[i]; kc[i] = kn[i]; }
        if (s + 1 < CTXL + SEQ) { rown = seq_row(b, dir, s + 1);
#pragma unroll
            for (int i = 0; i < 4; ++i) { qn[i] = *(const u32x4*)(qb + (size_t)rown * AW + 8 * i); kn[i] = *(const u32x4*)(kb + (size_t)rown * AW + 8 * i); }
            vn = bf2f(vb[(size_t)rown * AW]); gn = gb[(size_t)rown * 32]; bn = gb[(size_t)rown * 32 + 16]; }
        const float al = __expf(gc); float ks = 0.f; float kk[32];
#pragma unroll
        for (int i = 0; i < 32; ++i) { const unsigned kw = kc[i >> 3][(i >> 1) & 3]; kk[i] = (i & 1) ? bfhi(kw) : bflo(kw); ks += kk[i] * S[i]; }
        ks += __shfl_xor(ks, 16); ks += __shfl_xor(ks, 32);
        const float dl = bc * (vc - al * ks); float o = 0.f;
#pragma unroll
        for (int i = 0; i < 32; ++i) { const unsigned qw = qc[i >> 3][(i >> 1) & 3]; const float q = (i & 1) ? bfhi(qw) : bflo(qw); S[i] = al * S[i] + kk[i] * dl; o += S[i] * q; }
        o += __shfl_xor(o, 16); o += __shfl_xor(o, 32);
        if (kq == 0) ob[(size_t)row * AW] = (bf16)f2bf(o);
    }
}
__device__ __forceinline__ void ph_even_scan(Frame& F, const Args& a) {
    unsigned char* ws = a.ws;
    if (F.wave == 0) { for (int wi = blockIdx.x; wi < 256; wi += F.G) hgrn_wave(wi, F.lane, (const bf16*)(ws + WS_QA), (const float*)(ws + WS_LF), (const bf16*)(ws + WS_VA), (bf16*)(ws + WS_OA)); }
    else if (F.wave == 1) { for (int wi = blockIdx.x; wi < 256; wi += F.G) gdn_wave(wi, F.lane, (const bf16*)(ws + WS_QB), (const bf16*)(ws + WS_KB), (const bf16*)(ws + WS_VB), (const float*)(ws + WS_GB), (bf16*)(ws + WS_OB)); }
}
constexpr int N_PHASES = 3 + 10 * DEPTH;
__host__ __device__ constexpr bool phase_used(int ph) { return ph < 3 ? true : !((((ph - 3) / 10) & 1) == 0 && ((ph - 3) % 10) == 4); }

__global__ void __launch_bounds__(NTHREADS, 2) fwd(Args args) {
    extern __shared__ __attribute__((aligned(16))) unsigned char lds[];
    Frame F;
    F.lds = (LAS unsigned char*)lds; F.tid = threadIdx.x; F.lane = F.tid & 63; F.wave = __builtin_amdgcn_readfirstlane(F.tid >> 6);
    F.G = gridDim.x; F.gw = F.wave * F.G + blockIdx.x; F.NGW = F.G * NWAVES;
    for (int u = F.tid; u < (LDS_BYTES - LDSCTL_OFF) / 4; u += NTHREADS) ((LAS unsigned*)(F.lds + LDSCTL_OFF))[u] = 0u;
    __syncthreads();
    const int lo = args.ph_lo, hi = args.ph_hi; const bool multi = (hi - lo) > 1;
    unsigned char* ws = args.ws;
    XcdBarrier bar; bar.bar = (unsigned*)(ws + WS_CTL) + CW_BAR; bar.x = 0; bar.st = nullptr;
    if (multi) bar = xcd_barrier_post((unsigned*)(ws + WS_CTL) + CW_BAR, (volatile LAS unsigned*)(F.lds + MISC_OFF) + 8);
#ifndef PH_SITES
#define PH_SITES 0x1ffff
#endif
#define SITE(n) ((PH_SITES >> (n)) & 1)
#define IN(k) (lo <= (k) && (k) < hi)
#define LAUNDER() do { asm volatile("" : "+v"(F.tid), "+v"(F.lane)); } while (0)
#define SEAM() do { if (multi) xcd_barrier(bar); } while (0)
    bf16* HX = (bf16*)(ws + WS_HX); bf16* MIX = (bf16*)(ws + WS_MIX); float* XA = (float*)(ws + WS_XA); float* Z = (float*)(ws + WS_Z); bf16* ACT = (bf16*)(ws + WS_ACT);
    LAS unsigned char* ring = F.lds + RING_OFF;

    if (SITE(0) && IN(0)) { LAUNDER(); ph_prologue(F, args); SEAM(); }
    if (SITE(1) && IN(1)) { LAUNDER(); ph_modreduce(F, args); SEAM(); }
    if (SITE(2) && IN(2)) { LAUNDER(); ph_mod0(F, args); SEAM(); }
#pragma unroll 1
    for (int l = 0; l < DEPTH; ++l) {
        const int base = 3 + 10 * l, j = l >> 1; const bool last = (l == DEPTH - 1); const int Mo = last ? MX : M;
        const float* MODL = (const float*)(ws + WS_MOD) + (size_t)l * 3 * 12288;
        if ((l & 1) == 0) {
            if (SITE(3) && IN(base + 0)) {
                pg8::Gemm g{HX, (const bf16*)(ws + WS_WINE + j * SZ_WINE), M, NE_INP, D, D, D}; pg8::StaticOrder S; S.init(M, NE_INP, F.G, (int)blockIdx.x);
                EpiEven1 E{(bf16*)(ws + WS_QA), (bf16*)(ws + WS_VA), (bf16*)(ws + WS_GA), (bf16*)(ws + WS_ZB), (bf16*)(ws + WS_QKVB), (float*)(ws + WS_LF), (float*)(ws + WS_GB),
                           (const float*)(ws + WS_LB) + j * AW, args.in[12] + j * 16, args.in[13] + j * 16};
                pg8::gemm_phase<EpiEven1, pg8::StaticOrder, true, true>(ring, g, S, E); SEAM(); }
            if (SITE(4) && IN(base + 1)) { LAUNDER(); ph_gdn_prep(F, args, j); SEAM(); }
            if (SITE(5) && IN(base + 2)) { LAUNDER(); ph_even_scan(F, args); SEAM(); }
            if (SITE(6) && IN(base + 3)) { LAUNDER(); ph_merge(F, args, j); SEAM(); }
        } else {
            if (SITE(7) && IN(base + 0)) {
                pg8::Gemm g{HX, (const bf16*)(ws + WS_WINO + j * SZ_WINO), M, 2 * D, D, D, D}; pg8::StaticOrder S; S.init(M, 2 * D, F.G, (int)blockIdx.x);
                EpiOdd1 E{(bf16*)(ws + WS_GY), (bf16*)(ws + WS_XBR)};
                pg8::gemm_phase<EpiOdd1, pg8::StaticOrder, true, true>(ring, g, S, E); SEAM(); }
            if (SITE(8) && IN(base + 1)) { LAUNDER(); ph_odd_conv(F, args, j); SEAM(); }
            if (SITE(9) && IN(base + 2)) {
                pg8::Gemm g{(const bf16*)(ws + WS_XC), (const bf16*)(ws + WS_WGATE + j * SZ_WGATE), M, 8192, 256, D, 256}; pg8::GateOrder S; S.init(M, F.G, (int)blockIdx.x);
                EpiGates E{(const bf16*)(ws + WS_XC), (unsigned*)(ws + WS_AB), args.in[22] + (size_t)j * 4 * D, args.in[23] + (size_t)j * 2 * D};
                pg8::gemm_phase<EpiGates, pg8::GateOrder, true, true>(ring, g, S, E); SEAM(); }
            if (SITE(10) && IN(base + 3)) { LAUNDER(); ph_odd_scan(F, args); SEAM(); }
            if (SITE(11) && IN(base + 4)) { LAUNDER(); ph_odd_mix(F, args); SEAM(); }
        }
        if (SITE(12) && IN(base + 5)) {
            pg8::Gemm g{MIX, (const bf16*)((l & 1) ? ws + WS_WOUTO + j * SZ_WSQ : ws + WS_WOUTE + j * SZ_WSQ), Mo, D, D, D, D}; pg8::StaticOrder S; S.init(Mo, D, F.G, (int)blockIdx.x);
            EpiResid E{l == 0 ? args.in[0] : XA, l == 0 ? args.in[2] : XA + (size_t)MX * D, Z, MODL + 2 * D, l & 1};
            pg8::gemm_phase<EpiResid, pg8::StaticOrder, true, true>(ring, g, S, E); SEAM(); }
        if (SITE(13) && IN(base + 6)) { LAUNDER(); ph_ln(F, Z, Mo, args.in[6] + (size_t)(l * 2) * D, args.in[7] + (size_t)(l * 2) * D, nullptr, HX, MODL + 3 * D, MODL + 4 * D, 0); SEAM(); }
        if (SITE(14) && IN(base + 7)) {
            pg8::Gemm g{HX, (const bf16*)(ws + WS_WGU + l * SZ_WGU), Mo, 2 * FF, D, D, D}; pg8::StaticOrder S; S.init(Mo, 2 * FF, F.G, (int)blockIdx.x);
            EpiSwiGLU E{ACT};
            pg8::gemm_phase<EpiSwiGLU, pg8::StaticOrder, true, true>(ring, g, S, E); SEAM(); }
        if (SITE(15) && IN(base + 8)) {
            pg8::Gemm g{ACT, (const bf16*)(ws + WS_WDN + l * SZ_WDN), Mo, D, FF, FF, FF}; pg8::StaticOrder S; S.init(Mo, D, F.G, (int)blockIdx.x);
            EpiResid E{Z, Z + (size_t)MX * D, XA, MODL + 5 * D, 0};
            pg8::gemm_phase<EpiResid, pg8::StaticOrder, true, true>(ring, g, S, E); SEAM(); }
        if (SITE(16) && IN(base + 9)) {
            const float* g1 = args.in[6] + (size_t)(l * 2 + 1) * D; const float* b1 = args.in[7] + (size_t)(l * 2 + 1) * D;
            LAUNDER(); if (last) ph_ln(F, XA, MX, g1, b1, args.out, nullptr, nullptr, nullptr, 0);
            else { LAUNDER(); ph_ln(F, XA, M, g1, b1, nullptr, HX, MODL + 3 * 12288, MODL + 3 * 12288 + D, (l + 1) & 1); SEAM(); } }
    }
#undef IN
#undef SEAM
}

extern "C" void kernel_launch(void* const* d_in, const int* in_sizes, int n_in, void* d_out, int out_size, void* d_ws, size_t ws_size, hipStream_t stream) {
    static int grid = 0;
    if (grid == 0) {
        if (n_in != 25 || in_sizes[0] != MX * D || out_size != MX * D || ws_size < WS_END) { fprintf(stderr, "kernel_launch: unexpected shapes (n_in %d, in0 %d, out %d, ws %zu < %zu); nothing launched\n", n_in, n_in > 0 ? in_sizes[0] : -1, out_size, ws_size, (size_t)WS_END); grid = -1; return; }
        int dev = 0, cus = 0, per_cu = 0;
        if (hipGetDevice(&dev) != hipSuccess || hipDeviceGetAttribute(&cus, hipDeviceAttributeMultiprocessorCount, dev) != hipSuccess) { grid = -1; return; }
        if (hipFuncSetAttribute((const void*)fwd, hipFuncAttributeMaxDynamicSharedMemorySize, LDS_BYTES) != hipSuccess) { fprintf(stderr, "kernel_launch: hipFuncSetAttribute failed\n"); grid = -1; return; }
        if (hipOccupancyMaxActiveBlocksPerMultiprocessor(&per_cu, (const void*)fwd, NTHREADS, LDS_BYTES) != hipSuccess || per_cu < 1) { fprintf(stderr, "kernel_launch: occupancy query says %d\n", per_cu); }
        (void)hipGetLastError();
        grid = cus;
    }
    if (grid < 0) return;
    if (hipMemsetAsync((char*)d_ws + WS_CTL, 0, CTL_ZERO_BYTES, stream) != hipSuccess) return;
    Args a{};
    for (int i = 0; i < 25; ++i) a.in[i] = (const float*)d_in[i];
    a.out = (float*)d_out; a.ws = (unsigned char*)d_ws;
#if MK_ONE_LAUNCH
    a.ph_lo = 0; a.ph_hi = N_PHASES;
    hipLaunchKernelGGL(fwd, dim3(grid), dim3(NTHREADS), LDS_BYTES, stream, a);
#else
    for (int ph = 0; ph < N_PHASES; ++ph) { if (!phase_used(ph)) continue; a.ph_lo = ph; a.ph_hi = ph + 1;
        hipLaunchKernelGGL(fwd, dim3(grid), dim3(NTHREADS), LDS_BYTES, stream, a); }
#endif
}
```

```cpp
#include <hip/hip_runtime.h>
#include <cstdio>
#include <cstdint>
#ifndef MK_ONE_LAUNCH
#define MK_ONE_LAUNCH 1
#endif
namespace pg8 {
#define PG8_LAS __attribute__((address_space(3)))
typedef unsigned short bf16_t;
typedef short bf16x8 __attribute__((ext_vector_type(8)));
typedef float f32x4 __attribute__((ext_vector_type(4)));
typedef unsigned u32x4 __attribute__((ext_vector_type(4)));
typedef unsigned u32x2 __attribute__((ext_vector_type(2)));
constexpr int BM = 256, BK = 64, HALF = 128, HTB = HALF * BK * 2  , STAGE_BYTES = 8 * HTB, NXCD = 8, WGM = 8;
__host__ __device__ __forceinline__ int lds_byte(int r, int c) { const int st = (r >> 4) * 2 + (c >> 5), rr = r & 15, cc = c & 31, ob = rr * 64 + cc * 2; return st * 1024 + (ob ^ (((ob >> 9) & 1) << 5)); }
__host__ __device__ __forceinline__ void stage_rc(int b, int& R, int& C) { const int st = b / 1024, sb = b % 1024, swz = sb ^ (((sb >> 9) & 1) << 5); R = (st >> 1) * 16 + swz / 64; C = (st & 1) * 32 + (swz % 64) / 2; }
__host__ __device__ __forceinline__ int perm32(int rho) { const int n = rho >> 4, i = rho & 15; return 8 * (i >> 2) + 4 * n + (i & 3); }

struct Unit { int pm, pn, ka; };
struct Gemm { const bf16_t* A; const bf16_t* Bt; int M, N, K, lda, ldb; };

struct StaticOrder {
    int nM, nN, nwg, G, c;
    __host__ __device__ void init(int M, int N, int G_, int c_) { nM = M / BM; nN = N / BM; nwg = nM * nN; G = G_; c = c_; }
    __host__ __device__ bool next(int i, Unit& u) const {
        const long L = (long)i * G + c; if (L >= nwg) return false;
        int wgid = (int)L; { const int q = nwg / NXCD, r = nwg % NXCD, xcd = wgid % NXCD, off = wgid / NXCD; wgid = (xcd < r ? xcd * (q + 1) : r * (q + 1) + (xcd - r) * q) + off; }
        const int nig = WGM * nN, gid = wgid / nig, fm = gid * WGM, gsz = (nM - fm) < WGM ? (nM - fm) : WGM;
        u.pm = fm + ((wgid % nig) % gsz); u.pn = (wgid % nig) / gsz; u.ka = 0; return true;
    }
    __device__ __forceinline__ void a_ready(const Unit&) const {}
    __device__ __forceinline__ void done(const Unit&) const {}
};
struct GateOrder {
    int nM, nwg, G, c;
    __host__ __device__ void init(int M, int G_, int c_) { nM = M / BM; nwg = nM * 32; G = G_; c = c_; }
    __host__ __device__ bool next(int i, Unit& u) const {
        const long L = (long)i * G + c; if (L >= nwg) return false;
        const int l = (int)L, pn4 = l & 3, pm = (l >> 2) % nM, nb = (l >> 2) / nM;
        u.pm = pm; u.pn = nb * 4 + pn4; u.ka = nb * 256; return true;
    }
    __device__ __forceinline__ void a_ready(const Unit&) const {}
    __device__ __forceinline__ void done(const Unit&) const {}
};
__device__ __forceinline__ unsigned cvt_pk_bf16(float lo, float hi) { unsigned r; asm volatile("v_cvt_pk_bf16_f32 %0, %1, %2" : "=v"(r) : "v"(lo), "v"(hi)); return r; }
template <class Epi, class Sched, bool ALIGN_EPI = false, bool SP2 = false>
__device__ __forceinline__ void gemm_phase(PG8_LAS unsigned char* lds, const Gemm g, const Sched& S, const Epi& E) {
    int tid = threadIdx.x; asm volatile("" : "+v"(tid)); const int wid = __builtin_amdgcn_readfirstlane(tid >> 6), lane = tid & 63, wr = wid >> 2, wc = wid & 3, fr = lane & 15, fq = lane >> 4;
    int nt = g.K / BK; asm volatile("" : "+s"(nt));
    unsigned voffA[2], voffB[2];
#pragma unroll
    for (int i = 0; i < 2; ++i) { int R, C; stage_rc(tid * 16 + i * 8192, R, C); const int Rb = Epi::PERM ? ((R & ~31) + perm32(R & 31)) : R;
        voffA[i] = (unsigned)(R * g.lda + C) * 2u; voffB[i] = (unsigned)(Rb * g.ldb + C) * 2u; }
    const size_t kstep = (size_t)(BK * 2);
    const size_t hstepA = (size_t)HALF * g.lda * 2, hstepB = (size_t)HALF * g.ldb * 2;
    const size_t tstepA = 2 * hstepA, tstepB = 2 * hstepB;
    const unsigned ldsw = (unsigned)wid * 1024u;
    const int aoff = lds_byte(wr * 64 + fr, fq * 8), boff = lds_byte(wc * 32 + fr, fq * 8);
#define PG8_SA(b, h) (((b) * 2 + (h)) * HTB)
#define PG8_SB(b, h) ((4 + (b) * 2 + (h)) * HTB)
#define PG8_STAGE(bufoff, gbase, voff) do { _Pragma("unroll") for (int _i = 0; _i < 2; ++_i) \
        __builtin_amdgcn_global_load_lds((const unsigned*)((const char*)(gbase) + (voff)[_i]), (PG8_LAS unsigned*)(lds + (bufoff) + ldsw + _i * 8192), 16, 0, 0); } while (0)
#define PG8_LDA(dst, b, h) do { _Pragma("unroll") for (int m = 0; m < 4; ++m) _Pragma("unroll") for (int k = 0; k < 2; ++k) dst[m][k] = *(const PG8_LAS bf16x8*)(lds + PG8_SA(b, h) + aoff + m * 2048 + k * 1024); } while (0)
#define PG8_LDB(dst, b, h) do { _Pragma("unroll") for (int n = 0; n < 2; ++n) _Pragma("unroll") for (int k = 0; k < 2; ++k) dst[n][k] = *(const PG8_LAS bf16x8*)(lds + PG8_SB(b, h) + boff + n * 2048 + k * 1024); } while (0)
#define PG8_MMA(ai, bj, At, Bt) do { __builtin_amdgcn_s_setprio(1); _Pragma("unroll") for (int m = 0; m < 4; ++m) _Pragma("unroll") for (int n = 0; n < 2; ++n) _Pragma("unroll") for (int k = 0; k < 2; ++k) \
        acc[ai][bj][m][n] = __builtin_amdgcn_mfma_f32_16x16x32_bf16(Bt[n][k], At[m][k], acc[ai][bj][m][n], 0, 0, 0); __builtin_amdgcn_s_setprio(0); } while (0)
#define PG8_WAIT_V(n) asm volatile("s_waitcnt vmcnt(" #n ")" ::: "memory")
#define PG8_WAIT_L(n) asm volatile("s_waitcnt lgkmcnt(" #n ")" ::: "memory")
#define PG8_BAR __builtin_amdgcn_s_barrier()
#define PG8_SCHED __builtin_amdgcn_sched_barrier(0)
    Unit cur, nxt; int ui = 0;
    if (!S.next(0, cur)) return;
    f32x4 acc[2][2][4][2];
#pragma unroll
    for (int a = 0; a < 2; ++a)
#pragma unroll
        for (int b = 0; b < 2; ++b)
#pragma unroll
            for (int m = 0; m < 4; ++m)
#pragma unroll
                for (int n = 0; n < 2; ++n) acc[a][b][m][n] = (f32x4){0.f, 0.f, 0.f, 0.f};
    bf16x8 At[4][2], B0[2][2], B1[2][2];
    const char* cA = (const char*)g.A + (size_t)cur.pm * tstepA + (size_t)cur.ka * 2; const char* cB = (const char*)g.Bt + (size_t)cur.pn * tstepB;
    S.a_ready(cur);
    if constexpr (SP2) {
        PG8_STAGE(PG8_SB(0, 0), cB, voffB); PG8_STAGE(PG8_SB(0, 1), cB + hstepB, voffB); PG8_STAGE(PG8_SA(0, 0), cA, voffA); PG8_STAGE(PG8_SA(0, 1), cA + hstepA, voffA);
        if (wr == 1) PG8_BAR;
        PG8_WAIT_V(2); PG8_BAR;
        PG8_STAGE(PG8_SB(1, 0), cB + kstep, voffB); PG8_STAGE(PG8_SA(1, 0), cA + kstep, voffA); PG8_STAGE(PG8_SB(1, 1), cB + hstepB + kstep, voffB);
        PG8_WAIT_V(6); PG8_BAR;
    } else {
        PG8_STAGE(PG8_SB(0, 0), cB, voffB); PG8_STAGE(PG8_SA(0, 0), cA, voffA); PG8_STAGE(PG8_SB(0, 1), cB + hstepB, voffB); PG8_STAGE(PG8_SA(0, 1), cA + hstepA, voffA);
        if (wr == 1) PG8_BAR;
        PG8_WAIT_V(4); PG8_BAR;
        PG8_STAGE(PG8_SB(1, 0), cB + kstep, voffB); PG8_STAGE(PG8_SA(1, 0), cA + kstep, voffA); PG8_STAGE(PG8_SB(1, 1), cB + hstepB + kstep, voffB);
        PG8_WAIT_V(6); PG8_BAR;
    }
    for (;;) {
        const bool has_next = S.next(ui + 1, nxt);
        const char* nA = has_next ? (const char*)g.A + (size_t)nxt.pm * tstepA + (size_t)nxt.ka * 2 : cA; const char* nB = has_next ? (const char*)g.Bt + (size_t)nxt.pn * tstepB : cB;
        for (int t = 0; t < nt; t += 2) {
            const bool last = (t == nt - 2);
            const char* a1 = cA + (size_t)(t + 1) * kstep;
            const char* a2 = last ? nA : cA + (size_t)(t + 2) * kstep; const char* b2 = last ? nB : cB + (size_t)(t + 2) * kstep;
            const char* a3 = a2 + kstep; const char* b3 = b2 + kstep;
            if (last && has_next) S.a_ready(nxt);
            if constexpr (SP2) {
            PG8_LDB(B0, 0, 0); PG8_LDB(B1, 0, 1); PG8_SCHED; PG8_LDA(At, 0, 0); PG8_STAGE(PG8_SA(1, 1), a1 + hstepA, voffA);
            PG8_WAIT_V(8); PG8_WAIT_L(0); PG8_BAR; PG8_MMA(0, 0, At, B0); PG8_MMA(0, 1, At, B1); PG8_BAR; PG8_SCHED;
            PG8_LDA(At, 0, 1); PG8_STAGE(PG8_SB(0, 0), b2, voffB); PG8_STAGE(PG8_SB(0, 1), b2 + hstepB, voffB); PG8_STAGE(PG8_SA(0, 0), a2, voffA);
            PG8_WAIT_V(8); PG8_WAIT_L(0); PG8_BAR; PG8_MMA(1, 0, At, B0); PG8_MMA(1, 1, At, B1); PG8_BAR; PG8_SCHED;
            PG8_LDB(B0, 1, 0); PG8_LDB(B1, 1, 1); PG8_SCHED; PG8_LDA(At, 1, 0); PG8_STAGE(PG8_SA(0, 1), a2 + hstepA, voffA);
            PG8_WAIT_V(8); PG8_WAIT_L(0); PG8_BAR; PG8_MMA(0, 0, At, B0); PG8_MMA(0, 1, At, B1); PG8_BAR; PG8_SCHED;
            PG8_LDA(At, 1, 1); PG8_STAGE(PG8_SB(1, 0), b3, voffB); PG8_STAGE(PG8_SB(1, 1), b3 + hstepB, voffB); PG8_STAGE(PG8_SA(1, 0), a3, voffA);
            PG8_WAIT_V(8); PG8_WAIT_L(0); PG8_BAR; PG8_MMA(1, 0, At, B0); PG8_MMA(1, 1, At, B1); PG8_BAR; PG8_SCHED;
            } else {
            PG8_LDB(B0, 0, 0); PG8_SCHED; PG8_LDA(At, 0, 0); PG8_STAGE(PG8_SA(1, 1), a1 + hstepA, voffA);
            PG8_WAIT_L(8); PG8_BAR; PG8_WAIT_L(0); PG8_MMA(0, 0, At, B0); PG8_BAR; PG8_SCHED;
            PG8_LDB(B1, 0, 1); PG8_STAGE(PG8_SB(0, 0), b2, voffB);
            PG8_BAR; PG8_WAIT_L(0); PG8_MMA(0, 1, At, B1); PG8_BAR;
            PG8_LDA(At, 0, 1); PG8_STAGE(PG8_SA(0, 0), a2, voffA);
            PG8_BAR; PG8_WAIT_L(0); PG8_MMA(1, 0, At, B0); PG8_BAR; PG8_SCHED;
            PG8_STAGE(PG8_SB(0, 1), b2 + hstepB, voffB);
            PG8_WAIT_V(6); PG8_BAR; PG8_MMA(1, 1, At, B1); PG8_BAR;
            PG8_LDB(B0, 1, 0); PG8_SCHED; PG8_LDA(At, 1, 0); PG8_STAGE(PG8_SA(0, 1), a2 + hstepA, voffA);
            PG8_WAIT_L(8); PG8_BAR; PG8_WAIT_L(0); PG8_MMA(0, 0, At, B0); PG8_BAR; PG8_SCHED;
            PG8_LDB(B1, 1, 1); PG8_STAGE(PG8_SB(1, 0), b3, voffB);
            PG8_BAR; PG8_WAIT_L(0); PG8_MMA(0, 1, At, B1); PG8_BAR;
            PG8_LDA(At, 1, 1); PG8_STAGE(PG8_SA(1, 0), a3, voffA);
            PG8_BAR; PG8_WAIT_L(0); PG8_MMA(1, 0, At, B0); PG8_BAR; PG8_SCHED;
            PG8_STAGE(PG8_SB(1, 1), b3 + hstepB, voffB);
            PG8_WAIT_V(6); PG8_BAR; PG8_MMA(1, 1, At, B1); PG8_BAR;
            }
        }
        if constexpr (ALIGN_EPI) { if (wr == 0) PG8_BAR; }
        if constexpr (!Epi::AFTER_DRAIN) { E(acc, cur, wr, wc, fr, fq); S.done(cur); }
        if (!has_next) break;
#pragma unroll
        for (int a = 0; a < 2; ++a)
#pragma unroll
            for (int b = 0; b < 2; ++b)
#pragma unroll
                for (int m = 0; m < 4; ++m)
#pragma unroll
                    for (int n = 0; n < 2; ++n) acc[a][b][m][n] = (f32x4){0.f, 0.f, 0.f, 0.f};
        cur = nxt; cA = nA; cB = nB; ++ui;
        if constexpr (ALIGN_EPI) { if (wr == 1) PG8_BAR; }
    }
    PG8_WAIT_V(0);
    if constexpr (!ALIGN_EPI) { if (wr == 0) PG8_BAR; }
    PG8_BAR;
    if constexpr (Epi::AFTER_DRAIN) { E.fused(acc, cur, wr, wc, fr, fq, lds, wid, lane); S.done(cur); }
#undef PG8_SA
#undef PG8_SB
#undef PG8_STAGE
#undef PG8_LDA
#undef PG8_LDB
#undef PG8_MMA
#undef PG8_WAIT_V
#undef PG8_WAIT_L
#undef PG8_BAR
#undef PG8_SCHED
}
}
using pg8::bf16_t; using pg8::f32x4; using pg8::u32x4; using pg8::u32x2; using pg8::Unit; using pg8::cvt_pk_bf16;

constexpr int D = 2048, NBATCH = 2, SEQ = 8192, CTXL = 256, DEPTH = 4;
constexpr int MX = NBATCH * SEQ;
constexpr int MC = NBATCH * CTXL;
constexpr int M = MX + MC;
constexpr int NE_IN = 9248, NE_INP = 9472, FF = 5632, AW = 1024;
constexpr int NWAVES = 8, NTHREADS = 512;
constexpr float LN_EPS = 1e-6f, DN_ALPHA = 1.681792830507429f;
constexpr float QSCALE = 0.08838834764831845f;

constexpr size_t MiB = 1u << 20;
constexpr size_t al256(size_t x) { return (x + 255) & ~(size_t)255; }
constexpr size_t WS_CTL = 0, CTL_ZERO_BYTES = 1 * MiB;
constexpr size_t WS_MOD = 1 * MiB;
constexpr size_t WS_LB = 2 * MiB;
constexpr size_t WS_PART = 3 * MiB;
constexpr size_t WS_W0 = 8 * MiB;
constexpr size_t SZ_WINE = (size_t)NE_INP * D * 2, SZ_WSQ = (size_t)D * D * 2, SZ_WINO = (size_t)2 * D * D * 2, SZ_WGATE = (size_t)8192 * 256 * 2, SZ_WGU = (size_t)2 * FF * D * 2, SZ_WDN = (size_t)D * FF * 2;
constexpr size_t WS_WINE = WS_W0;
constexpr size_t WS_WOUTE = WS_WINE + 2 * SZ_WINE;
constexpr size_t WS_WINO = WS_WOUTE + 2 * SZ_WSQ;
constexpr size_t WS_WGATE = WS_WINO + 2 * SZ_WINO;
constexpr size_t WS_WOUTO = WS_WGATE + 2 * SZ_WGATE;
constexpr size_t WS_WGU = WS_WOUTO + 2 * SZ_WSQ;
constexpr size_t WS_WDN = WS_WGU + 4 * SZ_WGU;
constexpr size_t WS_XA = al256(WS_WDN + 4 * SZ_WDN);
constexpr size_t SZ_F32ROW = (size_t)M * D * 4, SZ_BF16ROW = (size_t)M * D * 2, SZ_BF16HALF = (size_t)M * AW * 2;
constexpr size_t WS_Z = WS_XA + SZ_F32ROW;
constexpr size_t WS_HX = WS_Z + SZ_F32ROW;
constexpr size_t WS_MIX = WS_HX + SZ_BF16ROW;
constexpr size_t WS_MR = WS_MIX + SZ_BF16ROW;
constexpr size_t WS_QA = WS_MR, WS_VA = WS_QA + SZ_BF16HALF, WS_GA = WS_VA + SZ_BF16HALF, WS_ZB = WS_GA + SZ_BF16HALF;
constexpr size_t WS_LF = WS_ZB + SZ_BF16HALF;
constexpr size_t WS_QKVB = WS_LF + 2 * (size_t)M * AW * 4;
constexpr size_t WS_GB = WS_QKVB + (size_t)M * 3072 * 2;
constexpr size_t WS_QB = WS_GB + (size_t)M * 32 * 4, WS_KB = WS_QB + SZ_BF16HALF, WS_VB = WS_KB + SZ_BF16HALF;
constexpr size_t WS_OA = WS_VB + SZ_BF16HALF;
constexpr size_t WS_OB = WS_OA + 2 * SZ_BF16HALF;
constexpr size_t WS_EVEN_END = WS_OB + 2 * SZ_BF16HALF;
constexpr size_t WS_GY = WS_MR, WS_XBR = WS_GY + SZ_BF16ROW, WS_XC = WS_XBR + SZ_BF16ROW;
constexpr size_t WS_AB = WS_XC + SZ_BF16ROW;
constexpr size_t WS_R = WS_AB + 2 * (size_t)M * D * 4;
constexpr size_t WS_ODD_END = WS_R + 2 * SZ_BF16ROW;
constexpr size_t WS_ACT = WS_MR;
constexpr size_t WS_END = (WS_EVEN_END > WS_ODD_END ? WS_EVEN_END : WS_ODD_END);
static_assert(WS_ACT + (size_t)M * FF * 2 <= WS_END, "ACT fits the mixer region");
static_assert(WS_END <= (size_t)1560 * MiB, "workspace budget");
constexpr int CW_BAR = 4096;

constexpr int RING_OFF = 0, RING_BYTES = 131072;
constexpr int LDSCTL_OFF = RING_BYTES, MISC_OFF = LDSCTL_OFF + 320;
constexpr int LDS_BYTES = 147456;

#define GAS __attribute__((address_space(1)))
#define LAS __attribute__((address_space(3)))
typedef unsigned short bf16;
#define LDS_WAIT() asm volatile("s_waitcnt lgkmcnt(0)" ::: "memory")
#define VM_WAIT() asm volatile("s_waitcnt vmcnt(0)" ::: "memory")
__device__ __forceinline__ unsigned f2bf(float f) { unsigned u = __builtin_bit_cast(unsigned, f); return (u + 0x7fffu + ((u >> 16) & 1u)) >> 16; }
__device__ __forceinline__ unsigned pk2(float lo, float hi) { return f2bf(lo) | (f2bf(hi) << 16); }
__device__ __forceinline__ float bflo(unsigned u) { return __builtin_bit_cast(float, u << 16); }
__device__ __forceinline__ float bfhi(unsigned u) { return __builtin_bit_cast(float, u & 0xffff0000u); }
__device__ __forceinline__ float bf2f(bf16 h) { return __builtin_bit_cast(float, (unsigned)h << 16); }
__device__ __forceinline__ float sigm(float x) { return 1.f / (1.f + __expf(-x)); }
__device__ __forceinline__ float siluf(float x) { return x / (1.f + __expf(-x)); }
__device__ __forceinline__ float log1p_fast(float t) { const float p = t * (1.f + t * (-0.5f + t * (0.33333333f + t * (-0.25f + t * 0.2f)))); return t < 0.03f ? p : __logf(1.f + t); }
__device__ __forceinline__ float softplusf(float x) { return fmaxf(x, 0.f) + log1p_fast(__expf(-fabsf(x))); }
__device__ __forceinline__ float neg_expm1_fast(float x) { const float p = -x * (1.f + x * (0.5f + x * (0.16666667f + x * (0.041666668f + x * 0.0083333338f)))); return x > -0.25f ? p : 1.f - __expf(x); }
__device__ __forceinline__ float gelu_tanh(float x) { const float u = 0.7978845608028654f * (x + 0.044715f * x * x * x); return x / (1.f + __expf(-2.f * u)); }
__device__ __forceinline__ float wave_sum(float v) {
#pragma unroll
    for (int o = 1; o < 64; o <<= 1) v += __shfl_xor(v, o);
    return v;
}
__device__ __forceinline__ int mod_index(int row) { return row < SEQ ? 0 : (row < MX ? 1 : 2); }
__device__ __forceinline__ int perm_row(int r) { if (r >= MX) return r; const int b = r >> 13, t = r & 8191; return (b << 13) + ((t & 63) << 7) + (t >> 6); }
__device__ __forceinline__ int unperm_row(int r) { if (r >= MX) return r; const int b = r >> 13, i = r & 8191; return (b << 13) + ((i & 127) << 6) + (i >> 7); }
__device__ __forceinline__ int seq_row(int b, int dir, int s) {
    if (s < CTXL) { const int pos = dir ? (CTXL - 1 - s) : s; return MX + b * CTXL + pos; }
    const int p = s - CTXL, pos = dir ? (SEQ - 1 - p) : p; return b * SEQ + pos;
}
#define XB_TMO      128
#define XB_XCNT(j)  (256  + 64 * (j))
#define XB_XSUB(j)  (1280 + 64 * (j))
#define XB_XGEN(j)  (2304 + 64 * (j))
#define XB_TOP      3328
#define XB_TOPGEN   3392
#define XCD_BAR_WORDS 3456
#define XB_SPIN_CAP (1u << 18)

__device__ __forceinline__ unsigned xb_ld(unsigned* p)              { return __hip_atomic_load(p, __ATOMIC_RELAXED, __HIP_MEMORY_SCOPE_AGENT); }
__device__ __forceinline__ unsigned xb_add(unsigned* p, unsigned v) { return __hip_atomic_fetch_add(p, v, __ATOMIC_RELAXED, __HIP_MEMORY_SCOPE_AGENT); }
__device__ __forceinline__ unsigned xb_xcc_id() { return (unsigned)__builtin_amdgcn_s_getreg((3 << 11) | 20) & 0xFu; }
#define XB_SPIN(cond, bar) do { unsigned _sp = 0; while (cond) { __builtin_amdgcn_s_sleep(1); \
    if ((++_sp & 255u) == 0u) { if (xb_ld(&(bar)[XB_TMO])) break; if (_sp > XB_SPIN_CAP) { atomicAdd(&(bar)[XB_TMO], 1u); break; } } } } while (0)

struct XcdBarrier {
    unsigned* bar; unsigned x;
    volatile LAS unsigned* st;
};

__device__ __forceinline__ XcdBarrier xcd_barrier_post(unsigned* bar, volatile LAS unsigned* st) {
    XcdBarrier b; b.bar = bar; b.x = xb_xcc_id(); b.st = st;
    if (threadIdx.x == 0) (void)xb_add(&bar[XB_XCNT(b.x)], 1u);
    return b;
}
__device__ __forceinline__ void xcd_barrier_complete(unsigned* bar, unsigned x, unsigned& nloc, unsigned& nx) {
    const unsigned G = gridDim.x * gridDim.y * gridDim.z;
    unsigned sum, cnt, mine, sp = 0u;
    for (;;) {
        sum = 0u; cnt = 0u; mine = 0u;
#pragma unroll
        for (unsigned j = 0; j < 16; ++j) { const unsigned c = xb_ld(&bar[XB_XCNT(j)]); sum += c; cnt += (c > 0u) ? 1u : 0u; mine = (j == x) ? c : mine; }
        if (sum == G) break;
        __builtin_amdgcn_s_sleep(1);
        if ((++sp & 255u) == 0u) { if (xb_ld(&bar[XB_TMO])) break; if (sp > XB_SPIN_CAP) { atomicAdd(&bar[XB_TMO], 1u); break; } }
    }
    nloc = mine > 0u ? mine : 1u; nx = cnt > 0u ? cnt : 1u;
}

__device__ __forceinline__ void xcd_barrier(const XcdBarrier& b) {
    asm volatile("s_waitcnt vmcnt(0)" ::: "memory");
    __syncthreads();
    if (threadIdx.x == 0) {
        unsigned* bar = b.bar;
        __builtin_amdgcn_s_waitcnt(0);
        unsigned nloc = b.st[0], nx = b.st[1];
        if (nloc == 0u) { xcd_barrier_complete(bar, b.x, nloc, nx); b.st[0] = nloc; b.st[1] = nx; }
        const unsigned old = xb_add(&bar[XB_XSUB(b.x)], 1u);
        const unsigned gen = old / nloc;
        if (old + 1u == (gen + 1u) * nloc) {
            __builtin_amdgcn_fence(__ATOMIC_RELEASE, "agent");
            asm volatile("s_waitcnt vmcnt(0)" ::: "memory");
            const unsigned og = xb_add(&bar[XB_TOP], 1u);
            const unsigned tg = og / nx;
            if (og + 1u == (tg + 1u) * nx) xb_add(&bar[XB_TOPGEN], 1u);
            else XB_SPIN(xb_ld(&bar[XB_TOPGEN]) == tg, bar);
            __builtin_amdgcn_fence(__ATOMIC_ACQUIRE, "agent");
            xb_add(&bar[XB_XGEN(b.x)], 1u);
            asm volatile("s_waitcnt vmcnt(0)" ::: "memory");
        } else {
            XB_SPIN(xb_ld(&bar[XB_XGEN(b.x)]) == gen, bar);
            __builtin_amdgcn_fence(__ATOMIC_ACQUIRE, "agent");
            asm volatile("s_waitcnt vmcnt(0)" ::: "memory");
        }
    }
    __syncthreads();
}

struct EpiEven1 {
    static constexpr bool PERM = true, AFTER_DRAIN = false;
    bf16_t *QA, *VA, *GA, *ZB, *QKVB; float *LF, *GB; const float *lb, *a_log, *dt_bias;
    __device__ __forceinline__ void operator()(const f32x4 (&acc)[2][2][4][2], const Unit& u, int wr, int wc, int fr_, int fq_) const {
        int fr = fr_, fq = fq_; asm volatile("" : "+v"(fr), "+v"(fq));
        const int grp = u.pn >> 2, row0 = u.pm * 256 + wr * 64 + fr;
        if (grp == 9) {
            if (wc != 0) return;
            float al[8], db[8];
#pragma unroll
            for (int i = 0; i < 8; ++i) { const int c = (8 * fq + i) & 15; al[i] = -__expf(a_log[c]); db[i] = dt_bias[c]; }
#pragma unroll
            for (int ai = 0; ai < 2; ++ai)
#pragma unroll
                for (int m = 0; m < 4; ++m) { float* rowp = GB + (size_t)(row0 + ai * 128 + m * 16) * 32 + 8 * fq;
#pragma unroll
                    for (int n = 0; n < 2; ++n) { const f32x4 v = acc[ai][0][m][n]; f32x4 o;
#pragma unroll
                        for (int j = 0; j < 4; ++j) o[j] = (fq < 2) ? al[4 * n + j] * softplusf(v[j] + db[4 * n + j]) : sigm(v[j]);
                        *(f32x4*)(rowp + 4 * n) = o; } }
            return;
        }
        const int col0 = (u.pn & 3) * 256 + wc * 32 + 8 * fq;
        int op = 0, ld = 1024; bf16_t* dstb = VA; float* dstf = LF;
        switch (grp) {
            case 0: op = 2; dstb = QA; break;
            case 1: op = 0; dstb = VA; break;
            case 2: op = 3; dstf = LF; break;
            case 3: op = 3; dstf = LF + (size_t)M * 1024; break;
            case 4: op = 1; dstb = GA; break;
            case 5: case 6: case 7: op = 0; dstb = QKVB + (grp - 5) * 1024; ld = 3072; break;
            default: op = 1; dstb = ZB; break;
        }
        if (op == 3) {
#pragma unroll
            for (int bj = 0; bj < 2; ++bj) { float lbv[8];
#pragma unroll
                for (int i = 0; i < 8; ++i) lbv[i] = lb[col0 + bj * 128 + i];
#pragma unroll
                for (int ai = 0; ai < 2; ++ai)
#pragma unroll
                    for (int m = 0; m < 4; ++m) { float* rowp = dstf + (size_t)(row0 + ai * 128 + m * 16) * 1024 + col0 + bj * 128;
#pragma unroll
                        for (int n = 0; n < 2; ++n) { const f32x4 v = acc[ai][bj][m][n]; f32x4 o;
#pragma unroll
                            for (int j = 0; j < 4; ++j) { const float l = lbv[4 * n + j]; o[j] = __logf(l + (1.f - l) * sigm(v[j])); }
                            *(f32x4*)(rowp + 4 * n) = o; } } }
            return;
        }
#pragma unroll
        for (int ai = 0; ai < 2; ++ai)
#pragma unroll
            for (int m = 0; m < 4; ++m) { bf16_t* rowp = dstb + (size_t)(row0 + ai * 128 + m * 16) * ld + col0;
#pragma unroll
                for (int bj = 0; bj < 2; ++bj) { f32x4 v0 = acc[ai][bj][m][0], v1 = acc[ai][bj][m][1];
                    if (op >= 1) {
#pragma unroll
                        for (int j = 0; j < 4; ++j) { v0[j] = siluf(v0[j]); v1[j] = siluf(v1[j]); }
                        if (op == 2) { v0 = v0 * QSCALE; v1 = v1 * QSCALE; } }
                    u32x4 w; w.x = cvt_pk_bf16(v0[0], v0[1]); w.y = cvt_pk_bf16(v0[2], v0[3]); w.z = cvt_pk_bf16(v1[0], v1[1]); w.w = cvt_pk_bf16(v1[2], v1[3]);
                    *(u32x4*)(rowp + bj * 128) = w; } }
    }
};
struct EpiOdd1 {
    static constexpr bool PERM = true, AFTER_DRAIN = false;
    bf16_t *GY, *XBR;
    __device__ __forceinline__ void operator()(const f32x4 (&acc)[2][2][4][2], const Unit& u, int wr, int wc, int fr_, int fq_) const {
        int fr = fr_, fq = fq_; asm volatile("" : "+v"(fr), "+v"(fq));
        const int row0 = u.pm * 256 + wr * 64 + fr; const bool isy = u.pn < 8;
        bf16_t* dst = isy ? GY : XBR; const int col0 = (u.pn & 7) * 256 + wc * 32 + 8 * fq;
#pragma unroll
        for (int ai = 0; ai < 2; ++ai)
#pragma unroll
            for (int m = 0; m < 4; ++m) { bf16_t* rowp = dst + (size_t)(row0 + ai * 128 + m * 16) * D + col0;
#pragma unroll
                for (int bj = 0; bj < 2; ++bj) { f32x4 v0 = acc[ai][bj][m][0], v1 = acc[ai][bj][m][1];
                    if (isy) {
#pragma unroll
                        for (int j = 0; j < 4; ++j) { v0[j] = gelu_tanh(v0[j]); v1[j] = gelu_tanh(v1[j]); } }
                    u32x4 w; w.x = cvt_pk_bf16(v0[0], v0[1]); w.y = cvt_pk_bf16(v0[2], v0[3]); w.z = cvt_pk_bf16(v1[0], v1[1]); w.w = cvt_pk_bf16(v1[2], v1[3]);
                    *(u32x4*)(rowp + bj * 128) = w; } }
    }
};
struct EpiGates {
    static constexpr bool PERM = true, AFTER_DRAIN = false;
    const bf16_t* XC; unsigned* AB; const float *gate_b  , *lam  ;
    __device__ __forceinline__ void operator()(const f32x4 (&acc)[2][2][4][2], const Unit& u, int wr, int wc, int fr_, int fq_) const {
        int fr = fr_, fq = fq_; asm volatile("" : "+v"(fr), "+v"(fq));
        const int nb = u.pn >> 2, pn4 = u.pn & 3, d = pn4 >> 1, half = pn4 & 1;
        const int row0 = u.pm * 256 + wr * 64 + fr, ch0 = nb * 256 + half * 128 + wc * 32 + 8 * fq;
        unsigned* ab = AB + (size_t)d * M * D;
#pragma unroll
        for (int n = 0; n < 2; ++n) {
            const int ch = ch0 + 4 * n;
            const f32x4 gr = *(const f32x4*)(gate_b + (d * 2 + 0) * D + ch), gi = *(const f32x4*)(gate_b + (d * 2 + 1) * D + ch), lm = *(const f32x4*)(lam + d * D + ch);
            f32x4 sp;
#pragma unroll
            for (int j = 0; j < 4; ++j) sp[j] = -8.0f * softplusf(-lm[j]);
#pragma unroll
            for (int ai = 0; ai < 2; ++ai)
#pragma unroll
                for (int m = 0; m < 4; ++m) { const size_t ro = (size_t)(row0 + ai * 128 + m * 16) * D + ch;
                    const u32x2 xr = *(const u32x2*)(XC + ro); const float xc[4] = {bflo(xr.x), bfhi(xr.x), bflo(xr.y), bfhi(xr.y)};
                    u32x4 o;
#pragma unroll
                    for (int j = 0; j < 4; ++j) { const float r = sigm(acc[ai][0][m][n][j] + gr[j]), ig = sigm(acc[ai][1][m][n][j] + gi[j]);
                        const float la = r * sp[j], bb = __builtin_sqrtf(neg_expm1_fast(2.f * la)) * (ig * xc[j]); o[j] = pk2(la, bb); }
                    *(u32x4*)(ab + ro) = o; }
        }
    }
};
struct EpiResid {
    static constexpr bool PERM = false, AFTER_DRAIN = false;
    const float *r0, *r1; float* out; const float* gt; int permute;
    __device__ __forceinline__ void operator()(const f32x4 (&acc)[2][2][4][2], const Unit& u, int wr, int wc, int fr_, int fq_) const {
        int fr = fr_, fq = fq_; asm volatile("" : "+v"(fr), "+v"(fq));
        const int rowt = u.pm * 256, mi = mod_index(rowt), col0 = u.pn * 256 + wc * 32 + 4 * fq;
        f32x4 gv[2][2];
#pragma unroll
        for (int bj = 0; bj < 2; ++bj)
#pragma unroll
            for (int n = 0; n < 2; ++n) gv[bj][n] = *(const f32x4*)(gt + (size_t)mi * 12288 + col0 + bj * 128 + n * 16) + 1.0f;
#pragma unroll
        for (int ai = 0; ai < 2; ++ai)
#pragma unroll
            for (int m = 0; m < 4; ++m) { const int rr = rowt + ai * 128 + wr * 64 + m * 16 + fr, tok = permute ? unperm_row(rr) : rr;
                const float* rp = (tok < MX ? r0 + (size_t)tok * D : r1 + (size_t)(tok - MX) * D) + col0; float* op = out + (size_t)tok * D + col0;
#pragma unroll
                for (int bj = 0; bj < 2; ++bj)
#pragma unroll
                    for (int n = 0; n < 2; ++n) { const f32x4 rs = *(const f32x4*)(rp + bj * 128 + n * 16); *(f32x4*)(op + bj * 128 + n * 16) = rs * DN_ALPHA + gv[bj][n] * acc[ai][bj][m][n]; }
                asm volatile("" ::: "memory"); }
    }
};
struct EpiSwiGLU {
    static constexpr bool PERM = true, AFTER_DRAIN = false;
    bf16_t* ACT;
    __device__ __forceinline__ void operator()(const f32x4 (&acc)[2][2][4][2], const Unit& u, int wr, int wc, int fr_, int fq_) const {
        int fr = fr_, fq = fq_; asm volatile("" : "+v"(fr), "+v"(fq));
        const int row0 = u.pm * 256 + wr * 64 + fr, col0 = u.pn * 128 + wc * 32 + 8 * fq;
#pragma unroll
        for (int ai = 0; ai < 2; ++ai)
#pragma unroll
            for (int m = 0; m < 4; ++m) { f32x4 v0 = acc[ai][0][m][0], v1 = acc[ai][0][m][1]; const f32x4 u0 = acc[ai][1][m][0], u1 = acc[ai][1][m][1];
#pragma unroll
                for (int j = 0; j < 4; ++j) { v0[j] = siluf(v0[j]) * u0[j]; v1[j] = siluf(v1[j]) * u1[j]; }
                u32x4 w; w.x = cvt_pk_bf16(v0[0], v0[1]); w.y = cvt_pk_bf16(v0[2], v0[3]); w.z = cvt_pk_bf16(v1[0], v1[1]); w.w = cvt_pk_bf16(v1[2], v1[3]);
                *(u32x4*)(ACT + (size_t)(row0 + ai * 128 + m * 16) * FF + col0) = w; }
    }
};
struct Frame {
    LAS unsigned char* lds;
    int tid, lane, wave, G, gw, NGW;
};
struct Args { const float* in[25]; float* out; unsigned char* ws; int ph_lo, ph_hi; };

template <int MODE> __device__ __forceinline__ long src_off(int n, int nsrc) {
    if (MODE == 0) return n < nsrc ? (long)n : -1L;
    if (MODE == 1) { const int pn = n >> 8, bj = (n >> 7) & 1, jj = n & 127; return (long)bj * FF + pn * 128 + jj; }
    const int nb = n >> 10, c = n & 1023, pn4 = c >> 8, g = (c >> 7) & 1, jj = c & 127, d = pn4 >> 1, half = pn4 & 1;
    return (long)(((d * 2 + g) * 8 + nb) * 256) * 256 + half * 128 + jj;
}
template <int MODE> __device__ __forceinline__ void tr_item(const float* W, int ldin, int K, bf16* WT, int nout, int nsrc, LAS float* scr, int item, int lane) {
    const int nblk = nout / 32, kb = item / nblk, nb = item % nblk, k0 = 64 * kb, n0 = 32 * nb;
    const long off = src_off<MODE>(n0 + (lane & 31), nsrc);
#pragma unroll 8
    for (int i = 0; i < 32; ++i) { const int kk = 2 * i + (lane >> 5); scr[kk * 33 + (lane & 31)] = off >= 0 ? W[off + (size_t)(k0 + kk) * ldin] : 0.f; }
    LDS_WAIT(); asm volatile("" ::: "memory");
    const int c = lane & 7;
#pragma unroll
    for (int j = 0; j < 4; ++j) { const int n = (lane >> 3) + 8 * j; const LAS float* s = scr + (8 * c) * 33 + n;
        u32x4 o; o.x = pk2(s[0 * 33], s[1 * 33]); o.y = pk2(s[2 * 33], s[3 * 33]); o.z = pk2(s[4 * 33], s[5 * 33]); o.w = pk2(s[6 * 33], s[7 * 33]);
        *(u32x4*)(WT + (size_t)(n0 + n) * K + k0 + 8 * c) = o; }
    LDS_WAIT(); asm volatile("" ::: "memory");
}
__device__ __forceinline__ void gemv_item(const Args& a, int gi, int lane, float* PART) {
    const int l = gi / 384, c48 = (gi >> 3) % 48, kp = gi & 7, col = c48 * 256 + lane * 4;
    const float* W = a.in[4] + ((size_t)l * D + kp * 256) * 12288 + col;
    const float* c0 = a.in[1] + kp * 256; const float* c1 = c0 + D; const float* c2 = a.in[3] + kp * 256;
    f32x4 s0 = {0.f, 0.f, 0.f, 0.f}, s1 = s0, s2 = s0;
#pragma unroll 8
    for (int k = 0; k < 256; ++k) { const f32x4 w = *(const f32x4*)(W + (size_t)k * 12288); s0 += w * siluf(c0[k]); s1 += w * siluf(c1[k]); s2 += w * siluf(c2[k]); }
    float* p = PART + ((size_t)(kp * 4 + l) * 3) * 12288 + col;
    *(f32x4*)p = s0; *(f32x4*)(p + 12288) = s1; *(f32x4*)(p + 2 * 12288) = s2;
}
__device__ __forceinline__ void ph_prologue(Frame& F, const Args& a) {
    LAS float* scr = (LAS float*)(F.lds + RING_OFF + F.wave * 16384);
    unsigned char* ws = a.ws;
    constexpr int I_INE = (D / 64) * (NE_INP / 32), I_SQ = (D / 64) * (D / 32), I_INO = (D / 64) * (2 * D / 32), I_GATE = (256 / 64) * (8192 / 32), I_GU = (D / 64) * (2 * FF / 32), I_DN = (FF / 64) * (D / 32);
    constexpr int NGEMV = 4 * 48 * 8;
    constexpr int NITEMS = NGEMV + 2 * (I_INE + I_SQ + I_INO + I_GATE + I_SQ) + 4 * (I_GU + I_DN);
    for (int it = F.gw; it < NITEMS; it += F.NGW) {
        int r = it;
        if (r < NGEMV) { gemv_item(a, r, F.lane, (float*)(ws + WS_PART)); continue; } r -= NGEMV;
        bool done = false;
#pragma unroll 1
        for (int j = 0; j < 2 && !done; ++j) {
            if (r < I_INE) { tr_item<0>(a.in[10] + (size_t)j * D * NE_IN, NE_IN, D, (bf16*)(ws + WS_WINE + j * SZ_WINE), NE_INP, NE_IN, scr, r, F.lane); done = true; break; } r -= I_INE;
            if (r < I_SQ) { tr_item<0>(a.in[17] + (size_t)j * D * D, D, D, (bf16*)(ws + WS_WOUTE + j * SZ_WSQ), D, D, scr, r, F.lane); done = true; break; } r -= I_SQ;
            if (r < I_INO) { tr_item<0>(a.in[18] + (size_t)j * D * 2 * D, 2 * D, D, (bf16*)(ws + WS_WINO + j * SZ_WINO), 2 * D, 2 * D, scr, r, F.lane); done = true; break; } r -= I_INO;
            if (r < I_GATE) { tr_item<2>(a.in[21] + (size_t)j * 4 * 8 * 256 * 256, 256, 256, (bf16*)(ws + WS_WGATE + j * SZ_WGATE), 8192, 8192, scr, r, F.lane); done = true; break; } r -= I_GATE;
            if (r < I_SQ) { tr_item<0>(a.in[24] + (size_t)j * D * D, D, D, (bf16*)(ws + WS_WOUTO + j * SZ_WSQ), D, D, scr, r, F.lane); done = true; break; } r -= I_SQ;
        }
        if (done) continue;
#pragma unroll 1
        for (int l = 0; l < 4; ++l) {
            if (r < I_GU) { tr_item<1>(a.in[8] + (size_t)l * D * 2 * FF, 2 * FF, D, (bf16*)(ws + WS_WGU + l * SZ_WGU), 2 * FF, 2 * FF, scr, r, F.lane); break; } r -= I_GU;
            if (r < I_DN) { tr_item<0>(a.in[9] + (size_t)l * FF * D, D, FF, (bf16*)(ws + WS_WDN + l * SZ_WDN), D, D, scr, r, F.lane); break; } r -= I_DN;
        }
    }
}
__device__ __forceinline__ void ph_modreduce(Frame& F, const Args& a) {
    float* MOD = (float*)(a.ws + WS_MOD); const float* PART = (const float*)(a.ws + WS_PART); float* LB = (float*)(a.ws + WS_LB);
    const int gt = blockIdx.x * NTHREADS + F.tid, NT = F.G * NTHREADS;
    for (int i = gt; i < 4 * 3 * 12288; i += NT) { const int l = i / 36864, n = i % 12288; float s = a.in[5][l * 12288 + n];
#pragma unroll
        for (int kp = 0; kp < 8; ++kp) s += PART[(size_t)kp * 147456 + i];
        MOD[i] = s; }
    for (int i = gt; i < 2048; i += NT) { const int c = i & 1023; LB[i] = i < 1024 ? 0.f : sigm(a.in[14][1024 + c] - a.in[14][c]); }
}
__device__ __forceinline__ void store_hx(bf16* HX, int orow, const f32x4 (&v)[8], const float* sh, const float* sc, int lane) {
    unsigned long long* o8 = (unsigned long long*)(HX + (size_t)orow * D) + lane;
#pragma unroll
    for (int j = 0; j < 8; ++j) { const f32x4 s = *(const f32x4*)(sc + 4 * (lane + 64 * j)), h = *(const f32x4*)(sh + 4 * (lane + 64 * j)); const f32x4 y = v[j] * (s + 1.0f) + h;
        o8[64 * j] = (unsigned long long)pk2(y[0], y[1]) | ((unsigned long long)pk2(y[2], y[3]) << 32); }
}
__device__ __forceinline__ void ph_mod0(Frame& F, const Args& a) {
    const float* MOD = (const float*)(a.ws + WS_MOD); bf16* HX = (bf16*)(a.ws + WS_HX);
    for (int row = F.gw; row < M; row += F.NGW) {
        const float* p = row < MX ? a.in[0] + (size_t)row * D : a.in[2] + (size_t)(row - MX) * D; f32x4 v[8];
#pragma unroll
        for (int j = 0; j < 8; ++j) v[j] = *(const f32x4*)(p + 4 * (F.lane + 64 * j));
        const float* md = MOD + (size_t)mod_index(row) * 12288;
        store_hx(HX, row, v, md, md + D, F.lane);
    }
}
__device__ __forceinline__ void ph_ln(Frame& F, float* buf, int nrows, const float* g, const float* b, float* dout, bf16* HX, const float* modsh, const float* modsc, int permute) {
    for (int row = F.gw; row < nrows; row += F.NGW) {
        float* p = buf + (size_t)row * D; f32x4 v[8]; float s = 0.f;
#pragma unroll
        for (int j = 0; j < 8; ++j) { v[j] = *(const f32x4*)(p + 4 * (F.lane + 64 * j)); s += (v[j][0] + v[j][1]) + (v[j][2] + v[j][3]); }
        const float mean = wave_sum(s) * (1.f / D); float q = 0.f;
#pragma unroll
        for (int j = 0; j < 8; ++j) { v[j] = v[j] - mean; q += (v[j][0] * v[j][0] + v[j][1] * v[j][1]) + (v[j][2] * v[j][2] + v[j][3] * v[j][3]); }
        const float rstd = 1.f / sqrtf(wave_sum(q) * (1.f / D) + LN_EPS);
        float* o = dout ? dout + (size_t)row * D : p;
#pragma unroll
        for (int j = 0; j < 8; ++j) { const f32x4 gg = *(const f32x4*)(g + 4 * (F.lane + 64 * j)), bb = *(const f32x4*)(b + 4 * (F.lane + 64 * j)); v[j] = v[j] * rstd * gg + bb; *(f32x4*)(o + 4 * (F.lane + 64 * j)) = v[j]; }
        if (HX) { const int mi = mod_index(row); store_hx(HX, permute ? perm_row(row) : row, v, modsh + (size_t)mi * 12288, modsc + (size_t)mi * 12288, F.lane); }
    }
}
__device__ __forceinline__ void seg_bounds(int r, int& lo, int& hi) { if (r < MX) { lo = r & ~(SEQ - 1); hi = lo + SEQ; } else { lo = MX + ((r - MX) & ~(CTXL - 1)); hi = lo + CTXL; } }
__device__ __forceinline__ void ph_gdn_prep(Frame& F, const Args& a, int j) {
    const bf16* QKVB = (const bf16*)(a.ws + WS_QKVB); bf16* QB = (bf16*)(a.ws + WS_QB); bf16* KB = (bf16*)(a.ws + WS_KB); bf16* VB = (bf16*)(a.ws + WS_VB);
    const float* cw = a.in[11] + (size_t)j * 4 * 3072;
    for (int row = F.gw; row < M; row += F.NGW) {
        int lo, hi; seg_bounds(row, lo, hi);
#pragma unroll 2
        for (int it = 0; it < 24; ++it) { const int s = it >> 3, h = it & 7, ch = s * 1024 + h * 128 + F.lane * 2; float y0 = 0.f, y1 = 0.f;
#pragma unroll
            for (int k = 0; k < 4; ++k) { const int rr = row + k - 2; if (rr >= lo && rr < hi) { const unsigned x = *(const unsigned*)(QKVB + (size_t)rr * 3072 + ch); y0 += cw[k * 3072 + ch] * bflo(x); y1 += cw[k * 3072 + ch + 1] * bfhi(x); } }
            y0 = siluf(y0); y1 = siluf(y1);
            if (s < 2) { const float sc = rsqrtf(wave_sum(y0 * y0 + y1 * y1) + 1e-6f) * (s == 0 ? QSCALE : 1.f); y0 *= sc; y1 *= sc; }
            bf16* dst = s == 0 ? QB : (s == 1 ? KB : VB);
            *(unsigned*)(dst + (size_t)row * AW + h * 128 + F.lane * 2) = pk2(y0, y1); }
    }
}
__device__ __forceinline__ void ph_merge(Frame& F, const Args& a, int j) {
    const bf16* OA = (const bf16*)(a.ws + WS_OA); const bf16* OB = (const bf16*)(a.ws + WS_OB); const bf16* GA = (const bf16*)(a.ws + WS_GA); const bf16* ZB = (const bf16*)(a.ws + WS_ZB);
    bf16* MIX = (bf16*)(a.ws + WS_MIX); const float* na = a.in[15] + (size_t)j * AW; const float* nb = a.in[16] + (size_t)j * AW;
    for (int row = F.gw; row < M; row += F.NGW) {
#pragma unroll 2
        for (int it = 0; it < 16; ++it) { const int part = it >> 3, c = (it & 7) * 128 + F.lane * 2; const bf16* O = part ? OB : OA; const size_t o = (size_t)row * AW + c;
            const unsigned x0 = *(const unsigned*)(O + o), x1 = *(const unsigned*)(O + (size_t)M * AW + o), gg = *(const unsigned*)((part ? ZB : GA) + o);
            float y0 = bflo(x0) + bflo(x1), y1 = bfhi(x0) + bfhi(x1);
            const float sc = rsqrtf(wave_sum(y0 * y0 + y1 * y1) * (1.f / 128.f) + 1e-6f); const float* nw = part ? nb : na;
            y0 = y0 * sc * nw[c] * bflo(gg); y1 = y1 * sc * nw[c + 1] * bfhi(gg);
            *(unsigned*)(MIX + (size_t)row * D + part * AW + c) = pk2(y0, y1); }
    }
}
__device__ __forceinline__ void ph_odd_conv(Frame& F, const Args& a, int j) {
    const bf16* XBR = (const bf16*)(a.ws + WS_XBR); bf16* XC = (bf16*)(a.ws + WS_XC); const float* cw = a.in[19] + (size_t)j * 4 * D; const float* cb = a.in[20] + (size_t)j * D;
    for (int row = F.gw; row < M; row += F.NGW) {
        int lo, hi; seg_bounds(row, lo, hi);
#pragma unroll 2
        for (int it = 0; it < 16; ++it) { const int ch = it * 128 + F.lane * 2; float y0 = cb[ch], y1 = cb[ch + 1];
#pragma unroll
            for (int k = 0; k < 4; ++k) { const int rr = row + k - 2; if (rr >= lo && rr < hi) { const unsigned x = *(const unsigned*)(XBR + (size_t)rr * D + ch); y0 += cw[k * D + ch] * bflo(x); y1 += cw[k * D + ch + 1] * bfhi(x); } }
            *(unsigned*)(XC + (size_t)row * D + ch) = pk2(y0, y1); }
    }
}
__device__ __forceinline__ void ph_odd_l1(Frame& F, const Args& a) {
    const unsigned* AB = (const unsigned*)(a.ws + WS_AB); float2* PH = (float2*)(a.ws + WS_R);
    for (int it = F.gw; it < 128 * 132; it += F.NGW) {
        const int cgp = it & 127, tc = it >> 7, c = cgp * 64 + F.lane, ch = c & 2047, d = (c >> 11) & 1, b = c >> 12;
        const unsigned* ab = AB + (size_t)d * M * D + ch; float P = 1.f, H = 0.f;
        const int row0 = seq_row(b, d, tc * 64), stp = d ? -1 : 1;
#pragma unroll 1
        for (int k0 = 0; k0 < 64; k0 += 16) { unsigned x[16];
#pragma unroll
            for (int k = 0; k < 16; ++k) x[k] = ab[(size_t)(row0 + stp * (k0 + k)) * D];
#pragma unroll
            for (int k = 0; k < 16; ++k) { const float al = __expf(bflo(x[k])); P *= al; H = al * H + bfhi(x[k]); } }
        PH[(size_t)tc * 8192 + c] = make_float2(P, H);
    }
}
__device__ __forceinline__ void ph_odd_l3(Frame& F, const Args& a) {
    const unsigned* AB = (const unsigned*)(a.ws + WS_AB); const float2* PH = (const float2*)(a.ws + WS_R); const bf16* GY = (const bf16*)(a.ws + WS_GY); bf16* MIX = (bf16*)(a.ws + WS_MIX);
    for (int it = F.gw; it < 64 * 132; it += F.NGW) {
        const int g64 = it & 63, jb = it >> 6, b = g64 >> 5, ch = (g64 & 31) * 64 + F.lane;
        const int row0 = jb < 4 ? MX + b * CTXL + jb * 64 : b * SEQ + (jb - 4) * 64;
        const int tcf = jb, tcb = jb < 4 ? 3 - jb : 4 + (131 - jb);
        const int cf = (b << 12) + ch, cb = (b << 12) + 2048 + ch;
        float hf = 0.f, hb = 0.f;
        for (int q = 0; q < tcf; ++q) { const float2 p = PH[(size_t)q * 8192 + cf]; hf = p.x * hf + p.y; }
        for (int q = 0; q < tcb; ++q) { const float2 p = PH[(size_t)q * 8192 + cb]; hb = p.x * hb + p.y; }
        const unsigned* ab0 = AB + (size_t)row0 * D + ch; const unsigned* ab1 = ab0 + (size_t)M * D;
        float hs[64];
#pragma unroll
        for (int k0 = 0; k0 < 64; k0 += 16) { unsigned x[16];
#pragma unroll
            for (int k = 0; k < 16; ++k) x[k] = ab0[(size_t)(k0 + k) * D];
#pragma unroll
            for (int k = 0; k < 16; ++k) { hf = __expf(bflo(x[k])) * hf + bfhi(x[k]); hs[k0 + k] = hf; } }
        const bf16* gy = GY + (size_t)row0 * D + ch; bf16* mx = MIX + (size_t)row0 * D + ch;
#pragma unroll
        for (int k0 = 48; k0 >= 0; k0 -= 16) { unsigned x[16]; bf16 gv[16];
#pragma unroll
            for (int k = 0; k < 16; ++k) { x[k] = ab1[(size_t)(k0 + k) * D]; gv[k] = gy[(size_t)(k0 + k) * D]; }
#pragma unroll
            for (int k = 15; k >= 0; --k) { hb = __expf(bflo(x[k])) * hb + bfhi(x[k]); mx[(size_t)(k0 + k) * D] = (bf16)f2bf(bf2f(gv[k]) * (hs[k0 + k] + hb)); } }
    }
}
__device__ __forceinline__ void hgrn_wave(int wi, int lane, const bf16* QA, const float* LF, const bf16* VA, bf16* OA) {
    const int chain = wi >> 3, cg = wi & 7, b = chain >> 4, h = (chain >> 1) & 7, dir = chain & 1, kq = lane >> 4, col = cg * 16 + (lane & 15);
    const float* lf = LF + (size_t)dir * M * AW + h * 128 + kq * 32; const bf16* qa = QA + h * 128 + kq * 32; const bf16* va = VA + h * 128 + col; bf16* oa = OA + (size_t)dir * M * AW + h * 128 + col;
    float S[32];
#pragma unroll
    for (int i = 0; i < 32; ++i) S[i] = 0.f;
    u32x4 qn[4]; f32x4 fn[8]; float vn; int rown = seq_row(b, dir, 0);
#pragma unroll
    for (int i = 0; i < 4; ++i) qn[i] = *(const u32x4*)(qa + (size_t)rown * AW + 8 * i);
#pragma unroll
    for (int i = 0; i < 8; ++i) fn[i] = *(const f32x4*)(lf + (size_t)rown * AW + 4 * i);
    vn = bf2f(va[(size_t)rown * AW]);
    for (int s = 0; s < CTXL + SEQ; ++s) {
        u32x4 qc[4]; f32x4 fc[8]; const float vc = vn; const int row = rown;
#pragma unroll
        for (int i = 0; i < 4; ++i) qc[i] = qn[i];
#pragma unroll
        for (int i = 0; i < 8; ++i) fc[i] = fn[i];
        if (s + 1 < CTXL + SEQ) { rown = seq_row(b, dir, s + 1);
#pragma unroll
            for (int i = 0; i < 4; ++i) qn[i] = *(const u32x4*)(qa + (size_t)rown * AW + 8 * i);
#pragma unroll
            for (int i = 0; i < 8; ++i) fn[i] = *(const f32x4*)(lf + (size_t)rown * AW + 4 * i);
            vn = bf2f(va[(size_t)rown * AW]); }
        float o = 0.f;
#pragma unroll
        for (int i = 0; i < 32; ++i) { const float f = __expf(fc[i >> 2][i & 3]); const unsigned qw = qc[i >> 3][(i >> 1) & 3]; const float q = (i & 1) ? bfhi(qw) : bflo(qw);
            S[i] = f * (S[i] - vc) + vc; o += S[i] * q; }
        o += __shfl_xor(o, 16); o += __shfl_xor(o, 32);
        if (kq == 0) oa[(size_t)row * AW] = (bf16)f2bf(o);
    }
}
__device__ __forceinline__ void gdn_wave(int wi, int lane, const bf16* QB, const bf16* KB, const bf16* VB, const float* GB, bf16* OB) {
    const int chain = wi >> 3, cg = wi & 7, b = chain >> 4, h = (chain >> 1) & 7, dir = chain & 1, kq = lane >> 4, col = cg * 16 + (lane & 15);
    const bf16* qb = QB + h * 128 + kq * 32; const bf16* kb = KB + h * 128 + kq * 32; const bf16* vb = VB + h * 128 + col; const float* gb = GB + dir * 8 + h; bf16* ob = OB + (size_t)dir * M * AW + h * 128 + col;
    float S[32];
#pragma unroll
    for (int i = 0; i < 32; ++i) S[i] = 0.f;
    u32x4 qn[4], kn[4]; float vn, gn, bn; int rown = seq_row(b, dir, 0);
#pragma unroll
    for (int i = 0; i < 4; ++i) { qn[i] = *(const u32x4*)(qb + (size_t)rown * AW + 8 * i); kn[i] = *(const u32x4*)(kb + (size_t)rown * AW + 8 * i); }
    vn = bf2f(vb[(size_t)rown * AW]); gn = gb[(size_t)rown * 32]; bn = gb[(size_t)rown * 32 + 16];
    for (int s = 0; s < CTXL + SEQ; ++s) {
        u32x4 qc[4], kc[4]; const float vc = vn, gc = gn, bc = bn; const int row = rown;
#pragma unroll
        for (int i = 0; i < 4; ++i) { qc[i] = qn[i]; kc[i] = kn[i]; }
        if (s + 1 < CTXL + SEQ) { rown = seq_row(b, dir, s + 1);
#pragma unroll
            for (int i = 0; i < 4; ++i) { qn[i] = *(const u32x4*)(qb + (size_t)rown * AW + 8 * i); kn[i] = *(const u32x4*)(kb + (size_t)rown * AW + 8 * i); }
            vn = bf2f(vb[(size_t)rown * AW]); gn = gb[(size_t)rown * 32]; bn = gb[(size_t)rown * 32 + 16]; }
        const float al = __expf(gc); float ks = 0.f; float kk[32];
#pragma unroll
        for (int i = 0; i < 32; ++i) { const unsigned kw = kc[i >> 3][(i >> 1) & 3]; kk[i] = (i & 1) ? bfhi(kw) : bflo(kw); ks += kk[i] * S[i]; }
        ks += __shfl_xor(ks, 16); ks += __shfl_xor(ks, 32);
        const float dl = bc * (vc - al * ks); float o = 0.f;
#pragma unroll
        for (int i = 0; i < 32; ++i) { const unsigned qw = qc[i >> 3][(i >> 1) & 3]; const float q = (i & 1) ? bfhi(qw) : bflo(qw); S[i] = al * S[i] + kk[i] * dl; o += S[i] * q; }
        o += __shfl_xor(o, 16); o += __shfl_xor(o, 32);
        if (kq == 0) ob[(size_t)row * AW] = (bf16)f2bf(o);
    }
}
__device__ __forceinline__ void ph_even_scan(Frame& F, const Args& a) {
    unsigned char* ws = a.ws;
    if (F.wave == 0) { for (int wi = blockIdx.x; wi < 256; wi += F.G) hgrn_wave(wi, F.lane, (const bf16*)(ws + WS_QA), (const float*)(ws + WS_LF), (const bf16*)(ws + WS_VA), (bf16*)(ws + WS_OA)); }
    else if (F.wave == 1) { for (int wi = blockIdx.x; wi < 256; wi += F.G) gdn_wave(wi, F.lane, (const bf16*)(ws + WS_QB), (const bf16*)(ws + WS_KB), (const bf16*)(ws + WS_VB), (const float*)(ws + WS_GB), (bf16*)(ws + WS_OB)); }
}
constexpr int N_PHASES = 3 + 10 * DEPTH;
__host__ __device__ constexpr bool phase_used(int ph) { return ph < 3 ? true : !((((ph - 3) / 10) & 1) == 0 && ((ph - 3) % 10) == 4); }

__global__ void __launch_bounds__(NTHREADS, 2) fwd(Args args) {
    extern __shared__ __attribute__((aligned(16))) unsigned char lds[];
    Frame F;
    F.lds = (LAS unsigned char*)lds; F.tid = threadIdx.x; F.lane = F.tid & 63; F.wave = __builtin_amdgcn_readfirstlane(F.tid >> 6);
    F.G = gridDim.x; F.gw = F.wave * F.G + blockIdx.x; F.NGW = F.G * NWAVES;
    for (int u = F.tid; u < (LDS_BYTES - LDSCTL_OFF) / 4; u += NTHREADS) ((LAS unsigned*)(F.lds + LDSCTL_OFF))[u] = 0u;
    __syncthreads();
    const int lo = args.ph_lo, hi = args.ph_hi; const bool multi = (hi - lo) > 1;
    unsigned char* ws = args.ws;
    XcdBarrier bar; bar.bar = (unsigned*)(ws + WS_CTL) + CW_BAR; bar.x = 0; bar.st = nullptr;
    if (multi) bar = xcd_barrier_post((unsigned*)(ws + WS_CTL) + CW_BAR, (volatile LAS unsigned*)(F.lds + MISC_OFF) + 8);
#ifndef PH_SITES
#define PH_SITES 0x1ffff
#endif
#define SITE(n) ((PH_SITES >> (n)) & 1)
#define IN(k) (lo <= (k) && (k) < hi)
#define LAUNDER() do { asm volatile("" : "+v"(F.tid), "+v"(F.lane)); } while (0)
#define SEAM() do { if (multi) xcd_barrier(bar); } while (0)
    bf16* HX = (bf16*)(ws + WS_HX); bf16* MIX = (bf16*)(ws + WS_MIX); float* XA = (float*)(ws + WS_XA); float* Z = (float*)(ws + WS_Z); bf16* ACT = (bf16*)(ws + WS_ACT);
    LAS unsigned char* ring = F.lds + RING_OFF;

    if (SITE(0) && IN(0)) { LAUNDER(); ph_prologue(F, args); SEAM(); }
    if (SITE(1) && IN(1)) { LAUNDER(); ph_modreduce(F, args); SEAM(); }
    if (SITE(2) && IN(2)) { LAUNDER(); ph_mod0(F, args); SEAM(); }
#pragma unroll 1
    for (int l = 0; l < DEPTH; ++l) {
        const int base = 3 + 10 * l, j = l >> 1; const bool last = (l == DEPTH - 1); const int Mo = last ? MX : M;
        const float* MODL = (const float*)(ws + WS_MOD) + (size_t)l * 3 * 12288;
        if ((l & 1) == 0) {
            if (SITE(3) && IN(base + 0)) {
                pg8::Gemm g{HX, (const bf16*)(ws + WS_WINE + j * SZ_WINE), M, NE_INP, D, D, D}; pg8::StaticOrder S; S.init(M, NE_INP, F.G, (int)blockIdx.x);
                EpiEven1 E{(bf16*)(ws + WS_QA), (bf16*)(ws + WS_VA), (bf16*)(ws + WS_GA), (bf16*)(ws + WS_ZB), (bf16*)(ws + WS_QKVB), (float*)(ws + WS_LF), (float*)(ws + WS_GB),
                           (const float*)(ws + WS_LB) + j * AW, args.in[12] + j * 16, args.in[13] + j * 16};
                pg8::gemm_phase<EpiEven1, pg8::StaticOrder, true, true>(ring, g, S, E); SEAM(); }
            if (SITE(4) && IN(base + 1)) { LAUNDER(); ph_gdn_prep(F, args, j); SEAM(); }
            if (SITE(5) && IN(base + 2)) { LAUNDER(); ph_even_scan(F, args); SEAM(); }
            if (SITE(6) && IN(base + 3)) { LAUNDER(); ph_merge(F, args, j); SEAM(); }
        } else {
            if (SITE(7) && IN(base + 0)) {
                pg8::Gemm g{HX, (const bf16*)(ws + WS_WINO + j * SZ_WINO), M, 2 * D, D, D, D}; pg8::StaticOrder S; S.init(M, 2 * D, F.G, (int)blockIdx.x);
                EpiOdd1 E{(bf16*)(ws + WS_GY), (bf16*)(ws + WS_XBR)};
                pg8::gemm_phase<EpiOdd1, pg8::StaticOrder, true, true>(ring, g, S, E); SEAM(); }
            if (SITE(8) && IN(base + 1)) { LAUNDER(); ph_odd_conv(F, args, j); SEAM(); }
            if (SITE(9) && IN(base + 2)) {
                pg8::Gemm g{(const bf16*)(ws + WS_XC), (const bf16*)(ws + WS_WGATE + j * SZ_WGATE), M, 8192, 256, D, 256}; pg8::GateOrder S; S.init(M, F.G, (int)blockIdx.x);
                EpiGates E{(const bf16*)(ws + WS_XC), (unsigned*)(ws + WS_AB), args.in[22] + (size_t)j * 4 * D, args.in[23] + (size_t)j * 2 * D};
                pg8::gemm_phase<EpiGates, pg8::GateOrder, true, true>(ring, g, S, E); SEAM(); }
            if (SITE(10) && IN(base + 3)) { LAUNDER(); ph_odd_l1(F, args); SEAM(); }
            if (SITE(11) && IN(base + 4)) { LAUNDER(); ph_odd_l3(F, args); SEAM(); }
        }
        if (SITE(12) && IN(base + 5)) {
            pg8::Gemm g{MIX, (const bf16*)((l & 1) ? ws + WS_WOUTO + j * SZ_WSQ : ws + WS_WOUTE + j * SZ_WSQ), Mo, D, D, D, D}; pg8::StaticOrder S; S.init(Mo, D, F.G, (int)blockIdx.x);
            EpiResid E{l == 0 ? args.in[0] : XA, l == 0 ? args.in[2] : XA + (size_t)MX * D, Z, MODL + 2 * D, l & 1};
            pg8::gemm_phase<EpiResid, pg8::StaticOrder, true, true>(ring, g, S, E); SEAM(); }
        if (SITE(13) && IN(base + 6)) { LAUNDER(); ph_ln(F, Z, Mo, args.in[6] + (size_t)(l * 2) * D, args.in[7] + (size_t)(l * 2) * D, nullptr, HX, MODL + 3 * D, MODL + 4 * D, 0); SEAM(); }
        if (SITE(14) && IN(base + 7)) {
            pg8::Gemm g{HX, (const bf16*)(ws + WS_WGU + l * SZ_WGU), Mo, 2 * FF, D, D, D}; pg8::StaticOrder S; S.init(Mo, 2 * FF, F.G, (int)blockIdx.x);
            EpiSwiGLU E{ACT};
            pg8::gemm_phase<EpiSwiGLU, pg8::StaticOrder, true, true>(ring, g, S, E); SEAM(); }
        if (SITE(15) && IN(base + 8)) {
            pg8::Gemm g{ACT, (const bf16*)(ws + WS_WDN + l * SZ_WDN), Mo, D, FF, FF, FF}; pg8::StaticOrder S; S.init(Mo, D, F.G, (int)blockIdx.x);
            EpiResid E{Z, Z + (size_t)MX * D, XA, MODL + 5 * D, 0};
            pg8::gemm_phase<EpiResid, pg8::StaticOrder, true, true>(ring, g, S, E); SEAM(); }
        if (SITE(16) && IN(base + 9)) {
            const float* g1 = args.in[6] + (size_t)(l * 2 + 1) * D; const float* b1 = args.in[7] + (size_t)(l * 2 + 1) * D;
            LAUNDER(); if (last) ph_ln(F, XA, MX, g1, b1, args.out, nullptr, nullptr, nullptr, 0);
            else { LAUNDER(); ph_ln(F, XA, M, g1, b1, nullptr, HX, MODL + 3 * 12288, MODL + 3 * 12288 + D, (l + 1) & 1); SEAM(); } }
    }
#undef IN
#undef SEAM
}

extern "C" void kernel_launch(void* const* d_in, const int* in_sizes, int n_in, void* d_out, int out_size, void* d_ws, size_t ws_size, hipStream_t stream) {
    static int grid = 0;
    if (grid == 0) {
        if (n_in != 25 || in_sizes[0] != MX * D || out_size != MX * D || ws_size < WS_END) { fprintf(stderr, "kernel_launch: unexpected shapes (n_in %d, in0 %d, out %d, ws %zu < %zu); nothing launched\n", n_in, n_in > 0 ? in_sizes[0] : -1, out_size, ws_size, (size_t)WS_END); grid = -1; return; }
        int dev = 0, cus = 0, per_cu = 0;
        if (hipGetDevice(&dev) != hipSuccess || hipDeviceGetAttribute(&cus, hipDeviceAttributeMultiprocessorCount, dev) != hipSuccess) { grid = -1; return; }
        if (hipFuncSetAttribute((const void*)fwd, hipFuncAttributeMaxDynamicSharedMemorySize, LDS_BYTES) != hipSuccess) { fprintf(stderr, "kernel_launch: hipFuncSetAttribute failed\n"); grid = -1; return; }
        if (hipOccupancyMaxActiveBlocksPerMultiprocessor(&per_cu, (const void*)fwd, NTHREADS, LDS_BYTES) != hipSuccess || per_cu < 1) { fprintf(stderr, "kernel_launch: occupancy query says %d\n", per_cu); }
        (void)hipGetLastError();
        grid = cus;
    }
    if (grid < 0) return;
    if (hipMemsetAsync((char*)d_ws + WS_CTL, 0, CTL_ZERO_BYTES, stream) != hipSuccess) return;
    Args a{};
    for (int i = 0; i < 25; ++i) a.in[i] = (const float*)d_in[i];
    a.out = (float*)d_out; a.ws = (unsigned char*)d_ws;
#if MK_ONE_LAUNCH
    a.ph_lo = 0; a.ph_hi = N_PHASES;
    hipLaunchKernelGGL(fwd, dim3(grid), dim3(NTHREADS), LDS_BYTES, stream, a);
#else
    for (int ph = 0; ph < N_PHASES; ++ph) { if (!phase_used(ph)) continue; a.ph_lo = ph; a.ph_hi = ph + 1;
        hipLaunchKernelGGL(fwd, dim3(grid), dim3(NTHREADS), LDS_BYTES, stream, a); }
#endif
}
```

```cpp
#include <hip/hip_runtime.h>
#include <cstdio>
#include <cstdint>
#ifndef MK_ONE_LAUNCH
#define MK_ONE_LAUNCH 1
#endif
namespace pg8 {
#define PG8_LAS __attribute__((address_space(3)))
typedef unsigned short bf16_t;
typedef short bf16x8 __attribute__((ext_vector_type(8)));
typedef float f32x4 __attribute__((ext_vector_type(4)));
typedef unsigned u32x4 __attribute__((ext_vector_type(4)));
typedef unsigned u32x2 __attribute__((ext_vector_type(2)));
constexpr int BM = 256, BK = 64, HALF = 128, HTB = HALF * BK * 2  , STAGE_BYTES = 8 * HTB, NXCD = 8, WGM = 8;
__host__ __device__ __forceinline__ int lds_byte(int r, int c) { const int st = (r >> 4) * 2 + (c >> 5), rr = r & 15, cc = c & 31, ob = rr * 64 + cc * 2; return st * 1024 + (ob ^ (((ob >> 9) & 1) << 5)); }
__host__ __device__ __forceinline__ void stage_rc(int b, int& R, int& C) { const int st = b / 1024, sb = b % 1024, swz = sb ^ (((sb >> 9) & 1) << 5); R = (st >> 1) * 16 + swz / 64; C = (st & 1) * 32 + (swz % 64) / 2; }
__host__ __device__ __forceinline__ int perm32(int rho) { const int n = rho >> 4, i = rho & 15; return 8 * (i >> 2) + 4 * n + (i & 3); }

struct Unit { int pm, pn, ka; };
struct Gemm { const bf16_t* A; const bf16_t* Bt; int M, N, K, lda, ldb; };

struct StaticOrder {
    int nM, nN, nwg, G, c;
    __host__ __device__ void init(int M, int N, int G_, int c_) { nM = M / BM; nN = N / BM; nwg = nM * nN; G = G_; c = c_; }
    __host__ __device__ bool next(int i, Unit& u) const {
        const long L = (long)i * G + c; if (L >= nwg) return false;
        int wgid = (int)L; { const int q = nwg / NXCD, r = nwg % NXCD, xcd = wgid % NXCD, off = wgid / NXCD; wgid = (xcd < r ? xcd * (q + 1) : r * (q + 1) + (xcd - r) * q) + off; }
        const int nig = WGM * nN, gid = wgid / nig, fm = gid * WGM, gsz = (nM - fm) < WGM ? (nM - fm) : WGM;
        u.pm = fm + ((wgid % nig) % gsz); u.pn = (wgid % nig) / gsz; u.ka = 0; return true;
    }
    __device__ __forceinline__ void a_ready(const Unit&) const {}
    __device__ __forceinline__ void done(const Unit&) const {}
};
struct GateOrder {
    int nM, nwg, G, c;
    __host__ __device__ void init(int M, int G_, int c_) { nM = M / BM; nwg = nM * 32; G = G_; c = c_; }
    __host__ __device__ bool next(int i, Unit& u) const {
        const long L = (long)i * G + c; if (L >= nwg) return false;
        const int l = (int)L, pn4 = l & 3, pm = (l >> 2) % nM, nb = (l >> 2) / nM;
        u.pm = pm; u.pn = nb * 4 + pn4; u.ka = nb * 256; return true;
    }
    __device__ __forceinline__ void a_ready(const Unit&) const {}
    __device__ __forceinline__ void done(const Unit&) const {}
};
typedef float f32x2c __attribute__((ext_vector_type(2))); typedef __bf16 bf16x2c __attribute__((ext_vector_type(2)));
__device__ __forceinline__ unsigned cvt_pk_bf16(float lo, float hi) { const f32x2c v = {lo, hi}; return __builtin_bit_cast(unsigned, __builtin_convertvector(v, bf16x2c)); }
template <class Epi, class Sched, bool ALIGN_EPI = false, bool SP2 = false>
__device__ __forceinline__ void gemm_phase(PG8_LAS unsigned char* lds, const Gemm g, const Sched& S, const Epi& E) {
    int tid = threadIdx.x; asm volatile("" : "+v"(tid)); const int wid = __builtin_amdgcn_readfirstlane(tid >> 6), lane = tid & 63, wr = wid >> 2, wc = wid & 3, fr = lane & 15, fq = lane >> 4;
    int nt = g.K / BK; asm volatile("" : "+s"(nt));
    unsigned voffA[2], voffB[2];
#pragma unroll
    for (int i = 0; i < 2; ++i) { int R, C; stage_rc(tid * 16 + i * 8192, R, C); const int Rb = Epi::PERM ? ((R & ~31) + perm32(R & 31)) : R;
        voffA[i] = (unsigned)(R * g.lda + C) * 2u; voffB[i] = (unsigned)(Rb * g.ldb + C) * 2u; }
    const size_t kstep = (size_t)(BK * 2);
    const size_t hstepA = (size_t)HALF * g.lda * 2, hstepB = (size_t)HALF * g.ldb * 2;
    const size_t tstepA = 2 * hstepA, tstepB = 2 * hstepB;
    const unsigned ldsw = (unsigned)wid * 1024u;
    const int aoff = lds_byte(wr * 64 + fr, fq * 8), boff = lds_byte(wc * 32 + fr, fq * 8);
#define PG8_SA(b, h) (((b) * 2 + (h)) * HTB)
#define PG8_SB(b, h) ((4 + (b) * 2 + (h)) * HTB)
#define PG8_STAGE(bufoff, gbase, voff) do { _Pragma("unroll") for (int _i = 0; _i < 2; ++_i) \
        __builtin_amdgcn_global_load_lds((const unsigned*)((const char*)(gbase) + (voff)[_i]), (PG8_LAS unsigned*)(lds + (bufoff) + ldsw + _i * 8192), 16, 0, 0); } while (0)
#define PG8_LDA(dst, b, h) do { _Pragma("unroll") for (int m = 0; m < 4; ++m) _Pragma("unroll") for (int k = 0; k < 2; ++k) dst[m][k] = *(const PG8_LAS bf16x8*)(lds + PG8_SA(b, h) + aoff + m * 2048 + k * 1024); } while (0)
#define PG8_LDB(dst, b, h) do { _Pragma("unroll") for (int n = 0; n < 2; ++n) _Pragma("unroll") for (int k = 0; k < 2; ++k) dst[n][k] = *(const PG8_LAS bf16x8*)(lds + PG8_SB(b, h) + boff + n * 2048 + k * 1024); } while (0)
#define PG8_MMA(ai, bj, At, Bt) do { __builtin_amdgcn_s_setprio(1); _Pragma("unroll") for (int m = 0; m < 4; ++m) _Pragma("unroll") for (int n = 0; n < 2; ++n) _Pragma("unroll") for (int k = 0; k < 2; ++k) \
        acc[ai][bj][m][n] = __builtin_amdgcn_mfma_f32_16x16x32_bf16(Bt[n][k], At[m][k], acc[ai][bj][m][n], 0, 0, 0); __builtin_amdgcn_s_setprio(0); } while (0)
#define PG8_WAIT_V(n) asm volatile("s_waitcnt vmcnt(" #n ")" ::: "memory")
#define PG8_WAIT_L(n) asm volatile("s_waitcnt lgkmcnt(" #n ")" ::: "memory")
#define PG8_BAR __builtin_amdgcn_s_barrier()
#define PG8_SCHED __builtin_amdgcn_sched_barrier(0)
    Unit cur, nxt; int ui = 0;
    if (!S.next(0, cur)) return;
    f32x4 acc[2][2][4][2];
#pragma unroll
    for (int a = 0; a < 2; ++a)
#pragma unroll
        for (int b = 0; b < 2; ++b)
#pragma unroll
            for (int m = 0; m < 4; ++m)
#pragma unroll
                for (int n = 0; n < 2; ++n) acc[a][b][m][n] = (f32x4){0.f, 0.f, 0.f, 0.f};
    bf16x8 At[4][2], B0[2][2], B1[2][2];
    const char* cA = (const char*)g.A + (size_t)cur.pm * tstepA + (size_t)cur.ka * 2; const char* cB = (const char*)g.Bt + (size_t)cur.pn * tstepB;
    S.a_ready(cur);
    if constexpr (SP2) {
        PG8_STAGE(PG8_SB(0, 0), cB, voffB); PG8_STAGE(PG8_SB(0, 1), cB + hstepB, voffB); PG8_STAGE(PG8_SA(0, 0), cA, voffA); PG8_STAGE(PG8_SA(0, 1), cA + hstepA, voffA);
        if (wr == 1) PG8_BAR;
        PG8_WAIT_V(2); PG8_BAR;
        PG8_STAGE(PG8_SB(1, 0), cB + kstep, voffB); PG8_STAGE(PG8_SA(1, 0), cA + kstep, voffA); PG8_STAGE(PG8_SB(1, 1), cB + hstepB + kstep, voffB);
        PG8_WAIT_V(6); PG8_BAR;
    } else {
        PG8_STAGE(PG8_SB(0, 0), cB, voffB); PG8_STAGE(PG8_SA(0, 0), cA, voffA); PG8_STAGE(PG8_SB(0, 1), cB + hstepB, voffB); PG8_STAGE(PG8_SA(0, 1), cA + hstepA, voffA);
        if (wr == 1) PG8_BAR;
        PG8_WAIT_V(4); PG8_BAR;
        PG8_STAGE(PG8_SB(1, 0), cB + kstep, voffB); PG8_STAGE(PG8_SA(1, 0), cA + kstep, voffA); PG8_STAGE(PG8_SB(1, 1), cB + hstepB + kstep, voffB);
        PG8_WAIT_V(6); PG8_BAR;
    }
    for (;;) {
        const bool has_next = S.next(ui + 1, nxt);
        const char* nA = has_next ? (const char*)g.A + (size_t)nxt.pm * tstepA + (size_t)nxt.ka * 2 : cA; const char* nB = has_next ? (const char*)g.Bt + (size_t)nxt.pn * tstepB : cB;
        for (int t = 0; t < nt; t += 2) {
            const bool last = (t == nt - 2);
            const char* a1 = cA + (size_t)(t + 1) * kstep;
            const char* a2 = last ? nA : cA + (size_t)(t + 2) * kstep; const char* b2 = last ? nB : cB + (size_t)(t + 2) * kstep;
            const char* a3 = a2 + kstep; const char* b3 = b2 + kstep;
            if (last && has_next) S.a_ready(nxt);
            if constexpr (SP2) {
            PG8_LDB(B0, 0, 0); PG8_LDB(B1, 0, 1); PG8_SCHED; PG8_LDA(At, 0, 0); PG8_STAGE(PG8_SA(1, 1), a1 + hstepA, voffA);
            PG8_WAIT_V(8); PG8_WAIT_L(0); PG8_BAR; PG8_MMA(0, 0, At, B0); PG8_MMA(0, 1, At, B1); PG8_BAR; PG8_SCHED;
            PG8_LDA(At, 0, 1); PG8_STAGE(PG8_SB(0, 0), b2, voffB); PG8_STAGE(PG8_SB(0, 1), b2 + hstepB, voffB); PG8_STAGE(PG8_SA(0, 0), a2, voffA);
            PG8_WAIT_V(8); PG8_WAIT_L(0); PG8_BAR; PG8_MMA(1, 0, At, B0); PG8_MMA(1, 1, At, B1); PG8_BAR; PG8_SCHED;
            PG8_LDB(B0, 1, 0); PG8_LDB(B1, 1, 1); PG8_SCHED; PG8_LDA(At, 1, 0); PG8_STAGE(PG8_SA(0, 1), a2 + hstepA, voffA);
            PG8_WAIT_V(8); PG8_WAIT_L(0); PG8_BAR; PG8_MMA(0, 0, At, B0); PG8_MMA(0, 1, At, B1); PG8_BAR; PG8_SCHED;
            PG8_LDA(At, 1, 1); PG8_STAGE(PG8_SB(1, 0), b3, voffB); PG8_STAGE(PG8_SB(1, 1), b3 + hstepB, voffB); PG8_STAGE(PG8_SA(1, 0), a3, voffA);
            PG8_WAIT_V(8); PG8_WAIT_L(0); PG8_BAR; PG8_MMA(1, 0, At, B0); PG8_MMA(1, 1, At, B1); PG8_BAR; PG8_SCHED;
            } else {
            PG8_LDB(B0, 0, 0); PG8_SCHED; PG8_LDA(At, 0, 0); PG8_STAGE(PG8_SA(1, 1), a1 + hstepA, voffA);
            PG8_WAIT_L(8); PG8_BAR; PG8_WAIT_L(0); PG8_MMA(0, 0, At, B0); PG8_BAR; PG8_SCHED;
            PG8_LDB(B1, 0, 1); PG8_STAGE(PG8_SB(0, 0), b2, voffB);
            PG8_BAR; PG8_WAIT_L(0); PG8_MMA(0, 1, At, B1); PG8_BAR;
            PG8_LDA(At, 0, 1); PG8_STAGE(PG8_SA(0, 0), a2, voffA);
            PG8_BAR; PG8_WAIT_L(0); PG8_MMA(1, 0, At, B0); PG8_BAR; PG8_SCHED;
            PG8_STAGE(PG8_SB(0, 1), b2 + hstepB, voffB);
            PG8_WAIT_V(6); PG8_BAR; PG8_MMA(1, 1, At, B1); PG8_BAR;
            PG8_LDB(B0, 1, 0); PG8_SCHED; PG8_LDA(At, 1, 0); PG8_STAGE(PG8_SA(0, 1), a2 + hstepA, voffA);
            PG8_WAIT_L(8); PG8_BAR; PG8_WAIT_L(0); PG8_MMA(0, 0, At, B0); PG8_BAR; PG8_SCHED;
            PG8_LDB(B1, 1, 1); PG8_STAGE(PG8_SB(1, 0), b3, voffB);
            PG8_BAR; PG8_WAIT_L(0); PG8_MMA(0, 1, At, B1); PG8_BAR;
            PG8_LDA(At, 1, 1); PG8_STAGE(PG8_SA(1, 0), a3, voffA);
            PG8_BAR; PG8_WAIT_L(0); PG8_MMA(1, 0, At, B0); PG8_BAR; PG8_SCHED;
            PG8_STAGE(PG8_SB(1, 1), b3 + hstepB, voffB);
            PG8_WAIT_V(6); PG8_BAR; PG8_MMA(1, 1, At, B1); PG8_BAR;
            }
        }
        if constexpr (ALIGN_EPI) { if (wr == 0) PG8_BAR; }
        if constexpr (!Epi::AFTER_DRAIN) { E(acc, cur, wr, wc, fr, fq); S.done(cur); }
        if (!has_next) break;
#pragma unroll
        for (int a = 0; a < 2; ++a)
#pragma unroll
            for (int b = 0; b < 2; ++b)
#pragma unroll
                for (int m = 0; m < 4; ++m)
#pragma unroll
                    for (int n = 0; n < 2; ++n) acc[a][b][m][n] = (f32x4){0.f, 0.f, 0.f, 0.f};
        cur = nxt; cA = nA; cB = nB; ++ui;
        if constexpr (ALIGN_EPI) { if (wr == 1) PG8_BAR; }
    }
    PG8_WAIT_V(0);
    if constexpr (!ALIGN_EPI) { if (wr == 0) PG8_BAR; }
    PG8_BAR;
    if constexpr (Epi::AFTER_DRAIN) { E.fused(acc, cur, wr, wc, fr, fq, lds, wid, lane); S.done(cur); }
#undef PG8_SA
#undef PG8_SB
#undef PG8_STAGE
#undef PG8_LDA
#undef PG8_LDB
#undef PG8_MMA
#undef PG8_WAIT_V
#undef PG8_WAIT_L
#undef PG8_BAR
#undef PG8_SCHED
}
}
using pg8::bf16_t; using pg8::f32x4; using pg8::u32x4; using pg8::u32x2; using pg8::Unit; using pg8::cvt_pk_bf16;

constexpr int D = 2048, NBATCH = 2, SEQ = 8192, CTXL = 256, DEPTH = 4;
constexpr int MX = NBATCH * SEQ;
constexpr int MC = NBATCH * CTXL;
constexpr int M = MX + MC;
constexpr int NE_IN = 9248, NE_INP = 9472, FF = 5632, AW = 1024;
constexpr int NWAVES = 8, NTHREADS = 512;
constexpr float LN_EPS = 1e-6f, DN_ALPHA = 1.681792830507429f;
constexpr float QSCALE = 0.08838834764831845f;

constexpr size_t MiB = 1u << 20;
constexpr size_t al256(size_t x) { return (x + 255) & ~(size_t)255; }
constexpr size_t WS_CTL = 0, CTL_ZERO_BYTES = 1 * MiB;
constexpr size_t WS_MOD = 1 * MiB;
constexpr size_t WS_LB = 2 * MiB;
constexpr size_t WS_PART = 3 * MiB;
constexpr size_t WS_W0 = 8 * MiB;
constexpr size_t SZ_WINE = (size_t)NE_INP * D * 2, SZ_WSQ = (size_t)D * D * 2, SZ_WINO = (size_t)2 * D * D * 2, SZ_WGATE = (size_t)8192 * 256 * 2, SZ_WGU = (size_t)2 * FF * D * 2, SZ_WDN = (size_t)D * FF * 2;
constexpr size_t WS_WINE = WS_W0;
constexpr size_t WS_WOUTE = WS_WINE + 2 * SZ_WINE;
constexpr size_t WS_WINO = WS_WOUTE + 2 * SZ_WSQ;
constexpr size_t WS_WGATE = WS_WINO + 2 * SZ_WINO;
constexpr size_t WS_WOUTO = WS_WGATE + 2 * SZ_WGATE;
constexpr size_t WS_WGU = WS_WOUTO + 2 * SZ_WSQ;
constexpr size_t WS_WDN = WS_WGU + 4 * SZ_WGU;
constexpr size_t WS_XA = al256(WS_WDN + 4 * SZ_WDN);
constexpr size_t SZ_F32ROW = (size_t)M * D * 4, SZ_BF16ROW = (size_t)M * D * 2, SZ_BF16HALF = (size_t)M * AW * 2;
constexpr size_t WS_Z = WS_XA + SZ_F32ROW;
constexpr size_t WS_HX = WS_Z + SZ_F32ROW;
constexpr size_t WS_MIX = WS_HX + SZ_BF16ROW;
constexpr size_t WS_MR = WS_MIX + SZ_BF16ROW;
constexpr size_t SZ_HRECS = (size_t)16896 * 9216, SZ_GRECS = (size_t)16896 * 17152;
constexpr size_t WS_HREC = WS_HX, WS_GREC = WS_HREC + SZ_HRECS;
constexpr size_t WS_QKVB = WS_MIX;
constexpr size_t WS_QA = al256(WS_GREC + SZ_GRECS), WS_VA = WS_QA + SZ_BF16HALF, WS_GA = WS_VA + SZ_BF16HALF, WS_ZB = WS_GA + SZ_BF16HALF;
constexpr size_t WS_LF = WS_ZB + SZ_BF16HALF;
constexpr size_t WS_GB = WS_LF + 2 * (size_t)M * AW * 4;
constexpr size_t WS_QB = WS_GB + (size_t)M * 32 * 4, WS_KB = WS_QB + SZ_BF16HALF, WS_VB = WS_KB + SZ_BF16HALF;
#ifdef EXP_B
constexpr size_t WS_OA = WS_HREC;
#else
constexpr size_t WS_OA = WS_LF;
#endif
constexpr size_t WS_OB = WS_OA + 2 * SZ_BF16HALF;
constexpr size_t WS_EVEN_END = WS_VB + SZ_BF16HALF;
#ifndef EXP_B
static_assert(WS_QKVB + (size_t)M * 3072 * 2 <= WS_QA && WS_OB + 2 * SZ_BF16HALF <= WS_GB, "even-layer overlays");
#endif
constexpr size_t WS_GY = WS_MR, WS_XBR = WS_GY + SZ_BF16ROW, WS_XC = WS_XBR + SZ_BF16ROW;
constexpr size_t WS_AB = WS_XC + SZ_BF16ROW;
constexpr size_t WS_R = WS_AB + 2 * (size_t)M * D * 4;
constexpr size_t WS_ODD_END = WS_R + 2 * SZ_BF16ROW;
constexpr size_t WS_ACT = WS_MR;
constexpr size_t WS_END = (WS_EVEN_END > WS_ODD_END ? WS_EVEN_END : WS_ODD_END);
static_assert(WS_ACT + (size_t)M * FF * 2 <= WS_END, "ACT fits the mixer region");
static_assert(WS_END <= (size_t)1536 * MiB, "workspace budget: d_ws is at least 4 x the largest input = 1536 MiB");
constexpr int CW_BAR = 4096;

constexpr int RING_OFF = 0, RING_BYTES = 131072;
constexpr int LDSCTL_OFF = RING_BYTES, MISC_OFF = LDSCTL_OFF + 320;
constexpr int LDS_BYTES = 147456;

#define GAS __attribute__((address_space(1)))
#define LAS __attribute__((address_space(3)))
typedef unsigned short bf16;
#define LDS_WAIT() asm volatile("s_waitcnt lgkmcnt(0)" ::: "memory")
#define VM_WAIT() asm volatile("s_waitcnt vmcnt(0)" ::: "memory")
__device__ __forceinline__ unsigned f2bf(float f) { unsigned u = __builtin_bit_cast(unsigned, f); return (u + 0x7fffu + ((u >> 16) & 1u)) >> 16; }
__device__ __forceinline__ unsigned pk2(float lo, float hi) { return f2bf(lo) | (f2bf(hi) << 16); }
__device__ __forceinline__ float bflo(unsigned u) { return __builtin_bit_cast(float, u << 16); }
__device__ __forceinline__ float bfhi(unsigned u) { return __builtin_bit_cast(float, u & 0xffff0000u); }
__device__ __forceinline__ float bf2f(bf16 h) { return __builtin_bit_cast(float, (unsigned)h << 16); }
__device__ __forceinline__ float sigm(float x) { return 1.f / (1.f + __expf(-x)); }
__device__ __forceinline__ float siluf(float x) { return x / (1.f + __expf(-x)); }
__device__ __forceinline__ float log1p_fast(float t) { const float p = t * (1.f + t * (-0.5f + t * (0.33333333f + t * (-0.25f + t * 0.2f)))); return t < 0.03f ? p : __logf(1.f + t); }
__device__ __forceinline__ float softplusf(float x) { return fmaxf(x, 0.f) + log1p_fast(__expf(-fabsf(x))); }
__device__ __forceinline__ float neg_expm1_fast(float x) { const float p = -x * (1.f + x * (0.5f + x * (0.16666667f + x * (0.041666668f + x * 0.0083333338f)))); return x > -0.25f ? p : 1.f - __expf(x); }
__device__ __forceinline__ float gelu_tanh(float x) { const float u = 0.7978845608028654f * (x + 0.044715f * x * x * x); return x / (1.f + __expf(-2.f * u)); }
__device__ __forceinline__ float wave_sum(float v) {
#pragma unroll
    for (int o = 1; o < 64; o <<= 1) v += __shfl_xor(v, o);
    return v;
}
__device__ __forceinline__ int mod_index(int row) { return row < SEQ ? 0 : (row < MX ? 1 : 2); }
__device__ __forceinline__ int perm_row(int r) { if (r >= MX) return r; const int b = r >> 13, t = r & 8191; return (b << 13) + ((t & 63) << 7) + (t >> 6); }
__device__ __forceinline__ int unperm_row(int r) { if (r >= MX) return r; const int b = r >> 13, i = r & 8191; return (b << 13) + ((i & 127) << 6) + (i >> 7); }
__device__ __forceinline__ int seq_row(int b, int dir, int s) {
    if (s < CTXL) { const int pos = dir ? (CTXL - 1 - s) : s; return MX + b * CTXL + pos; }
    const int p = s - CTXL, pos = dir ? (SEQ - 1 - p) : p; return b * SEQ + pos;
}
#define XB_TMO      128
#define XB_XCNT(j)  (256  + 64 * (j))
#define XB_XSUB(j)  (1280 + 64 * (j))
#define XB_XGEN(j)  (2304 + 64 * (j))
#define XB_TOP      3328
#define XB_TOPGEN   3392
#define XCD_BAR_WORDS 3456
#define XB_SPIN_CAP (1u << 18)

__device__ __forceinline__ unsigned xb_ld(unsigned* p)              { return __hip_atomic_load(p, __ATOMIC_RELAXED, __HIP_MEMORY_SCOPE_AGENT); }
__device__ __forceinline__ unsigned xb_add(unsigned* p, unsigned v) { return __hip_atomic_fetch_add(p, v, __ATOMIC_RELAXED, __HIP_MEMORY_SCOPE_AGENT); }
__device__ __forceinline__ unsigned xb_xcc_id() { return (unsigned)__builtin_amdgcn_s_getreg((3 << 11) | 20) & 0xFu; }
#define XB_SPIN(cond, bar) do { unsigned _sp = 0; while (cond) { __builtin_amdgcn_s_sleep(1); \
    if ((++_sp & 255u) == 0u) { if (xb_ld(&(bar)[XB_TMO])) break; if (_sp > XB_SPIN_CAP) { atomicAdd(&(bar)[XB_TMO], 1u); break; } } } } while (0)

struct XcdBarrier {
    unsigned* bar; unsigned x;
    volatile LAS unsigned* st;
};

__device__ __forceinline__ XcdBarrier xcd_barrier_post(unsigned* bar, volatile LAS unsigned* st) {
    XcdBarrier b; b.bar = bar; b.x = xb_xcc_id(); b.st = st;
    if (threadIdx.x == 0) (void)xb_add(&bar[XB_XCNT(b.x)], 1u);
    return b;
}
__device__ __forceinline__ void xcd_barrier_complete(unsigned* bar, unsigned x, unsigned& nloc, unsigned& nx) {
    const unsigned G = gridDim.x * gridDim.y * gridDim.z;
    unsigned sum, cnt, mine, sp = 0u;
    for (;;) {
        sum = 0u; cnt = 0u; mine = 0u;
#pragma unroll
        for (unsigned j = 0; j < 16; ++j) { const unsigned c = xb_ld(&bar[XB_XCNT(j)]); sum += c; cnt += (c > 0u) ? 1u : 0u; mine = (j == x) ? c : mine; }
        if (sum == G) break;
        __builtin_amdgcn_s_sleep(1);
        if ((++sp & 255u) == 0u) { if (xb_ld(&bar[XB_TMO])) break; if (sp > XB_SPIN_CAP) { atomicAdd(&bar[XB_TMO], 1u); break; } }
    }
    nloc = mine > 0u ? mine : 1u; nx = cnt > 0u ? cnt : 1u;
}

__device__ __forceinline__ void xcd_barrier(const XcdBarrier& b) {
    asm volatile("s_waitcnt vmcnt(0)" ::: "memory");
    __syncthreads();
    if (threadIdx.x == 0) {
        unsigned* bar = b.bar;
        __builtin_amdgcn_s_waitcnt(0);
        unsigned nloc = b.st[0], nx = b.st[1];
        if (nloc == 0u) { xcd_barrier_complete(bar, b.x, nloc, nx); b.st[0] = nloc; b.st[1] = nx; }
        const unsigned old = xb_add(&bar[XB_XSUB(b.x)], 1u);
        const unsigned gen = old / nloc;
        if (old + 1u == (gen + 1u) * nloc) {
            __builtin_amdgcn_fence(__ATOMIC_RELEASE, "agent");
            asm volatile("s_waitcnt vmcnt(0)" ::: "memory");
            const unsigned og = xb_add(&bar[XB_TOP], 1u);
            const unsigned tg = og / nx;
            if (og + 1u == (tg + 1u) * nx) xb_add(&bar[XB_TOPGEN], 1u);
            else XB_SPIN(xb_ld(&bar[XB_TOPGEN]) == tg, bar);
            __builtin_amdgcn_fence(__ATOMIC_ACQUIRE, "agent");
            xb_add(&bar[XB_XGEN(b.x)], 1u);
            asm volatile("s_waitcnt vmcnt(0)" ::: "memory");
        } else {
            XB_SPIN(xb_ld(&bar[XB_XGEN(b.x)]) == gen, bar);
            __builtin_amdgcn_fence(__ATOMIC_ACQUIRE, "agent");
            asm volatile("s_waitcnt vmcnt(0)" ::: "memory");
        }
    }
    __syncthreads();
}

struct EpiEven1 {
    static constexpr bool PERM = true, AFTER_DRAIN = false;
    bf16_t *QA, *VA, *GA, *ZB, *QKVB; float *LF, *GB; const float *lb, *a_log, *dt_bias;
    __device__ __forceinline__ void operator()(const f32x4 (&acc)[2][2][4][2], const Unit& u, int wr, int wc, int fr_, int fq_) const {
        int fr = fr_, fq = fq_; asm volatile("" : "+v"(fr), "+v"(fq));
        const int grp = u.pn >> 2, row0 = u.pm * 256 + wr * 64 + fr;
        if (grp == 9) {
            if (wc != 0) return;
            float al[8], db[8];
#pragma unroll
            for (int i = 0; i < 8; ++i) { const int c = (8 * fq + i) & 15; al[i] = -__expf(a_log[c]); db[i] = dt_bias[c]; }
#pragma unroll
            for (int ai = 0; ai < 2; ++ai)
#pragma unroll
                for (int m = 0; m < 4; ++m) { float* rowp = GB + (size_t)(row0 + ai * 128 + m * 16) * 32 + 8 * fq;
#pragma unroll
                    for (int n = 0; n < 2; ++n) { const f32x4 v = acc[ai][0][m][n]; f32x4 o;
#pragma unroll
                        for (int j = 0; j < 4; ++j) o[j] = (fq < 2) ? al[4 * n + j] * softplusf(v[j] + db[4 * n + j]) : sigm(v[j]);
                        *(f32x4*)(rowp + 4 * n) = o; } }
            return;
        }
        const int col0 = (u.pn & 3) * 256 + wc * 32 + 8 * fq;
        int op = 0, ld = 1024; bf16_t* dstb = VA; float* dstf = LF;
        switch (grp) {
            case 0: op = 2; dstb = QA; break;
            case 1: op = 0; dstb = VA; break;
            case 2: op = 3; dstf = LF; break;
            case 3: op = 3; dstf = LF + (size_t)M * 1024; break;
            case 4: op = 1; dstb = GA; break;
            case 5: case 6: case 7: op = 0; dstb = QKVB + (grp - 5) * 1024; ld = 3072; break;
            default: op = 1; dstb = ZB; break;
        }
        if (op == 3) {
#pragma unroll
            for (int bj = 0; bj < 2; ++bj) { float lbv[8];
#pragma unroll
                for (int i = 0; i < 8; ++i) lbv[i] = lb[col0 + bj * 128 + i];
#pragma unroll
                for (int ai = 0; ai < 2; ++ai)
#pragma unroll
                    for (int m = 0; m < 4; ++m) { float* rowp = dstf + (size_t)(row0 + ai * 128 + m * 16) * 1024 + col0 + bj * 128;
#pragma unroll
                        for (int n = 0; n < 2; ++n) { const f32x4 v = acc[ai][bj][m][n]; f32x4 o;
#pragma unroll
                            for (int j = 0; j < 4; ++j) { const float l = lbv[4 * n + j]; o[j] = __logf(l + (1.f - l) * sigm(v[j])); }
                            *(f32x4*)(rowp + 4 * n) = o; } } }
            return;
        }
#pragma unroll
        for (int ai = 0; ai < 2; ++ai)
#pragma unroll
            for (int m = 0; m < 4; ++m) { bf16_t* rowp = dstb + (size_t)(row0 + ai * 128 + m * 16) * ld + col0;
#pragma unroll
                for (int bj = 0; bj < 2; ++bj) { f32x4 v0 = acc[ai][bj][m][0], v1 = acc[ai][bj][m][1];
                    if (op >= 1) {
#pragma unroll
                        for (int j = 0; j < 4; ++j) { v0[j] = siluf(v0[j]); v1[j] = siluf(v1[j]); }
                        if (op == 2) { v0 = v0 * QSCALE; v1 = v1 * QSCALE; } }
                    u32x4 w; w.x = cvt_pk_bf16(v0[0], v0[1]); w.y = cvt_pk_bf16(v0[2], v0[3]); w.z = cvt_pk_bf16(v1[0], v1[1]); w.w = cvt_pk_bf16(v1[2], v1[3]);
                    *(u32x4*)(rowp + bj * 128) = w; } }
    }
};
struct EpiOdd1 {
    static constexpr bool PERM = true, AFTER_DRAIN = false;
    bf16_t *GY, *XBR;
    __device__ __forceinline__ void operator()(const f32x4 (&acc)[2][2][4][2], const Unit& u, int wr, int wc, int fr_, int fq_) const {
        int fr = fr_, fq = fq_; asm volatile("" : "+v"(fr), "+v"(fq));
        const int row0 = u.pm * 256 + wr * 64 + fr; const bool isy = u.pn < 8;
        bf16_t* dst = isy ? GY : XBR; const int col0 = (u.pn & 7) * 256 + wc * 32 + 8 * fq;
#pragma unroll
        for (int ai = 0; ai < 2; ++ai)
#pragma unroll
            for (int m = 0; m < 4; ++m) { bf16_t* rowp = dst + (size_t)(row0 + ai * 128 + m * 16) * D + col0;
#pragma unroll
                for (int bj = 0; bj < 2; ++bj) { f32x4 v0 = acc[ai][bj][m][0], v1 = acc[ai][bj][m][1];
                    if (isy) {
#pragma unroll
                        for (int j = 0; j < 4; ++j) { v0[j] = gelu_tanh(v0[j]); v1[j] = gelu_tanh(v1[j]); } }
                    u32x4 w; w.x = cvt_pk_bf16(v0[0], v0[1]); w.y = cvt_pk_bf16(v0[2], v0[3]); w.z = cvt_pk_bf16(v1[0], v1[1]); w.w = cvt_pk_bf16(v1[2], v1[3]);
                    *(u32x4*)(rowp + bj * 128) = w; } }
    }
};
struct EpiGates {
    static constexpr bool PERM = true, AFTER_DRAIN = false;
    const bf16_t* XC; unsigned* AB; const float *gate_b  , *lam  ;
    __device__ __forceinline__ void operator()(const f32x4 (&acc)[2][2][4][2], const Unit& u, int wr, int wc, int fr_, int fq_) const {
        int fr = fr_, fq = fq_; asm volatile("" : "+v"(fr), "+v"(fq));
        const int nb = u.pn >> 2, pn4 = u.pn & 3, d = pn4 >> 1, half = pn4 & 1;
        const int row0 = u.pm * 256 + wr * 64 + fr, ch0 = nb * 256 + half * 128 + wc * 32 + 8 * fq;
        unsigned* ab = AB + (size_t)d * M * D;
#pragma unroll
        for (int n = 0; n < 2; ++n) {
            const int ch = ch0 + 4 * n;
            const f32x4 gr = *(const f32x4*)(gate_b + (d * 2 + 0) * D + ch), gi = *(const f32x4*)(gate_b + (d * 2 + 1) * D + ch), lm = *(const f32x4*)(lam + d * D + ch);
            f32x4 sp;
#pragma unroll
            for (int j = 0; j < 4; ++j) sp[j] = -8.0f * softplusf(-lm[j]);
#pragma unroll
            for (int ai = 0; ai < 2; ++ai)
#pragma unroll
                for (int m = 0; m < 4; ++m) { const size_t ro = (size_t)(row0 + ai * 128 + m * 16) * D + ch;
                    const u32x2 xr = *(const u32x2*)(XC + ro); const float xc[4] = {bflo(xr.x), bfhi(xr.x), bflo(xr.y), bfhi(xr.y)};
                    u32x4 o;
#pragma unroll
                    for (int j = 0; j < 4; ++j) { const float r = sigm(acc[ai][0][m][n][j] + gr[j]), ig = sigm(acc[ai][1][m][n][j] + gi[j]);
                        const float la = r * sp[j], bb = __builtin_sqrtf(neg_expm1_fast(2.f * la)) * (ig * xc[j]); o[j] = pk2(la, bb); }
                    *(u32x4*)(ab + ro) = o; }
        }
    }
};
struct EpiResid {
    static constexpr bool PERM = false, AFTER_DRAIN = false;
    const float *r0, *r1; float* out; const float* gt; int permute;
    __device__ __forceinline__ void operator()(const f32x4 (&acc)[2][2][4][2], const Unit& u, int wr, int wc, int fr_, int fq_) const {
        int fr = fr_, fq = fq_; asm volatile("" : "+v"(fr), "+v"(fq));
        const int rowt = u.pm * 256, mi = mod_index(rowt), col0 = u.pn * 256 + wc * 32 + 4 * fq;
        f32x4 gv[2][2];
#pragma unroll
        for (int bj = 0; bj < 2; ++bj)
#pragma unroll
            for (int n = 0; n < 2; ++n) gv[bj][n] = *(const f32x4*)(gt + (size_t)mi * 12288 + col0 + bj * 128 + n * 16) + 1.0f;
#pragma unroll
        for (int ai = 0; ai < 2; ++ai)
#pragma unroll
            for (int m = 0; m < 4; ++m) { const int rr = rowt + ai * 128 + wr * 64 + m * 16 + fr, tok = permute ? unperm_row(rr) : rr;
                const float* rp = (tok < MX ? r0 + (size_t)tok * D : r1 + (size_t)(tok - MX) * D) + col0; float* op = out + (size_t)tok * D + col0;
#pragma unroll
                for (int bj = 0; bj < 2; ++bj)
#pragma unroll
                    for (int n = 0; n < 2; ++n) { const f32x4 rs = *(const f32x4*)(rp + bj * 128 + n * 16); *(f32x4*)(op + bj * 128 + n * 16) = rs * DN_ALPHA + gv[bj][n] * acc[ai][bj][m][n]; }
                asm volatile("" ::: "memory"); }
    }
};
struct EpiSwiGLU {
    static constexpr bool PERM = true, AFTER_DRAIN = false;
    bf16_t* ACT;
    __device__ __forceinline__ void operator()(const f32x4 (&acc)[2][2][4][2], const Unit& u, int wr, int wc, int fr_, int fq_) const {
        int fr = fr_, fq = fq_; asm volatile("" : "+v"(fr), "+v"(fq));
        const int row0 = u.pm * 256 + wr * 64 + fr, col0 = u.pn * 128 + wc * 32 + 8 * fq;
#pragma unroll
        for (int ai = 0; ai < 2; ++ai)
#pragma unroll
            for (int m = 0; m < 4; ++m) { f32x4 v0 = acc[ai][0][m][0], v1 = acc[ai][0][m][1]; const f32x4 u0 = acc[ai][1][m][0], u1 = acc[ai][1][m][1];
#pragma unroll
                for (int j = 0; j < 4; ++j) { v0[j] = siluf(v0[j]) * u0[j]; v1[j] = siluf(v1[j]) * u1[j]; }
                u32x4 w; w.x = cvt_pk_bf16(v0[0], v0[1]); w.y = cvt_pk_bf16(v0[2], v0[3]); w.z = cvt_pk_bf16(v1[0], v1[1]); w.w = cvt_pk_bf16(v1[2], v1[3]);
                *(u32x4*)(ACT + (size_t)(row0 + ai * 128 + m * 16) * FF + col0) = w; }
    }
};
struct Frame {
    LAS unsigned char* lds;
    int tid, lane, wave, G, gw, NGW;
};
struct Args { const float* in[25]; float* out; unsigned char* ws; int ph_lo, ph_hi; };

template <int MODE> __device__ __forceinline__ long src_off(int n, int nsrc) {
    if (MODE == 0) return n < nsrc ? (long)n : -1L;
    if (MODE == 1) { const int pn = n >> 8, bj = (n >> 7) & 1, jj = n & 127; return (long)bj * FF + pn * 128 + jj; }
    const int nb = n >> 10, c = n & 1023, pn4 = c >> 8, g = (c >> 7) & 1, jj = c & 127, d = pn4 >> 1, half = pn4 & 1;
    return (long)(((d * 2 + g) * 8 + nb) * 256) * 256 + half * 128 + jj;
}
template <int MODE> __device__ __forceinline__ void tr_item(const float* W, int ldin, int K, bf16* WT, int nout, int nsrc, LAS float* scr, int item, int lane) {
    const int nblk = nout / 32, kb = item / nblk, nb = item % nblk, k0 = 64 * kb, n0 = 32 * nb;
    const long off = src_off<MODE>(n0 + (lane & 31), nsrc);
#pragma unroll 8
    for (int i = 0; i < 32; ++i) { const int kk = 2 * i + (lane >> 5); scr[kk * 33 + (lane & 31)] = off >= 0 ? W[off + (size_t)(k0 + kk) * ldin] : 0.f; }
    LDS_WAIT(); asm volatile("" ::: "memory");
    const int c = lane & 7;
#pragma unroll
    for (int j = 0; j < 4; ++j) { const int n = (lane >> 3) + 8 * j; const LAS float* s = scr + (8 * c) * 33 + n;
        u32x4 o; o.x = pk2(s[0 * 33], s[1 * 33]); o.y = pk2(s[2 * 33], s[3 * 33]); o.z = pk2(s[4 * 33], s[5 * 33]); o.w = pk2(s[6 * 33], s[7 * 33]);
        *(u32x4*)(WT + (size_t)(n0 + n) * K + k0 + 8 * c) = o; }
    LDS_WAIT(); asm volatile("" ::: "memory");
}
__device__ __forceinline__ void gemv_item(const Args& a, int gi, int lane, float* PART) {
    const int l = gi / 384, c48 = (gi >> 3) % 48, kp = gi & 7, col = c48 * 256 + lane * 4;
    const float* W = a.in[4] + ((size_t)l * D + kp * 256) * 12288 + col;
    const float* c0 = a.in[1] + kp * 256; const float* c1 = c0 + D; const float* c2 = a.in[3] + kp * 256;
    f32x4 s0 = {0.f, 0.f, 0.f, 0.f}, s1 = s0, s2 = s0;
#pragma unroll 8
    for (int k = 0; k < 256; ++k) { const f32x4 w = *(const f32x4*)(W + (size_t)k * 12288); s0 += w * siluf(c0[k]); s1 += w * siluf(c1[k]); s2 += w * siluf(c2[k]); }
    float* p = PART + ((size_t)(kp * 4 + l) * 3) * 12288 + col;
    *(f32x4*)p = s0; *(f32x4*)(p + 12288) = s1; *(f32x4*)(p + 2 * 12288) = s2;
}
__device__ __forceinline__ void ph_prologue(Frame& F, const Args& a) {
    LAS float* scr = (LAS float*)(F.lds + RING_OFF + F.wave * 16384);
    unsigned char* ws = a.ws;
    constexpr int I_INE = (D / 64) * (NE_INP / 32), I_SQ = (D / 64) * (D / 32), I_INO = (D / 64) * (2 * D / 32), I_GATE = (256 / 64) * (8192 / 32), I_GU = (D / 64) * (2 * FF / 32), I_DN = (FF / 64) * (D / 32);
    constexpr int NGEMV = 4 * 48 * 8;
    constexpr int NITEMS = NGEMV + 2 * (I_INE + I_SQ + I_INO + I_GATE + I_SQ) + 4 * (I_GU + I_DN);
    for (int it = F.gw; it < NITEMS; it += F.NGW) {
        int r = it;
        if (r < NGEMV) { gemv_item(a, r, F.lane, (float*)(ws + WS_PART)); continue; } r -= NGEMV;
        bool done = false;
#pragma unroll 1
        for (int j = 0; j < 2 && !done; ++j) {
            if (r < I_INE) { tr_item<0>(a.in[10] + (size_t)j * D * NE_IN, NE_IN, D, (bf16*)(ws + WS_WINE + j * SZ_WINE), NE_INP, NE_IN, scr, r, F.lane); done = true; break; } r -= I_INE;
            if (r < I_SQ) { tr_item<0>(a.in[17] + (size_t)j * D * D, D, D, (bf16*)(ws + WS_WOUTE + j * SZ_WSQ), D, D, scr, r, F.lane); done = true; break; } r -= I_SQ;
            if (r < I_INO) { tr_item<0>(a.in[18] + (size_t)j * D * 2 * D, 2 * D, D, (bf16*)(ws + WS_WINO + j * SZ_WINO), 2 * D, 2 * D, scr, r, F.lane); done = true; break; } r -= I_INO;
            if (r < I_GATE) { tr_item<2>(a.in[21] + (size_t)j * 4 * 8 * 256 * 256, 256, 256, (bf16*)(ws + WS_WGATE + j * SZ_WGATE), 8192, 8192, scr, r, F.lane); done = true; break; } r -= I_GATE;
            if (r < I_SQ) { tr_item<0>(a.in[24] + (size_t)j * D * D, D, D, (bf16*)(ws + WS_WOUTO + j * SZ_WSQ), D, D, scr, r, F.lane); done = true; break; } r -= I_SQ;
        }
        if (done) continue;
#pragma unroll 1
        for (int l = 0; l < 4; ++l) {
            if (r < I_GU) { tr_item<1>(a.in[8] + (size_t)l * D * 2 * FF, 2 * FF, D, (bf16*)(ws + WS_WGU + l * SZ_WGU), 2 * FF, 2 * FF, scr, r, F.lane); break; } r -= I_GU;
            if (r < I_DN) { tr_item<0>(a.in[9] + (size_t)l * FF * D, D, FF, (bf16*)(ws + WS_WDN + l * SZ_WDN), D, D, scr, r, F.lane); break; } r -= I_DN;
        }
    }
}
__device__ __forceinline__ void ph_modreduce(Frame& F, const Args& a) {
    float* MOD = (float*)(a.ws + WS_MOD); const float* PART = (const float*)(a.ws + WS_PART); float* LB = (float*)(a.ws + WS_LB);
    const int gt = blockIdx.x * NTHREADS + F.tid, NT = F.G * NTHREADS;
    for (int i = gt; i < 4 * 3 * 12288; i += NT) { const int l = i / 36864, n = i % 12288; float s = a.in[5][l * 12288 + n];
#pragma unroll
        for (int kp = 0; kp < 8; ++kp) s += PART[(size_t)kp * 147456 + i];
        MOD[i] = s; }
    for (int i = gt; i < 2048; i += NT) { const int c = i & 1023; LB[i] = i < 1024 ? 0.f : sigm(a.in[14][1024 + c] - a.in[14][c]); }
}
__device__ __forceinline__ void store_hx(bf16* HX, int orow, const f32x4 (&v)[8], const float* sh, const float* sc, int lane) {
    unsigned long long* o8 = (unsigned long long*)(HX + (size_t)orow * D) + lane;
#pragma unroll
    for (int j = 0; j < 8; ++j) { const f32x4 s = *(const f32x4*)(sc + 4 * (lane + 64 * j)), h = *(const f32x4*)(sh + 4 * (lane + 64 * j)); const f32x4 y = v[j] * (s + 1.0f) + h;
        o8[64 * j] = (unsigned long long)pk2(y[0], y[1]) | ((unsigned long long)pk2(y[2], y[3]) << 32); }
}
__device__ __forceinline__ void ph_mod0(Frame& F, const Args& a) {
    const float* MOD = (const float*)(a.ws + WS_MOD); bf16* HX = (bf16*)(a.ws + WS_HX);
    for (int row = F.gw; row < M; row += F.NGW) {
        const float* p = row < MX ? a.in[0] + (size_t)row * D : a.in[2] + (size_t)(row - MX) * D; f32x4 v[8];
#pragma unroll
        for (int j = 0; j < 8; ++j) v[j] = *(const f32x4*)(p + 4 * (F.lane + 64 * j));
        const float* md = MOD + (size_t)mod_index(row) * 12288;
        store_hx(HX, row, v, md, md + D, F.lane);
    }
}
__device__ __forceinline__ void ph_ln(Frame& F, float* buf, int nrows, const float* g, const float* b, float* dout, bf16* HX, const float* modsh, const float* modsc, int permute) {
    for (int row = F.gw; row < nrows; row += F.NGW) {
        float* p = buf + (size_t)row * D; f32x4 v[8]; float s = 0.f;
#pragma unroll
        for (int j = 0; j < 8; ++j) { v[j] = *(const f32x4*)(p + 4 * (F.lane + 64 * j)); s += (v[j][0] + v[j][1]) + (v[j][2] + v[j][3]); }
        const float mean = wave_sum(s) * (1.f / D); float q = 0.f;
#pragma unroll
        for (int j = 0; j < 8; ++j) { v[j] = v[j] - mean; q += (v[j][0] * v[j][0] + v[j][1] * v[j][1]) + (v[j][2] * v[j][2] + v[j][3] * v[j][3]); }
        const float rstd = 1.f / sqrtf(wave_sum(q) * (1.f / D) + LN_EPS);
        float* o = dout ? dout + (size_t)row * D : p;
#pragma unroll
        for (int j = 0; j < 8; ++j) { const f32x4 gg = *(const f32x4*)(g + 4 * (F.lane + 64 * j)), bb = *(const f32x4*)(b + 4 * (F.lane + 64 * j)); v[j] = v[j] * rstd * gg + bb; *(f32x4*)(o + 4 * (F.lane + 64 * j)) = v[j]; }
        if (HX) { const int mi = mod_index(row); store_hx(HX, permute ? perm_row(row) : row, v, modsh + (size_t)mi * 12288, modsc + (size_t)mi * 12288, F.lane); }
    }
}
__device__ __forceinline__ void seg_bounds(int r, int& lo, int& hi) { if (r < MX) { lo = r & ~(SEQ - 1); hi = lo + SEQ; } else { lo = MX + ((r - MX) & ~(CTXL - 1)); hi = lo + CTXL; } }
__device__ __forceinline__ void ph_gdn_prep(Frame& F, const Args& a, int j) {
    const bf16* QKVB = (const bf16*)(a.ws + WS_QKVB); bf16* QB = (bf16*)(a.ws + WS_QB); bf16* KB = (bf16*)(a.ws + WS_KB); bf16* VB = (bf16*)(a.ws + WS_VB);
    const float* cw = a.in[11] + (size_t)j * 4 * 3072;
    for (int row = F.gw; row < M; row += F.NGW) {
        int lo, hi; seg_bounds(row, lo, hi);
#pragma unroll 2
        for (int it = 0; it < 24; ++it) { const int s = it >> 3, h = it & 7, ch = s * 1024 + h * 128 + F.lane * 2; float y0 = 0.f, y1 = 0.f;
#pragma unroll
            for (int k = 0; k < 4; ++k) { const int rr = row + k - 2; if (rr >= lo && rr < hi) { const unsigned x = *(const unsigned*)(QKVB + (size_t)rr * 3072 + ch); y0 += cw[k * 3072 + ch] * bflo(x); y1 += cw[k * 3072 + ch + 1] * bfhi(x); } }
            y0 = siluf(y0); y1 = siluf(y1);
            if (s < 2) { const float sc = rsqrtf(wave_sum(y0 * y0 + y1 * y1) + 1e-6f) * (s == 0 ? QSCALE : 1.f); y0 *= sc; y1 *= sc; }
            bf16* dst = s == 0 ? QB : (s == 1 ? KB : VB);
            *(unsigned*)(dst + (size_t)row * AW + h * 128 + F.lane * 2) = pk2(y0, y1); }
    }
}
__device__ __forceinline__ void ph_merge(Frame& F, const Args& a, int j) {
    const bf16* OA = (const bf16*)(a.ws + WS_OA); const bf16* OB = (const bf16*)(a.ws + WS_OB); const bf16* GA = (const bf16*)(a.ws + WS_GA); const bf16* ZB = (const bf16*)(a.ws + WS_ZB);
    bf16* MIX = (bf16*)(a.ws + WS_MIX); const float* na = a.in[15] + (size_t)j * AW; const float* nb = a.in[16] + (size_t)j * AW;
    for (int row = F.gw; row < M; row += F.NGW) {
#pragma unroll 2
        for (int it = 0; it < 16; ++it) { const int part = it >> 3, c = (it & 7) * 128 + F.lane * 2; const bf16* O = part ? OB : OA; const size_t o = (size_t)row * AW + c;
            const unsigned x0 = *(const unsigned*)(O + o), x1 = *(const unsigned*)(O + (size_t)M * AW + o), gg = *(const unsigned*)((part ? ZB : GA) + o);
            float y0 = bflo(x0) + bflo(x1), y1 = bfhi(x0) + bfhi(x1);
            const float sc = rsqrtf(wave_sum(y0 * y0 + y1 * y1) * (1.f / 128.f) + 1e-6f); const float* nw = part ? nb : na;
            y0 = y0 * sc * nw[c] * bflo(gg); y1 = y1 * sc * nw[c + 1] * bfhi(gg);
            *(unsigned*)(MIX + (size_t)row * D + part * AW + c) = pk2(y0, y1); }
    }
}
__device__ __forceinline__ void ph_odd_conv(Frame& F, const Args& a, int j) {
    const bf16* XBR = (const bf16*)(a.ws + WS_XBR); bf16* XC = (bf16*)(a.ws + WS_XC); const float* cw = a.in[19] + (size_t)j * 4 * D; const float* cb = a.in[20] + (size_t)j * D;
    for (int row = F.gw; row < M; row += F.NGW) {
        int lo, hi; seg_bounds(row, lo, hi);
#pragma unroll 2
        for (int it = 0; it < 16; ++it) { const int ch = it * 128 + F.lane * 2; float y0 = cb[ch], y1 = cb[ch + 1];
#pragma unroll
            for (int k = 0; k < 4; ++k) { const int rr = row + k - 2; if (rr >= lo && rr < hi) { const unsigned x = *(const unsigned*)(XBR + (size_t)rr * D + ch); y0 += cw[k * D + ch] * bflo(x); y1 += cw[k * D + ch + 1] * bfhi(x); } }
            *(unsigned*)(XC + (size_t)row * D + ch) = pk2(y0, y1); }
    }
}
__device__ __forceinline__ void ph_odd_l1(Frame& F, const Args& a) {
    const unsigned* AB = (const unsigned*)(a.ws + WS_AB); float2* PH = (float2*)(a.ws + WS_R);
    for (int it = F.gw; it < 128 * 132; it += F.NGW) {
        const int cgp = it & 127, tc = it >> 7, c = cgp * 64 + F.lane, ch = c & 2047, d = (c >> 11) & 1, b = c >> 12;
        const unsigned* ab = AB + (size_t)d * M * D + ch; float P = 1.f, H = 0.f;
        const int row0 = seq_row(b, d, tc * 64), stp = d ? -1 : 1;
#pragma unroll 1
        for (int k0 = 0; k0 < 64; k0 += 16) { unsigned x[16];
#pragma unroll
            for (int k = 0; k < 16; ++k) x[k] = ab[(size_t)(row0 + stp * (k0 + k)) * D];
#pragma unroll
            for (int k = 0; k < 16; ++k) { const float al = __expf(bflo(x[k])); P *= al; H = al * H + bfhi(x[k]); } }
        PH[(size_t)tc * 8192 + c] = make_float2(P, H);
    }
}
__device__ __forceinline__ void ph_odd_l3(Frame& F, const Args& a) {
    const unsigned* AB = (const unsigned*)(a.ws + WS_AB); const float2* PH = (const float2*)(a.ws + WS_R); const bf16* GY = (const bf16*)(a.ws + WS_GY); bf16* MIX = (bf16*)(a.ws + WS_MIX);
    for (int it = F.gw; it < 64 * 132; it += F.NGW) {
        const int g64 = it & 63, jb = it >> 6, b = g64 >> 5, ch = (g64 & 31) * 64 + F.lane;
        const int row0 = jb < 4 ? MX + b * CTXL + jb * 64 : b * SEQ + (jb - 4) * 64;
        const int tcf = jb, tcb = jb < 4 ? 3 - jb : 4 + (131 - jb);
        const int cf = (b << 12) + ch, cb = (b << 12) + 2048 + ch;
        float hf = 0.f, hb = 0.f;
        for (int q = 0; q < tcf; ++q) { const float2 p = PH[(size_t)q * 8192 + cf]; hf = p.x * hf + p.y; }
        for (int q = 0; q < tcb; ++q) { const float2 p = PH[(size_t)q * 8192 + cb]; hb = p.x * hb + p.y; }
        const unsigned* ab0 = AB + (size_t)row0 * D + ch; const unsigned* ab1 = ab0 + (size_t)M * D;
        float hs[64];
#pragma unroll
        for (int k0 = 0; k0 < 64; k0 += 16) { unsigned x[16];
#pragma unroll
            for (int k = 0; k < 16; ++k) x[k] = ab0[(size_t)(k0 + k) * D];
#pragma unroll
            for (int k = 0; k < 16; ++k) { hf = __expf(bflo(x[k])) * hf + bfhi(x[k]); hs[k0 + k] = hf; } }
        const bf16* gy = GY + (size_t)row0 * D + ch; bf16* mx = MIX + (size_t)row0 * D + ch;
#pragma unroll
        for (int k0 = 48; k0 >= 0; k0 -= 16) { unsigned x[16]; bf16 gv[16];
#pragma unroll
            for (int k = 0; k < 16; ++k) { x[k] = ab1[(size_t)(k0 + k) * D]; gv[k] = gy[(size_t)(k0 + k) * D]; }
#pragma unroll
            for (int k = 15; k >= 0; --k) { hb = __expf(bflo(x[k])) * hb + bfhi(x[k]); mx[(size_t)(k0 + k) * D] = (bf16)f2bf(bf2f(gv[k]) * (hs[k0 + k] + hb)); } }
    }
}
__device__ __forceinline__ void hgrn_wave(int wi, int lane, const bf16* QA, const float* LF, const bf16* VA, bf16* OA) {
    const int chain = wi >> 3, cg = wi & 7, b = chain >> 4, h = (chain >> 1) & 7, dir = chain & 1, kq = lane >> 4, col = cg * 16 + (lane & 15);
    const float* lf = LF + (size_t)dir * M * AW + h * 128 + kq * 32; const bf16* qa = QA + h * 128 + kq * 32; const bf16* va = VA + h * 128 + col; bf16* oa = OA + (size_t)dir * M * AW + h * 128 + col;
    float S[32];
#pragma unroll
    for (int i = 0; i < 32; ++i) S[i] = 0.f;
    u32x4 qn[4]; f32x4 fn[8]; float vn; int rown = seq_row(b, dir, 0);
#pragma unroll
    for (int i = 0; i < 4; ++i) qn[i] = *(const u32x4*)(qa + (size_t)rown * AW + 8 * i);
#pragma unroll
    for (int i = 0; i < 8; ++i) fn[i] = *(const f32x4*)(lf + (size_t)rown * AW + 4 * i);
    vn = bf2f(va[(size_t)rown * AW]);
    for (int s = 0; s < CTXL + SEQ; ++s) {
        u32x4 qc[4]; f32x4 fc[8]; const float vc = vn; const int row = rown;
#pragma unroll
        for (int i = 0; i < 4; ++i) qc[i] = qn[i];
#pragma unroll
        for (int i = 0; i < 8; ++i) fc[i] = fn[i];
        if (s + 1 < CTXL + SEQ) { rown = seq_row(b, dir, s + 1);
#pragma unroll
            for (int i = 0; i < 4; ++i) qn[i] = *(const u32x4*)(qa + (size_t)rown * AW + 8 * i);
#pragma unroll
            for (int i = 0; i < 8; ++i) fn[i] = *(const f32x4*)(lf + (size_t)rown * AW + 4 * i);
            vn = bf2f(va[(size_t)rown * AW]); }
        float o = 0.f;
#pragma unroll
        for (int i = 0; i < 32; ++i) { const float f = __expf(fc[i >> 2][i & 3]); const unsigned qw = qc[i >> 3][(i >> 1) & 3]; const float q = (i & 1) ? bfhi(qw) : bflo(qw);
            S[i] = f * (S[i] - vc) + vc; o += S[i] * q; }
        o += __shfl_xor(o, 16); o += __shfl_xor(o, 32);
        if (kq == 0) oa[(size_t)row * AW] = (bf16)f2bf(o);
    }
}
__device__ __forceinline__ void gdn_wave(int wi, int lane, const bf16* QB, const bf16* KB, const bf16* VB, const float* GB, bf16* OB) {
    const int chain = wi >> 3, cg = wi & 7, b = chain >> 4, h = (chain >> 1) & 7, dir = chain & 1, kq = lane >> 4, col = cg * 16 + (lane & 15);
    const bf16* qb = QB + h * 128 + kq * 32; const bf16* kb = KB + h * 128 + kq * 32; const bf16* vb = VB + h * 128 + col; const float* gb = GB + dir * 8 + h; bf16* ob = OB + (size_t)dir * M * AW + h * 128 + col;
    float S[32];
#pragma unroll
    for (int i = 0; i < 32; ++i) S[i] = 0.f;
    u32x4 qn[4], kn[4]; float vn, gn, bn; int rown = seq_row(b, dir, 0);
#pragma unroll
    for (int i = 0; i < 4; ++i) { qn[i] = *(const u32x4*)(qb + (size_t)rown * AW + 8 * i); kn[i] = *(const u32x4*)(kb + (size_t)rown * AW + 8 * i); }
    vn = bf2f(vb[(size_t)rown * AW]); gn = gb[(size_t)rown * 32]; bn = gb[(size_t)rown * 32 + 16];
    for (int s = 0; s < CTXL + SEQ; ++s) {
        u32x4 qc[4], kc[4]; const float vc = vn, gc = gn, bc = bn; const int row = rown;
#pragma unroll
        for (int i = 0; i < 4; ++i) { qc[i] = qn[i]; kc[i] = kn[i]; }
        if (s + 1 < CTXL + SEQ) { rown = seq_row(b, dir, s + 1);
#pragma unroll
            for (int i = 0; i < 4; ++i) { qn[i] = *(const u32x4*)(qb + (size_t)rown * AW + 8 * i); kn[i] = *(const u32x4*)(kb + (size_t)rown * AW + 8 * i); }
            vn = bf2f(vb[(size_t)rown * AW]); gn = gb[(size_t)rown * 32]; bn = gb[(size_t)rown * 32 + 16]; }
        const float al = __expf(gc); float ks = 0.f; float kk[32];
#pragma unroll
        for (int i = 0; i < 32; ++i) { const unsigned kw = kc[i >> 3][(i >> 1) & 3]; kk[i] = (i & 1) ? bfhi(kw) : bflo(kw); ks += kk[i] * S[i]; }
        ks += __shfl_xor(ks, 16); ks += __shfl_xor(ks, 32);
        const float dl = bc * (vc - al * ks); float o = 0.f;
#pragma unroll
        for (int i = 0; i < 32; ++i) { const unsigned qw = qc[i >> 3][(i >> 1) & 3]; const float q = (i & 1) ? bfhi(qw) : bflo(qw); S[i] = al * S[i] + kk[i] * dl; o += S[i] * q; }
        o += __shfl_xor(o, 16); o += __shfl_xor(o, 32);
        if (kq == 0) ob[(size_t)row * AW] = (bf16)f2bf(o);
    }
}
__device__ __forceinline__ void ph_even_scan(Frame& F, const Args& a) {
    unsigned char* ws = a.ws;
    if (F.wave == 0) { for (int wi = blockIdx.x; wi < 256; wi += F.G) hgrn_wave(wi, F.lane, (const bf16*)(ws + WS_QA), (const float*)(ws + WS_LF), (const bf16*)(ws + WS_VA), (bf16*)(ws + WS_OA)); }
    else if (F.wave == 1) { for (int wi = blockIdx.x; wi < 256; wi += F.G) gdn_wave(wi, F.lane, (const bf16*)(ws + WS_QB), (const bf16*)(ws + WS_KB), (const bf16*)(ws + WS_VB), (const float*)(ws + WS_GB), (bf16*)(ws + WS_OB)); }
}
typedef short bf16x8 __attribute__((ext_vector_type(8)));
typedef short bf16x4 __attribute__((ext_vector_type(4)));
constexpr int NCHUNK = (CTXL + SEQ) / 16;
constexpr int NCHH = 32 * NCHUNK;
constexpr int HREC = 9216;
constexpr int HQ_OFF = 0, HK_OFF = 4096, HP_OFF = 8192, HD_OFF = 8704;
constexpr int GREC = 17152;
constexpr int GW_OFF = 0, GQ_OFF = 4096, GK_OFF = 8192, GU_OFF = 12288, GAT_OFF = 16384, GAL_OFF = 16896;
__device__ __forceinline__ unsigned cvtpk(float lo, float hi) { return pg8::cvt_pk_bf16(lo, hi); }
template <int N> __device__ __forceinline__ float row_shr(float x) { return __builtin_bit_cast(float, __builtin_amdgcn_update_dpp(0, __builtin_bit_cast(int, x), 0x110 + N, 0xf, 0xf, true)); }
__device__ __forceinline__ float row_prefix(float x) { x += row_shr<1>(x); x += row_shr<2>(x); x += row_shr<4>(x); x += row_shr<8>(x); return x; }
__device__ __forceinline__ float rdlane(float x, int l) { return __builtin_bit_cast(float, __builtin_amdgcn_readlane(__builtin_bit_cast(int, x), l)); }
__device__ __forceinline__ bf16x8 mk8(unsigned a, unsigned b, unsigned c, unsigned d) { return __builtin_bit_cast(bf16x8, (u32x4){a, b, c, d}); }
__device__ __forceinline__ bf16x4 mk4(unsigned a, unsigned b) { return __builtin_bit_cast(bf16x4, (u32x2){a, b}); }
#define MFMA32(a, b, c) __builtin_amdgcn_mfma_f32_16x16x32_bf16((a), (b), (c), 0, 0, 0)
#define MFMA16(a, b, c) __builtin_amdgcn_mfma_f32_16x16x16bf16_1k((a), (b), (c), 0, 0, 0)

__device__ __forceinline__ void hgrn_s1(int chh, int lane, unsigned char* ws) {
    const int chain = chh / NCHUNK, ci = chh - chain * NCHUNK, b = chain >> 4, h = (chain >> 1) & 7, dir = chain & 1, i = lane & 15, g = lane >> 4;
    const int row = seq_row(b, dir, ci * 16 + i);
    const bf16* qrow = (const bf16*)(ws + WS_QA) + (size_t)row * AW + h * 128 + 4 * g;
    const float* frow = (const float*)(ws + WS_LF) + (size_t)dir * M * AW + (size_t)row * AW + h * 128 + 4 * g;
    unsigned char* rec = ws + WS_HREC + (size_t)chh * HREC;
    bf16* hk = (bf16*)(rec + HK_OFF) + (16 * (i >> 2)) * 4 + (i & 3);
    f32x4 pacc = {0.f, 0.f, 0.f, 0.f};
#pragma unroll
    for (int s = 0; s < 4; ++s) {
        u32x2 qv[2]; f32x4 fv[2];
#pragma unroll
        for (int hh = 0; hh < 2; ++hh) { qv[hh] = *(const u32x2*)(qrow + 32 * s + 16 * hh); fv[hh] = *(const f32x4*)(frow + 32 * s + 16 * hh); }
        float qt[8], kh[8];
#pragma unroll
        for (int hh = 0; hh < 2; ++hh) { f32x4 ddv;
#pragma unroll
            for (int j = 0; j < 4; ++j) { const int idx = 4 * hh + j; const float lf = fv[hh][j], gc = row_prefix(lf), gl = __shfl(gc, (lane & 48) | 15);
                const float eg = __expf(gc), einv = __builtin_amdgcn_rcpf(eg), f = __expf(lf), dd = __expf(gl);
                const unsigned qw = qv[hh][j >> 1]; const float q = (j & 1) ? bfhi(qw) : bflo(qw);
                qt[idx] = q * eg; kh[idx] = (1.f - f) * einv; ddv[j] = dd;
                hk[((2 * s + hh) * 64 + 4 * g + j) * 4] = (bf16)f2bf(kh[idx] * dd); }
            if (i == 0) *(f32x4*)(rec + HD_OFF + (32 * s + 16 * hh + 4 * g) * 4) = ddv; }
        const bf16x8 Qf = mk8(cvtpk(qt[0], qt[1]), cvtpk(qt[2], qt[3]), cvtpk(qt[4], qt[5]), cvtpk(qt[6], qt[7]));
        const bf16x8 Kf = mk8(cvtpk(kh[0], kh[1]), cvtpk(kh[2], kh[3]), cvtpk(kh[4], kh[5]), cvtpk(kh[6], kh[7]));
        *(bf16x8*)(rec + HQ_OFF + (s * 64 + lane) * 16) = Qf;
        pacc = MFMA32(Kf, Qf, pacc);
    }
    float p[4];
#pragma unroll
    for (int r = 0; r < 4; ++r) p[r] = (4 * g + r <= i) ? pacc[r] : 0.f;
    *(bf16x4*)(rec + HP_OFF + lane * 8) = mk4(cvtpk(p[0], p[1]), cvtpk(p[2], p[3]));
}

__device__ __forceinline__ void gdn_s1(int chh, int lane, unsigned char* ws) {
    const int chain = chh / NCHUNK, ci = chh - chain * NCHUNK, b = chain >> 4, h = (chain >> 1) & 7, dir = chain & 1, i = lane & 15, g = lane >> 4;
    const int row = seq_row(b, dir, ci * 16 + i), row0 = seq_row(b, dir, ci * 16), stp = dir ? -1 : 1;
    const float* GB = (const float*)(ws + WS_GB);
    const float gval = GB[(size_t)row * 32 + dir * 8 + h], beta = GB[(size_t)row * 32 + 16 + dir * 8 + h];
    const float gc = row_prefix(gval), gl = __shfl(gc, (lane & 48) | 15), eg = __expf(gc), ekl = __expf(gl - gc);
    const bf16* qrow = (const bf16*)(ws + WS_QB) + (size_t)row * AW + h * 128 + 4 * g;
    const bf16* krow = (const bf16*)(ws + WS_KB) + (size_t)row * AW + h * 128 + 4 * g;
    unsigned char* rec = ws + WS_GREC + (size_t)chh * GREC;
    f32x4 kkacc = {0.f, 0.f, 0.f, 0.f}, qkacc = {0.f, 0.f, 0.f, 0.f};
#pragma unroll
    for (int s = 0; s < 4; ++s) {
        u32x2 qv[2], kv[2];
#pragma unroll
        for (int hh = 0; hh < 2; ++hh) { qv[hh] = *(const u32x2*)(qrow + 32 * s + 16 * hh); kv[hh] = *(const u32x2*)(krow + 32 * s + 16 * hh); }
        const bf16x8 Kf = mk8(kv[0].x, kv[0].y, kv[1].x, kv[1].y), Qf = mk8(qv[0].x, qv[0].y, qv[1].x, qv[1].y);
        kkacc = MFMA32(Kf, Kf, kkacc);
        qkacc = MFMA32(Kf, Qf, qkacc);
        unsigned qs[4];
#pragma unroll
        for (int w = 0; w < 4; ++w) { const unsigned qw = qv[w >> 1][w & 1]; qs[w] = cvtpk(bflo(qw) * eg, bfhi(qw) * eg); }
        *(bf16x8*)(rec + GQ_OFF + (s * 64 + lane) * 16) = mk8(qs[0], qs[1], qs[2], qs[3]);
    }
    float att[4], Areg[4];
#pragma unroll
    for (int r = 0; r < 4; ++r) { const float gcs = __shfl(gc, 4 * g + r), bts = __shfl(beta, 4 * g + r);
        att[r] = (4 * g + r <= i) ? qkacc[r] * __expf(gc - gcs) : 0.f;
        Areg[r] = (i < 4 * g + r) ? bts * kkacc[r] * __expf(gcs - gc) : 0.f; }
    *(bf16x4*)(rec + GAT_OFF + lane * 8) = mk4(cvtpk(att[0], att[1]), cvtpk(att[2], att[3]));
    if (lane == 0) *(float*)(rec + GAL_OFF) = __expf(gl);
    float xu[16][2], xw[16][2], kt[16][2];
    const bf16* vcol = (const bf16*)(ws + WS_VB) + h * 128 + 2 * lane; const bf16* kcol = (const bf16*)(ws + WS_KB) + h * 128 + 2 * lane;
#pragma unroll
    for (int t = 0; t < 16; ++t) { const size_t ro = (size_t)(row0 + stp * t) * AW; const unsigned vv = *(const unsigned*)(vcol + ro), kv = *(const unsigned*)(kcol + ro);
        const float bt = rdlane(beta, t), egt = rdlane(eg, t), et = rdlane(ekl, t), k0 = bflo(kv), k1 = bfhi(kv);
        xu[t][0] = bt * bflo(vv); xu[t][1] = bt * bfhi(vv); xw[t][0] = bt * egt * k0; xw[t][1] = bt * egt * k1; kt[t][0] = k0 * et; kt[t][1] = k1 * et; }
#pragma unroll
    for (int t = 1; t < 16; ++t)
#pragma unroll
        for (int s = 0; s < t; ++s) { const float a = rdlane(Areg[t & 3], s + 16 * (t >> 2));
            xu[t][0] -= a * xu[s][0]; xu[t][1] -= a * xu[s][1]; xw[t][0] -= a * xw[s][0]; xw[t][1] -= a * xw[s][1]; }
#pragma unroll
    for (int e = 0; e < 2; ++e) { const int c = 2 * lane + e, t16 = c >> 4, m = c & 15;
        const int ks = c >> 5, slot = 4 * ((c >> 4) & 1) + (c & 3), gq = (c >> 2) & 3;
#pragma unroll
        for (int gp = 0; gp < 4; ++gp) {
            *(u32x2*)(rec + GU_OFF + ((t16 * 64 + m + 16 * gp) * 4) * 2) = (u32x2){cvtpk(xu[4 * gp][e], xu[4 * gp + 1][e]), cvtpk(xu[4 * gp + 2][e], xu[4 * gp + 3][e])};
            *(u32x2*)(rec + GK_OFF + ((t16 * 64 + m + 16 * gp) * 4) * 2) = (u32x2){cvtpk(kt[4 * gp][e], kt[4 * gp + 1][e]), cvtpk(kt[4 * gp + 2][e], kt[4 * gp + 3][e])}; }
#pragma unroll
        for (int t = 0; t < 16; ++t) *(bf16*)(rec + GW_OFF + (((ks * 64 + t + 16 * gq) * 8) + slot) * 2) = (bf16)f2bf(xw[t][e]); }
}
__device__ __forceinline__ void ph_even_s1(Frame& F, const Args& a) {
    for (int chh = F.gw; chh < NCHH; chh += F.NGW) {
#ifndef EXP_B
        hgrn_s1(chh, F.lane, a.ws);
#endif
#ifndef EXP_A
        gdn_s1(chh, F.lane, a.ws);
#endif
    }
}

#ifndef MK_TOUCH
#define MK_TOUCH 1
#endif
constexpr int PFD = 6;
__device__ __forceinline__ void touch(const unsigned char* p0, const unsigned char* p1, LAS unsigned char* scr) {
#if MK_TOUCH
    __builtin_amdgcn_global_load_lds((const unsigned*)p0, (LAS unsigned*)scr, 4, 0, 0);
    __builtin_amdgcn_global_load_lds((const unsigned*)p1, (LAS unsigned*)(scr + 256), 4, 0, 0);
#endif
}
typedef float f32x2v __attribute__((ext_vector_type(2)));
struct HSet { bf16x8 q[4]; bf16x4 p; bf16x4 v; f32x2v dpre; };
__device__ __forceinline__ void hgrn_load(HSet& R, const unsigned char* rec, const bf16* va, int row0, int stp, int lane, int g) {
#pragma unroll
    for (int s = 0; s < 4; ++s) R.q[s] = *(const bf16x8*)(rec + HQ_OFF + (s * 64 + lane) * 16);
    R.p = *(const bf16x4*)(rec + HP_OFF + lane * 8); R.dpre = *(const f32x2v*)(rec + HD_OFF + lane * 8);
#pragma unroll
    for (int j = 0; j < 4; ++j) R.v[j] = (short)va[(size_t)(row0 + stp * (4 * g + j)) * AW];
}
__device__ __forceinline__ void hgrn_s2(int chain, int vs, int lane, unsigned char* ws, LAS unsigned char* scr) {
    const int b = chain >> 4, h = (chain >> 1) & 7, dir = chain & 1, g = lane >> 4, stp = dir ? -1 : 1;
    const bf16* va = (const bf16*)(ws + WS_VA) + h * 128 + vs * 16 + (lane & 15);
    bf16* oa = (bf16*)(ws + WS_OA) + (size_t)dir * M * AW + h * 128 + vs * 16 + (lane & 15);
    const unsigned char* recs = ws + WS_HREC + (size_t)chain * NCHUNK * HREC;
    LAS unsigned char* ldsd = scr + 512;
    f32x4 S[8]; bf16x8 Sb[4];
#pragma unroll
    for (int t = 0; t < 8; ++t) S[t] = (f32x4){0.f, 0.f, 0.f, 0.f};
#pragma unroll
    for (int s = 0; s < 4; ++s) Sb[s] = mk8(0u, 0u, 0u, 0u);
    HSet A, B; u32x2 Ob[8]; bf16x4 Kc[8];
    hgrn_load(A, recs, va, seq_row(b, dir, 0), stp, lane, g);
#pragma unroll
    for (int t = 0; t < 8; ++t) Kc[t] = *(const bf16x4*)(recs + HK_OFF + (t * 64 + lane) * 8);
#define HG_TOUCH(c_) do { const int cp = min((c_) + PFD, NCHUNK - 1); const unsigned char* r_ = recs + (size_t)cp * HREC; const int rp = seq_row(b, dir, cp * 16) + stp * (lane & 15); \
        touch(r_ + lane * 128, lane < 8 ? r_ + 8192 + lane * 128 : (const unsigned char*)(va + (size_t)rp * AW), scr); } while (0)
#define HG_STEP(R, k_, cnext_) do { f32x4 O = {0.f, 0.f, 0.f, 0.f}; const unsigned char* rn_ = recs + (size_t)min((cnext_), NCHUNK - 1) * HREC; \
        *(LAS f32x2v*)(ldsd + ((k_) & 1) * 512 + lane * 8) = R.dpre; \
        _Pragma("unroll") for (int s = 0; s < 4; ++s) O = MFMA32(R.q[s], Sb[s], O); \
        O = MFMA16(R.p, R.v, O); \
        _Pragma("unroll") for (int t = 0; t < 8; ++t) { const f32x4 dv = *(const LAS f32x4*)(ldsd + ((k_) & 1) * 512 + (16 * t + 4 * g) * 4); S[t] = S[t] * dv; S[t] = MFMA16(Kc[t], R.v, S[t]); Kc[t] = *(const bf16x4*)(rn_ + HK_OFF + (t * 64 + lane) * 8); } \
        _Pragma("unroll") for (int s = 0; s < 4; ++s) Sb[s] = mk8(cvtpk(S[2 * s][0], S[2 * s][1]), cvtpk(S[2 * s][2], S[2 * s][3]), cvtpk(S[2 * s + 1][0], S[2 * s + 1][1]), cvtpk(S[2 * s + 1][2], S[2 * s + 1][3])); \
        Ob[k_] = (u32x2){cvtpk(O[0], O[1]), cvtpk(O[2], O[3])}; } while (0)
#pragma unroll 1
    for (int c8 = 0; c8 < NCHUNK; c8 += 8) {
#pragma unroll
        for (int k = 0; k < 8; k += 2) { const int ci = c8 + k;
            HG_TOUCH(ci);
            hgrn_load(B, recs + (size_t)(ci + 1) * HREC, va, seq_row(b, dir, (ci + 1) * 16), stp, lane, g);
            HG_STEP(A, k, ci + 1);
            HG_TOUCH(ci + 1);
            { const int cn = min(ci + 2, NCHUNK - 1); hgrn_load(A, recs + (size_t)cn * HREC, va, seq_row(b, dir, cn * 16), stp, lane, g); }
            HG_STEP(B, k + 1, ci + 2); }
#pragma unroll
        for (int k = 0; k < 8; ++k) { const int row0 = seq_row(b, dir, (c8 + k) * 16) + stp * 4 * g;
            oa[(size_t)row0 * AW] = (bf16)(Ob[k].x & 0xffffu); oa[(size_t)(row0 + stp) * AW] = (bf16)(Ob[k].x >> 16); oa[(size_t)(row0 + 2 * stp) * AW] = (bf16)(Ob[k].y & 0xffffu); oa[(size_t)(row0 + 3 * stp) * AW] = (bf16)(Ob[k].y >> 16); }
    }
#undef HG_STEP
#undef HG_TOUCH
}
struct GSet { bf16x8 w[4], q[4]; bf16x4 at; u32x2 u; float al; };
__device__ __forceinline__ void gdn_load(GSet& R, const unsigned char* rec, int vs, int lane) {
#pragma unroll
    for (int s = 0; s < 4; ++s) { R.w[s] = *(const bf16x8*)(rec + GW_OFF + (s * 64 + lane) * 16); R.q[s] = *(const bf16x8*)(rec + GQ_OFF + (s * 64 + lane) * 16); }
    R.at = *(const bf16x4*)(rec + GAT_OFF + lane * 8); R.u = *(const u32x2*)(rec + GU_OFF + (vs * 64 + lane) * 8); R.al = *(const float*)(rec + GAL_OFF);
}
__device__ __forceinline__ void gdn_s2(int chain, int vs, int lane, unsigned char* ws, LAS unsigned char* scr) {
    const int b = chain >> 4, h = (chain >> 1) & 7, dir = chain & 1, g = lane >> 4, stp = dir ? -1 : 1;
    bf16* ob = (bf16*)(ws + WS_OB) + (size_t)dir * M * AW + h * 128 + vs * 16 + (lane & 15);
    const unsigned char* recs = ws + WS_GREC + (size_t)chain * NCHUNK * GREC;
    f32x4 S[8]; bf16x8 Sb[4];
#pragma unroll
    for (int t = 0; t < 8; ++t) S[t] = (f32x4){0.f, 0.f, 0.f, 0.f};
#pragma unroll
    for (int s = 0; s < 4; ++s) Sb[s] = mk8(0u, 0u, 0u, 0u);
    GSet A, B; u32x2 Ob[4]; bf16x4 Kc[8];
    gdn_load(A, recs, vs, lane);
#pragma unroll
    for (int t = 0; t < 8; ++t) Kc[t] = *(const bf16x4*)(recs + GK_OFF + (t * 64 + lane) * 8);
#define GD_TOUCH(c_) do { const unsigned char* r_ = recs + (size_t)min((c_) + PFD, NCHUNK - 1) * GREC; \
        touch(r_ + lane * 128, r_ + 8192 + (lane < 32 ? lane * 128 : (lane < 36 ? 4096 + vs * 512 + (lane - 32) * 128 : 8192 + ((lane & 3) + ((lane >> 2) & 1)) * 128)), scr); } while (0)
#define GD_STEP(R, k_, cnext_) do { f32x4 WS_ = {0.f, 0.f, 0.f, 0.f}, O = {0.f, 0.f, 0.f, 0.f}; const unsigned char* rn_ = recs + (size_t)min((cnext_), NCHUNK - 1) * GREC; \
        _Pragma("unroll") for (int s = 0; s < 4; ++s) WS_ = MFMA32(R.w[s], Sb[s], WS_); \
        _Pragma("unroll") for (int s = 0; s < 4; ++s) O = MFMA32(R.q[s], Sb[s], O); \
        const bf16x4 Vn = mk4(cvtpk(bflo(R.u.x) - WS_[0], bfhi(R.u.x) - WS_[1]), cvtpk(bflo(R.u.y) - WS_[2], bfhi(R.u.y) - WS_[3])); \
        O = MFMA16(R.at, Vn, O); \
        _Pragma("unroll") for (int t = 0; t < 8; ++t) { S[t] = S[t] * R.al; S[t] = MFMA16(Kc[t], Vn, S[t]); Kc[t] = *(const bf16x4*)(rn_ + GK_OFF + (t * 64 + lane) * 8); } \
        _Pragma("unroll") for (int s = 0; s < 4; ++s) Sb[s] = mk8(cvtpk(S[2 * s][0], S[2 * s][1]), cvtpk(S[2 * s][2], S[2 * s][3]), cvtpk(S[2 * s + 1][0], S[2 * s + 1][1]), cvtpk(S[2 * s + 1][2], S[2 * s + 1][3])); \
        Ob[k_] = (u32x2){cvtpk(O[0], O[1]), cvtpk(O[2], O[3])}; } while (0)
#pragma unroll 1
    for (int c8 = 0; c8 < NCHUNK; c8 += 4) {
#pragma unroll
        for (int k = 0; k < 4; k += 2) { const int ci = c8 + k;
            GD_TOUCH(ci);
            gdn_load(B, recs + (size_t)(ci + 1) * GREC, vs, lane);
            GD_STEP(A, k, ci + 1);
            GD_TOUCH(ci + 1);
            gdn_load(A, recs + (size_t)min(ci + 2, NCHUNK - 1) * GREC, vs, lane);
            GD_STEP(B, k + 1, ci + 2); }
#pragma unroll
        for (int k = 0; k < 4; ++k) { const int row0 = seq_row(b, dir, (c8 + k) * 16) + stp * 4 * g;
            ob[(size_t)row0 * AW] = (bf16)(Ob[k].x & 0xffffu); ob[(size_t)(row0 + stp) * AW] = (bf16)(Ob[k].x >> 16); ob[(size_t)(row0 + 2 * stp) * AW] = (bf16)(Ob[k].y & 0xffffu); ob[(size_t)(row0 + 3 * stp) * AW] = (bf16)(Ob[k].y >> 16); }
    }
#undef GD_STEP
#undef GD_TOUCH
}
__device__ __forceinline__ void ph_even_s2(Frame& F, const Args& a) {
    if (F.wave >= 2) return;
    const int bx = blockIdx.x, vcu = (F.G % 8 == 0) ? (bx % 8) * (F.G / 8) + bx / 8 : bx;
    LAS unsigned char* scr = F.lds + RING_OFF + F.wave * 2048;
    for (int tp = vcu; tp < 256; tp += F.G) { const int task = 2 * tp + F.wave, mixer = task >> 8, chain = (task >> 3) & 31, vs = task & 7;
#if defined(EXP_A)
        if (mixer == 0) gdn_wave(task & 255, F.lane, (const bf16*)(a.ws + WS_QB), (const bf16*)(a.ws + WS_KB), (const bf16*)(a.ws + WS_VB), (const float*)(a.ws + WS_GB), (bf16*)(a.ws + WS_OB));
        else hgrn_s2(chain, vs, F.lane, a.ws, scr);
#elif defined(EXP_B)
        if (mixer == 0) gdn_s2(chain, vs, F.lane, a.ws, scr);
        else hgrn_wave(task & 255, F.lane, (const bf16*)(a.ws + WS_QA), (const float*)(a.ws + WS_LF), (const bf16*)(a.ws + WS_VA), (bf16*)(a.ws + WS_OA));
#else
        if (mixer == 0) gdn_s2(chain, vs, F.lane, a.ws, scr); else hgrn_s2(chain, vs, F.lane, a.ws, scr);
#endif
    }
}
constexpr int N_PHASES = 3 + 10 * DEPTH;
__host__ __device__ constexpr bool phase_used(int ph) { return true; }

__global__ void __launch_bounds__(NTHREADS, 2) fwd(Args args) {
    extern __shared__ __attribute__((aligned(16))) unsigned char lds[];
    Frame F;
    F.lds = (LAS unsigned char*)lds; F.tid = threadIdx.x; F.lane = F.tid & 63; F.wave = __builtin_amdgcn_readfirstlane(F.tid >> 6);
    F.G = gridDim.x; F.gw = F.wave * F.G + blockIdx.x; F.NGW = F.G * NWAVES;
    for (int u = F.tid; u < (LDS_BYTES - LDSCTL_OFF) / 4; u += NTHREADS) ((LAS unsigned*)(F.lds + LDSCTL_OFF))[u] = 0u;
    __syncthreads();
    const int lo = args.ph_lo, hi = args.ph_hi; const bool multi = (hi - lo) > 1;
    unsigned char* ws = args.ws;
    XcdBarrier bar; bar.bar = (unsigned*)(ws + WS_CTL) + CW_BAR; bar.x = 0; bar.st = nullptr;
    if (multi) bar = xcd_barrier_post((unsigned*)(ws + WS_CTL) + CW_BAR, (volatile LAS unsigned*)(F.lds + MISC_OFF) + 8);
#ifndef PH_SITES
#define PH_SITES 0x3ffff
#endif
#define SITE(n) ((PH_SITES >> (n)) & 1)
#define IN(k) (lo <= (k) && (k) < hi)
#define LAUNDER() do { asm volatile("" : "+v"(F.tid), "+v"(F.lane)); } while (0)
#define SEAM() do { if (multi) xcd_barrier(bar); } while (0)
    bf16* HX = (bf16*)(ws + WS_HX); bf16* MIX = (bf16*)(ws + WS_MIX); float* XA = (float*)(ws + WS_XA); float* Z = (float*)(ws + WS_Z); bf16* ACT = (bf16*)(ws + WS_ACT);
    LAS unsigned char* ring = F.lds + RING_OFF;

    if (SITE(0) && IN(0)) { LAUNDER(); ph_prologue(F, args); SEAM(); }
    if (SITE(1) && IN(1)) { LAUNDER(); ph_modreduce(F, args); SEAM(); }
    if (SITE(2) && IN(2)) { LAUNDER(); ph_mod0(F, args); SEAM(); }
#pragma unroll 1
    for (int l = 0; l < DEPTH; ++l) {
        const int base = 3 + 10 * l, j = l >> 1; const bool last = (l == DEPTH - 1); const int Mo = last ? MX : M;
        const float* MODL = (const float*)(ws + WS_MOD) + (size_t)l * 3 * 12288;
        if ((l & 1) == 0) {
            if (SITE(3) && IN(base + 0)) {
                pg8::Gemm g{HX, (const bf16*)(ws + WS_WINE + j * SZ_WINE), M, NE_INP, D, D, D}; pg8::StaticOrder S; S.init(M, NE_INP, F.G, (int)blockIdx.x);
                EpiEven1 E{(bf16*)(ws + WS_QA), (bf16*)(ws + WS_VA), (bf16*)(ws + WS_GA), (bf16*)(ws + WS_ZB), (bf16*)(ws + WS_QKVB), (float*)(ws + WS_LF), (float*)(ws + WS_GB),
                           (const float*)(ws + WS_LB) + j * AW, args.in[12] + j * 16, args.in[13] + j * 16};
                pg8::gemm_phase<EpiEven1, pg8::StaticOrder, true, true>(ring, g, S, E); SEAM(); }
            if (SITE(4) && IN(base + 1)) { LAUNDER(); ph_gdn_prep(F, args, j); SEAM(); }
            if (SITE(5) && IN(base + 2)) { LAUNDER(); ph_even_s1(F, args); SEAM(); }
            if (SITE(17) && IN(base + 3)) { LAUNDER(); ph_even_s2(F, args); SEAM(); }
            if (SITE(6) && IN(base + 4)) { LAUNDER(); ph_merge(F, args, j); SEAM(); }
        } else {
            if (SITE(7) && IN(base + 0)) {
                pg8::Gemm g{HX, (const bf16*)(ws + WS_WINO + j * SZ_WINO), M, 2 * D, D, D, D}; pg8::StaticOrder S; S.init(M, 2 * D, F.G, (int)blockIdx.x);
                EpiOdd1 E{(bf16*)(ws + WS_GY), (bf16*)(ws + WS_XBR)};
                pg8::gemm_phase<EpiOdd1, pg8::StaticOrder, true, true>(ring, g, S, E); SEAM(); }
            if (SITE(8) && IN(base + 1)) { LAUNDER(); ph_odd_conv(F, args, j); SEAM(); }
            if (SITE(9) && IN(base + 2)) {
                pg8::Gemm g{(const bf16*)(ws + WS_XC), (const bf16*)(ws + WS_WGATE + j * SZ_WGATE), M, 8192, 256, D, 256}; pg8::GateOrder S; S.init(M, F.G, (int)blockIdx.x);
                EpiGates E{(const bf16*)(ws + WS_XC), (unsigned*)(ws + WS_AB), args.in[22] + (size_t)j * 4 * D, args.in[23] + (size_t)j * 2 * D};
                pg8::gemm_phase<EpiGates, pg8::GateOrder, true, true>(ring, g, S, E); SEAM(); }
            if (SITE(10) && IN(base + 3)) { LAUNDER(); ph_odd_l1(F, args); SEAM(); }
            if (SITE(11) && IN(base + 4)) { LAUNDER(); ph_odd_l3(F, args); SEAM(); }
        }
        if (SITE(12) && IN(base + 5)) {
            pg8::Gemm g{MIX, (const bf16*)((l & 1) ? ws + WS_WOUTO + j * SZ_WSQ : ws + WS_WOUTE + j * SZ_WSQ), Mo, D, D, D, D}; pg8::StaticOrder S; S.init(Mo, D, F.G, (int)blockIdx.x);
            EpiResid E{l == 0 ? args.in[0] : XA, l == 0 ? args.in[2] : XA + (size_t)MX * D, Z, MODL + 2 * D, l & 1};
            pg8::gemm_phase<EpiResid, pg8::StaticOrder, true, true>(ring, g, S, E); SEAM(); }
        if (SITE(13) && IN(base + 6)) { LAUNDER(); ph_ln(F, Z, Mo, args.in[6] + (size_t)(l * 2) * D, args.in[7] + (size_t)(l * 2) * D, nullptr, HX, MODL + 3 * D, MODL + 4 * D, 0); SEAM(); }
        if (SITE(14) && IN(base + 7)) {
            pg8::Gemm g{HX, (const bf16*)(ws + WS_WGU + l * SZ_WGU), Mo, 2 * FF, D, D, D}; pg8::StaticOrder S; S.init(Mo, 2 * FF, F.G, (int)blockIdx.x);
            EpiSwiGLU E{ACT};
            pg8::gemm_phase<EpiSwiGLU, pg8::StaticOrder, true, true>(ring, g, S, E); SEAM(); }
        if (SITE(15) && IN(base + 8)) {
            pg8::Gemm g{ACT, (const bf16*)(ws + WS_WDN + l * SZ_WDN), Mo, D, FF, FF, FF}; pg8::StaticOrder S; S.init(Mo, D, F.G, (int)blockIdx.x);
            EpiResid E{Z, Z + (size_t)MX * D, XA, MODL + 5 * D, 0};
            pg8::gemm_phase<EpiResid, pg8::StaticOrder, true, true>(ring, g, S, E); SEAM(); }
        if (SITE(16) && IN(base + 9)) {
            const float* g1 = args.in[6] + (size_t)(l * 2 + 1) * D; const float* b1 = args.in[7] + (size_t)(l * 2 + 1) * D;
            LAUNDER(); if (last) ph_ln(F, XA, MX, g1, b1, args.out, nullptr, nullptr, nullptr, 0);
            else { LAUNDER(); ph_ln(F, XA, M, g1, b1, nullptr, HX, MODL + 3 * 12288, MODL + 3 * 12288 + D, (l + 1) & 1); SEAM(); } }
    }
#undef IN
#undef SEAM
}

extern "C" void kernel_launch(void* const* d_in, const int* in_sizes, int n_in, void* d_out, int out_size, void* d_ws, size_t ws_size, hipStream_t stream) {
    static int grid = 0;
    if (grid == 0) {
        if (n_in != 25 || in_sizes[0] != MX * D || out_size != MX * D || ws_size < WS_END) { fprintf(stderr, "kernel_launch: unexpected shapes (n_in %d, in0 %d, out %d, ws %zu < %zu); nothing launched\n", n_in, n_in > 0 ? in_sizes[0] : -1, out_size, ws_size, (size_t)WS_END); grid = -1; return; }
        int dev = 0, cus = 0, per_cu = 0;
        if (hipGetDevice(&dev) != hipSuccess || hipDeviceGetAttribute(&cus, hipDeviceAttributeMultiprocessorCount, dev) != hipSuccess) { grid = -1; return; }
        if (hipFuncSetAttribute((const void*)fwd, hipFuncAttributeMaxDynamicSharedMemorySize, LDS_BYTES) != hipSuccess) { fprintf(stderr, "kernel_launch: hipFuncSetAttribute failed\n"); grid = -1; return; }
        if (hipOccupancyMaxActiveBlocksPerMultiprocessor(&per_cu, (const void*)fwd, NTHREADS, LDS_BYTES) != hipSuccess || per_cu < 1) { fprintf(stderr, "kernel_launch: occupancy query says %d\n", per_cu); }
        (void)hipGetLastError();
        grid = cus;
    }
    if (grid < 0) return;
    if (hipMemsetAsync((char*)d_ws + WS_CTL, 0, CTL_ZERO_BYTES, stream) != hipSuccess) return;
    Args a{};
    for (int i = 0; i < 25; ++i) a.in[i] = (const float*)d_in[i];
    a.out = (float*)d_out; a.ws = (unsigned char*)d_ws;
#if MK_ONE_LAUNCH
    a.ph_lo = 0; a.ph_hi = N_PHASES;
    hipLaunchKernelGGL(fwd, dim3(grid), dim3(NTHREADS), LDS_BYTES, stream, a);
#else
    for (int ph = 0; ph < N_PHASES; ++ph) { if (!phase_used(ph)) continue; a.ph_lo = ph; a.ph_hi = ph + 1;
        hipLaunchKernelGGL(fwd, dim3(grid), dim3(NTHREADS), LDS_BYTES, stream, a); }
#endif
}
```

```cpp
#include <hip/hip_runtime.h>
#include <cstdio>
#include <cstdint>
#ifndef MK_ONE_LAUNCH
#define MK_ONE_LAUNCH 1
#endif
namespace pg8 {
#define PG8_LAS __attribute__((address_space(3)))
typedef unsigned short bf16_t;
typedef short bf16x8 __attribute__((ext_vector_type(8)));
typedef float f32x4 __attribute__((ext_vector_type(4)));
typedef unsigned u32x4 __attribute__((ext_vector_type(4)));
typedef unsigned u32x2 __attribute__((ext_vector_type(2)));
constexpr int BM = 256, BK = 64, HALF = 128, HTB = HALF * BK * 2  , STAGE_BYTES = 8 * HTB, NXCD = 8, WGM = 8;
__host__ __device__ __forceinline__ int lds_byte(int r, int c) { const int st = (r >> 4) * 2 + (c >> 5), rr = r & 15, cc = c & 31, ob = rr * 64 + cc * 2; return st * 1024 + (ob ^ (((ob >> 9) & 1) << 5)); }
__host__ __device__ __forceinline__ void stage_rc(int b, int& R, int& C) { const int st = b / 1024, sb = b % 1024, swz = sb ^ (((sb >> 9) & 1) << 5); R = (st >> 1) * 16 + swz / 64; C = (st & 1) * 32 + (swz % 64) / 2; }
__host__ __device__ __forceinline__ int perm32(int rho) { const int n = rho >> 4, i = rho & 15; return 8 * (i >> 2) + 4 * n + (i & 3); }

struct Unit { int pm, pn, ka; };
struct Gemm { const bf16_t* A; const bf16_t* Bt; int M, N, K, lda, ldb; };

struct StaticOrder {
    int nM, nN, nwg, G, c;
    __host__ __device__ void init(int M, int N, int G_, int c_) { nM = M / BM; nN = N / BM; nwg = nM * nN; G = G_; c = c_; }
    __host__ __device__ bool next(int i, Unit& u) const {
        const long L = (long)i * G + c; if (L >= nwg) return false;
        int wgid = (int)L; { const int q = nwg / NXCD, r = nwg % NXCD, xcd = wgid % NXCD, off = wgid / NXCD; wgid = (xcd < r ? xcd * (q + 1) : r * (q + 1) + (xcd - r) * q) + off; }
        const int nig = WGM * nN, gid = wgid / nig, fm = gid * WGM, gsz = (nM - fm) < WGM ? (nM - fm) : WGM;
        u.pm = fm + ((wgid % nig) % gsz); u.pn = (wgid % nig) / gsz; u.ka = 0; return true;
    }
    __device__ __forceinline__ void a_ready(const Unit&) const {}
    __device__ __forceinline__ void done(const Unit&) const {}
};
struct GateOrder {
    int nM, nwg, G, c;
    __host__ __device__ void init(int M, int G_, int c_) { nM = M / BM; nwg = nM * 32; G = G_; c = c_; }
    __host__ __device__ bool next(int i, Unit& u) const {
        const long L = (long)i * G + c; if (L >= nwg) return false;
        const int l = (int)L, pn4 = l & 3, pm = (l >> 2) % nM, nb = (l >> 2) / nM;
        u.pm = pm; u.pn = nb * 4 + pn4; u.ka = nb * 256; return true;
    }
    __device__ __forceinline__ void a_ready(const Unit&) const {}
    __device__ __forceinline__ void done(const Unit&) const {}
};
typedef float f32x2c __attribute__((ext_vector_type(2))); typedef __bf16 bf16x2c __attribute__((ext_vector_type(2)));
__device__ __forceinline__ unsigned cvt_pk_bf16(float lo, float hi) { const f32x2c v = {lo, hi}; return __builtin_bit_cast(unsigned, __builtin_convertvector(v, bf16x2c)); }
template <class Epi, class Sched, bool ALIGN_EPI = false, bool SP2 = false>
__device__ __forceinline__ void gemm_phase(PG8_LAS unsigned char* lds, const Gemm g, const Sched& S, const Epi& E) {
    int tid = threadIdx.x; asm volatile("" : "+v"(tid)); const int wid = __builtin_amdgcn_readfirstlane(tid >> 6), lane = tid & 63, wr = wid >> 2, wc = wid & 3, fr = lane & 15, fq = lane >> 4;
    int nt = g.K / BK; asm volatile("" : "+s"(nt));
    unsigned voffA[2], voffB[2];
#pragma unroll
    for (int i = 0; i < 2; ++i) { int R, C; stage_rc(tid * 16 + i * 8192, R, C); const int Rb = Epi::PERM ? ((R & ~31) + perm32(R & 31)) : R;
        voffA[i] = (unsigned)(R * g.lda + C) * 2u; voffB[i] = (unsigned)(Rb * g.ldb + C) * 2u; }
    const size_t kstep = (size_t)(BK * 2);
    const size_t hstepA = (size_t)HALF * g.lda * 2, hstepB = (size_t)HALF * g.ldb * 2;
    const size_t tstepA = 2 * hstepA, tstepB = 2 * hstepB;
    const unsigned ldsw = (unsigned)wid * 1024u;
    const int aoff = lds_byte(wr * 64 + fr, fq * 8), boff = lds_byte(wc * 32 + fr, fq * 8);
#define PG8_SA(b, h) (((b) * 2 + (h)) * HTB)
#define PG8_SB(b, h) ((4 + (b) * 2 + (h)) * HTB)
#define PG8_STAGE(bufoff, gbase, voff) do { _Pragma("unroll") for (int _i = 0; _i < 2; ++_i) \
        __builtin_amdgcn_global_load_lds((const unsigned*)((const char*)(gbase) + (voff)[_i]), (PG8_LAS unsigned*)(lds + (bufoff) + ldsw + _i * 8192), 16, 0, 0); } while (0)
#define PG8_LDA(dst, b, h) do { _Pragma("unroll") for (int m = 0; m < 4; ++m) _Pragma("unroll") for (int k = 0; k < 2; ++k) dst[m][k] = *(const PG8_LAS bf16x8*)(lds + PG8_SA(b, h) + aoff + m * 2048 + k * 1024); } while (0)
#define PG8_LDB(dst, b, h) do { _Pragma("unroll") for (int n = 0; n < 2; ++n) _Pragma("unroll") for (int k = 0; k < 2; ++k) dst[n][k] = *(const PG8_LAS bf16x8*)(lds + PG8_SB(b, h) + boff + n * 2048 + k * 1024); } while (0)
#define PG8_MMA(ai, bj, At, Bt) do { __builtin_amdgcn_s_setprio(1); _Pragma("unroll") for (int m = 0; m < 4; ++m) _Pragma("unroll") for (int n = 0; n < 2; ++n) _Pragma("unroll") for (int k = 0; k < 2; ++k) \
        acc[ai][bj][m][n] = __builtin_amdgcn_mfma_f32_16x16x32_bf16(Bt[n][k], At[m][k], acc[ai][bj][m][n], 0, 0, 0); __builtin_amdgcn_s_setprio(0); } while (0)
#define PG8_WAIT_V(n) asm volatile("s_waitcnt vmcnt(" #n ")" ::: "memory")
#define PG8_WAIT_L(n) asm volatile("s_waitcnt lgkmcnt(" #n ")" ::: "memory")
#define PG8_BAR __builtin_amdgcn_s_barrier()
#define PG8_SCHED __builtin_amdgcn_sched_barrier(0)
    Unit cur, nxt; int ui = 0;
    if (!S.next(0, cur)) return;
    f32x4 acc[2][2][4][2];
#pragma unroll
    for (int a = 0; a < 2; ++a)
#pragma unroll
        for (int b = 0; b < 2; ++b)
#pragma unroll
            for (int m = 0; m < 4; ++m)
#pragma unroll
                for (int n = 0; n < 2; ++n) acc[a][b][m][n] = (f32x4){0.f, 0.f, 0.f, 0.f};
    bf16x8 At[4][2], B0[2][2], B1[2][2];
    const char* cA = (const char*)g.A + (size_t)cur.pm * tstepA + (size_t)cur.ka * 2; const char* cB = (const char*)g.Bt + (size_t)cur.pn * tstepB;
    S.a_ready(cur);
    if constexpr (SP2) {
        PG8_STAGE(PG8_SB(0, 0), cB, voffB); PG8_STAGE(PG8_SB(0, 1), cB + hstepB, voffB); PG8_STAGE(PG8_SA(0, 0), cA, voffA); PG8_STAGE(PG8_SA(0, 1), cA + hstepA, voffA);
        if (wr == 1) PG8_BAR;
        PG8_WAIT_V(2); PG8_BAR;
        PG8_STAGE(PG8_SB(1, 0), cB + kstep, voffB); PG8_STAGE(PG8_SA(1, 0), cA + kstep, voffA); PG8_STAGE(PG8_SB(1, 1), cB + hstepB + kstep, voffB);
        PG8_WAIT_V(6); PG8_BAR;
    } else {
        PG8_STAGE(PG8_SB(0, 0), cB, voffB); PG8_STAGE(PG8_SA(0, 0), cA, voffA); PG8_STAGE(PG8_SB(0, 1), cB + hstepB, voffB); PG8_STAGE(PG8_SA(0, 1), cA + hstepA, voffA);
        if (wr == 1) PG8_BAR;
        PG8_WAIT_V(4); PG8_BAR;
        PG8_STAGE(PG8_SB(1, 0), cB + kstep, voffB); PG8_STAGE(PG8_SA(1, 0), cA + kstep, voffA); PG8_STAGE(PG8_SB(1, 1), cB + hstepB + kstep, voffB);
        PG8_WAIT_V(6); PG8_BAR;
    }
    for (;;) {
        const bool has_next = S.next(ui + 1, nxt);
        const char* nA = has_next ? (const char*)g.A + (size_t)nxt.pm * tstepA + (size_t)nxt.ka * 2 : cA; const char* nB = has_next ? (const char*)g.Bt + (size_t)nxt.pn * tstepB : cB;
        for (int t = 0; t < nt; t += 2) {
            const bool last = (t == nt - 2);
            const char* a1 = cA + (size_t)(t + 1) * kstep;
            const char* a2 = last ? nA : cA + (size_t)(t + 2) * kstep; const char* b2 = last ? nB : cB + (size_t)(t + 2) * kstep;
            const char* a3 = a2 + kstep; const char* b3 = b2 + kstep;
            if (last && has_next) S.a_ready(nxt);
            if constexpr (SP2) {
            PG8_LDB(B0, 0, 0); PG8_LDB(B1, 0, 1); PG8_SCHED; PG8_LDA(At, 0, 0); PG8_STAGE(PG8_SA(1, 1), a1 + hstepA, voffA);
            PG8_WAIT_V(8); PG8_WAIT_L(0); PG8_BAR; PG8_MMA(0, 0, At, B0); PG8_MMA(0, 1, At, B1); PG8_BAR; PG8_SCHED;
            PG8_LDA(At, 0, 1); PG8_STAGE(PG8_SB(0, 0), b2, voffB); PG8_STAGE(PG8_SB(0, 1), b2 + hstepB, voffB); PG8_STAGE(PG8_SA(0, 0), a2, voffA);
            PG8_WAIT_V(8); PG8_WAIT_L(0); PG8_BAR; PG8_MMA(1, 0, At, B0); PG8_MMA(1, 1, At, B1); PG8_BAR; PG8_SCHED;
            PG8_LDB(B0, 1, 0); PG8_LDB(B1, 1, 1); PG8_SCHED; PG8_LDA(At, 1, 0); PG8_STAGE(PG8_SA(0, 1), a2 + hstepA, voffA);
            PG8_WAIT_V(8); PG8_WAIT_L(0); PG8_BAR; PG8_MMA(0, 0, At, B0); PG8_MMA(0, 1, At, B1); PG8_BAR; PG8_SCHED;
            PG8_LDA(At, 1, 1); PG8_STAGE(PG8_SB(1, 0), b3, voffB); PG8_STAGE(PG8_SB(1, 1), b3 + hstepB, voffB); PG8_STAGE(PG8_SA(1, 0), a3, voffA);
            PG8_WAIT_V(8); PG8_WAIT_L(0); PG8_BAR; PG8_MMA(1, 0, At, B0); PG8_MMA(1, 1, At, B1); PG8_BAR; PG8_SCHED;
            } else {
            PG8_LDB(B0, 0, 0); PG8_SCHED; PG8_LDA(At, 0, 0); PG8_STAGE(PG8_SA(1, 1), a1 + hstepA, voffA);
            PG8_WAIT_L(8); PG8_BAR; PG8_WAIT_L(0); PG8_MMA(0, 0, At, B0); PG8_BAR; PG8_SCHED;
            PG8_LDB(B1, 0, 1); PG8_STAGE(PG8_SB(0, 0), b2, voffB);
            PG8_BAR; PG8_WAIT_L(0); PG8_MMA(0, 1, At, B1); PG8_BAR;
            PG8_LDA(At, 0, 1); PG8_STAGE(PG8_SA(0, 0), a2, voffA);
            PG8_BAR; PG8_WAIT_L(0); PG8_MMA(1, 0, At, B0); PG8_BAR; PG8_SCHED;
            PG8_STAGE(PG8_SB(0, 1), b2 + hstepB, voffB);
            PG8_WAIT_V(6); PG8_BAR; PG8_MMA(1, 1, At, B1); PG8_BAR;
            PG8_LDB(B0, 1, 0); PG8_SCHED; PG8_LDA(At, 1, 0); PG8_STAGE(PG8_SA(0, 1), a2 + hstepA, voffA);
            PG8_WAIT_L(8); PG8_BAR; PG8_WAIT_L(0); PG8_MMA(0, 0, At, B0); PG8_BAR; PG8_SCHED;
            PG8_LDB(B1, 1, 1); PG8_STAGE(PG8_SB(1, 0), b3, voffB);
            PG8_BAR; PG8_WAIT_L(0); PG8_MMA(0, 1, At, B1); PG8_BAR;
            PG8_LDA(At, 1, 1); PG8_STAGE(PG8_SA(1, 0), a3, voffA);
            PG8_BAR; PG8_WAIT_L(0); PG8_MMA(1, 0, At, B0); PG8_BAR; PG8_SCHED;
            PG8_STAGE(PG8_SB(1, 1), b3 + hstepB, voffB);
            PG8_WAIT_V(6); PG8_BAR; PG8_MMA(1, 1, At, B1); PG8_BAR;
            }
        }
        if constexpr (ALIGN_EPI) { if (wr == 0) PG8_BAR; }
        if constexpr (!Epi::AFTER_DRAIN) { E(acc, cur, wr, wc, fr, fq); S.done(cur); }
        if (!has_next) break;
#pragma unroll
        for (int a = 0; a < 2; ++a)
#pragma unroll
            for (int b = 0; b < 2; ++b)
#pragma unroll
                for (int m = 0; m < 4; ++m)
#pragma unroll
                    for (int n = 0; n < 2; ++n) acc[a][b][m][n] = (f32x4){0.f, 0.f, 0.f, 0.f};
        cur = nxt; cA = nA; cB = nB; ++ui;
        if constexpr (ALIGN_EPI) { if (wr == 1) PG8_BAR; }
    }
    PG8_WAIT_V(0);
    if constexpr (!ALIGN_EPI) { if (wr == 0) PG8_BAR; }
    PG8_BAR;
    if constexpr (Epi::AFTER_DRAIN) { E.fused(acc, cur, wr, wc, fr, fq, lds, wid, lane); S.done(cur); }
#undef PG8_SA
#undef PG8_SB
#undef PG8_STAGE
#undef PG8_LDA
#undef PG8_LDB
#undef PG8_MMA
#undef PG8_WAIT_V
#undef PG8_WAIT_L
#undef PG8_BAR
#undef PG8_SCHED
}
}
using pg8::bf16_t; using pg8::f32x4; using pg8::u32x4; using pg8::u32x2; using pg8::Unit; using pg8::cvt_pk_bf16;

constexpr int D = 2048, NBATCH = 2, SEQ = 8192, CTXL = 256, DEPTH = 4;
constexpr int MX = NBATCH * SEQ;
constexpr int MC = NBATCH * CTXL;
constexpr int M = MX + MC;
constexpr int NE_IN = 9248, NE_INP = 9472, FF = 5632, AW = 1024;
constexpr int NWAVES = 8, NTHREADS = 512;
constexpr float LN_EPS = 1e-6f, DN_ALPHA = 1.681792830507429f;
constexpr float QSCALE = 0.08838834764831845f;

constexpr size_t MiB = 1u << 20;
constexpr size_t al256(size_t x) { return (x + 255) & ~(size_t)255; }
constexpr size_t WS_CTL = 0, CTL_ZERO_BYTES = 1 * MiB;
constexpr size_t WS_MOD = 1 * MiB;
constexpr size_t WS_LB = 2 * MiB;
constexpr size_t WS_PART = 3 * MiB;
constexpr size_t WS_W0 = 8 * MiB;
constexpr size_t SZ_WINE = (size_t)NE_INP * D * 2, SZ_WSQ = (size_t)D * D * 2, SZ_WINO = (size_t)2 * D * D * 2, SZ_WGATE = (size_t)8192 * 256 * 2, SZ_WGU = (size_t)2 * FF * D * 2, SZ_WDN = (size_t)D * FF * 2;
constexpr size_t WS_WINE = WS_W0;
constexpr size_t WS_WOUTE = WS_WINE + 2 * SZ_WINE;
constexpr size_t WS_WINO = WS_WOUTE + 2 * SZ_WSQ;
constexpr size_t WS_WGATE = WS_WINO + 2 * SZ_WINO;
constexpr size_t WS_WOUTO = WS_WGATE + 2 * SZ_WGATE;
constexpr size_t WS_WGU = WS_WOUTO + 2 * SZ_WSQ;
constexpr size_t WS_WDN = WS_WGU + 4 * SZ_WGU;
constexpr size_t WS_XA = al256(WS_WDN + 4 * SZ_WDN);
constexpr size_t SZ_F32ROW = (size_t)M * D * 4, SZ_BF16ROW = (size_t)M * D * 2, SZ_BF16HALF = (size_t)M * AW * 2;
constexpr size_t WS_Z = WS_XA + SZ_F32ROW;
constexpr size_t WS_HX = WS_Z + SZ_F32ROW;
constexpr size_t WS_MIX = WS_HX + SZ_BF16ROW;
constexpr size_t WS_MR = WS_MIX + SZ_BF16ROW;
constexpr size_t SZ_HRECS = (size_t)16896 * 9216, SZ_GRECS = (size_t)16896 * 17152;
constexpr size_t WS_HREC = WS_HX, WS_GREC = WS_HREC + SZ_HRECS;
constexpr size_t WS_QKVB = WS_MIX;
constexpr size_t WS_QA = al256(WS_GREC + SZ_GRECS), WS_VA = WS_QA + SZ_BF16HALF, WS_GA = WS_VA + SZ_BF16HALF, WS_ZB = WS_GA + SZ_BF16HALF;
constexpr size_t WS_LF = WS_ZB + SZ_BF16HALF;
constexpr size_t WS_GB = WS_LF + 2 * (size_t)M * AW * 4;
constexpr size_t WS_QB = WS_GB + (size_t)M * 32 * 4, WS_KB = WS_QB + SZ_BF16HALF, WS_VB = WS_KB + SZ_BF16HALF;
#ifdef EXP_B
constexpr size_t WS_OA = WS_HREC;
#else
constexpr size_t WS_OA = WS_LF;
#endif
constexpr size_t WS_OB = WS_OA + 2 * SZ_BF16HALF;
constexpr size_t WS_EVEN_END = WS_VB + SZ_BF16HALF;
#ifndef EXP_B
static_assert(WS_QKVB + (size_t)M * 3072 * 2 <= WS_QA && WS_OB + 2 * SZ_BF16HALF <= WS_GB, "even-layer overlays");
#endif
constexpr size_t WS_GY = WS_MR, WS_XBR = WS_GY + SZ_BF16ROW, WS_XC = WS_XBR + SZ_BF16ROW;
constexpr size_t WS_AB = WS_XC + SZ_BF16ROW;
constexpr size_t WS_R = WS_AB + 2 * (size_t)M * D * 4;
constexpr size_t WS_ODD_END = WS_R + 2 * SZ_BF16ROW;
constexpr size_t WS_ACT = WS_MR;
constexpr size_t WS_END = (WS_EVEN_END > WS_ODD_END ? WS_EVEN_END : WS_ODD_END);
static_assert(WS_ACT + (size_t)M * FF * 2 <= WS_END, "ACT fits the mixer region");
static_assert(WS_END <= (size_t)1536 * MiB, "workspace budget: d_ws is at least 4 x the largest input = 1536 MiB");
constexpr int CW_BAR = 4096;

constexpr int RING_OFF = 0, RING_BYTES = 131072;
constexpr int LDSCTL_OFF = RING_BYTES, MISC_OFF = LDSCTL_OFF + 320;
constexpr int LDS_BYTES = 147456;

#define GAS __attribute__((address_space(1)))
#define LAS __attribute__((address_space(3)))
typedef unsigned short bf16;
#define LDS_WAIT() asm volatile("s_waitcnt lgkmcnt(0)" ::: "memory")
#define VM_WAIT() asm volatile("s_waitcnt vmcnt(0)" ::: "memory")
__device__ __forceinline__ unsigned f2bf(float f) { unsigned u = __builtin_bit_cast(unsigned, f); return (u + 0x7fffu + ((u >> 16) & 1u)) >> 16; }
__device__ __forceinline__ unsigned pk2(float lo, float hi) { return f2bf(lo) | (f2bf(hi) << 16); }
__device__ __forceinline__ float bflo(unsigned u) { return __builtin_bit_cast(float, u << 16); }
__device__ __forceinline__ float bfhi(unsigned u) { return __builtin_bit_cast(float, u & 0xffff0000u); }
__device__ __forceinline__ float bf2f(bf16 h) { return __builtin_bit_cast(float, (unsigned)h << 16); }
__device__ __forceinline__ float sigm(float x) { return 1.f / (1.f + __expf(-x)); }
__device__ __forceinline__ float siluf(float x) { return x / (1.f + __expf(-x)); }
__device__ __forceinline__ float log1p_fast(float t) { const float p = t * (1.f + t * (-0.5f + t * (0.33333333f + t * (-0.25f + t * 0.2f)))); return t < 0.03f ? p : __logf(1.f + t); }
__device__ __forceinline__ float softplusf(float x) { return fmaxf(x, 0.f) + log1p_fast(__expf(-fabsf(x))); }
__device__ __forceinline__ float neg_expm1_fast(float x) { const float p = -x * (1.f + x * (0.5f + x * (0.16666667f + x * (0.041666668f + x * 0.0083333338f)))); return x > -0.25f ? p : 1.f - __expf(x); }
__device__ __forceinline__ float gelu_tanh(float x) { const float u = 0.7978845608028654f * (x + 0.044715f * x * x * x); return x / (1.f + __expf(-2.f * u)); }
__device__ __forceinline__ float wave_sum(float v) {
#pragma unroll
    for (int o = 1; o < 64; o <<= 1) v += __shfl_xor(v, o);
    return v;
}
__device__ __forceinline__ int mod_index(int row) { return row < SEQ ? 0 : (row < MX ? 1 : 2); }
__device__ __forceinline__ int perm_row(int r) { if (r >= MX) return r; const int b = r >> 13, t = r & 8191; return (b << 13) + ((t & 63) << 7) + (t >> 6); }
__device__ __forceinline__ int unperm_row(int r) { if (r >= MX) return r; const int b = r >> 13, i = r & 8191; return (b << 13) + ((i & 127) << 6) + (i >> 7); }
__device__ __forceinline__ int seq_row(int b, int dir, int s) {
    if (s < CTXL) { const int pos = dir ? (CTXL - 1 - s) : s; return MX + b * CTXL + pos; }
    const int p = s - CTXL, pos = dir ? (SEQ - 1 - p) : p; return b * SEQ + pos;
}
#define XB_TMO      128
#define XB_XCNT(j)  (256  + 64 * (j))
#define XB_XSUB(j)  (1280 + 64 * (j))
#define XB_XGEN(j)  (2304 + 64 * (j))
#define XB_TOP      3328
#define XB_TOPGEN   3392
#define XCD_BAR_WORDS 3456
#define XB_SPIN_CAP (1u << 18)

__device__ __forceinline__ unsigned xb_ld(unsigned* p)              { return __hip_atomic_load(p, __ATOMIC_RELAXED, __HIP_MEMORY_SCOPE_AGENT); }
__device__ __forceinline__ unsigned xb_add(unsigned* p, unsigned v) { return __hip_atomic_fetch_add(p, v, __ATOMIC_RELAXED, __HIP_MEMORY_SCOPE_AGENT); }
__device__ __forceinline__ unsigned xb_xcc_id() { return (unsigned)__builtin_amdgcn_s_getreg((3 << 11) | 20) & 0xFu; }
#define XB_SPIN(cond, bar) do { unsigned _sp = 0; while (cond) { __builtin_amdgcn_s_sleep(1); \
    if ((++_sp & 255u) == 0u) { if (xb_ld(&(bar)[XB_TMO])) break; if (_sp > XB_SPIN_CAP) { atomicAdd(&(bar)[XB_TMO], 1u); break; } } } } while (0)

struct XcdBarrier {
    unsigned* bar; unsigned x;
    volatile LAS unsigned* st;
};

__device__ __forceinline__ XcdBarrier xcd_barrier_post(unsigned* bar, volatile LAS unsigned* st) {
    XcdBarrier b; b.bar = bar; b.x = xb_xcc_id(); b.st = st;
    if (threadIdx.x == 0) (void)xb_add(&bar[XB_XCNT(b.x)], 1u);
    return b;
}
__device__ __forceinline__ void xcd_barrier_complete(unsigned* bar, unsigned x, unsigned& nloc, unsigned& nx) {
    const unsigned G = gridDim.x * gridDim.y * gridDim.z;
    unsigned sum, cnt, mine, sp = 0u;
    for (;;) {
        sum = 0u; cnt = 0u; mine = 0u;
#pragma unroll
        for (unsigned j = 0; j < 16; ++j) { const unsigned c = xb_ld(&bar[XB_XCNT(j)]); sum += c; cnt += (c > 0u) ? 1u : 0u; mine = (j == x) ? c : mine; }
        if (sum == G) break;
        __builtin_amdgcn_s_sleep(1);
        if ((++sp & 255u) == 0u) { if (xb_ld(&bar[XB_TMO])) break; if (sp > XB_SPIN_CAP) { atomicAdd(&bar[XB_TMO], 1u); break; } }
    }
    nloc = mine > 0u ? mine : 1u; nx = cnt > 0u ? cnt : 1u;
}

__device__ __forceinline__ void xcd_barrier(const XcdBarrier& b) {
    asm volatile("s_waitcnt vmcnt(0)" ::: "memory");
    __syncthreads();
    if (threadIdx.x == 0) {
        unsigned* bar = b.bar;
        __builtin_amdgcn_s_waitcnt(0);
        unsigned nloc = b.st[0], nx = b.st[1];
        if (nloc == 0u) { xcd_barrier_complete(bar, b.x, nloc, nx); b.st[0] = nloc; b.st[1] = nx; }
        const unsigned old = xb_add(&bar[XB_XSUB(b.x)], 1u);
        const unsigned gen = old / nloc;
        if (old + 1u == (gen + 1u) * nloc) {
            __builtin_amdgcn_fence(__ATOMIC_RELEASE, "agent");
            asm volatile("s_waitcnt vmcnt(0)" ::: "memory");
            const unsigned og = xb_add(&bar[XB_TOP], 1u);
            const unsigned tg = og / nx;
            if (og + 1u == (tg + 1u) * nx) xb_add(&bar[XB_TOPGEN], 1u);
            else XB_SPIN(xb_ld(&bar[XB_TOPGEN]) == tg, bar);
            __builtin_amdgcn_fence(__ATOMIC_ACQUIRE, "agent");
            xb_add(&bar[XB_XGEN(b.x)], 1u);
            asm volatile("s_waitcnt vmcnt(0)" ::: "memory");
        } else {
            XB_SPIN(xb_ld(&bar[XB_XGEN(b.x)]) == gen, bar);
            __builtin_amdgcn_fence(__ATOMIC_ACQUIRE, "agent");
            asm volatile("s_waitcnt vmcnt(0)" ::: "memory");
        }
    }
    __syncthreads();
}

struct EpiEven1 {
    static constexpr bool PERM = true, AFTER_DRAIN = false;
    bf16_t *QA, *VA, *GA, *ZB, *QKVB; float *LF, *GB; const float *lb, *a_log, *dt_bias;
    __device__ __forceinline__ void operator()(const f32x4 (&acc)[2][2][4][2], const Unit& u, int wr, int wc, int fr_, int fq_) const {
        int fr = fr_, fq = fq_; asm volatile("" : "+v"(fr), "+v"(fq));
        const int grp = u.pn >> 2, row0 = u.pm * 256 + wr * 64 + fr;
        if (grp == 9) {
            if (wc != 0) return;
            float al[8], db[8];
#pragma unroll
            for (int i = 0; i < 8; ++i) { const int c = (8 * fq + i) & 15; al[i] = -__expf(a_log[c]); db[i] = dt_bias[c]; }
#pragma unroll
            for (int ai = 0; ai < 2; ++ai)
#pragma unroll
                for (int m = 0; m < 4; ++m) { float* rowp = GB + (size_t)(row0 + ai * 128 + m * 16) * 32 + 8 * fq;
#pragma unroll
                    for (int n = 0; n < 2; ++n) { const f32x4 v = acc[ai][0][m][n]; f32x4 o;
#pragma unroll
                        for (int j = 0; j < 4; ++j) o[j] = (fq < 2) ? al[4 * n + j] * softplusf(v[j] + db[4 * n + j]) : sigm(v[j]);
                        *(f32x4*)(rowp + 4 * n) = o; } }
            return;
        }
        const int col0 = (u.pn & 3) * 256 + wc * 32 + 8 * fq;
        int op = 0, ld = 1024; bf16_t* dstb = VA; float* dstf = LF;
        switch (grp) {
            case 0: op = 2; dstb = QA; break;
            case 1: op = 0; dstb = VA; break;
            case 2: op = 3; dstf = LF; break;
            case 3: op = 3; dstf = LF + (size_t)M * 1024; break;
            case 4: op = 1; dstb = GA; break;
            case 5: case 6: case 7: op = 0; dstb = QKVB + (grp - 5) * 1024; ld = 3072; break;
            default: op = 1; dstb = ZB; break;
        }
        if (op == 3) {
#pragma unroll
            for (int bj = 0; bj < 2; ++bj) { float lbv[8];
#pragma unroll
                for (int i = 0; i < 8; ++i) lbv[i] = lb[col0 + bj * 128 + i];
#pragma unroll
                for (int ai = 0; ai < 2; ++ai)
#pragma unroll
                    for (int m = 0; m < 4; ++m) { float* rowp = dstf + (size_t)(row0 + ai * 128 + m * 16) * 1024 + col0 + bj * 128;
#pragma unroll
                        for (int n = 0; n < 2; ++n) { const f32x4 v = acc[ai][bj][m][n]; f32x4 o;
#pragma unroll
                            for (int j = 0; j < 4; ++j) { const float l = lbv[4 * n + j]; o[j] = __logf(l + (1.f - l) * sigm(v[j])); }
                            *(f32x4*)(rowp + 4 * n) = o; } } }
            return;
        }
#pragma unroll
        for (int ai = 0; ai < 2; ++ai)
#pragma unroll
            for (int m = 0; m < 4; ++m) { bf16_t* rowp = dstb + (size_t)(row0 + ai * 128 + m * 16) * ld + col0;
#pragma unroll
                for (int bj = 0; bj < 2; ++bj) { f32x4 v0 = acc[ai][bj][m][0], v1 = acc[ai][bj][m][1];
                    if (op >= 1) {
#pragma unroll
                        for (int j = 0; j < 4; ++j) { v0[j] = siluf(v0[j]); v1[j] = siluf(v1[j]); }
                        if (op == 2) { v0 = v0 * QSCALE; v1 = v1 * QSCALE; } }
                    u32x4 w; w.x = cvt_pk_bf16(v0[0], v0[1]); w.y = cvt_pk_bf16(v0[2], v0[3]); w.z = cvt_pk_bf16(v1[0], v1[1]); w.w = cvt_pk_bf16(v1[2], v1[3]);
                    *(u32x4*)(rowp + bj * 128) = w; } }
    }
};
struct EpiOdd1 {
    static constexpr bool PERM = true, AFTER_DRAIN = false;
    bf16_t *GY, *XBR;
    __device__ __forceinline__ void operator()(const f32x4 (&acc)[2][2][4][2], const Unit& u, int wr, int wc, int fr_, int fq_) const {
        int fr = fr_, fq = fq_; asm volatile("" : "+v"(fr), "+v"(fq));
        const int row0 = u.pm * 256 + wr * 64 + fr; const bool isy = u.pn < 8;
        bf16_t* dst = isy ? GY : XBR; const int col0 = (u.pn & 7) * 256 + wc * 32 + 8 * fq;
#pragma unroll
        for (int ai = 0; ai < 2; ++ai)
#pragma unroll
            for (int m = 0; m < 4; ++m) { bf16_t* rowp = dst + (size_t)(row0 + ai * 128 + m * 16) * D + col0;
#pragma unroll
                for (int bj = 0; bj < 2; ++bj) { f32x4 v0 = acc[ai][bj][m][0], v1 = acc[ai][bj][m][1];
                    if (isy) {
#pragma unroll
                        for (int j = 0; j < 4; ++j) { v0[j] = gelu_tanh(v0[j]); v1[j] = gelu_tanh(v1[j]); } }
                    u32x4 w; w.x = cvt_pk_bf16(v0[0], v0[1]); w.y = cvt_pk_bf16(v0[2], v0[3]); w.z = cvt_pk_bf16(v1[0], v1[1]); w.w = cvt_pk_bf16(v1[2], v1[3]);
                    *(u32x4*)(rowp + bj * 128) = w; } }
    }
};
struct EpiGates {
    static constexpr bool PERM = true, AFTER_DRAIN = false;
    const bf16_t* XC; unsigned* AB; const float *gate_b  , *lam  ;
    __device__ __forceinline__ void operator()(const f32x4 (&acc)[2][2][4][2], const Unit& u, int wr, int wc, int fr_, int fq_) const {
        int fr = fr_, fq = fq_; asm volatile("" : "+v"(fr), "+v"(fq));
        const int nb = u.pn >> 2, pn4 = u.pn & 3, d = pn4 >> 1, half = pn4 & 1;
        const int row0 = u.pm * 256 + wr * 64 + fr, ch0 = nb * 256 + half * 128 + wc * 32 + 8 * fq;
        unsigned* ab = AB + (size_t)d * M * D;
#pragma unroll
        for (int n = 0; n < 2; ++n) {
            const int ch = ch0 + 4 * n;
            const f32x4 gr = *(const f32x4*)(gate_b + (d * 2 + 0) * D + ch), gi = *(const f32x4*)(gate_b + (d * 2 + 1) * D + ch), lm = *(const f32x4*)(lam + d * D + ch);
            f32x4 sp;
#pragma unroll
            for (int j = 0; j < 4; ++j) sp[j] = -8.0f * softplusf(-lm[j]);
#pragma unroll
            for (int ai = 0; ai < 2; ++ai)
#pragma unroll
                for (int m = 0; m < 4; ++m) { const size_t ro = (size_t)(row0 + ai * 128 + m * 16) * D + ch;
                    const u32x2 xr = *(const u32x2*)(XC + ro); const float xc[4] = {bflo(xr.x), bfhi(xr.x), bflo(xr.y), bfhi(xr.y)};
                    u32x4 o;
#pragma unroll
                    for (int j = 0; j < 4; ++j) { const float r = sigm(acc[ai][0][m][n][j] + gr[j]), ig = sigm(acc[ai][1][m][n][j] + gi[j]);
                        const float la = r * sp[j], bb = __builtin_sqrtf(neg_expm1_fast(2.f * la)) * (ig * xc[j]); o[j] = pk2(la, bb); }
                    *(u32x4*)(ab + ro) = o; }
        }
    }
};
struct EpiResid {
    static constexpr bool PERM = false, AFTER_DRAIN = false;
    const float *r0, *r1; float* out; const float* gt; int permute;
    __device__ __forceinline__ void operator()(const f32x4 (&acc)[2][2][4][2], const Unit& u, int wr, int wc, int fr_, int fq_) const {
        int fr = fr_, fq = fq_; asm volatile("" : "+v"(fr), "+v"(fq));
        const int rowt = u.pm * 256, mi = mod_index(rowt), col0 = u.pn * 256 + wc * 32 + 4 * fq;
        f32x4 gv[2][2];
#pragma unroll
        for (int bj = 0; bj < 2; ++bj)
#pragma unroll
            for (int n = 0; n < 2; ++n) gv[bj][n] = *(const f32x4*)(gt + (size_t)mi * 12288 + col0 + bj * 128 + n * 16) + 1.0f;
#pragma unroll
        for (int ai = 0; ai < 2; ++ai)
#pragma unroll
            for (int m = 0; m < 4; ++m) { const int rr = rowt + ai * 128 + wr * 64 + m * 16 + fr, tok = permute ? unperm_row(rr) : rr;
                const float* rp = (tok < MX ? r0 + (size_t)tok * D : r1 + (size_t)(tok - MX) * D) + col0; float* op = out + (size_t)tok * D + col0;
#pragma unroll
                for (int bj = 0; bj < 2; ++bj)
#pragma unroll
                    for (int n = 0; n < 2; ++n) { const f32x4 rs = *(const f32x4*)(rp + bj * 128 + n * 16); *(f32x4*)(op + bj * 128 + n * 16) = rs * DN_ALPHA + gv[bj][n] * acc[ai][bj][m][n]; }
                asm volatile("" ::: "memory"); }
    }
};
struct EpiSwiGLU {
    static constexpr bool PERM = true, AFTER_DRAIN = false;
    bf16_t* ACT;
    __device__ __forceinline__ void operator()(const f32x4 (&acc)[2][2][4][2], const Unit& u, int wr, int wc, int fr_, int fq_) const {
        int fr = fr_, fq = fq_; asm volatile("" : "+v"(fr), "+v"(fq));
        const int row0 = u.pm * 256 + wr * 64 + fr, col0 = u.pn * 128 + wc * 32 + 8 * fq;
#pragma unroll
        for (int ai = 0; ai < 2; ++ai)
#pragma unroll
            for (int m = 0; m < 4; ++m) { f32x4 v0 = acc[ai][0][m][0], v1 = acc[ai][0][m][1]; const f32x4 u0 = acc[ai][1][m][0], u1 = acc[ai][1][m][1];
#pragma unroll
                for (int j = 0; j < 4; ++j) { v0[j] = siluf(v0[j]) * u0[j]; v1[j] = siluf(v1[j]) * u1[j]; }
                u32x4 w; w.x = cvt_pk_bf16(v0[0], v0[1]); w.y = cvt_pk_bf16(v0[2], v0[3]); w.z = cvt_pk_bf16(v1[0], v1[1]); w.w = cvt_pk_bf16(v1[2], v1[3]);
                *(u32x4*)(ACT + (size_t)(row0 + ai * 128 + m * 16) * FF + col0) = w; }
    }
};
struct Frame {
    LAS unsigned char* lds;
    int tid, lane, wave, G, gw, NGW;
};
struct Args { const float* in[25]; float* out; unsigned char* ws; int ph_lo, ph_hi; };

template <int MODE> __device__ __forceinline__ long src_off(int n, int nsrc) {
    if (MODE == 0) return n < nsrc ? (long)n : -1L;
    if (MODE == 1) { const int pn = n >> 8, bj = (n >> 7) & 1, jj = n & 127; return (long)bj * FF + pn * 128 + jj; }
    const int nb = n >> 10, c = n & 1023, pn4 = c >> 8, g = (c >> 7) & 1, jj = c & 127, d = pn4 >> 1, half = pn4 & 1;
    return (long)(((d * 2 + g) * 8 + nb) * 256) * 256 + half * 128 + jj;
}
template <int MODE> __device__ __forceinline__ void tr_item(const float* W, int ldin, int K, bf16* WT, int nout, int nsrc, LAS float* scr, int item, int lane) {
    const int nblk = nout / 32, kb = item / nblk, nb = item % nblk, k0 = 64 * kb, n0 = 32 * nb;
    const long off = src_off<MODE>(n0 + (lane & 31), nsrc);
#pragma unroll 8
    for (int i = 0; i < 32; ++i) { const int kk = 2 * i + (lane >> 5); scr[kk * 33 + (lane & 31)] = off >= 0 ? W[off + (size_t)(k0 + kk) * ldin] : 0.f; }
    LDS_WAIT(); asm volatile("" ::: "memory");
    const int c = lane & 7;
#pragma unroll
    for (int j = 0; j < 4; ++j) { const int n = (lane >> 3) + 8 * j; const LAS float* s = scr + (8 * c) * 33 + n;
        u32x4 o; o.x = pk2(s[0 * 33], s[1 * 33]); o.y = pk2(s[2 * 33], s[3 * 33]); o.z = pk2(s[4 * 33], s[5 * 33]); o.w = pk2(s[6 * 33], s[7 * 33]);
        *(u32x4*)(WT + (size_t)(n0 + n) * K + k0 + 8 * c) = o; }
    LDS_WAIT(); asm volatile("" ::: "memory");
}
__device__ __forceinline__ void gemv_item(const Args& a, int gi, int lane, float* PART) {
    const int l = gi / 384, c48 = (gi >> 3) % 48, kp = gi & 7, col = c48 * 256 + lane * 4;
    const float* W = a.in[4] + ((size_t)l * D + kp * 256) * 12288 + col;
    const float* c0 = a.in[1] + kp * 256; const float* c1 = c0 + D; const float* c2 = a.in[3] + kp * 256;
    f32x4 s0 = {0.f, 0.f, 0.f, 0.f}, s1 = s0, s2 = s0;
#pragma unroll 8
    for (int k = 0; k < 256; ++k) { const f32x4 w = *(const f32x4*)(W + (size_t)k * 12288); s0 += w * siluf(c0[k]); s1 += w * siluf(c1[k]); s2 += w * siluf(c2[k]); }
    float* p = PART + ((size_t)(kp * 4 + l) * 3) * 12288 + col;
    *(f32x4*)p = s0; *(f32x4*)(p + 12288) = s1; *(f32x4*)(p + 2 * 12288) = s2;
}
__device__ __forceinline__ void ph_prologue(Frame& F, const Args& a) {
    LAS float* scr = (LAS float*)(F.lds + RING_OFF + F.wave * 16384);
    unsigned char* ws = a.ws;
    constexpr int I_INE = (D / 64) * (NE_INP / 32), I_SQ = (D / 64) * (D / 32), I_INO = (D / 64) * (2 * D / 32), I_GATE = (256 / 64) * (8192 / 32), I_GU = (D / 64) * (2 * FF / 32), I_DN = (FF / 64) * (D / 32);
    constexpr int NGEMV = 4 * 48 * 8;
    constexpr int NITEMS = NGEMV + 2 * (I_INE + I_SQ + I_INO + I_GATE + I_SQ) + 4 * (I_GU + I_DN);
    for (int it = F.gw; it < NITEMS; it += F.NGW) {
        int r = it;
        if (r < NGEMV) { gemv_item(a, r, F.lane, (float*)(ws + WS_PART)); continue; } r -= NGEMV;
        bool done = false;
#pragma unroll 1
        for (int j = 0; j < 2 && !done; ++j) {
            if (r < I_INE) { tr_item<0>(a.in[10] + (size_t)j * D * NE_IN, NE_IN, D, (bf16*)(ws + WS_WINE + j * SZ_WINE), NE_INP, NE_IN, scr, r, F.lane); done = true; break; } r -= I_INE;
            if (r < I_SQ) { tr_item<0>(a.in[17] + (size_t)j * D * D, D, D, (bf16*)(ws + WS_WOUTE + j * SZ_WSQ), D, D, scr, r, F.lane); done = true; break; } r -= I_SQ;
            if (r < I_INO) { tr_item<0>(a.in[18] + (size_t)j * D * 2 * D, 2 * D, D, (bf16*)(ws + WS_WINO + j * SZ_WINO), 2 * D, 2 * D, scr, r, F.lane); done = true; break; } r -= I_INO;
            if (r < I_GATE) { tr_item<2>(a.in[21] + (size_t)j * 4 * 8 * 256 * 256, 256, 256, (bf16*)(ws + WS_WGATE + j * SZ_WGATE), 8192, 8192, scr, r, F.lane); done = true; break; } r -= I_GATE;
            if (r < I_SQ) { tr_item<0>(a.in[24] + (size_t)j * D * D, D, D, (bf16*)(ws + WS_WOUTO + j * SZ_WSQ), D, D, scr, r, F.lane); done = true; break; } r -= I_SQ;
        }
        if (done) continue;
#pragma unroll 1
        for (int l = 0; l < 4; ++l) {
            if (r < I_GU) { tr_item<1>(a.in[8] + (size_t)l * D * 2 * FF, 2 * FF, D, (bf16*)(ws + WS_WGU + l * SZ_WGU), 2 * FF, 2 * FF, scr, r, F.lane); break; } r -= I_GU;
            if (r < I_DN) { tr_item<0>(a.in[9] + (size_t)l * FF * D, D, FF, (bf16*)(ws + WS_WDN + l * SZ_WDN), D, D, scr, r, F.lane); break; } r -= I_DN;
        }
    }
}
__device__ __forceinline__ void ph_modreduce(Frame& F, const Args& a) {
    float* MOD = (float*)(a.ws + WS_MOD); const float* PART = (const float*)(a.ws + WS_PART); float* LB = (float*)(a.ws + WS_LB);
    const int gt = blockIdx.x * NTHREADS + F.tid, NT = F.G * NTHREADS;
    for (int i = gt; i < 4 * 3 * 12288; i += NT) { const int l = i / 36864, n = i % 12288; float s = a.in[5][l * 12288 + n];
#pragma unroll
        for (int kp = 0; kp < 8; ++kp) s += PART[(size_t)kp * 147456 + i];
        MOD[i] = s; }
    for (int i = gt; i < 2048; i += NT) { const int c = i & 1023; LB[i] = i < 1024 ? 0.f : sigm(a.in[14][1024 + c] - a.in[14][c]); }
}
__device__ __forceinline__ void store_hx(bf16* HX, int orow, const f32x4 (&v)[8], const float* sh, const float* sc, int lane) {
    unsigned long long* o8 = (unsigned long long*)(HX + (size_t)orow * D) + lane;
#pragma unroll
    for (int j = 0; j < 8; ++j) { const f32x4 s = *(const f32x4*)(sc + 4 * (lane + 64 * j)), h = *(const f32x4*)(sh + 4 * (lane + 64 * j)); const f32x4 y = v[j] * (s + 1.0f) + h;
        o8[64 * j] = (unsigned long long)pk2(y[0], y[1]) | ((unsigned long long)pk2(y[2], y[3]) << 32); }
}
__device__ __forceinline__ void ph_mod0(Frame& F, const Args& a) {
    const float* MOD = (const float*)(a.ws + WS_MOD); bf16* HX = (bf16*)(a.ws + WS_HX);
    for (int row = F.gw; row < M; row += F.NGW) {
        const float* p = row < MX ? a.in[0] + (size_t)row * D : a.in[2] + (size_t)(row - MX) * D; f32x4 v[8];
#pragma unroll
        for (int j = 0; j < 8; ++j) v[j] = *(const f32x4*)(p + 4 * (F.lane + 64 * j));
        const float* md = MOD + (size_t)mod_index(row) * 12288;
        store_hx(HX, row, v, md, md + D, F.lane);
    }
}
__device__ __forceinline__ void ph_ln(Frame& F, float* buf, int nrows, const float* g, const float* b, float* dout, bf16* HX, const float* modsh, const float* modsc, int permute) {
    for (int row = F.gw; row < nrows; row += F.NGW) {
        float* p = buf + (size_t)row * D; f32x4 v[8]; float s = 0.f;
#pragma unroll
        for (int j = 0; j < 8; ++j) { v[j] = *(const f32x4*)(p + 4 * (F.lane + 64 * j)); s += (v[j][0] + v[j][1]) + (v[j][2] + v[j][3]); }
        const float mean = wave_sum(s) * (1.f / D); float q = 0.f;
#pragma unroll
        for (int j = 0; j < 8; ++j) { v[j] = v[j] - mean; q += (v[j][0] * v[j][0] + v[j][1] * v[j][1]) + (v[j][2] * v[j][2] + v[j][3] * v[j][3]); }
        const float rstd = 1.f / sqrtf(wave_sum(q) * (1.f / D) + LN_EPS);
        float* o = dout ? dout + (size_t)row * D : p;
#pragma unroll
        for (int j = 0; j < 8; ++j) { const f32x4 gg = *(const f32x4*)(g + 4 * (F.lane + 64 * j)), bb = *(const f32x4*)(b + 4 * (F.lane + 64 * j)); v[j] = v[j] * rstd * gg + bb; *(f32x4*)(o + 4 * (F.lane + 64 * j)) = v[j]; }
        if (HX) { const int mi = mod_index(row); store_hx(HX, permute ? perm_row(row) : row, v, modsh + (size_t)mi * 12288, modsc + (size_t)mi * 12288, F.lane); }
    }
}
__device__ __forceinline__ void seg_bounds(int r, int& lo, int& hi) { if (r < MX) { lo = r & ~(SEQ - 1); hi = lo + SEQ; } else { lo = MX + ((r - MX) & ~(CTXL - 1)); hi = lo + CTXL; } }
__device__ __forceinline__ float row16_sum(float v) { v += __shfl_xor(v, 1); v += __shfl_xor(v, 2); v += __shfl_xor(v, 4); v += __shfl_xor(v, 8); return v; }
template <int MODE> __device__ __forceinline__ void ph_conv(Frame& F, const Args& a, int j) {
    constexpr int NG = MODE == 0 ? 6 : 4, LDI = MODE == 0 ? 3072 : D;
    const bf16* X = (const bf16*)(a.ws + (MODE == 0 ? WS_QKVB : WS_XBR));
    const float* cw = MODE == 0 ? a.in[11] + (size_t)j * 4 * 3072 : a.in[19] + (size_t)j * 4 * D;
    for (int it = F.gw; it < (M / 16) * NG; it += F.NGW) {
        const int si = it / NG, kg = it - si * NG, r0 = si * 16, ch = kg * 512 + 8 * F.lane;
        int lo, hi; seg_bounds(r0, lo, hi);
        float w[4][8];
#pragma unroll
        for (int k = 0; k < 4; ++k) { const f32x4 w0 = *(const f32x4*)(cw + k * LDI + ch), w1 = *(const f32x4*)(cw + k * LDI + ch + 4);
#pragma unroll
            for (int c = 0; c < 4; ++c) { w[k][c] = w0[c]; w[k][4 + c] = w1[c]; } }
        float bias[8];
#pragma unroll
        for (int c = 0; c < 8; ++c) bias[c] = 0.f;
        if (MODE == 1) { const float* cb = a.in[20] + (size_t)j * D + ch; const f32x4 b0 = *(const f32x4*)cb, b1 = *(const f32x4*)(cb + 4);
#pragma unroll
            for (int c = 0; c < 4; ++c) { bias[c] = b0[c]; bias[4 + c] = b1[c]; } }
        u32x4 xr[19];
#pragma unroll
        for (int r = 0; r < 19; ++r) { const int rr = r0 + r - 2; xr[r] = (rr >= lo && rr < hi) ? *(const u32x4*)(X + (size_t)rr * LDI + ch) : (u32x4){0u, 0u, 0u, 0u}; }
#pragma unroll
        for (int r = 0; r < 16; ++r) { float y[8];
#pragma unroll
            for (int c = 0; c < 8; ++c) y[c] = bias[c];
#pragma unroll
            for (int k = 0; k < 4; ++k) { const u32x4 x = xr[r + k];
#pragma unroll
                for (int c = 0; c < 4; ++c) { y[2 * c] += w[k][2 * c] * bflo(x[c]); y[2 * c + 1] += w[k][2 * c + 1] * bfhi(x[c]); } }
            const int row = r0 + r;
            if (MODE == 0) {
#pragma unroll
                for (int c = 0; c < 8; ++c) y[c] = siluf(y[c]);
                if (kg < 4) { float ss = 0.f;
#pragma unroll
                    for (int c = 0; c < 8; ++c) ss += y[c] * y[c];
                    const float sc = rsqrtf(row16_sum(ss) + 1e-6f) * (kg < 2 ? QSCALE : 1.f);
#pragma unroll
                    for (int c = 0; c < 8; ++c) y[c] *= sc; }
                bf16* dst = (bf16*)(a.ws + (kg < 2 ? WS_QB : (kg < 4 ? WS_KB : WS_VB))) + (size_t)row * AW + (kg & 1) * 512 + 8 * F.lane;
                *(u32x4*)dst = (u32x4){pk2(y[0], y[1]), pk2(y[2], y[3]), pk2(y[4], y[5]), pk2(y[6], y[7])};
            } else {
                *(u32x4*)((bf16*)(a.ws + WS_XC) + (size_t)row * D + ch) = (u32x4){pk2(y[0], y[1]), pk2(y[2], y[3]), pk2(y[4], y[5]), pk2(y[6], y[7])};
            } }
    }
}
__device__ __forceinline__ void ph_merge(Frame& F, const Args& a, int j) {
    bf16* MIX = (bf16*)(a.ws + WS_MIX);
    for (int row = F.gw; row < M; row += F.NGW) {
        u32x4 o0[4], o1[4], gg[4];
#pragma unroll
        for (int q = 0; q < 4; ++q) { const int part = q >> 1, c = (q & 1) * 512 + 8 * F.lane; const bf16* O = (const bf16*)(a.ws + (part ? WS_OB : WS_OA)); const size_t o = (size_t)row * AW + c;
            o0[q] = *(const u32x4*)(O + o); o1[q] = *(const u32x4*)(O + (size_t)M * AW + o); gg[q] = *(const u32x4*)((const bf16*)(a.ws + (part ? WS_ZB : WS_GA)) + o); }
#pragma unroll
        for (int q = 0; q < 4; ++q) { const int part = q >> 1, c = (q & 1) * 512 + 8 * F.lane; const float* nw = (part ? a.in[16] : a.in[15]) + (size_t)j * AW + c;
            const f32x4 n0 = *(const f32x4*)nw, n1 = *(const f32x4*)(nw + 4); float y[8]; float ss = 0.f;
#pragma unroll
            for (int k = 0; k < 4; ++k) { y[2 * k] = bflo(o0[q][k]) + bflo(o1[q][k]); y[2 * k + 1] = bfhi(o0[q][k]) + bfhi(o1[q][k]); ss += y[2 * k] * y[2 * k] + y[2 * k + 1] * y[2 * k + 1]; }
            const float sc = rsqrtf(row16_sum(ss) * (1.f / 128.f) + 1e-6f);
#pragma unroll
            for (int k = 0; k < 4; ++k) { y[2 * k] *= sc * (k < 2 ? n0[2 * k] : n1[2 * k - 4]) * bflo(gg[q][k]); y[2 * k + 1] *= sc * (k < 2 ? n0[2 * k + 1] : n1[2 * k - 3]) * bfhi(gg[q][k]); }
            *(u32x4*)(MIX + (size_t)row * D + part * AW + c) = (u32x4){pk2(y[0], y[1]), pk2(y[2], y[3]), pk2(y[4], y[5]), pk2(y[6], y[7])}; }
    }
}
__device__ __forceinline__ void ph_odd_l1(Frame& F, const Args& a) {
    const unsigned* AB = (const unsigned*)(a.ws + WS_AB); float2* PH = (float2*)(a.ws + WS_R);
    for (int it = F.gw; it < 128 * 132; it += F.NGW) {
        const int cgp = it & 127, tc = it >> 7, c = cgp * 64 + F.lane, ch = c & 2047, d = (c >> 11) & 1, b = c >> 12;
        const unsigned* ab = AB + (size_t)d * M * D + ch; float P = 1.f, H = 0.f;
        const int row0 = seq_row(b, d, tc * 64), stp = d ? -1 : 1;
#pragma unroll 1
        for (int k0 = 0; k0 < 64; k0 += 16) { unsigned x[16];
#pragma unroll
            for (int k = 0; k < 16; ++k) x[k] = ab[(size_t)(row0 + stp * (k0 + k)) * D];
#pragma unroll
            for (int k = 0; k < 16; ++k) { const float al = __expf(bflo(x[k])); P *= al; H = al * H + bfhi(x[k]); } }
        PH[(size_t)tc * 8192 + c] = make_float2(P, H);
    }
}
__device__ __forceinline__ void ph_odd_l3(Frame& F, const Args& a) {
    const unsigned* AB = (const unsigned*)(a.ws + WS_AB); const float2* PH = (const float2*)(a.ws + WS_R); const bf16* GY = (const bf16*)(a.ws + WS_GY); bf16* MIX = (bf16*)(a.ws + WS_MIX);
    for (int it = F.gw; it < 64 * 132; it += F.NGW) {
        const int g64 = it & 63, jb = it >> 6, b = g64 >> 5, ch = (g64 & 31) * 64 + F.lane;
        const int row0 = jb < 4 ? MX + b * CTXL + jb * 64 : b * SEQ + (jb - 4) * 64;
        const int tcf = jb, tcb = jb < 4 ? 3 - jb : 4 + (131 - jb);
        const int cf = (b << 12) + ch, cb = (b << 12) + 2048 + ch;
        float hf = 0.f, hb = 0.f;
        for (int q = 0; q < tcf; ++q) { const float2 p = PH[(size_t)q * 8192 + cf]; hf = p.x * hf + p.y; }
        for (int q = 0; q < tcb; ++q) { const float2 p = PH[(size_t)q * 8192 + cb]; hb = p.x * hb + p.y; }
        const unsigned* ab0 = AB + (size_t)row0 * D + ch; const unsigned* ab1 = ab0 + (size_t)M * D;
        float hs[64];
#pragma unroll
        for (int k0 = 0; k0 < 64; k0 += 16) { unsigned x[16];
#pragma unroll
            for (int k = 0; k < 16; ++k) x[k] = ab0[(size_t)(k0 + k) * D];
#pragma unroll
            for (int k = 0; k < 16; ++k) { hf = __expf(bflo(x[k])) * hf + bfhi(x[k]); hs[k0 + k] = hf; } }
        const bf16* gy = GY + (size_t)row0 * D + ch; bf16* mx = MIX + (size_t)row0 * D + ch;
#pragma unroll
        for (int k0 = 48; k0 >= 0; k0 -= 16) { unsigned x[16]; bf16 gv[16];
#pragma unroll
            for (int k = 0; k < 16; ++k) { x[k] = ab1[(size_t)(k0 + k) * D]; gv[k] = gy[(size_t)(k0 + k) * D]; }
#pragma unroll
            for (int k = 15; k >= 0; --k) { hb = __expf(bflo(x[k])) * hb + bfhi(x[k]); mx[(size_t)(k0 + k) * D] = (bf16)f2bf(bf2f(gv[k]) * (hs[k0 + k] + hb)); } }
    }
}
__device__ __forceinline__ void hgrn_wave(int wi, int lane, const bf16* QA, const float* LF, const bf16* VA, bf16* OA) {
    const int chain = wi >> 3, cg = wi & 7, b = chain >> 4, h = (chain >> 1) & 7, dir = chain & 1, kq = lane >> 4, col = cg * 16 + (lane & 15);
    const float* lf = LF + (size_t)dir * M * AW + h * 128 + kq * 32; const bf16* qa = QA + h * 128 + kq * 32; const bf16* va = VA + h * 128 + col; bf16* oa = OA + (size_t)dir * M * AW + h * 128 + col;
    float S[32];
#pragma unroll
    for (int i = 0; i < 32; ++i) S[i] = 0.f;
    u32x4 qn[4]; f32x4 fn[8]; float vn; int rown = seq_row(b, dir, 0);
#pragma unroll
    for (int i = 0; i < 4; ++i) qn[i] = *(const u32x4*)(qa + (size_t)rown * AW + 8 * i);
#pragma unroll
    for (int i = 0; i < 8; ++i) fn[i] = *(const f32x4*)(lf + (size_t)rown * AW + 4 * i);
    vn = bf2f(va[(size_t)rown * AW]);
    for (int s = 0; s < CTXL + SEQ; ++s) {
        u32x4 qc[4]; f32x4 fc[8]; const float vc = vn; const int row = rown;
#pragma unroll
        for (int i = 0; i < 4; ++i) qc[i] = qn[i];
#pragma unroll
        for (int i = 0; i < 8; ++i) fc[i] = fn[i];
        if (s + 1 < CTXL + SEQ) { rown = seq_row(b, dir, s + 1);
#pragma unroll
            for (int i = 0; i < 4; ++i) qn[i] = *(const u32x4*)(qa + (size_t)rown * AW + 8 * i);
#pragma unroll
            for (int i = 0; i < 8; ++i) fn[i] = *(const f32x4*)(lf + (size_t)rown * AW + 4 * i);
            vn = bf2f(va[(size_t)rown * AW]); }
        float o = 0.f;
#pragma unroll
        for (int i = 0; i < 32; ++i) { const float f = __expf(fc[i >> 2][i & 3]); const unsigned qw = qc[i >> 3][(i >> 1) & 3]; const float q = (i & 1) ? bfhi(qw) : bflo(qw);
            S[i] = f * (S[i] - vc) + vc; o += S[i] * q; }
        o += __shfl_xor(o, 16); o += __shfl_xor(o, 32);
        if (kq == 0) oa[(size_t)row * AW] = (bf16)f2bf(o);
    }
}
__device__ __forceinline__ void gdn_wave(int wi, int lane, const bf16* QB, const bf16* KB, const bf16* VB, const float* GB, bf16* OB) {
    const int chain = wi >> 3, cg = wi & 7, b = chain >> 4, h = (chain >> 1) & 7, dir = chain & 1, kq = lane >> 4, col = cg * 16 + (lane & 15);
    const bf16* qb = QB + h * 128 + kq * 32; const bf16* kb = KB + h * 128 + kq * 32; const bf16* vb = VB + h * 128 + col; const float* gb = GB + dir * 8 + h; bf16* ob = OB + (size_t)dir * M * AW + h * 128 + col;
    float S[32];
#pragma unroll
    for (int i = 0; i < 32; ++i) S[i] = 0.f;
    u32x4 qn[4], kn[4]; float vn, gn, bn; int rown = seq_row(b, dir, 0);
#pragma unroll
    for (int i = 0; i < 4; ++i) { qn[i] = *(const u32x4*)(qb + (size_t)rown * AW + 8 * i); kn[i] = *(const u32x4*)(kb + (size_t)rown * AW + 8 * i); }
    vn = bf2f(vb[(size_t)rown * AW]); gn = gb[(size_t)rown * 32]; bn = gb[(size_t)rown * 32 + 16];
    for (int s = 0; s < CTXL + SEQ; ++s) {
        u32x4 qc[4], kc[4]; const float vc = vn, gc = gn, bc = bn; const int row = rown;
#pragma unroll
        for (int i = 0; i < 4; ++i) { qc[i] = qn[i]; kc[i] = kn[i]; }
        if (s + 1 < CTXL + SEQ) { rown = seq_row(b, dir, s + 1);
#pragma unroll
            for (int i = 0; i < 4; ++i) { qn[i] = *(const u32x4*)(qb + (size_t)rown * AW + 8 * i); kn[i] = *(const u32x4*)(kb + (size_t)rown * AW + 8 * i); }
            vn = bf2f(vb[(size_t)rown * AW]); gn = gb[(size_t)rown * 32]; bn = gb[(size_t)rown * 32 + 16]; }
        const float al = __expf(gc); float ks = 0.f; float kk[32];
#pragma unroll
        for (int i = 0; i < 32; ++i) { const unsigned kw = kc[i >> 3][(i >> 1) & 3]; kk[i] = (i & 1) ? bfhi(kw) : bflo(kw); ks += kk[i] * S[i]; }
        ks += __shfl_xor(ks, 16); ks += __shfl_xor(ks, 32);
        const float dl = bc * (vc - al * ks); float o = 0.f;
#pragma unroll
        for (int i = 0; i < 32; ++i) { const unsigned qw = qc[i >> 3][(i >> 1) & 3]; const float q = (i & 1) ? bfhi(qw) : bflo(qw); S[i] = al * S[i] + kk[i] * dl; o += S[i] * q; }
        o += __shfl_xor(o, 16); o += __shfl_xor(o, 32);
        if (kq == 0) ob[(size_t)row * AW] = (bf16)f2bf(o);
    }
}
__device__ __forceinline__ void ph_even_scan(Frame& F, const Args& a) {
    unsigned char* ws = a.ws;
    if (F.wave == 0) { for (int wi = blockIdx.x; wi < 256; wi += F.G) hgrn_wave(wi, F.lane, (const bf16*)(ws + WS_QA), (const float*)(ws + WS_LF), (const bf16*)(ws + WS_VA), (bf16*)(ws + WS_OA)); }
    else if (F.wave == 1) { for (int wi = blockIdx.x; wi < 256; wi += F.G) gdn_wave(wi, F.lane, (const bf16*)(ws + WS_QB), (const bf16*)(ws + WS_KB), (const bf16*)(ws + WS_VB), (const float*)(ws + WS_GB), (bf16*)(ws + WS_OB)); }
}
typedef short bf16x8 __attribute__((ext_vector_type(8)));
typedef short bf16x4 __attribute__((ext_vector_type(4)));
constexpr int NCHUNK = (CTXL + SEQ) / 16;
constexpr int NCHH = 32 * NCHUNK;
constexpr int HREC = 9216;
constexpr int HQ_OFF = 0, HK_OFF = 4096, HP_OFF = 8192, HD_OFF = 8704;
constexpr int GREC = 17152;
constexpr int GW_OFF = 0, GQ_OFF = 4096, GK_OFF = 8192, GU_OFF = 12288, GAT_OFF = 16384, GAL_OFF = 16896;
__device__ __forceinline__ unsigned cvtpk(float lo, float hi) { return pg8::cvt_pk_bf16(lo, hi); }
template <int N> __device__ __forceinline__ float row_shr(float x) { return __builtin_bit_cast(float, __builtin_amdgcn_update_dpp(0, __builtin_bit_cast(int, x), 0x110 + N, 0xf, 0xf, true)); }
__device__ __forceinline__ float row_prefix(float x) { x += row_shr<1>(x); x += row_shr<2>(x); x += row_shr<4>(x); x += row_shr<8>(x); return x; }
__device__ __forceinline__ float rdlane(float x, int l) { return __builtin_bit_cast(float, __builtin_amdgcn_readlane(__builtin_bit_cast(int, x), l)); }
__device__ __forceinline__ bf16x8 mk8(unsigned a, unsigned b, unsigned c, unsigned d) { return __builtin_bit_cast(bf16x8, (u32x4){a, b, c, d}); }
__device__ __forceinline__ bf16x4 mk4(unsigned a, unsigned b) { return __builtin_bit_cast(bf16x4, (u32x2){a, b}); }
#define MFMA32(a, b, c) __builtin_amdgcn_mfma_f32_16x16x32_bf16((a), (b), (c), 0, 0, 0)
#define MFMA16(a, b, c) __builtin_amdgcn_mfma_f32_16x16x16bf16_1k((a), (b), (c), 0, 0, 0)

__device__ __forceinline__ void hgrn_s1(int chh, int lane, unsigned char* ws) {
    const int chain = chh / NCHUNK, ci = chh - chain * NCHUNK, b = chain >> 4, h = (chain >> 1) & 7, dir = chain & 1, i = lane & 15, g = lane >> 4;
    const int row = seq_row(b, dir, ci * 16 + i);
    const bf16* qrow = (const bf16*)(ws + WS_QA) + (size_t)row * AW + h * 128 + 4 * g;
    const float* frow = (const float*)(ws + WS_LF) + (size_t)dir * M * AW + (size_t)row * AW + h * 128 + 4 * g;
    unsigned char* rec = ws + WS_HREC + (size_t)chh * HREC;
    bf16* hk = (bf16*)(rec + HK_OFF) + (16 * (i >> 2)) * 4 + (i & 3);
    f32x4 pacc = {0.f, 0.f, 0.f, 0.f};
#pragma unroll
    for (int s = 0; s < 4; ++s) {
        u32x2 qv[2]; f32x4 fv[2];
#pragma unroll
        for (int hh = 0; hh < 2; ++hh) { qv[hh] = *(const u32x2*)(qrow + 32 * s + 16 * hh); fv[hh] = *(const f32x4*)(frow + 32 * s + 16 * hh); }
        float qt[8], kh[8];
#pragma unroll
        for (int hh = 0; hh < 2; ++hh) { f32x4 ddv;
#pragma unroll
            for (int j = 0; j < 4; ++j) { const int idx = 4 * hh + j; const float lf = fv[hh][j], gc = row_prefix(lf), gl = __shfl(gc, (lane & 48) | 15);
                const float eg = __expf(gc), einv = __builtin_amdgcn_rcpf(eg), f = __expf(lf), dd = __expf(gl);
                const unsigned qw = qv[hh][j >> 1]; const float q = (j & 1) ? bfhi(qw) : bflo(qw);
                qt[idx] = q * eg; kh[idx] = (1.f - f) * einv; ddv[j] = dd;
                hk[((2 * s + hh) * 64 + 4 * g + j) * 4] = (bf16)f2bf(kh[idx] * dd); }
            if (i == 0) *(f32x4*)(rec + HD_OFF + (32 * s + 16 * hh + 4 * g) * 4) = ddv; }
        const bf16x8 Qf = mk8(cvtpk(qt[0], qt[1]), cvtpk(qt[2], qt[3]), cvtpk(qt[4], qt[5]), cvtpk(qt[6], qt[7]));
        const bf16x8 Kf = mk8(cvtpk(kh[0], kh[1]), cvtpk(kh[2], kh[3]), cvtpk(kh[4], kh[5]), cvtpk(kh[6], kh[7]));
        *(bf16x8*)(rec + HQ_OFF + (s * 64 + lane) * 16) = Qf;
        pacc = MFMA32(Kf, Qf, pacc);
    }
    float p[4];
#pragma unroll
    for (int r = 0; r < 4; ++r) p[r] = (4 * g + r <= i) ? pacc[r] : 0.f;
    *(bf16x4*)(rec + HP_OFF + lane * 8) = mk4(cvtpk(p[0], p[1]), cvtpk(p[2], p[3]));
}

__device__ __forceinline__ void gdn_s1(int chh, int lane, unsigned char* ws) {
    const int chain = chh / NCHUNK, ci = chh - chain * NCHUNK, b = chain >> 4, h = (chain >> 1) & 7, dir = chain & 1, i = lane & 15, g = lane >> 4;
    const int row = seq_row(b, dir, ci * 16 + i), row0 = seq_row(b, dir, ci * 16), stp = dir ? -1 : 1;
    const float* GB = (const float*)(ws + WS_GB);
    const float gval = GB[(size_t)row * 32 + dir * 8 + h], beta = GB[(size_t)row * 32 + 16 + dir * 8 + h];
    const float gc = row_prefix(gval), gl = __shfl(gc, (lane & 48) | 15), eg = __expf(gc), ekl = __expf(gl - gc);
    const bf16* qrow = (const bf16*)(ws + WS_QB) + (size_t)row * AW + h * 128 + 4 * g;
    const bf16* krow = (const bf16*)(ws + WS_KB) + (size_t)row * AW + h * 128 + 4 * g;
    unsigned char* rec = ws + WS_GREC + (size_t)chh * GREC;
    f32x4 kkacc = {0.f, 0.f, 0.f, 0.f}, qkacc = {0.f, 0.f, 0.f, 0.f};
#pragma unroll
    for (int s = 0; s < 4; ++s) {
        u32x2 qv[2], kv[2];
#pragma unroll
        for (int hh = 0; hh < 2; ++hh) { qv[hh] = *(const u32x2*)(qrow + 32 * s + 16 * hh); kv[hh] = *(const u32x2*)(krow + 32 * s + 16 * hh); }
        const bf16x8 Kf = mk8(kv[0].x, kv[0].y, kv[1].x, kv[1].y), Qf = mk8(qv[0].x, qv[0].y, qv[1].x, qv[1].y);
        kkacc = MFMA32(Kf, Kf, kkacc);
        qkacc = MFMA32(Kf, Qf, qkacc);
        unsigned qs[4];
#pragma unroll
        for (int w = 0; w < 4; ++w) { const unsigned qw = qv[w >> 1][w & 1]; qs[w] = cvtpk(bflo(qw) * eg, bfhi(qw) * eg); }
        *(bf16x8*)(rec + GQ_OFF + (s * 64 + lane) * 16) = mk8(qs[0], qs[1], qs[2], qs[3]);
    }
    float att[4], Areg[4];
#pragma unroll
    for (int r = 0; r < 4; ++r) { const float gcs = __shfl(gc, 4 * g + r), bts = __shfl(beta, 4 * g + r);
        att[r] = (4 * g + r <= i) ? qkacc[r] * __expf(gc - gcs) : 0.f;
        Areg[r] = (i < 4 * g + r) ? bts * kkacc[r] * __expf(gcs - gc) : 0.f; }
    *(bf16x4*)(rec + GAT_OFF + lane * 8) = mk4(cvtpk(att[0], att[1]), cvtpk(att[2], att[3]));
    if (lane == 0) *(float*)(rec + GAL_OFF) = __expf(gl);
    float xu[16][2], xw[16][2], kt[16][2];
    const bf16* vcol = (const bf16*)(ws + WS_VB) + h * 128 + 2 * lane; const bf16* kcol = (const bf16*)(ws + WS_KB) + h * 128 + 2 * lane;
#pragma unroll
    for (int t = 0; t < 16; ++t) { const size_t ro = (size_t)(row0 + stp * t) * AW; const unsigned vv = *(const unsigned*)(vcol + ro), kv = *(const unsigned*)(kcol + ro);
        const float bt = rdlane(beta, t), egt = rdlane(eg, t), et = rdlane(ekl, t), k0 = bflo(kv), k1 = bfhi(kv);
        xu[t][0] = bt * bflo(vv); xu[t][1] = bt * bfhi(vv); xw[t][0] = bt * egt * k0; xw[t][1] = bt * egt * k1; kt[t][0] = k0 * et; kt[t][1] = k1 * et; }
#pragma unroll
    for (int t = 1; t < 16; ++t)
#pragma unroll
        for (int s = 0; s < t; ++s) { const float a = rdlane(Areg[t & 3], s + 16 * (t >> 2));
            xu[t][0] -= a * xu[s][0]; xu[t][1] -= a * xu[s][1]; xw[t][0] -= a * xw[s][0]; xw[t][1] -= a * xw[s][1]; }
#pragma unroll
    for (int e = 0; e < 2; ++e) { const int c = 2 * lane + e, t16 = c >> 4, m = c & 15;
        const int ks = c >> 5, slot = 4 * ((c >> 4) & 1) + (c & 3), gq = (c >> 2) & 3;
#pragma unroll
        for (int gp = 0; gp < 4; ++gp) {
            *(u32x2*)(rec + GU_OFF + ((t16 * 64 + m + 16 * gp) * 4) * 2) = (u32x2){cvtpk(xu[4 * gp][e], xu[4 * gp + 1][e]), cvtpk(xu[4 * gp + 2][e], xu[4 * gp + 3][e])};
            *(u32x2*)(rec + GK_OFF + ((t16 * 64 + m + 16 * gp) * 4) * 2) = (u32x2){cvtpk(kt[4 * gp][e], kt[4 * gp + 1][e]), cvtpk(kt[4 * gp + 2][e], kt[4 * gp + 3][e])}; }
#pragma unroll
        for (int t = 0; t < 16; ++t) *(bf16*)(rec + GW_OFF + (((ks * 64 + t + 16 * gq) * 8) + slot) * 2) = (bf16)f2bf(xw[t][e]); }
}
__device__ __forceinline__ void ph_even_s1(Frame& F, const Args& a) {
    for (int chh = F.gw; chh < NCHH; chh += F.NGW) {
#ifndef EXP_B
        hgrn_s1(chh, F.lane, a.ws);
#endif
#ifndef EXP_A
        gdn_s1(chh, F.lane, a.ws);
#endif
    }
}

#ifndef MK_TOUCH
#define MK_TOUCH 1
#endif
constexpr int PFD = 6;
__device__ __forceinline__ void touch(const unsigned char* p0, const unsigned char* p1, LAS unsigned char* scr) {
#if MK_TOUCH
    __builtin_amdgcn_global_load_lds((const unsigned*)p0, (LAS unsigned*)scr, 4, 0, 0);
    __builtin_amdgcn_global_load_lds((const unsigned*)p1, (LAS unsigned*)(scr + 256), 4, 0, 0);
#endif
}
typedef float f32x2v __attribute__((ext_vector_type(2)));
struct HSet { bf16x8 q[4]; bf16x4 p; bf16x4 v; f32x2v dpre; };
__device__ __forceinline__ void hgrn_load(HSet& R, const unsigned char* rec, const bf16* va, int row0, int stp, int lane, int g) {
#pragma unroll
    for (int s = 0; s < 4; ++s) R.q[s] = *(const bf16x8*)(rec + HQ_OFF + (s * 64 + lane) * 16);
    R.p = *(const bf16x4*)(rec + HP_OFF + lane * 8); R.dpre = *(const f32x2v*)(rec + HD_OFF + lane * 8);
#pragma unroll
    for (int j = 0; j < 4; ++j) R.v[j] = (short)va[(size_t)(row0 + stp * (4 * g + j)) * AW];
}
__device__ __forceinline__ void hgrn_s2(int chain, int vs, int lane, unsigned char* ws, LAS unsigned char* scr) {
    const int b = chain >> 4, h = (chain >> 1) & 7, dir = chain & 1, g = lane >> 4, stp = dir ? -1 : 1;
    const bf16* va = (const bf16*)(ws + WS_VA) + h * 128 + vs * 16 + (lane & 15);
    bf16* oa = (bf16*)(ws + WS_OA) + (size_t)dir * M * AW + h * 128 + vs * 16 + (lane & 15);
    const unsigned char* recs = ws + WS_HREC + (size_t)chain * NCHUNK * HREC;
    LAS unsigned char* ldsd = scr + 512;
    f32x4 S[8]; bf16x8 Sb[4];
#pragma unroll
    for (int t = 0; t < 8; ++t) S[t] = (f32x4){0.f, 0.f, 0.f, 0.f};
#pragma unroll
    for (int s = 0; s < 4; ++s) Sb[s] = mk8(0u, 0u, 0u, 0u);
    HSet A, B; u32x2 Ob[8]; bf16x4 Kc[8];
    hgrn_load(A, recs, va, seq_row(b, dir, 0), stp, lane, g);
#pragma unroll
    for (int t = 0; t < 8; ++t) Kc[t] = *(const bf16x4*)(recs + HK_OFF + (t * 64 + lane) * 8);
#define HG_TOUCH(c_) do { const int cp = min((c_) + PFD, NCHUNK - 1); const unsigned char* r_ = recs + (size_t)cp * HREC; const int rp = seq_row(b, dir, cp * 16) + stp * (lane & 15); \
        touch(r_ + lane * 128, lane < 8 ? r_ + 8192 + lane * 128 : (const unsigned char*)(va + (size_t)rp * AW), scr); } while (0)
#define HG_STEP(R, k_, cnext_) do { f32x4 O = {0.f, 0.f, 0.f, 0.f}; const unsigned char* rn_ = recs + (size_t)min((cnext_), NCHUNK - 1) * HREC; \
        *(LAS f32x2v*)(ldsd + ((k_) & 1) * 512 + lane * 8) = R.dpre; \
        _Pragma("unroll") for (int s = 0; s < 4; ++s) O = MFMA32(R.q[s], Sb[s], O); \
        O = MFMA16(R.p, R.v, O); \
        _Pragma("unroll") for (int t = 0; t < 8; ++t) { const f32x4 dv = *(const LAS f32x4*)(ldsd + ((k_) & 1) * 512 + (16 * t + 4 * g) * 4); S[t] = S[t] * dv; S[t] = MFMA16(Kc[t], R.v, S[t]); Kc[t] = *(const bf16x4*)(rn_ + HK_OFF + (t * 64 + lane) * 8); } \
        _Pragma("unroll") for (int s = 0; s < 4; ++s) Sb[s] = mk8(cvtpk(S[2 * s][0], S[2 * s][1]), cvtpk(S[2 * s][2], S[2 * s][3]), cvtpk(S[2 * s + 1][0], S[2 * s + 1][1]), cvtpk(S[2 * s + 1][2], S[2 * s + 1][3])); \
        Ob[k_] = (u32x2){cvtpk(O[0], O[1]), cvtpk(O[2], O[3])}; } while (0)
#pragma unroll 1
    for (int c8 = 0; c8 < NCHUNK; c8 += 8) {
#pragma unroll
        for (int k = 0; k < 8; k += 2) { const int ci = c8 + k;
            HG_TOUCH(ci);
            hgrn_load(B, recs + (size_t)(ci + 1) * HREC, va, seq_row(b, dir, (ci + 1) * 16), stp, lane, g);
            HG_STEP(A, k, ci + 1);
            HG_TOUCH(ci + 1);
            { const int cn = min(ci + 2, NCHUNK - 1); hgrn_load(A, recs + (size_t)cn * HREC, va, seq_row(b, dir, cn * 16), stp, lane, g); }
            HG_STEP(B, k + 1, ci + 2); }
#pragma unroll
        for (int k = 0; k < 8; ++k) { const int row0 = seq_row(b, dir, (c8 + k) * 16) + stp * 4 * g;
            oa[(size_t)row0 * AW] = (bf16)(Ob[k].x & 0xffffu); oa[(size_t)(row0 + stp) * AW] = (bf16)(Ob[k].x >> 16); oa[(size_t)(row0 + 2 * stp) * AW] = (bf16)(Ob[k].y & 0xffffu); oa[(size_t)(row0 + 3 * stp) * AW] = (bf16)(Ob[k].y >> 16); }
    }
#undef HG_STEP
#undef HG_TOUCH
}
struct GSet { bf16x8 w[4], q[4]; bf16x4 at; u32x2 u; float al; };
__device__ __forceinline__ void gdn_load(GSet& R, const unsigned char* rec, int vs, int lane) {
#pragma unroll
    for (int s = 0; s < 4; ++s) { R.w[s] = *(const bf16x8*)(rec + GW_OFF + (s * 64 + lane) * 16); R.q[s] = *(const bf16x8*)(rec + GQ_OFF + (s * 64 + lane) * 16); }
    R.at = *(const bf16x4*)(rec + GAT_OFF + lane * 8); R.u = *(const u32x2*)(rec + GU_OFF + (vs * 64 + lane) * 8); R.al = *(const float*)(rec + GAL_OFF);
}
__device__ __forceinline__ void gdn_s2(int chain, int vs, int lane, unsigned char* ws, LAS unsigned char* scr) {
    const int b = chain >> 4, h = (chain >> 1) & 7, dir = chain & 1, g = lane >> 4, stp = dir ? -1 : 1;
    bf16* ob = (bf16*)(ws + WS_OB) + (size_t)dir * M * AW + h * 128 + vs * 16 + (lane & 15);
    const unsigned char* recs = ws + WS_GREC + (size_t)chain * NCHUNK * GREC;
    f32x4 S[8]; bf16x8 Sb[4];
#pragma unroll
    for (int t = 0; t < 8; ++t) S[t] = (f32x4){0.f, 0.f, 0.f, 0.f};
#pragma unroll
    for (int s = 0; s < 4; ++s) Sb[s] = mk8(0u, 0u, 0u, 0u);
    GSet A, B; u32x2 Ob[4]; bf16x4 Kc[8];
    gdn_load(A, recs, vs, lane);
#pragma unroll
    for (int t = 0; t < 8; ++t) Kc[t] = *(const bf16x4*)(recs + GK_OFF + (t * 64 + lane) * 8);
#define GD_TOUCH(c_) do { const unsigned char* r_ = recs + (size_t)min((c_) + PFD, NCHUNK - 1) * GREC; \
        touch(r_ + lane * 128, r_ + 8192 + (lane < 32 ? lane * 128 : (lane < 36 ? 4096 + vs * 512 + (lane - 32) * 128 : 8192 + ((lane & 3) + ((lane >> 2) & 1)) * 128)), scr); } while (0)
#define GD_STEP(R, k_, cnext_) do { f32x4 WS_ = {0.f, 0.f, 0.f, 0.f}, O = {0.f, 0.f, 0.f, 0.f}; const unsigned char* rn_ = recs + (size_t)min((cnext_), NCHUNK - 1) * GREC; \
        _Pragma("unroll") for (int s = 0; s < 4; ++s) WS_ = MFMA32(R.w[s], Sb[s], WS_); \
        _Pragma("unroll") for (int s = 0; s < 4; ++s) O = MFMA32(R.q[s], Sb[s], O); \
        const bf16x4 Vn = mk4(cvtpk(bflo(R.u.x) - WS_[0], bfhi(R.u.x) - WS_[1]), cvtpk(bflo(R.u.y) - WS_[2], bfhi(R.u.y) - WS_[3])); \
        O = MFMA16(R.at, Vn, O); \
        _Pragma("unroll") for (int t = 0; t < 8; ++t) { S[t] = S[t] * R.al; S[t] = MFMA16(Kc[t], Vn, S[t]); Kc[t] = *(const bf16x4*)(rn_ + GK_OFF + (t * 64 + lane) * 8); } \
        _Pragma("unroll") for (int s = 0; s < 4; ++s) Sb[s] = mk8(cvtpk(S[2 * s][0], S[2 * s][1]), cvtpk(S[2 * s][2], S[2 * s][3]), cvtpk(S[2 * s + 1][0], S[2 * s + 1][1]), cvtpk(S[2 * s + 1][2], S[2 * s + 1][3])); \
        Ob[k_] = (u32x2){cvtpk(O[0], O[1]), cvtpk(O[2], O[3])}; } while (0)
#pragma unroll 1
    for (int c8 = 0; c8 < NCHUNK; c8 += 4) {
#pragma unroll
        for (int k = 0; k < 4; k += 2) { const int ci = c8 + k;
            GD_TOUCH(ci);
            gdn_load(B, recs + (size_t)(ci + 1) * GREC, vs, lane);
            GD_STEP(A, k, ci + 1);
            GD_TOUCH(ci + 1);
            gdn_load(A, recs + (size_t)min(ci + 2, NCHUNK - 1) * GREC, vs, lane);
            GD_STEP(B, k + 1, ci + 2); }
#pragma unroll
        for (int k = 0; k < 4; ++k) { const int row0 = seq_row(b, dir, (c8 + k) * 16) + stp * 4 * g;
            ob[(size_t)row0 * AW] = (bf16)(Ob[k].x & 0xffffu); ob[(size_t)(row0 + stp) * AW] = (bf16)(Ob[k].x >> 16); ob[(size_t)(row0 + 2 * stp) * AW] = (bf16)(Ob[k].y & 0xffffu); ob[(size_t)(row0 + 3 * stp) * AW] = (bf16)(Ob[k].y >> 16); }
    }
#undef GD_STEP
#undef GD_TOUCH
}
__device__ __forceinline__ void ph_even_s2(Frame& F, const Args& a) {
    if (F.wave >= 2) return;
    const int bx = blockIdx.x, vcu = (F.G % 8 == 0) ? (bx % 8) * (F.G / 8) + bx / 8 : bx;
    LAS unsigned char* scr = F.lds + RING_OFF + F.wave * 2048;
    for (int tp = vcu; tp < 256; tp += F.G) { const int task = 2 * tp + F.wave, mixer = task >> 8, chain = (task >> 3) & 31, vs = task & 7;
#if defined(EXP_A)
        if (mixer == 0) gdn_wave(task & 255, F.lane, (const bf16*)(a.ws + WS_QB), (const bf16*)(a.ws + WS_KB), (const bf16*)(a.ws + WS_VB), (const float*)(a.ws + WS_GB), (bf16*)(a.ws + WS_OB));
        else hgrn_s2(chain, vs, F.lane, a.ws, scr);
#elif defined(EXP_B)
        if (mixer == 0) gdn_s2(chain, vs, F.lane, a.ws, scr);
        else hgrn_wave(task & 255, F.lane, (const bf16*)(a.ws + WS_QA), (const float*)(a.ws + WS_LF), (const bf16*)(a.ws + WS_VA), (bf16*)(a.ws + WS_OA));
#else
        if (mixer == 0) gdn_s2(chain, vs, F.lane, a.ws, scr); else hgrn_s2(chain, vs, F.lane, a.ws, scr);
#endif
    }
}
constexpr int N_PHASES = 3 + 10 * DEPTH;
__host__ __device__ constexpr bool phase_used(int ph) { return true; }

__global__ void __launch_bounds__(NTHREADS, 2) fwd(Args args) {
    extern __shared__ __attribute__((aligned(16))) unsigned char lds[];
    Frame F;
    F.lds = (LAS unsigned char*)lds; F.tid = threadIdx.x; F.lane = F.tid & 63; F.wave = __builtin_amdgcn_readfirstlane(F.tid >> 6);
    F.G = gridDim.x; F.gw = F.wave * F.G + blockIdx.x; F.NGW = F.G * NWAVES;
    for (int u = F.tid; u < (LDS_BYTES - LDSCTL_OFF) / 4; u += NTHREADS) ((LAS unsigned*)(F.lds + LDSCTL_OFF))[u] = 0u;
    __syncthreads();
    const int lo = args.ph_lo, hi = args.ph_hi; const bool multi = (hi - lo) > 1;
    unsigned char* ws = args.ws;
    XcdBarrier bar; bar.bar = (unsigned*)(ws + WS_CTL) + CW_BAR; bar.x = 0; bar.st = nullptr;
    if (multi) bar = xcd_barrier_post((unsigned*)(ws + WS_CTL) + CW_BAR, (volatile LAS unsigned*)(F.lds + MISC_OFF) + 8);
#ifndef PH_SITES
#define PH_SITES 0x3ffff
#endif
#define SITE(n) ((PH_SITES >> (n)) & 1)
#ifndef PROBE_MASK
#define PROBE_MASK 0
#endif
#define REPS(n) (((PROBE_MASK >> (n)) & 1) ? 2 : 1)
#define IN(k) (lo <= (k) && (k) < hi)
#define LAUNDER() do { asm volatile("" : "+v"(F.tid), "+v"(F.lane)); } while (0)
#define SEAM() do { if (multi) xcd_barrier(bar); } while (0)
    bf16* HX = (bf16*)(ws + WS_HX); bf16* MIX = (bf16*)(ws + WS_MIX); float* XA = (float*)(ws + WS_XA); float* Z = (float*)(ws + WS_Z); bf16* ACT = (bf16*)(ws + WS_ACT);
    LAS unsigned char* ring = F.lds + RING_OFF;

    if (SITE(0) && IN(0)) { _Pragma("unroll 1") for (int rep_ = 0; rep_ < REPS(0); ++rep_) { LAUNDER(); ph_prologue(F, args); } SEAM(); }
    if (SITE(1) && IN(1)) { _Pragma("unroll 1") for (int rep_ = 0; rep_ < REPS(1); ++rep_) { LAUNDER(); ph_modreduce(F, args); } SEAM(); }
    if (SITE(2) && IN(2)) { _Pragma("unroll 1") for (int rep_ = 0; rep_ < REPS(2); ++rep_) { LAUNDER(); ph_mod0(F, args); } SEAM(); }
#pragma unroll 1
    for (int l = 0; l < DEPTH; ++l) {
        const int base = 3 + 10 * l, j = l >> 1; const bool last = (l == DEPTH - 1); const int Mo = last ? MX : M;
        const float* MODL = (const float*)(ws + WS_MOD) + (size_t)l * 3 * 12288;
        if ((l & 1) == 0) {
            if (SITE(3) && IN(base + 0)) { _Pragma("unroll 1") for (int rep_ = 0; rep_ < REPS(3); ++rep_) {
                pg8::Gemm g{HX, (const bf16*)(ws + WS_WINE + j * SZ_WINE), M, NE_INP, D, D, D}; pg8::StaticOrder S; S.init(M, NE_INP, F.G, (int)blockIdx.x);
                EpiEven1 E{(bf16*)(ws + WS_QA), (bf16*)(ws + WS_VA), (bf16*)(ws + WS_GA), (bf16*)(ws + WS_ZB), (bf16*)(ws + WS_QKVB), (float*)(ws + WS_LF), (float*)(ws + WS_GB),
                           (const float*)(ws + WS_LB) + j * AW, args.in[12] + j * 16, args.in[13] + j * 16};
                pg8::gemm_phase<EpiEven1, pg8::StaticOrder, true, true>(ring, g, S, E); } SEAM(); }
            if (SITE(4) && IN(base + 1)) { _Pragma("unroll 1") for (int rep_ = 0; rep_ < REPS(4); ++rep_) { LAUNDER(); ph_conv<0>(F, args, j); } SEAM(); }
            if (SITE(5) && IN(base + 2)) { _Pragma("unroll 1") for (int rep_ = 0; rep_ < REPS(5); ++rep_) { LAUNDER(); ph_even_s1(F, args); } SEAM(); }
            if (SITE(17) && IN(base + 3)) { _Pragma("unroll 1") for (int rep_ = 0; rep_ < REPS(17); ++rep_) { LAUNDER(); ph_even_s2(F, args); } SEAM(); }
            if (SITE(6) && IN(base + 4)) { _Pragma("unroll 1") for (int rep_ = 0; rep_ < REPS(6); ++rep_) { LAUNDER(); ph_merge(F, args, j); } SEAM(); }
        } else {
            if (SITE(7) && IN(base + 0)) { _Pragma("unroll 1") for (int rep_ = 0; rep_ < REPS(7); ++rep_) {
                pg8::Gemm g{HX, (const bf16*)(ws + WS_WINO + j * SZ_WINO), M, 2 * D, D, D, D}; pg8::StaticOrder S; S.init(M, 2 * D, F.G, (int)blockIdx.x);
                EpiOdd1 E{(bf16*)(ws + WS_GY), (bf16*)(ws + WS_XBR)};
                pg8::gemm_phase<EpiOdd1, pg8::StaticOrder, true, true>(ring, g, S, E); } SEAM(); }
            if (SITE(8) && IN(base + 1)) { _Pragma("unroll 1") for (int rep_ = 0; rep_ < REPS(8); ++rep_) { LAUNDER(); ph_conv<1>(F, args, j); } SEAM(); }
            if (SITE(9) && IN(base + 2)) { _Pragma("unroll 1") for (int rep_ = 0; rep_ < REPS(9); ++rep_) {
                pg8::Gemm g{(const bf16*)(ws + WS_XC), (const bf16*)(ws + WS_WGATE + j * SZ_WGATE), M, 8192, 256, D, 256}; pg8::GateOrder S; S.init(M, F.G, (int)blockIdx.x);
                EpiGates E{(const bf16*)(ws + WS_XC), (unsigned*)(ws + WS_AB), args.in[22] + (size_t)j * 4 * D, args.in[23] + (size_t)j * 2 * D};
                pg8::gemm_phase<EpiGates, pg8::GateOrder, true, true>(ring, g, S, E); } SEAM(); }
            if (SITE(10) && IN(base + 3)) { _Pragma("unroll 1") for (int rep_ = 0; rep_ < REPS(10); ++rep_) { LAUNDER(); ph_odd_l1(F, args); } SEAM(); }
            if (SITE(11) && IN(base + 4)) { _Pragma("unroll 1") for (int rep_ = 0; rep_ < REPS(11); ++rep_) { LAUNDER(); ph_odd_l3(F, args); } SEAM(); }
        }
        if (SITE(12) && IN(base + 5)) { _Pragma("unroll 1") for (int rep_ = 0; rep_ < REPS(12); ++rep_) {
            pg8::Gemm g{MIX, (const bf16*)((l & 1) ? ws + WS_WOUTO + j * SZ_WSQ : ws + WS_WOUTE + j * SZ_WSQ), Mo, D, D, D, D}; pg8::StaticOrder S; S.init(Mo, D, F.G, (int)blockIdx.x);
            EpiResid E{l == 0 ? args.in[0] : XA, l == 0 ? args.in[2] : XA + (size_t)MX * D, Z, MODL + 2 * D, l & 1};
            pg8::gemm_phase<EpiResid, pg8::StaticOrder, true, true>(ring, g, S, E); } SEAM(); }
        if (SITE(13) && IN(base + 6)) { _Pragma("unroll 1") for (int rep_ = 0; rep_ < REPS(13); ++rep_) { LAUNDER(); ph_ln(F, Z, Mo, args.in[6] + (size_t)(l * 2) * D, args.in[7] + (size_t)(l * 2) * D, nullptr, HX, MODL + 3 * D, MODL + 4 * D, 0); } SEAM(); }
        if (SITE(14) && IN(base + 7)) { _Pragma("unroll 1") for (int rep_ = 0; rep_ < REPS(14); ++rep_) {
            pg8::Gemm g{HX, (const bf16*)(ws + WS_WGU + l * SZ_WGU), Mo, 2 * FF, D, D, D}; pg8::StaticOrder S; S.init(Mo, 2 * FF, F.G, (int)blockIdx.x);
            EpiSwiGLU E{ACT};
            pg8::gemm_phase<EpiSwiGLU, pg8::StaticOrder, true, true>(ring, g, S, E); } SEAM(); }
        if (SITE(15) && IN(base + 8)) { _Pragma("unroll 1") for (int rep_ = 0; rep_ < REPS(15); ++rep_) {
            pg8::Gemm g{ACT, (const bf16*)(ws + WS_WDN + l * SZ_WDN), Mo, D, FF, FF, FF}; pg8::StaticOrder S; S.init(Mo, D, F.G, (int)blockIdx.x);
            EpiResid E{Z, Z + (size_t)MX * D, XA, MODL + 5 * D, 0};
            pg8::gemm_phase<EpiResid, pg8::StaticOrder, true, true>(ring, g, S, E); } SEAM(); }
        if (SITE(16) && IN(base + 9)) {
            const float* g1 = args.in[6] + (size_t)(l * 2 + 1) * D; const float* b1 = args.in[7] + (size_t)(l * 2 + 1) * D;
            LAUNDER(); if (last) ph_ln(F, XA, MX, g1, b1, args.out, nullptr, nullptr, nullptr, 0);
            else { LAUNDER(); ph_ln(F, XA, M, g1, b1, nullptr, HX, MODL + 3 * 12288, MODL + 3 * 12288 + D, (l + 1) & 1); SEAM(); } }
    }
#undef IN
#undef SEAM
}

extern "C" void kernel_launch(void* const* d_in, const int* in_sizes, int n_in, void* d_out, int out_size, void* d_ws, size_t ws_size, hipStream_t stream) {
    static int grid = 0;
    if (grid == 0) {
        if (n_in != 25 || in_sizes[0] != MX * D || out_size != MX * D || ws_size < WS_END) { fprintf(stderr, "kernel_launch: unexpected shapes (n_in %d, in0 %d, out %d, ws %zu < %zu); nothing launched\n", n_in, n_in > 0 ? in_sizes[0] : -1, out_size, ws_size, (size_t)WS_END); grid = -1; return; }
        int dev = 0, cus = 0, per_cu = 0;
        if (hipGetDevice(&dev) != hipSuccess || hipDeviceGetAttribute(&cus, hipDeviceAttributeMultiprocessorCount, dev) != hipSuccess) { grid = -1; return; }
        if (hipFuncSetAttribute((const void*)fwd, hipFuncAttributeMaxDynamicSharedMemorySize, LDS_BYTES) != hipSuccess) { fprintf(stderr, "kernel_launch: hipFuncSetAttribute failed\n"); grid = -1; return; }
        if (hipOccupancyMaxActiveBlocksPerMultiprocessor(&per_cu, (const void*)fwd, NTHREADS, LDS_BYTES) != hipSuccess || per_cu < 1) { fprintf(stderr, "kernel_launch: occupancy query says %d\n", per_cu); }
        (void)hipGetLastError();
        grid = cus;
    }
    if (grid < 0) return;
    if (hipMemsetAsync((char*)d_ws + WS_CTL, 0, CTL_ZERO_BYTES, stream) != hipSuccess) return;
    Args a{};
    for (int i = 0; i < 25; ++i) a.in[i] = (const float*)d_in[i];
    a.out = (float*)d_out; a.ws = (unsigned char*)d_ws;
#if MK_ONE_LAUNCH
    a.ph_lo = 0; a.ph_hi = N_PHASES;
    hipLaunchKernelGGL(fwd, dim3(grid), dim3(NTHREADS), LDS_BYTES, stream, a);
#else
    for (int ph = 0; ph < N_PHASES; ++ph) { if (!phase_used(ph)) continue; a.ph_lo = ph; a.ph_hi = ph + 1;
        hipLaunchKernelGGL(fwd, dim3(grid), dim3(NTHREADS), LDS_BYTES, stream, a); }
#endif
}
```

```cpp
#include <hip/hip_runtime.h>
#include <cstdio>
#include <cstdint>
#ifndef MK_ONE_LAUNCH
#define MK_ONE_LAUNCH 1
#endif
namespace pg8 {
#define PG8_LAS __attribute__((address_space(3)))
typedef unsigned short bf16_t;
typedef short bf16x8 __attribute__((ext_vector_type(8)));
typedef float f32x4 __attribute__((ext_vector_type(4)));
typedef unsigned u32x4 __attribute__((ext_vector_type(4)));
typedef unsigned u32x2 __attribute__((ext_vector_type(2)));
constexpr int BM = 256, BK = 64, HALF = 128, HTB = HALF * BK * 2  , STAGE_BYTES = 8 * HTB, NXCD = 8, WGM = 8;
__host__ __device__ __forceinline__ int lds_byte(int r, int c) { const int st = (r >> 4) * 2 + (c >> 5), rr = r & 15, cc = c & 31, ob = rr * 64 + cc * 2; return st * 1024 + (ob ^ (((ob >> 9) & 1) << 5)); }
__host__ __device__ __forceinline__ void stage_rc(int b, int& R, int& C) { const int st = b / 1024, sb = b % 1024, swz = sb ^ (((sb >> 9) & 1) << 5); R = (st >> 1) * 16 + swz / 64; C = (st & 1) * 32 + (swz % 64) / 2; }
__host__ __device__ __forceinline__ int perm32(int rho) { const int n = rho >> 4, i = rho & 15; return 8 * (i >> 2) + 4 * n + (i & 3); }

struct Unit { int pm, pn, ka; };
struct Gemm { const bf16_t* A; const bf16_t* Bt; int M, N, K, lda, ldb; };

struct StaticOrder {
    int nM, nN, nwg, G, c;
    __host__ __device__ void init(int M, int N, int G_, int c_) { nM = M / BM; nN = N / BM; nwg = nM * nN; G = G_; c = c_; }
    __host__ __device__ bool next(int i, Unit& u) const {
        const long L = (long)i * G + c; if (L >= nwg) return false;
        int wgid = (int)L; { const int q = nwg / NXCD, r = nwg % NXCD, xcd = wgid % NXCD, off = wgid / NXCD; wgid = (xcd < r ? xcd * (q + 1) : r * (q + 1) + (xcd - r) * q) + off; }
        const int nig = WGM * nN, gid = wgid / nig, fm = gid * WGM, gsz = (nM - fm) < WGM ? (nM - fm) : WGM;
        u.pm = fm + ((wgid % nig) % gsz); u.pn = (wgid % nig) / gsz; u.ka = 0; return true;
    }
    __device__ __forceinline__ void a_ready(const Unit&) const {}
    __device__ __forceinline__ void done(const Unit&) const {}
};
struct GateOrder {
    int nM, nwg, G, c;
    __host__ __device__ void init(int M, int G_, int c_) { nM = M / BM; nwg = nM * 32; G = G_; c = c_; }
    __host__ __device__ bool next(int i, Unit& u) const {
        const long L = (long)i * G + c; if (L >= nwg) return false;
        const int l = (int)L, pn4 = l & 3, pm = (l >> 2) % nM, nb = (l >> 2) / nM;
        u.pm = pm; u.pn = nb * 4 + pn4; u.ka = nb * 256; return true;
    }
    __device__ __forceinline__ void a_ready(const Unit&) const {}
    __device__ __forceinline__ void done(const Unit&) const {}
};
typedef float f32x2c __attribute__((ext_vector_type(2))); typedef __bf16 bf16x2c __attribute__((ext_vector_type(2)));
__device__ __forceinline__ unsigned cvt_pk_bf16(float lo, float hi) { const f32x2c v = {lo, hi}; return __builtin_bit_cast(unsigned, __builtin_convertvector(v, bf16x2c)); }
template <class Epi, class Sched, bool ALIGN_EPI = false, bool SP2 = false>
__device__ __forceinline__ void gemm_phase(PG8_LAS unsigned char* lds, const Gemm g, const Sched& S, const Epi& E) {
    int tid = threadIdx.x; asm volatile("" : "+v"(tid)); const int wid = __builtin_amdgcn_readfirstlane(tid >> 6), lane = tid & 63, wr = wid >> 2, wc = wid & 3, fr = lane & 15, fq = lane >> 4;
    int nt = g.K / BK; asm volatile("" : "+s"(nt));
    unsigned voffA[2], voffB[2];
#pragma unroll
    for (int i = 0; i < 2; ++i) { int R, C; stage_rc(tid * 16 + i * 8192, R, C); const int Rb = Epi::PERM ? ((R & ~31) + perm32(R & 31)) : R;
        voffA[i] = (unsigned)(R * g.lda + C) * 2u; voffB[i] = (unsigned)(Rb * g.ldb + C) * 2u; }
    const size_t kstep = (size_t)(BK * 2);
    const size_t hstepA = (size_t)HALF * g.lda * 2, hstepB = (size_t)HALF * g.ldb * 2;
    const size_t tstepA = 2 * hstepA, tstepB = 2 * hstepB;
    const unsigned ldsw = (unsigned)wid * 1024u;
    const int aoff = lds_byte(wr * 64 + fr, fq * 8), boff = lds_byte(wc * 32 + fr, fq * 8);
#define PG8_SA(b, h) (((b) * 2 + (h)) * HTB)
#define PG8_SB(b, h) ((4 + (b) * 2 + (h)) * HTB)
#define PG8_STAGE(bufoff, gbase, voff) do { _Pragma("unroll") for (int _i = 0; _i < 2; ++_i) \
        __builtin_amdgcn_global_load_lds((const unsigned*)((const char*)(gbase) + (voff)[_i]), (PG8_LAS unsigned*)(lds + (bufoff) + ldsw + _i * 8192), 16, 0, 0); } while (0)
#define PG8_LDA(dst, b, h) do { _Pragma("unroll") for (int m = 0; m < 4; ++m) _Pragma("unroll") for (int k = 0; k < 2; ++k) dst[m][k] = *(const PG8_LAS bf16x8*)(lds + PG8_SA(b, h) + aoff + m * 2048 + k * 1024); } while (0)
#define PG8_LDB(dst, b, h) do { _Pragma("unroll") for (int n = 0; n < 2; ++n) _Pragma("unroll") for (int k = 0; k < 2; ++k) dst[n][k] = *(const PG8_LAS bf16x8*)(lds + PG8_SB(b, h) + boff + n * 2048 + k * 1024); } while (0)
#define PG8_MMA(ai, bj, At, Bt) do { __builtin_amdgcn_s_setprio(1); _Pragma("unroll") for (int m = 0; m < 4; ++m) _Pragma("unroll") for (int n = 0; n < 2; ++n) _Pragma("unroll") for (int k = 0; k < 2; ++k) \
        acc[ai][bj][m][n] = __builtin_amdgcn_mfma_f32_16x16x32_bf16(Bt[n][k], At[m][k], acc[ai][bj][m][n], 0, 0, 0); __builtin_amdgcn_s_setprio(0); } while (0)
#define PG8_WAIT_V(n) asm volatile("s_waitcnt vmcnt(" #n ")" ::: "memory")
#define PG8_WAIT_L(n) asm volatile("s_waitcnt lgkmcnt(" #n ")" ::: "memory")
#define PG8_BAR __builtin_amdgcn_s_barrier()
#define PG8_SCHED __builtin_amdgcn_sched_barrier(0)
    Unit cur, nxt; int ui = 0;
    if (!S.next(0, cur)) return;
    f32x4 acc[2][2][4][2];
#pragma unroll
    for (int a = 0; a < 2; ++a)
#pragma unroll
        for (int b = 0; b < 2; ++b)
#pragma unroll
            for (int m = 0; m < 4; ++m)
#pragma unroll
                for (int n = 0; n < 2; ++n) acc[a][b][m][n] = (f32x4){0.f, 0.f, 0.f, 0.f};
    bf16x8 At[4][2], B0[2][2], B1[2][2];
    const char* cA = (const char*)g.A + (size_t)cur.pm * tstepA + (size_t)cur.ka * 2; const char* cB = (const char*)g.Bt + (size_t)cur.pn * tstepB;
    S.a_ready(cur);
    if constexpr (SP2) {
        PG8_STAGE(PG8_SB(0, 0), cB, voffB); PG8_STAGE(PG8_SB(0, 1), cB + hstepB, voffB); PG8_STAGE(PG8_SA(0, 0), cA, voffA); PG8_STAGE(PG8_SA(0, 1), cA + hstepA, voffA);
        if (wr == 1) PG8_BAR;
        PG8_WAIT_V(2); PG8_BAR;
        PG8_STAGE(PG8_SB(1, 0), cB + kstep, voffB); PG8_STAGE(PG8_SA(1, 0), cA + kstep, voffA); PG8_STAGE(PG8_SB(1, 1), cB + hstepB + kstep, voffB);
        PG8_WAIT_V(6); PG8_BAR;
    } else {
        PG8_STAGE(PG8_SB(0, 0), cB, voffB); PG8_STAGE(PG8_SA(0, 0), cA, voffA); PG8_STAGE(PG8_SB(0, 1), cB + hstepB, voffB); PG8_STAGE(PG8_SA(0, 1), cA + hstepA, voffA);
        if (wr == 1) PG8_BAR;
        PG8_WAIT_V(4); PG8_BAR;
        PG8_STAGE(PG8_SB(1, 0), cB + kstep, voffB); PG8_STAGE(PG8_SA(1, 0), cA + kstep, voffA); PG8_STAGE(PG8_SB(1, 1), cB + hstepB + kstep, voffB);
        PG8_WAIT_V(6); PG8_BAR;
    }
    for (;;) {
        const bool has_next = S.next(ui + 1, nxt);
        const char* nA = has_next ? (const char*)g.A + (size_t)nxt.pm * tstepA + (size_t)nxt.ka * 2 : cA; const char* nB = has_next ? (const char*)g.Bt + (size_t)nxt.pn * tstepB : cB;
        for (int t = 0; t < nt; t += 2) {
            const bool last = (t == nt - 2);
            const char* a1 = cA + (size_t)(t + 1) * kstep;
            const char* a2 = last ? nA : cA + (size_t)(t + 2) * kstep; const char* b2 = last ? nB : cB + (size_t)(t + 2) * kstep;
            const char* a3 = a2 + kstep; const char* b3 = b2 + kstep;
            if (last && has_next) S.a_ready(nxt);
            if constexpr (SP2) {
            PG8_LDB(B0, 0, 0); PG8_LDB(B1, 0, 1); PG8_SCHED; PG8_LDA(At, 0, 0); PG8_STAGE(PG8_SA(1, 1), a1 + hstepA, voffA);
            PG8_WAIT_V(8); PG8_WAIT_L(0); PG8_BAR; PG8_MMA(0, 0, At, B0); PG8_MMA(0, 1, At, B1); PG8_BAR; PG8_SCHED;
            PG8_LDA(At, 0, 1); PG8_STAGE(PG8_SB(0, 0), b2, voffB); PG8_STAGE(PG8_SB(0, 1), b2 + hstepB, voffB); PG8_STAGE(PG8_SA(0, 0), a2, voffA);
            PG8_WAIT_V(8); PG8_WAIT_L(0); PG8_BAR; PG8_MMA(1, 0, At, B0); PG8_MMA(1, 1, At, B1); PG8_BAR; PG8_SCHED;
            PG8_LDB(B0, 1, 0); PG8_LDB(B1, 1, 1); PG8_SCHED; PG8_LDA(At, 1, 0); PG8_STAGE(PG8_SA(0, 1), a2 + hstepA, voffA);
            PG8_WAIT_V(8); PG8_WAIT_L(0); PG8_BAR; PG8_MMA(0, 0, At, B0); PG8_MMA(0, 1, At, B1); PG8_BAR; PG8_SCHED;
            PG8_LDA(At, 1, 1); PG8_STAGE(PG8_SB(1, 0), b3, voffB); PG8_STAGE(PG8_SB(1, 1), b3 + hstepB, voffB); PG8_STAGE(PG8_SA(1, 0), a3, voffA);
            PG8_WAIT_V(8); PG8_WAIT_L(0); PG8_BAR; PG8_MMA(1, 0, At, B0); PG8_MMA(1, 1, At, B1); PG8_BAR; PG8_SCHED;
            } else {
            PG8_LDB(B0, 0, 0); PG8_SCHED; PG8_LDA(At, 0, 0); PG8_STAGE(PG8_SA(1, 1), a1 + hstepA, voffA);
            PG8_WAIT_L(8); PG8_BAR; PG8_WAIT_L(0); PG8_MMA(0, 0, At, B0); PG8_BAR; PG8_SCHED;
            PG8_LDB(B1, 0, 1); PG8_STAGE(PG8_SB(0, 0), b2, voffB);
            PG8_BAR; PG8_WAIT_L(0); PG8_MMA(0, 1, At, B1); PG8_BAR;
            PG8_LDA(At, 0, 1); PG8_STAGE(PG8_SA(0, 0), a2, voffA);
            PG8_BAR; PG8_WAIT_L(0); PG8_MMA(1, 0, At, B0); PG8_BAR; PG8_SCHED;
            PG8_STAGE(PG8_SB(0, 1), b2 + hstepB, voffB);
            PG8_WAIT_V(6); PG8_BAR; PG8_MMA(1, 1, At, B1); PG8_BAR;
            PG8_LDB(B0, 1, 0); PG8_SCHED; PG8_LDA(At, 1, 0); PG8_STAGE(PG8_SA(0, 1), a2 + hstepA, voffA);
            PG8_WAIT_L(8); PG8_BAR; PG8_WAIT_L(0); PG8_MMA(0, 0, At, B0); PG8_BAR; PG8_SCHED;
            PG8_LDB(B1, 1, 1); PG8_STAGE(PG8_SB(1, 0), b3, voffB);
            PG8_BAR; PG8_WAIT_L(0); PG8_MMA(0, 1, At, B1); PG8_BAR;
            PG8_LDA(At, 1, 1); PG8_STAGE(PG8_SA(1, 0), a3, voffA);
            PG8_BAR; PG8_WAIT_L(0); PG8_MMA(1, 0, At, B0); PG8_BAR; PG8_SCHED;
            PG8_STAGE(PG8_SB(1, 1), b3 + hstepB, voffB);
            PG8_WAIT_V(6); PG8_BAR; PG8_MMA(1, 1, At, B1); PG8_BAR;
            }
        }
        if constexpr (ALIGN_EPI) { if (wr == 0) PG8_BAR; }
        if constexpr (!Epi::AFTER_DRAIN) { E(acc, cur, wr, wc, fr, fq); S.done(cur); }
        if (!has_next) break;
#pragma unroll
        for (int a = 0; a < 2; ++a)
#pragma unroll
            for (int b = 0; b < 2; ++b)
#pragma unroll
                for (int m = 0; m < 4; ++m)
#pragma unroll
                    for (int n = 0; n < 2; ++n) acc[a][b][m][n] = (f32x4){0.f, 0.f, 0.f, 0.f};
        cur = nxt; cA = nA; cB = nB; ++ui;
        if constexpr (ALIGN_EPI) { if (wr == 1) PG8_BAR; }
    }
    PG8_WAIT_V(0);
    if constexpr (!ALIGN_EPI) { if (wr == 0) PG8_BAR; }
    PG8_BAR;
    if constexpr (Epi::AFTER_DRAIN) { E.fused(acc, cur, wr, wc, fr, fq, lds, wid, lane); S.done(cur); }
#undef PG8_SA
#undef PG8_SB
#undef PG8_STAGE
#undef PG8_LDA
#undef PG8_LDB
#undef PG8_MMA
#undef PG8_WAIT_V
#undef PG8_WAIT_L
#undef PG8_BAR
#undef PG8_SCHED
}
}
using pg8::bf16_t; using pg8::f32x4; using pg8::u32x4; using pg8::u32x2; using pg8::Unit; using pg8::cvt_pk_bf16;

constexpr int D = 2048, NBATCH = 2, SEQ = 8192, CTXL = 256, DEPTH = 4;
constexpr int MX = NBATCH * SEQ;
constexpr int MC = NBATCH * CTXL;
constexpr int M = MX + MC;
constexpr int NE_IN = 9248, NE_INP = 9472, FF = 5632, AW = 1024;
constexpr int NWAVES = 8, NTHREADS = 512;
constexpr float LN_EPS = 1e-6f, DN_ALPHA = 1.681792830507429f;
constexpr float QSCALE = 0.08838834764831845f;

constexpr size_t MiB = 1u << 20;
constexpr size_t al256(size_t x) { return (x + 255) & ~(size_t)255; }
constexpr size_t WS_CTL = 0, CTL_ZERO_BYTES = 1 * MiB;
constexpr size_t WS_MOD = 1 * MiB;
constexpr size_t WS_LB = 2 * MiB;
constexpr size_t WS_PART = 3 * MiB;
constexpr size_t WS_W0 = 8 * MiB;
constexpr size_t SZ_WINE = (size_t)NE_INP * D * 2, SZ_WSQ = (size_t)D * D * 2, SZ_WINO = (size_t)2 * D * D * 2, SZ_WGATE = (size_t)8192 * 256 * 2, SZ_WGU = (size_t)2 * FF * D * 2, SZ_WDN = (size_t)D * FF * 2;
constexpr size_t WS_WINE = WS_W0;
constexpr size_t WS_WOUTE = WS_WINE + 2 * SZ_WINE;
constexpr size_t WS_WINO = WS_WOUTE + 2 * SZ_WSQ;
constexpr size_t WS_WGATE = WS_WINO + 2 * SZ_WINO;
constexpr size_t WS_WOUTO = WS_WGATE + 2 * SZ_WGATE;
constexpr size_t WS_WGU = WS_WOUTO + 2 * SZ_WSQ;
constexpr size_t WS_WDN = WS_WGU + 4 * SZ_WGU;
constexpr size_t WS_XA = al256(WS_WDN + 4 * SZ_WDN);
constexpr size_t SZ_F32ROW = (size_t)M * D * 4, SZ_BF16ROW = (size_t)M * D * 2, SZ_BF16HALF = (size_t)M * AW * 2;
constexpr size_t WS_Z = WS_XA + SZ_F32ROW;
constexpr size_t WS_HX = WS_Z + SZ_F32ROW;
constexpr size_t WS_MIX = WS_HX + SZ_BF16ROW;
constexpr size_t WS_MR = WS_MIX + SZ_BF16ROW;
constexpr size_t SZ_HRECS = (size_t)16896 * 9216, SZ_GRECS = (size_t)16896 * 17152;
constexpr size_t WS_HREC = WS_HX, WS_GREC = WS_HREC + SZ_HRECS;
constexpr size_t WS_QKVB = WS_MIX;
constexpr size_t WS_QA = al256(WS_GREC + SZ_GRECS), WS_VA = WS_QA + SZ_BF16HALF, WS_GA = WS_VA + SZ_BF16HALF, WS_ZB = WS_GA + SZ_BF16HALF;
constexpr size_t WS_LF = WS_ZB + SZ_BF16HALF;
constexpr size_t WS_GB = WS_LF + 2 * (size_t)M * AW * 4;
constexpr size_t WS_QB = WS_GB + (size_t)M * 32 * 4, WS_KB = WS_QB + SZ_BF16HALF, WS_VB = WS_KB + SZ_BF16HALF;
#ifdef EXP_B
constexpr size_t WS_OA = WS_HREC;
#else
constexpr size_t WS_OA = WS_LF;
#endif
constexpr size_t WS_OB = WS_OA + 2 * SZ_BF16HALF;
constexpr size_t WS_EVEN_END = WS_VB + SZ_BF16HALF;
#ifndef EXP_B
static_assert(WS_QKVB + (size_t)M * 3072 * 2 <= WS_QA && WS_OB + 2 * SZ_BF16HALF <= WS_GB, "even-layer overlays");
#endif
constexpr size_t WS_GY = WS_MR, WS_XBR = WS_GY + SZ_BF16ROW, WS_XC = WS_XBR + SZ_BF16ROW;
constexpr size_t WS_AB = WS_XC + SZ_BF16ROW;
constexpr size_t WS_R = WS_AB + 2 * (size_t)M * D * 4;
constexpr size_t WS_ODD_END = WS_R + 2 * SZ_BF16ROW;
constexpr size_t WS_ACT = WS_MR;
constexpr size_t WS_END = (WS_EVEN_END > WS_ODD_END ? WS_EVEN_END : WS_ODD_END);
static_assert(WS_ACT + (size_t)M * FF * 2 <= WS_END, "ACT fits the mixer region");
static_assert(WS_END <= (size_t)1536 * MiB, "workspace budget: d_ws is at least 4 x the largest input = 1536 MiB");
constexpr int CW_BAR = 4096;

constexpr int RING_OFF = 0, RING_BYTES = 131072;
constexpr int LDSCTL_OFF = RING_BYTES, MISC_OFF = LDSCTL_OFF + 320;
constexpr int LDS_BYTES = 147456;

#define GAS __attribute__((address_space(1)))
#define LAS __attribute__((address_space(3)))
typedef unsigned short bf16;
#define LDS_WAIT() asm volatile("s_waitcnt lgkmcnt(0)" ::: "memory")
#define VM_WAIT() asm volatile("s_waitcnt vmcnt(0)" ::: "memory")
__device__ __forceinline__ unsigned f2bf(float f) { unsigned u = __builtin_bit_cast(unsigned, f); return (u + 0x7fffu + ((u >> 16) & 1u)) >> 16; }
__device__ __forceinline__ unsigned pk2(float lo, float hi) { return f2bf(lo) | (f2bf(hi) << 16); }
__device__ __forceinline__ float bflo(unsigned u) { return __builtin_bit_cast(float, u << 16); }
__device__ __forceinline__ float bfhi(unsigned u) { return __builtin_bit_cast(float, u & 0xffff0000u); }
__device__ __forceinline__ float bf2f(bf16 h) { return __builtin_bit_cast(float, (unsigned)h << 16); }
__device__ __forceinline__ float sigm(float x) { return 1.f / (1.f + __expf(-x)); }
__device__ __forceinline__ float siluf(float x) { return x / (1.f + __expf(-x)); }
__device__ __forceinline__ float log1p_fast(float t) { const float p = t * (1.f + t * (-0.5f + t * (0.33333333f + t * (-0.25f + t * 0.2f)))); return t < 0.03f ? p : __logf(1.f + t); }
__device__ __forceinline__ float softplusf(float x) { return fmaxf(x, 0.f) + log1p_fast(__expf(-fabsf(x))); }
__device__ __forceinline__ float neg_expm1_fast(float x) { const float p = -x * (1.f + x * (0.5f + x * (0.16666667f + x * (0.041666668f + x * 0.0083333338f)))); return x > -0.25f ? p : 1.f - __expf(x); }
__device__ __forceinline__ float gelu_tanh(float x) { const float u = 0.7978845608028654f * (x + 0.044715f * x * x * x); return x / (1.f + __expf(-2.f * u)); }
__device__ __forceinline__ float wave_sum(float v) {
#pragma unroll
    for (int o = 1; o < 64; o <<= 1) v += __shfl_xor(v, o);
    return v;
}
__device__ __forceinline__ int mod_index(int row) { return row < SEQ ? 0 : (row < MX ? 1 : 2); }
__device__ __forceinline__ int perm_row(int r) { if (r >= MX) return r; const int b = r >> 13, t = r & 8191; return (b << 13) + ((t & 63) << 7) + (t >> 6); }
__device__ __forceinline__ int unperm_row(int r) { if (r >= MX) return r; const int b = r >> 13, i = r & 8191; return (b << 13) + ((i & 127) << 6) + (i >> 7); }
__device__ __forceinline__ int seq_row(int b, int dir, int s) {
    if (s < CTXL) { const int pos = dir ? (CTXL - 1 - s) : s; return MX + b * CTXL + pos; }
    const int p = s - CTXL, pos = dir ? (SEQ - 1 - p) : p; return b * SEQ + pos;
}
#define XB_TMO      128
#define XB_XCNT(j)  (256  + 64 * (j))
#define XB_XSUB(j)  (1280 + 64 * (j))
#define XB_XGEN(j)  (2304 + 64 * (j))
#define XB_TOP      3328
#define XB_TOPGEN   3392
#define XCD_BAR_WORDS 3456
#define XB_SPIN_CAP (1u << 18)

__device__ __forceinline__ unsigned xb_ld(unsigned* p)              { return __hip_atomic_load(p, __ATOMIC_RELAXED, __HIP_MEMORY_SCOPE_AGENT); }
__device__ __forceinline__ unsigned xb_add(unsigned* p, unsigned v) { return __hip_atomic_fetch_add(p, v, __ATOMIC_RELAXED, __HIP_MEMORY_SCOPE_AGENT); }
__device__ __forceinline__ unsigned xb_xcc_id() { return (unsigned)__builtin_amdgcn_s_getreg((3 << 11) | 20) & 0xFu; }
#define XB_SPIN(cond, bar) do { unsigned _sp = 0; while (cond) { __builtin_amdgcn_s_sleep(1); \
    if ((++_sp & 255u) == 0u) { if (xb_ld(&(bar)[XB_TMO])) break; if (_sp > XB_SPIN_CAP) { atomicAdd(&(bar)[XB_TMO], 1u); break; } } } } while (0)

struct XcdBarrier {
    unsigned* bar; unsigned x;
    volatile LAS unsigned* st;
};

__device__ __forceinline__ XcdBarrier xcd_barrier_post(unsigned* bar, volatile LAS unsigned* st) {
    XcdBarrier b; b.bar = bar; b.x = xb_xcc_id(); b.st = st;
    if (threadIdx.x == 0) (void)xb_add(&bar[XB_XCNT(b.x)], 1u);
    return b;
}
__device__ __forceinline__ void xcd_barrier_complete(unsigned* bar, unsigned x, unsigned& nloc, unsigned& nx) {
    const unsigned G = gridDim.x * gridDim.y * gridDim.z;
    unsigned sum, cnt, mine, sp = 0u;
    for (;;) {
        sum = 0u; cnt = 0u; mine = 0u;
#pragma unroll
        for (unsigned j = 0; j < 16; ++j) { const unsigned c = xb_ld(&bar[XB_XCNT(j)]); sum += c; cnt += (c > 0u) ? 1u : 0u; mine = (j == x) ? c : mine; }
        if (sum == G) break;
        __builtin_amdgcn_s_sleep(1);
        if ((++sp & 255u) == 0u) { if (xb_ld(&bar[XB_TMO])) break; if (sp > XB_SPIN_CAP) { atomicAdd(&bar[XB_TMO], 1u); break; } }
    }
    nloc = mine > 0u ? mine : 1u; nx = cnt > 0u ? cnt : 1u;
}

__device__ __forceinline__ void xcd_barrier(const XcdBarrier& b) {
    asm volatile("s_waitcnt vmcnt(0)" ::: "memory");
    __syncthreads();
    if (threadIdx.x == 0) {
        unsigned* bar = b.bar;
        __builtin_amdgcn_s_waitcnt(0);
        unsigned nloc = b.st[0], nx = b.st[1];
        if (nloc == 0u) { xcd_barrier_complete(bar, b.x, nloc, nx); b.st[0] = nloc; b.st[1] = nx; }
        const unsigned old = xb_add(&bar[XB_XSUB(b.x)], 1u);
        const unsigned gen = old / nloc;
        if (old + 1u == (gen + 1u) * nloc) {
            __builtin_amdgcn_fence(__ATOMIC_RELEASE, "agent");
            asm volatile("s_waitcnt vmcnt(0)" ::: "memory");
            const unsigned og = xb_add(&bar[XB_TOP], 1u);
            const unsigned tg = og / nx;
            if (og + 1u == (tg + 1u) * nx) xb_add(&bar[XB_TOPGEN], 1u);
            else XB_SPIN(xb_ld(&bar[XB_TOPGEN]) == tg, bar);
            __builtin_amdgcn_fence(__ATOMIC_ACQUIRE, "agent");
            xb_add(&bar[XB_XGEN(b.x)], 1u);
            asm volatile("s_waitcnt vmcnt(0)" ::: "memory");
        } else {
            XB_SPIN(xb_ld(&bar[XB_XGEN(b.x)]) == gen, bar);
            __builtin_amdgcn_fence(__ATOMIC_ACQUIRE, "agent");
            asm volatile("s_waitcnt vmcnt(0)" ::: "memory");
        }
    }
    __syncthreads();
}

struct EpiEven1 {
    static constexpr bool PERM = true, AFTER_DRAIN = false;
    bf16_t *QA, *VA, *GA, *ZB, *QKVB; float *LF, *GB; const float *lb, *a_log, *dt_bias;
    __device__ __forceinline__ void operator()(const f32x4 (&acc)[2][2][4][2], const Unit& u, int wr, int wc, int fr_, int fq_) const {
        int fr = fr_, fq = fq_; asm volatile("" : "+v"(fr), "+v"(fq));
        const int grp = u.pn >> 2, row0 = u.pm * 256 + wr * 64 + fr;
        if (grp == 9) {
            if (wc != 0) return;
            float al[8], db[8];
#pragma unroll
            for (int i = 0; i < 8; ++i) { const int c = (8 * fq + i) & 15; al[i] = -__expf(a_log[c]); db[i] = dt_bias[c]; }
#pragma unroll
            for (int ai = 0; ai < 2; ++ai)
#pragma unroll
                for (int m = 0; m < 4; ++m) { float* rowp = GB + (size_t)(row0 + ai * 128 + m * 16) * 32 + 8 * fq;
#pragma unroll
                    for (int n = 0; n < 2; ++n) { const f32x4 v = acc[ai][0][m][n]; f32x4 o;
#pragma unroll
                        for (int j = 0; j < 4; ++j) o[j] = (fq < 2) ? al[4 * n + j] * softplusf(v[j] + db[4 * n + j]) : sigm(v[j]);
                        *(f32x4*)(rowp + 4 * n) = o; } }
            return;
        }
        const int col0 = (u.pn & 3) * 256 + wc * 32 + 8 * fq;
        int op = 0, ld = 1024; bf16_t* dstb = VA; float* dstf = LF;
        switch (grp) {
            case 0: op = 2; dstb = QA; break;
            case 1: op = 0; dstb = VA; break;
            case 2: op = 3; dstf = LF; break;
            case 3: op = 3; dstf = LF + (size_t)M * 1024; break;
            case 4: op = 1; dstb = GA; break;
            case 5: case 6: case 7: op = 0; dstb = QKVB + (grp - 5) * 1024; ld = 3072; break;
            default: op = 1; dstb = ZB; break;
        }
        if (op == 3) {
#pragma unroll
            for (int bj = 0; bj < 2; ++bj) { float lbv[8];
#pragma unroll
                for (int i = 0; i < 8; ++i) lbv[i] = lb[col0 + bj * 128 + i];
#pragma unroll
                for (int ai = 0; ai < 2; ++ai)
#pragma unroll
                    for (int m = 0; m < 4; ++m) { float* rowp = dstf + (size_t)(row0 + ai * 128 + m * 16) * 1024 + col0 + bj * 128;
#pragma unroll
                        for (int n = 0; n < 2; ++n) { const f32x4 v = acc[ai][bj][m][n]; f32x4 o;
#pragma unroll
                            for (int j = 0; j < 4; ++j) { const float l = lbv[4 * n + j]; o[j] = __logf(l + (1.f - l) * sigm(v[j])); }
                            *(f32x4*)(rowp + 4 * n) = o; } } }
            return;
        }
#pragma unroll
        for (int ai = 0; ai < 2; ++ai)
#pragma unroll
            for (int m = 0; m < 4; ++m) { bf16_t* rowp = dstb + (size_t)(row0 + ai * 128 + m * 16) * ld + col0;
#pragma unroll
                for (int bj = 0; bj < 2; ++bj) { f32x4 v0 = acc[ai][bj][m][0], v1 = acc[ai][bj][m][1];
                    if (op >= 1) {
#pragma unroll
                        for (int j = 0; j < 4; ++j) { v0[j] = siluf(v0[j]); v1[j] = siluf(v1[j]); }
                        if (op == 2) { v0 = v0 * QSCALE; v1 = v1 * QSCALE; } }
                    u32x4 w; w.x = cvt_pk_bf16(v0[0], v0[1]); w.y = cvt_pk_bf16(v0[2], v0[3]); w.z = cvt_pk_bf16(v1[0], v1[1]); w.w = cvt_pk_bf16(v1[2], v1[3]);
                    *(u32x4*)(rowp + bj * 128) = w; } }
    }
};
struct EpiOdd1 {
    static constexpr bool PERM = true, AFTER_DRAIN = false;
    bf16_t *GY, *XBR;
    __device__ __forceinline__ void operator()(const f32x4 (&acc)[2][2][4][2], const Unit& u, int wr, int wc, int fr_, int fq_) const {
        int fr = fr_, fq = fq_; asm volatile("" : "+v"(fr), "+v"(fq));
        const int row0 = u.pm * 256 + wr * 64 + fr; const bool isy = u.pn < 8;
        bf16_t* dst = isy ? GY : XBR; const int col0 = (u.pn & 7) * 256 + wc * 32 + 8 * fq;
#pragma unroll
        for (int ai = 0; ai < 2; ++ai)
#pragma unroll
            for (int m = 0; m < 4; ++m) { bf16_t* rowp = dst + (size_t)(row0 + ai * 128 + m * 16) * D + col0;
#pragma unroll
                for (int bj = 0; bj < 2; ++bj) { f32x4 v0 = acc[ai][bj][m][0], v1 = acc[ai][bj][m][1];
                    if (isy) {
#pragma unroll
                        for (int j = 0; j < 4; ++j) { v0[j] = gelu_tanh(v0[j]); v1[j] = gelu_tanh(v1[j]); } }
                    u32x4 w; w.x = cvt_pk_bf16(v0[0], v0[1]); w.y = cvt_pk_bf16(v0[2], v0[3]); w.z = cvt_pk_bf16(v1[0], v1[1]); w.w = cvt_pk_bf16(v1[2], v1[3]);
                    *(u32x4*)(rowp + bj * 128) = w; } }
    }
};
struct EpiGates {
    static constexpr bool PERM = true, AFTER_DRAIN = false;
    const bf16_t* XC; unsigned* AB; const float *gate_b  , *lam  ;
    __device__ __forceinline__ void operator()(const f32x4 (&acc)[2][2][4][2], const Unit& u, int wr, int wc, int fr_, int fq_) const {
        int fr = fr_, fq = fq_; asm volatile("" : "+v"(fr), "+v"(fq));
        const int nb = u.pn >> 2, pn4 = u.pn & 3, d = pn4 >> 1, half = pn4 & 1;
        const int row0 = u.pm * 256 + wr * 64 + fr, ch0 = nb * 256 + half * 128 + wc * 32 + 8 * fq;
        unsigned* ab = AB + (size_t)d * M * D;
#pragma unroll
        for (int n = 0; n < 2; ++n) {
            const int ch = ch0 + 4 * n;
            const f32x4 gr = *(const f32x4*)(gate_b + (d * 2 + 0) * D + ch), gi = *(const f32x4*)(gate_b + (d * 2 + 1) * D + ch), lm = *(const f32x4*)(lam + d * D + ch);
            f32x4 sp;
#pragma unroll
            for (int j = 0; j < 4; ++j) sp[j] = -8.0f * softplusf(-lm[j]);
#pragma unroll
            for (int ai = 0; ai < 2; ++ai)
#pragma unroll
                for (int m = 0; m < 4; ++m) { const size_t ro = (size_t)(row0 + ai * 128 + m * 16) * D + ch;
                    const u32x2 xr = *(const u32x2*)(XC + ro); const float xc[4] = {bflo(xr.x), bfhi(xr.x), bflo(xr.y), bfhi(xr.y)};
                    u32x4 o;
#pragma unroll
                    for (int j = 0; j < 4; ++j) { const float r = sigm(acc[ai][0][m][n][j] + gr[j]), ig = sigm(acc[ai][1][m][n][j] + gi[j]);
                        const float la = r * sp[j], bb = __builtin_sqrtf(neg_expm1_fast(2.f * la)) * (ig * xc[j]); o[j] = pk2(la, bb); }
                    *(u32x4*)(ab + ro) = o; }
        }
    }
};
struct EpiResid {
    static constexpr bool PERM = false, AFTER_DRAIN = false;
    const float *r0, *r1; float* out; const float* gt; int permute;
    __device__ __forceinline__ void operator()(const f32x4 (&acc)[2][2][4][2], const Unit& u, int wr, int wc, int fr_, int fq_) const {
        int fr = fr_, fq = fq_; asm volatile("" : "+v"(fr), "+v"(fq));
        const int rowt = u.pm * 256, mi = mod_index(rowt), col0 = u.pn * 256 + wc * 32 + 4 * fq;
        f32x4 gv[2][2];
#pragma unroll
        for (int bj = 0; bj < 2; ++bj)
#pragma unroll
            for (int n = 0; n < 2; ++n) gv[bj][n] = *(const f32x4*)(gt + (size_t)mi * 12288 + col0 + bj * 128 + n * 16) + 1.0f;
#pragma unroll
        for (int ai = 0; ai < 2; ++ai)
#pragma unroll
            for (int m = 0; m < 4; ++m) { const int rr = rowt + ai * 128 + wr * 64 + m * 16 + fr, tok = permute ? unperm_row(rr) : rr;
                const float* rp = (tok < MX ? r0 + (size_t)tok * D : r1 + (size_t)(tok - MX) * D) + col0; float* op = out + (size_t)tok * D + col0;
#pragma unroll
                for (int bj = 0; bj < 2; ++bj)
#pragma unroll
                    for (int n = 0; n < 2; ++n) { const f32x4 rs = *(const f32x4*)(rp + bj * 128 + n * 16); *(f32x4*)(op + bj * 128 + n * 16) = rs * DN_ALPHA + gv[bj][n] * acc[ai][bj][m][n]; }
                asm volatile("" ::: "memory"); }
    }
};
struct EpiSwiGLU {
    static constexpr bool PERM = true, AFTER_DRAIN = false;
    bf16_t* ACT;
    __device__ __forceinline__ void operator()(const f32x4 (&acc)[2][2][4][2], const Unit& u, int wr, int wc, int fr_, int fq_) const {
        int fr = fr_, fq = fq_; asm volatile("" : "+v"(fr), "+v"(fq));
        const int row0 = u.pm * 256 + wr * 64 + fr, col0 = u.pn * 128 + wc * 32 + 8 * fq;
#pragma unroll
        for (int ai = 0; ai < 2; ++ai)
#pragma unroll
            for (int m = 0; m < 4; ++m) { f32x4 v0 = acc[ai][0][m][0], v1 = acc[ai][0][m][1]; const f32x4 u0 = acc[ai][1][m][0], u1 = acc[ai][1][m][1];
#pragma unroll
                for (int j = 0; j < 4; ++j) { v0[j] = siluf(v0[j]) * u0[j]; v1[j] = siluf(v1[j]) * u1[j]; }
                u32x4 w; w.x = cvt_pk_bf16(v0[0], v0[1]); w.y = cvt_pk_bf16(v0[2], v0[3]); w.z = cvt_pk_bf16(v1[0], v1[1]); w.w = cvt_pk_bf16(v1[2], v1[3]);
                *(u32x4*)(ACT + (size_t)(row0 + ai * 128 + m * 16) * FF + col0) = w; }
    }
};
struct Frame {
    LAS unsigned char* lds;
    int tid, lane, wave, G, gw, NGW;
};
struct Args { const float* in[25]; float* out; unsigned char* ws; int ph_lo, ph_hi; };

template <int MODE> __device__ __forceinline__ long src_off(int n, int nsrc) {
    if (MODE == 0) return n < nsrc ? (long)n : -1L;
    if (MODE == 1) { const int pn = n >> 8, bj = (n >> 7) & 1, jj = n & 127; return (long)bj * FF + pn * 128 + jj; }
    const int nb = n >> 10, c = n & 1023, pn4 = c >> 8, g = (c >> 7) & 1, jj = c & 127, d = pn4 >> 1, half = pn4 & 1;
    return (long)(((d * 2 + g) * 8 + nb) * 256) * 256 + half * 128 + jj;
}
template <int MODE> __device__ __forceinline__ void tr_item(const float* W, int ldin, int K, bf16* WT, int nout, int nsrc, LAS float* scr, int item, int lane) {
    const int nblk = nout / 32, kb = item / nblk, nb = item % nblk, k0 = 64 * kb, n0 = 32 * nb;
    const long off = src_off<MODE>(n0 + (lane & 31), nsrc);
#pragma unroll 8
    for (int i = 0; i < 32; ++i) { const int kk = 2 * i + (lane >> 5); scr[kk * 33 + (lane & 31)] = off >= 0 ? W[off + (size_t)(k0 + kk) * ldin] : 0.f; }
    LDS_WAIT(); asm volatile("" ::: "memory");
    const int c = lane & 7;
#pragma unroll
    for (int j = 0; j < 4; ++j) { const int n = (lane >> 3) + 8 * j; const LAS float* s = scr + (8 * c) * 33 + n;
        u32x4 o; o.x = pk2(s[0 * 33], s[1 * 33]); o.y = pk2(s[2 * 33], s[3 * 33]); o.z = pk2(s[4 * 33], s[5 * 33]); o.w = pk2(s[6 * 33], s[7 * 33]);
        *(u32x4*)(WT + (size_t)(n0 + n) * K + k0 + 8 * c) = o; }
    LDS_WAIT(); asm volatile("" ::: "memory");
}
__device__ __forceinline__ void gemv_item(const Args& a, int gi, int lane, float* PART) {
    const int l = gi / 384, c48 = (gi >> 3) % 48, kp = gi & 7, col = c48 * 256 + lane * 4;
    const float* W = a.in[4] + ((size_t)l * D + kp * 256) * 12288 + col;
    const float* c0 = a.in[1] + kp * 256; const float* c1 = c0 + D; const float* c2 = a.in[3] + kp * 256;
    f32x4 s0 = {0.f, 0.f, 0.f, 0.f}, s1 = s0, s2 = s0;
#pragma unroll 8
    for (int k = 0; k < 256; ++k) { const f32x4 w = *(const f32x4*)(W + (size_t)k * 12288); s0 += w * siluf(c0[k]); s1 += w * siluf(c1[k]); s2 += w * siluf(c2[k]); }
    float* p = PART + ((size_t)(kp * 4 + l) * 3) * 12288 + col;
    *(f32x4*)p = s0; *(f32x4*)(p + 12288) = s1; *(f32x4*)(p + 2 * 12288) = s2;
}
__device__ __forceinline__ void ph_prologue(Frame& F, const Args& a) {
    LAS float* scr = (LAS float*)(F.lds + RING_OFF + F.wave * 16384);
    unsigned char* ws = a.ws;
    constexpr int I_INE = (D / 64) * (NE_INP / 32), I_SQ = (D / 64) * (D / 32), I_INO = (D / 64) * (2 * D / 32), I_GATE = (256 / 64) * (8192 / 32), I_GU = (D / 64) * (2 * FF / 32), I_DN = (FF / 64) * (D / 32);
    constexpr int NGEMV = 4 * 48 * 8;
    constexpr int NITEMS = NGEMV + 2 * (I_INE + I_SQ + I_INO + I_GATE + I_SQ) + 4 * (I_GU + I_DN);
    for (int it = F.gw; it < NITEMS; it += F.NGW) {
        int r = it;
        if (r < NGEMV) { gemv_item(a, r, F.lane, (float*)(ws + WS_PART)); continue; } r -= NGEMV;
        bool done = false;
#pragma unroll 1
        for (int j = 0; j < 2 && !done; ++j) {
            if (r < I_INE) { tr_item<0>(a.in[10] + (size_t)j * D * NE_IN, NE_IN, D, (bf16*)(ws + WS_WINE + j * SZ_WINE), NE_INP, NE_IN, scr, r, F.lane); done = true; break; } r -= I_INE;
            if (r < I_SQ) { tr_item<0>(a.in[17] + (size_t)j * D * D, D, D, (bf16*)(ws + WS_WOUTE + j * SZ_WSQ), D, D, scr, r, F.lane); done = true; break; } r -= I_SQ;
            if (r < I_INO) { tr_item<0>(a.in[18] + (size_t)j * D * 2 * D, 2 * D, D, (bf16*)(ws + WS_WINO + j * SZ_WINO), 2 * D, 2 * D, scr, r, F.lane); done = true; break; } r -= I_INO;
            if (r < I_GATE) { tr_item<2>(a.in[21] + (size_t)j * 4 * 8 * 256 * 256, 256, 256, (bf16*)(ws + WS_WGATE + j * SZ_WGATE), 8192, 8192, scr, r, F.lane); done = true; break; } r -= I_GATE;
            if (r < I_SQ) { tr_item<0>(a.in[24] + (size_t)j * D * D, D, D, (bf16*)(ws + WS_WOUTO + j * SZ_WSQ), D, D, scr, r, F.lane); done = true; break; } r -= I_SQ;
        }
        if (done) continue;
#pragma unroll 1
        for (int l = 0; l < 4; ++l) {
            if (r < I_GU) { tr_item<1>(a.in[8] + (size_t)l * D * 2 * FF, 2 * FF, D, (bf16*)(ws + WS_WGU + l * SZ_WGU), 2 * FF, 2 * FF, scr, r, F.lane); break; } r -= I_GU;
            if (r < I_DN) { tr_item<0>(a.in[9] + (size_t)l * FF * D, D, FF, (bf16*)(ws + WS_WDN + l * SZ_WDN), D, D, scr, r, F.lane); break; } r -= I_DN;
        }
    }
}
__device__ __forceinline__ void ph_modreduce(Frame& F, const Args& a) {
    float* MOD = (float*)(a.ws + WS_MOD); const float* PART = (const float*)(a.ws + WS_PART); float* LB = (float*)(a.ws + WS_LB);
    const int gt = blockIdx.x * NTHREADS + F.tid, NT = F.G * NTHREADS;
    for (int i = gt; i < 4 * 3 * 12288; i += NT) { const int l = i / 36864, n = i % 12288; float s = a.in[5][l * 12288 + n];
#pragma unroll
        for (int kp = 0; kp < 8; ++kp) s += PART[(size_t)kp * 147456 + i];
        MOD[i] = s; }
    for (int i = gt; i < 2048; i += NT) { const int c = i & 1023; LB[i] = i < 1024 ? 0.f : sigm(a.in[14][1024 + c] - a.in[14][c]); }
}
__device__ __forceinline__ void store_hx(bf16* HX, int orow, const f32x4 (&v)[8], const float* sh, const float* sc, int lane) {
    unsigned long long* o8 = (unsigned long long*)(HX + (size_t)orow * D) + lane;
#pragma unroll
    for (int j = 0; j < 8; ++j) { const f32x4 s = *(const f32x4*)(sc + 4 * (lane + 64 * j)), h = *(const f32x4*)(sh + 4 * (lane + 64 * j)); const f32x4 y = v[j] * (s + 1.0f) + h;
        o8[64 * j] = (unsigned long long)pk2(y[0], y[1]) | ((unsigned long long)pk2(y[2], y[3]) << 32); }
}
__device__ __forceinline__ void ph_mod0(Frame& F, const Args& a) {
    const float* MOD = (const float*)(a.ws + WS_MOD); bf16* HX = (bf16*)(a.ws + WS_HX);
    for (int row = F.gw; row < M; row += F.NGW) {
        const float* p = row < MX ? a.in[0] + (size_t)row * D : a.in[2] + (size_t)(row - MX) * D; f32x4 v[8];
#pragma unroll
        for (int j = 0; j < 8; ++j) v[j] = *(const f32x4*)(p + 4 * (F.lane + 64 * j));
        const float* md = MOD + (size_t)mod_index(row) * 12288;
        store_hx(HX, row, v, md, md + D, F.lane);
    }
}
__device__ __forceinline__ void ph_ln(Frame& F, float* buf, int nrows, const float* g, const float* b, float* dout, bf16* HX, const float* modsh, const float* modsc, int permute) {
    for (int row0 = F.gw; row0 < nrows; row0 += 2 * F.NGW) {
        f32x4 v[2][8]; float s[2] = {0.f, 0.f}, q[2] = {0.f, 0.f};
#pragma unroll
        for (int u = 0; u < 2; ++u) { const int row = row0 + u * F.NGW; if (row < nrows) { const float* p = buf + (size_t)row * D;
#pragma unroll
            for (int jj = 0; jj < 8; ++jj) v[u][jj] = *(const f32x4*)(p + 4 * (F.lane + 64 * jj)); } else {
#pragma unroll
            for (int jj = 0; jj < 8; ++jj) v[u][jj] = (f32x4){0.f, 0.f, 0.f, 0.f}; } }
#pragma unroll
        for (int u = 0; u < 2; ++u)
#pragma unroll
            for (int jj = 0; jj < 8; ++jj) s[u] += (v[u][jj][0] + v[u][jj][1]) + (v[u][jj][2] + v[u][jj][3]);
#pragma unroll
        for (int u = 0; u < 2; ++u) { const float mean = wave_sum(s[u]) * (1.f / D);
#pragma unroll
            for (int jj = 0; jj < 8; ++jj) { v[u][jj] = v[u][jj] - mean; q[u] += (v[u][jj][0] * v[u][jj][0] + v[u][jj][1] * v[u][jj][1]) + (v[u][jj][2] * v[u][jj][2] + v[u][jj][3] * v[u][jj][3]); } }
#pragma unroll
        for (int u = 0; u < 2; ++u) { const int row = row0 + u * F.NGW; if (row >= nrows) continue;
            const float rstd = 1.f / sqrtf(wave_sum(q[u]) * (1.f / D) + LN_EPS);
            float* o = (dout ? dout : buf) + (size_t)row * D;
#pragma unroll
            for (int jj = 0; jj < 8; ++jj) { const f32x4 gg = *(const f32x4*)(g + 4 * (F.lane + 64 * jj)), bb = *(const f32x4*)(b + 4 * (F.lane + 64 * jj)); v[u][jj] = v[u][jj] * rstd * gg + bb; *(f32x4*)(o + 4 * (F.lane + 64 * jj)) = v[u][jj]; }
            if (HX) { const int mi = mod_index(row); store_hx(HX, permute ? perm_row(row) : row, v[u], modsh + (size_t)mi * 12288, modsc + (size_t)mi * 12288, F.lane); } }
    }
}
__device__ __forceinline__ void seg_bounds(int r, int& lo, int& hi) { if (r < MX) { lo = r & ~(SEQ - 1); hi = lo + SEQ; } else { lo = MX + ((r - MX) & ~(CTXL - 1)); hi = lo + CTXL; } }
__device__ __forceinline__ float row16_sum(float v) { v += __shfl_xor(v, 1); v += __shfl_xor(v, 2); v += __shfl_xor(v, 4); v += __shfl_xor(v, 8); return v; }
template <int MODE> __device__ __forceinline__ void ph_conv(Frame& F, const Args& a, int j) {
    constexpr int NG = MODE == 0 ? 6 : 4, LDI = MODE == 0 ? 3072 : D;
    const bf16* X = (const bf16*)(a.ws + (MODE == 0 ? WS_QKVB : WS_XBR));
    const float* cw = MODE == 0 ? a.in[11] + (size_t)j * 4 * 3072 : a.in[19] + (size_t)j * 4 * D;
    for (int it = F.gw; it < (M / 16) * NG; it += F.NGW) {
        const int si = it / NG, kg = it - si * NG, r0 = si * 16, ch = kg * 512 + 8 * F.lane;
        int lo, hi; seg_bounds(r0, lo, hi);
        float w[4][8];
#pragma unroll
        for (int k = 0; k < 4; ++k) { const f32x4 w0 = *(const f32x4*)(cw + k * LDI + ch), w1 = *(const f32x4*)(cw + k * LDI + ch + 4);
#pragma unroll
            for (int c = 0; c < 4; ++c) { w[k][c] = w0[c]; w[k][4 + c] = w1[c]; } }
        float bias[8];
#pragma unroll
        for (int c = 0; c < 8; ++c) bias[c] = 0.f;
        if (MODE == 1) { const float* cb = a.in[20] + (size_t)j * D + ch; const f32x4 b0 = *(const f32x4*)cb, b1 = *(const f32x4*)(cb + 4);
#pragma unroll
            for (int c = 0; c < 4; ++c) { bias[c] = b0[c]; bias[4 + c] = b1[c]; } }
        u32x4 xr[19];
#pragma unroll
        for (int r = 0; r < 19; ++r) { const int rr = r0 + r - 2; xr[r] = (rr >= lo && rr < hi) ? *(const u32x4*)(X + (size_t)rr * LDI + ch) : (u32x4){0u, 0u, 0u, 0u}; }
#pragma unroll
        for (int r = 0; r < 16; ++r) { float y[8];
#pragma unroll
            for (int c = 0; c < 8; ++c) y[c] = bias[c];
#pragma unroll
            for (int k = 0; k < 4; ++k) { const u32x4 x = xr[r + k];
#pragma unroll
                for (int c = 0; c < 4; ++c) { y[2 * c] += w[k][2 * c] * bflo(x[c]); y[2 * c + 1] += w[k][2 * c + 1] * bfhi(x[c]); } }
            const int row = r0 + r;
            if (MODE == 0) {
#pragma unroll
                for (int c = 0; c < 8; ++c) y[c] = siluf(y[c]);
                if (kg < 4) { float ss = 0.f;
#pragma unroll
                    for (int c = 0; c < 8; ++c) ss += y[c] * y[c];
                    const float sc = rsqrtf(row16_sum(ss) + 1e-6f) * (kg < 2 ? QSCALE : 1.f);
#pragma unroll
                    for (int c = 0; c < 8; ++c) y[c] *= sc; }
                bf16* dst = (bf16*)(a.ws + (kg < 2 ? WS_QB : (kg < 4 ? WS_KB : WS_VB))) + (size_t)row * AW + (kg & 1) * 512 + 8 * F.lane;
                *(u32x4*)dst = (u32x4){pk2(y[0], y[1]), pk2(y[2], y[3]), pk2(y[4], y[5]), pk2(y[6], y[7])};
            } else {
                *(u32x4*)((bf16*)(a.ws + WS_XC) + (size_t)row * D + ch) = (u32x4){pk2(y[0], y[1]), pk2(y[2], y[3]), pk2(y[4], y[5]), pk2(y[6], y[7])};
            } }
    }
}
__device__ __forceinline__ void ph_merge(Frame& F, const Args& a, int j) {
    bf16* MIX = (bf16*)(a.ws + WS_MIX);
    for (int row = F.gw; row < M; row += F.NGW) {
        u32x4 o0[4], o1[4], gg[4];
#pragma unroll
        for (int q = 0; q < 4; ++q) { const int part = q >> 1, c = (q & 1) * 512 + 8 * F.lane; const bf16* O = (const bf16*)(a.ws + (part ? WS_OB : WS_OA)); const size_t o = (size_t)row * AW + c;
            o0[q] = *(const u32x4*)(O + o); o1[q] = *(const u32x4*)(O + (size_t)M * AW + o); gg[q] = *(const u32x4*)((const bf16*)(a.ws + (part ? WS_ZB : WS_GA)) + o); }
#pragma unroll
        for (int q = 0; q < 4; ++q) { const int part = q >> 1, c = (q & 1) * 512 + 8 * F.lane; const float* nw = (part ? a.in[16] : a.in[15]) + (size_t)j * AW + c;
            const f32x4 n0 = *(const f32x4*)nw, n1 = *(const f32x4*)(nw + 4); float y[8]; float ss = 0.f;
#pragma unroll
            for (int k = 0; k < 4; ++k) { y[2 * k] = bflo(o0[q][k]) + bflo(o1[q][k]); y[2 * k + 1] = bfhi(o0[q][k]) + bfhi(o1[q][k]); ss += y[2 * k] * y[2 * k] + y[2 * k + 1] * y[2 * k + 1]; }
            const float sc = rsqrtf(row16_sum(ss) * (1.f / 128.f) + 1e-6f);
#pragma unroll
            for (int k = 0; k < 4; ++k) { y[2 * k] *= sc * (k < 2 ? n0[2 * k] : n1[2 * k - 4]) * bflo(gg[q][k]); y[2 * k + 1] *= sc * (k < 2 ? n0[2 * k + 1] : n1[2 * k - 3]) * bfhi(gg[q][k]); }
            *(u32x4*)(MIX + (size_t)row * D + part * AW + c) = (u32x4){pk2(y[0], y[1]), pk2(y[2], y[3]), pk2(y[4], y[5]), pk2(y[6], y[7])}; }
    }
}
__device__ __forceinline__ void ph_odd_l1(Frame& F, const Args& a) {
    const unsigned* AB = (const unsigned*)(a.ws + WS_AB); float2* PH = (float2*)(a.ws + WS_R);
    for (int it = F.gw; it < 128 * 132; it += F.NGW) {
        const int cgp = it & 127, tc = it >> 7, c = cgp * 64 + F.lane, ch = c & 2047, d = (c >> 11) & 1, b = c >> 12;
        const unsigned* ab = AB + (size_t)d * M * D + ch; float P = 1.f, H = 0.f;
        const int row0 = seq_row(b, d, tc * 64), stp = d ? -1 : 1;
#pragma unroll 1
        for (int k0 = 0; k0 < 64; k0 += 16) { unsigned x[16];
#pragma unroll
            for (int k = 0; k < 16; ++k) x[k] = ab[(size_t)(row0 + stp * (k0 + k)) * D];
#pragma unroll
            for (int k = 0; k < 16; ++k) { const float al = __expf(bflo(x[k])); P *= al; H = al * H + bfhi(x[k]); } }
        PH[(size_t)tc * 8192 + c] = make_float2(P, H);
    }
}
__device__ __forceinline__ void ph_odd_l3(Frame& F, const Args& a) {
    const unsigned* AB = (const unsigned*)(a.ws + WS_AB); const float2* PH = (const float2*)(a.ws + WS_R); const bf16* GY = (const bf16*)(a.ws + WS_GY); bf16* MIX = (bf16*)(a.ws + WS_MIX);
    for (int it = F.gw; it < 64 * 132; it += F.NGW) {
        const int g64 = it & 63, jb = it >> 6, b = g64 >> 5, ch = (g64 & 31) * 64 + F.lane;
        const int row0 = jb < 4 ? MX + b * CTXL + jb * 64 : b * SEQ + (jb - 4) * 64;
        const int tcf = jb, tcb = jb < 4 ? 3 - jb : 4 + (131 - jb);
        const int cf = (b << 12) + ch, cb = (b << 12) + 2048 + ch;
        float hf = 0.f, hb = 0.f;
        for (int q = 0; q < tcf; ++q) { const float2 p = PH[(size_t)q * 8192 + cf]; hf = p.x * hf + p.y; }
        for (int q = 0; q < tcb; ++q) { const float2 p = PH[(size_t)q * 8192 + cb]; hb = p.x * hb + p.y; }
        const unsigned* ab0 = AB + (size_t)row0 * D + ch; const unsigned* ab1 = ab0 + (size_t)M * D;
        float hs[64];
#pragma unroll
        for (int k0 = 0; k0 < 64; k0 += 16) { unsigned x[16];
#pragma unroll
            for (int k = 0; k < 16; ++k) x[k] = ab0[(size_t)(k0 + k) * D];
#pragma unroll
            for (int k = 0; k < 16; ++k) { hf = __expf(bflo(x[k])) * hf + bfhi(x[k]); hs[k0 + k] = hf; } }
        const bf16* gy = GY + (size_t)row0 * D + ch; bf16* mx = MIX + (size_t)row0 * D + ch;
#pragma unroll
        for (int k0 = 48; k0 >= 0; k0 -= 16) { unsigned x[16]; bf16 gv[16];
#pragma unroll
            for (int k = 0; k < 16; ++k) { x[k] = ab1[(size_t)(k0 + k) * D]; gv[k] = gy[(size_t)(k0 + k) * D]; }
#pragma unroll
            for (int k = 15; k >= 0; --k) { hb = __expf(bflo(x[k])) * hb + bfhi(x[k]); mx[(size_t)(k0 + k) * D] = (bf16)f2bf(bf2f(gv[k]) * (hs[k0 + k] + hb)); } }
    }
}
__device__ __forceinline__ void hgrn_wave(int wi, int lane, const bf16* QA, const float* LF, const bf16* VA, bf16* OA) {
    const int chain = wi >> 3, cg = wi & 7, b = chain >> 4, h = (chain >> 1) & 7, dir = chain & 1, kq = lane >> 4, col = cg * 16 + (lane & 15);
    const float* lf = LF + (size_t)dir * M * AW + h * 128 + kq * 32; const bf16* qa = QA + h * 128 + kq * 32; const bf16* va = VA + h * 128 + col; bf16* oa = OA + (size_t)dir * M * AW + h * 128 + col;
    float S[32];
#pragma unroll
    for (int i = 0; i < 32; ++i) S[i] = 0.f;
    u32x4 qn[4]; f32x4 fn[8]; float vn; int rown = seq_row(b, dir, 0);
#pragma unroll
    for (int i = 0; i < 4; ++i) qn[i] = *(const u32x4*)(qa + (size_t)rown * AW + 8 * i);
#pragma unroll
    for (int i = 0; i < 8; ++i) fn[i] = *(const f32x4*)(lf + (size_t)rown * AW + 4 * i);
    vn = bf2f(va[(size_t)rown * AW]);
    for (int s = 0; s < CTXL + SEQ; ++s) {
        u32x4 qc[4]; f32x4 fc[8]; const float vc = vn; const int row = rown;
#pragma unroll
        for (int i = 0; i < 4; ++i) qc[i] = qn[i];
#pragma unroll
        for (int i = 0; i < 8; ++i) fc[i] = fn[i];
        if (s + 1 < CTXL + SEQ) { rown = seq_row(b, dir, s + 1);
#pragma unroll
            for (int i = 0; i < 4; ++i) qn[i] = *(const u32x4*)(qa + (size_t)rown * AW + 8 * i);
#pragma unroll
            for (int i = 0; i < 8; ++i) fn[i] = *(const f32x4*)(lf + (size_t)rown * AW + 4 * i);
            vn = bf2f(va[(size_t)rown * AW]); }
        float o = 0.f;
#pragma unroll
        for (int i = 0; i < 32; ++i) { const float f = __expf(fc[i >> 2][i & 3]); const unsigned qw = qc[i >> 3][(i >> 1) & 3]; const float q = (i & 1) ? bfhi(qw) : bflo(qw);
            S[i] = f * (S[i] - vc) + vc; o += S[i] * q; }
        o += __shfl_xor(o, 16); o += __shfl_xor(o, 32);
        if (kq == 0) oa[(size_t)row * AW] = (bf16)f2bf(o);
    }
}
__device__ __forceinline__ void gdn_wave(int wi, int lane, const bf16* QB, const bf16* KB, const bf16* VB, const float* GB, bf16* OB) {
    const int chain = wi >> 3, cg = wi & 7, b = chain >> 4, h = (chain >> 1) & 7, dir = chain & 1, kq = lane >> 4, col = cg * 16 + (lane & 15);
    const bf16* qb = QB + h * 128 + kq * 32; const bf16* kb = KB + h * 128 + kq * 32; const bf16* vb = VB + h * 128 + col; const float* gb = GB + dir * 8 + h; bf16* ob = OB + (size_t)dir * M * AW + h * 128 + col;
    float S[32];
#pragma unroll
    for (int i = 0; i < 32; ++i) S[i] = 0.f;
    u32x4 qn[4], kn[4]; float vn, gn, bn; int rown = seq_row(b, dir, 0);
#pragma unroll
    for (int i = 0; i < 4; ++i) { qn[i] = *(const u32x4*)(qb + (size_t)rown * AW + 8 * i); kn[i] = *(const u32x4*)(kb + (size_t)rown * AW + 8 * i); }
    vn = bf2f(vb[(size_t)rown * AW]); gn = gb[(size_t)rown * 32]; bn = gb[(size_t)rown * 32 + 16];
    for (int s = 0; s < CTXL + SEQ; ++s) {
        u32x4 qc[4], kc[4]; const float vc = vn, gc = gn, bc = bn; const int row = rown;
#pragma unroll
        for (int i = 0; i < 4; ++i) { qc[i] = qn[i]; kc[i] = kn[i]; }
        if (s + 1 < CTXL + SEQ) { rown = seq_row(b, dir, s + 1);
#pragma unroll
            for (int i = 0; i < 4; ++i) { qn[i] = *(const u32x4*)(qb + (size_t)rown * AW + 8 * i); kn[i] = *(const u32x4*)(kb + (size_t)rown * AW + 8 * i); }
            vn = bf2f(vb[(size_t)rown * AW]); gn = gb[(size_t)rown * 32]; bn = gb[(size_t)rown * 32 + 16]; }
        const float al = __expf(gc); float ks = 0.f; float kk[32];
#pragma unroll
        for (int i = 0; i < 32; ++i) { const unsigned kw = kc[i >> 3][(i >> 1) & 3]; kk[i] = (i & 1) ? bfhi(kw) : bflo(kw); ks += kk[i] * S[i]; }
        ks += __shfl_xor(ks, 16); ks += __shfl_xor(ks, 32);
        const float dl = bc * (vc - al * ks); float o = 0.f;
#pragma unroll
        for (int i = 0; i < 32; ++i) { const unsigned qw = qc[i >> 3][(i >> 1) & 3]; const float q = (i & 1) ? bfhi(qw) : bflo(qw); S[i] = al * S[i] + kk[i] * dl; o += S[i] * q; }
        o += __shfl_xor(o, 16); o += __shfl_xor(o, 32);
        if (kq == 0) ob[(size_t)row * AW] = (bf16)f2bf(o);
    }
}
__device__ __forceinline__ void ph_even_scan(Frame& F, const Args& a) {
    unsigned char* ws = a.ws;
    if (F.wave == 0) { for (int wi = blockIdx.x; wi < 256; wi += F.G) hgrn_wave(wi, F.lane, (const bf16*)(ws + WS_QA), (const float*)(ws + WS_LF), (const bf16*)(ws + WS_VA), (bf16*)(ws + WS_OA)); }
    else if (F.wave == 1) { for (int wi = blockIdx.x; wi < 256; wi += F.G) gdn_wave(wi, F.lane, (const bf16*)(ws + WS_QB), (const bf16*)(ws + WS_KB), (const bf16*)(ws + WS_VB), (const float*)(ws + WS_GB), (bf16*)(ws + WS_OB)); }
}
typedef short bf16x8 __attribute__((ext_vector_type(8)));
typedef short bf16x4 __attribute__((ext_vector_type(4)));
constexpr int NCHUNK = (CTXL + SEQ) / 16;
constexpr int NCHH = 32 * NCHUNK;
constexpr int HREC = 9216;
constexpr int HQ_OFF = 0, HK_OFF = 4096, HP_OFF = 8192, HD_OFF = 8704;
constexpr int GREC = 17152;
constexpr int GW_OFF = 0, GQ_OFF = 4096, GK_OFF = 8192, GU_OFF = 12288, GAT_OFF = 16384, GAL_OFF = 16896;
__device__ __forceinline__ unsigned cvtpk(float lo, float hi) { return pg8::cvt_pk_bf16(lo, hi); }
template <int N> __device__ __forceinline__ float row_shr(float x) { return __builtin_bit_cast(float, __builtin_amdgcn_update_dpp(0, __builtin_bit_cast(int, x), 0x110 + N, 0xf, 0xf, true)); }
__device__ __forceinline__ float row_prefix(float x) { x += row_shr<1>(x); x += row_shr<2>(x); x += row_shr<4>(x); x += row_shr<8>(x); return x; }
__device__ __forceinline__ float rdlane(float x, int l) { return __builtin_bit_cast(float, __builtin_amdgcn_readlane(__builtin_bit_cast(int, x), l)); }
__device__ __forceinline__ bf16x8 mk8(unsigned a, unsigned b, unsigned c, unsigned d) { return __builtin_bit_cast(bf16x8, (u32x4){a, b, c, d}); }
__device__ __forceinline__ bf16x4 mk4(unsigned a, unsigned b) { return __builtin_bit_cast(bf16x4, (u32x2){a, b}); }
__device__ __forceinline__ f32x4 mfma32_safe(bf16x8 a, bf16x8 b, f32x4 c) { f32x4 d = __builtin_amdgcn_mfma_f32_16x16x32_bf16(a, b, c, 0, 0, 0); asm volatile("" : "+v"(d) : "v"(a), "v"(b)); return d; }
#define MFMA32(a, b, c) mfma32_safe((a), (b), (c))
#define MFMA16(a, b, c) __builtin_amdgcn_mfma_f32_16x16x16bf16_1k((a), (b), (c), 0, 0, 0)

__device__ __forceinline__ void hgrn_s1(int chh, int lane, unsigned char* ws) {
    const int chain = chh / NCHUNK, ci = chh - chain * NCHUNK, b = chain >> 4, h = (chain >> 1) & 7, dir = chain & 1, i = lane & 15, g = lane >> 4;
    const int row = seq_row(b, dir, ci * 16 + i);
    const bf16* qrow = (const bf16*)(ws + WS_QA) + (size_t)row * AW + h * 128 + 4 * g;
    const float* frow = (const float*)(ws + WS_LF) + (size_t)dir * M * AW + (size_t)row * AW + h * 128 + 4 * g;
    unsigned char* rec = ws + WS_HREC + (size_t)chh * HREC;
    bf16* hk = (bf16*)(rec + HK_OFF) + (16 * (i >> 2)) * 4 + (i & 3);
    f32x4 pacc = {0.f, 0.f, 0.f, 0.f};
#pragma unroll
    for (int s = 0; s < 4; ++s) {
        u32x2 qv[2]; f32x4 fv[2];
#pragma unroll
        for (int hh = 0; hh < 2; ++hh) { qv[hh] = *(const u32x2*)(qrow + 32 * s + 16 * hh); fv[hh] = *(const f32x4*)(frow + 32 * s + 16 * hh); }
        float qt[8], kh[8];
#pragma unroll
        for (int hh = 0; hh < 2; ++hh) { f32x4 ddv;
#pragma unroll
            for (int j = 0; j < 4; ++j) { const int idx = 4 * hh + j; const float lf = fv[hh][j], gc = row_prefix(lf), gl = __shfl(gc, (lane & 48) | 15);
                const float eg = __expf(gc), einv = __builtin_amdgcn_rcpf(eg), f = __expf(lf), dd = __expf(gl);
                const unsigned qw = qv[hh][j >> 1]; const float q = (j & 1) ? bfhi(qw) : bflo(qw);
                qt[idx] = q * eg; kh[idx] = (1.f - f) * einv; ddv[j] = dd;
                hk[((2 * s + hh) * 64 + 4 * g + j) * 4] = (bf16)f2bf(kh[idx] * dd); }
            if (i == 0) *(f32x4*)(rec + HD_OFF + (32 * s + 16 * hh + 4 * g) * 4) = ddv; }
        const bf16x8 Qf = mk8(cvtpk(qt[0], qt[1]), cvtpk(qt[2], qt[3]), cvtpk(qt[4], qt[5]), cvtpk(qt[6], qt[7]));
        const bf16x8 Kf = mk8(cvtpk(kh[0], kh[1]), cvtpk(kh[2], kh[3]), cvtpk(kh[4], kh[5]), cvtpk(kh[6], kh[7]));
        *(bf16x8*)(rec + HQ_OFF + (s * 64 + lane) * 16) = Qf;
        pacc = MFMA32(Kf, Qf, pacc);
    }
    float p[4];
#pragma unroll
    for (int r = 0; r < 4; ++r) p[r] = (4 * g + r <= i) ? pacc[r] : 0.f;
    *(bf16x4*)(rec + HP_OFF + lane * 8) = mk4(cvtpk(p[0], p[1]), cvtpk(p[2], p[3]));
}

__device__ __forceinline__ void gdn_s1(int chh, int lane, unsigned char* ws) {
    const int chain = chh / NCHUNK, ci = chh - chain * NCHUNK, b = chain >> 4, h = (chain >> 1) & 7, dir = chain & 1, i = lane & 15, g = lane >> 4;
    const int row = seq_row(b, dir, ci * 16 + i), row0 = seq_row(b, dir, ci * 16), stp = dir ? -1 : 1;
    const float* GB = (const float*)(ws + WS_GB);
    const float gval = GB[(size_t)row * 32 + dir * 8 + h], beta = GB[(size_t)row * 32 + 16 + dir * 8 + h];
    const float gc = row_prefix(gval), gl = __shfl(gc, (lane & 48) | 15), eg = __expf(gc), ekl = __expf(gl - gc);
    const bf16* qrow = (const bf16*)(ws + WS_QB) + (size_t)row * AW + h * 128 + 4 * g;
    const bf16* krow = (const bf16*)(ws + WS_KB) + (size_t)row * AW + h * 128 + 4 * g;
    unsigned char* rec = ws + WS_GREC + (size_t)chh * GREC;
    f32x4 kkacc = {0.f, 0.f, 0.f, 0.f}, qkacc = {0.f, 0.f, 0.f, 0.f};
#pragma unroll
    for (int s = 0; s < 4; ++s) {
        u32x2 qv[2], kv[2];
#pragma unroll
        for (int hh = 0; hh < 2; ++hh) { qv[hh] = *(const u32x2*)(qrow + 32 * s + 16 * hh); kv[hh] = *(const u32x2*)(krow + 32 * s + 16 * hh); }
        const bf16x8 Kf = mk8(kv[0].x, kv[0].y, kv[1].x, kv[1].y), Qf = mk8(qv[0].x, qv[0].y, qv[1].x, qv[1].y);
        kkacc = MFMA32(Kf, Kf, kkacc);
        qkacc = MFMA32(Kf, Qf, qkacc);
        unsigned qs[4];
#pragma unroll
        for (int w = 0; w < 4; ++w) { const unsigned qw = qv[w >> 1][w & 1]; qs[w] = cvtpk(bflo(qw) * eg, bfhi(qw) * eg); }
        *(bf16x8*)(rec + GQ_OFF + (s * 64 + lane) * 16) = mk8(qs[0], qs[1], qs[2], qs[3]);
    }
    float att[4], Areg[4];
#pragma unroll
    for (int r = 0; r < 4; ++r) { const float gcs = __shfl(gc, 4 * g + r), bts = __shfl(beta, 4 * g + r);
        att[r] = (4 * g + r <= i) ? qkacc[r] * __expf(gc - gcs) : 0.f;
        Areg[r] = (i < 4 * g + r) ? bts * kkacc[r] * __expf(gcs - gc) : 0.f; }
    *(bf16x4*)(rec + GAT_OFF + lane * 8) = mk4(cvtpk(att[0], att[1]), cvtpk(att[2], att[3]));
    if (lane == 0) *(float*)(rec + GAL_OFF) = __expf(gl);
    float xu[16][2], xw[16][2], kt[16][2];
    const bf16* vcol = (const bf16*)(ws + WS_VB) + h * 128 + 2 * lane; const bf16* kcol = (const bf16*)(ws + WS_KB) + h * 128 + 2 * lane;
#pragma unroll
    for (int t = 0; t < 16; ++t) { const size_t ro = (size_t)(row0 + stp * t) * AW; const unsigned vv = *(const unsigned*)(vcol + ro), kv = *(const unsigned*)(kcol + ro);
        const float bt = rdlane(beta, t), egt = rdlane(eg, t), et = rdlane(ekl, t), k0 = bflo(kv), k1 = bfhi(kv);
        xu[t][0] = bt * bflo(vv); xu[t][1] = bt * bfhi(vv); xw[t][0] = bt * egt * k0; xw[t][1] = bt * egt * k1; kt[t][0] = k0 * et; kt[t][1] = k1 * et; }
#pragma unroll
    for (int t = 1; t < 16; ++t)
#pragma unroll
        for (int s = 0; s < t; ++s) { const float a = rdlane(Areg[t & 3], s + 16 * (t >> 2));
            xu[t][0] -= a * xu[s][0]; xu[t][1] -= a * xu[s][1]; xw[t][0] -= a * xw[s][0]; xw[t][1] -= a * xw[s][1]; }
#pragma unroll
    for (int e = 0; e < 2; ++e) { const int c = 2 * lane + e, t16 = c >> 4, m = c & 15;
        const int ks = c >> 5, slot = 4 * ((c >> 4) & 1) + (c & 3), gq = (c >> 2) & 3;
#pragma unroll
        for (int gp = 0; gp < 4; ++gp) {
            *(u32x2*)(rec + GU_OFF + ((t16 * 64 + m + 16 * gp) * 4) * 2) = (u32x2){cvtpk(xu[4 * gp][e], xu[4 * gp + 1][e]), cvtpk(xu[4 * gp + 2][e], xu[4 * gp + 3][e])};
            *(u32x2*)(rec + GK_OFF + ((t16 * 64 + m + 16 * gp) * 4) * 2) = (u32x2){cvtpk(kt[4 * gp][e], kt[4 * gp + 1][e]), cvtpk(kt[4 * gp + 2][e], kt[4 * gp + 3][e])}; }
#pragma unroll
        for (int t = 0; t < 16; ++t) *(bf16*)(rec + GW_OFF + (((ks * 64 + t + 16 * gq) * 8) + slot) * 2) = (bf16)f2bf(xw[t][e]); }
}
__device__ __forceinline__ void ph_even_s1(Frame& F, const Args& a) {
    for (int chh = F.gw; chh < NCHH; chh += F.NGW) {
#ifndef EXP_B
        hgrn_s1(chh, F.lane, a.ws);
#endif
#ifndef EXP_A
        gdn_s1(chh, F.lane, a.ws);
#endif
    }
}

typedef float f32x2v __attribute__((ext_vector_type(2)));
constexpr int S2_NR = 4, S2_SLOT = 13824, S2_TB = 65536, S2_ORING = S2_NR * S2_SLOT, S2_CTL = S2_ORING + 4096, S2_SCR = S2_CTL + 256, PFD = 12;
static_assert(S2_SCR + 512 + 1024 <= S2_TB && 2 * S2_TB <= RING_BYTES, "S2 LDS map");
#define S2_SPIN(cond) do { while (cond) __builtin_amdgcn_s_sleep(1); asm volatile("" ::: "memory"); } while (0)
#define DMA16(g, l) __builtin_amdgcn_global_load_lds((const unsigned*)(g), (LAS unsigned*)(l), 16, 0, 0)
#define DMA4(g, l) __builtin_amdgcn_global_load_lds((const unsigned*)(g), (LAS unsigned*)(l), 4, 0, 0)
template <int MIXER> __device__ __forceinline__ void s2_toucher(int chain, int vs, int lane, unsigned char* ws, LAS unsigned char* tb) {
    const int b = chain >> 4, h = (chain >> 1) & 7, dir = chain & 1, stp = dir ? -1 : 1;
    constexpr int RS = MIXER == 0 ? GREC : HREC;
    const unsigned char* recs = ws + (MIXER == 0 ? WS_GREC : WS_HREC) + (size_t)chain * NCHUNK * RS;
    const bf16* va = (const bf16*)(ws + WS_VA) + h * 128 + vs * 16;
    volatile LAS unsigned* ctl = (volatile LAS unsigned*)(tb + S2_CTL);
#pragma unroll 1
    for (int c = 0; c < NCHUNK; ++c) {
        S2_SPIN((int)ctl[1] + PFD < c);
        const unsigned char* rp = recs + (size_t)c * RS;
        if (MIXER == 0) {
            DMA4(rp + lane * 64, tb + S2_SCR); DMA4(rp + 4096 + lane * 64, tb + S2_SCR + 256); DMA4(rp + 8192 + lane * 64, tb + S2_SCR);
            DMA4(lane < 8 ? rp + GU_OFF + vs * 512 + lane * 64 : rp + GAT_OFF + (lane & 15) * 64, tb + S2_SCR + 256);
        } else {
            DMA4(rp + lane * 64, tb + S2_SCR); DMA4(rp + 4096 + lane * 64, tb + S2_SCR + 256);
            DMA4(lane < 16 ? rp + 8192 + lane * 64 : (const unsigned char*)(va + (size_t)(seq_row(b, dir, c * 16) + stp * (lane & 15)) * AW), tb + S2_SCR);
        }
    }
}
__device__ __forceinline__ void s2_flusher(int mixer, int chain, int vs, int lane, unsigned char* ws, LAS unsigned char* tb) {
    const int b = chain >> 4, h = (chain >> 1) & 7, dir = chain & 1, stp = dir ? -1 : 1, t = lane >> 2, vq = lane & 3;
    bf16* o = (bf16*)(ws + (mixer == 0 ? WS_OB : WS_OA)) + (size_t)dir * M * AW + h * 128 + vs * 16 + 4 * vq;
    volatile LAS unsigned* ctl = (volatile LAS unsigned*)(tb + S2_CTL);
#pragma unroll 1
    for (int c = 0; c < NCHUNK; ++c) {
        S2_SPIN((int)ctl[2] <= c);
        const LAS unsigned short* sl = (const LAS unsigned short*)(tb + S2_ORING + (c & 7) * 512) + t;
        const unsigned a0 = sl[(4 * vq + 0) * 16], a1 = sl[(4 * vq + 1) * 16], a2 = sl[(4 * vq + 2) * 16], a3 = sl[(4 * vq + 3) * 16];
        *(u32x2*)(o + (size_t)(seq_row(b, dir, c * 16) + stp * t) * AW) = (u32x2){a0 | (a1 << 16), a2 | (a3 << 16)};
        asm volatile("s_waitcnt lgkmcnt(0)" ::: "memory");
        if (lane == 0) ctl[3] = (unsigned)(c + 1);
    }
}
#define S2_PUBLISH_O(c_, Ov, fl_) do { if ((int)(fl_) < (c_) - 7) S2_SPIN((int)ctl[3] < (c_) - 7); \
        *(LAS u32x2*)(tb + S2_ORING + ((c_) & 7) * 512 + (lane & 15) * 32 + g * 8) = (u32x2){cvtpk((Ov)[0], (Ov)[1]), cvtpk((Ov)[2], (Ov)[3])}; \
        asm volatile("" ::: "memory"); if (lane == 0) ctl[2] = (unsigned)((c_) + 1); } while (0)
#define S2_PACK_SB() do { _Pragma("unroll") for (int s = 0; s < 4; ++s) Sb[s] = mk8(cvtpk(S[2 * s][0], S[2 * s][1]), cvtpk(S[2 * s][2], S[2 * s][3]), cvtpk(S[2 * s + 1][0], S[2 * s + 1][1]), cvtpk(S[2 * s + 1][2], S[2 * s + 1][3])); } while (0)
struct HSet { bf16x8 q[4]; bf16x4 k[8]; bf16x4 p; bf16x4 v; f32x2v dpre; };
__device__ __forceinline__ void hgrn_ld(HSet& R, const unsigned char* rec, const bf16* va, int row0, int stp, int lane, int g) {
    const unsigned l16 = (unsigned)lane * 16u, l8 = (unsigned)lane * 8u;
#pragma unroll
    for (int s = 0; s < 4; ++s) R.q[s] = *(const bf16x8*)(rec + HQ_OFF + s * 1024 + l16);
#pragma unroll
    for (int t = 0; t < 8; ++t) R.k[t] = *(const bf16x4*)(rec + HK_OFF + t * 512 + l8);
    R.p = *(const bf16x4*)(rec + HP_OFF + l8); R.dpre = *(const f32x2v*)(rec + HD_OFF + l8);
#pragma unroll
    for (int j = 0; j < 4; ++j) R.v[j] = (short)va[(size_t)(row0 + stp * (4 * g + j)) * AW];
}
__device__ __forceinline__ void hgrn_s2c(int chain, int vs, int lane, unsigned char* ws, LAS unsigned char* tb) {
    const int b = chain >> 4, h = (chain >> 1) & 7, dir = chain & 1, g = lane >> 4, stp = dir ? -1 : 1;
    const bf16* va = (const bf16*)(ws + WS_VA) + h * 128 + vs * 16 + (lane & 15);
    const unsigned char* recs = ws + WS_HREC + (size_t)chain * NCHUNK * HREC;
    volatile LAS unsigned* ctl = (volatile LAS unsigned*)(tb + S2_CTL);
    f32x4 S[8]; bf16x8 Sb[4];
#pragma unroll
    for (int t = 0; t < 8; ++t) S[t] = (f32x4){0.f, 0.f, 0.f, 0.f};
#pragma unroll
    for (int s = 0; s < 4; ++s) Sb[s] = mk8(0u, 0u, 0u, 0u);
    HSet A, B;
    hgrn_ld(A, recs, va, seq_row(b, dir, 0), stp, lane, g);
#define HG_STEP(R, Rn, c_) do { const int cn_ = min((c_) + 1, NCHUNK - 1); \
        LAS unsigned char* ld_ = tb + S2_SCR + 512 + ((c_) & 1) * 512; \
        *(LAS f32x2v*)(ld_ + lane * 8) = R.dpre; const unsigned fl_ = ctl[3]; \
        f32x4 dv[8]; _Pragma("unroll") for (int t = 0; t < 8; ++t) dv[t] = *(const LAS f32x4*)(ld_ + (16 * t + 4 * g) * 4); \
        __builtin_amdgcn_s_waitcnt(0x0F70); \
        hgrn_ld(Rn, recs + (size_t)cn_ * HREC, va, seq_row(b, dir, cn_ * 16), stp, lane, g); \
        f32x4 O = {0.f, 0.f, 0.f, 0.f}; \
        _Pragma("unroll") for (int s = 0; s < 4; ++s) O = MFMA32(R.q[s], Sb[s], O); \
        _Pragma("unroll") for (int t = 0; t < 8; ++t) S[t] = S[t] * dv[t]; \
        O = MFMA16(R.p, R.v, O); \
        _Pragma("unroll") for (int t = 0; t < 8; ++t) S[t] = MFMA16(R.k[t], R.v, S[t]); \
        if (lane == 0) ctl[1] = (unsigned)((c_) + 1); \
        S2_PACK_SB(); S2_PUBLISH_O(c_, O, fl_); } while (0)
#pragma unroll 1
    for (int c = 0; c < NCHUNK; c += 2) { HG_STEP(A, B, c); HG_STEP(B, A, c + 1); }
#undef HG_STEP
}
struct GSet { bf16x8 w[4], q[4]; bf16x4 k[8]; bf16x4 at; u32x2 u; float al; };
__device__ __forceinline__ void gdn_ld(GSet& R, const unsigned char* rec, int vs, int lane) {
    const unsigned l16 = (unsigned)lane * 16u, l8 = (unsigned)lane * 8u;
#pragma unroll
    for (int s = 0; s < 4; ++s) { R.w[s] = *(const bf16x8*)(rec + GW_OFF + s * 1024 + l16); R.q[s] = *(const bf16x8*)(rec + GQ_OFF + s * 1024 + l16); }
#pragma unroll
    for (int t = 0; t < 8; ++t) R.k[t] = *(const bf16x4*)(rec + GK_OFF + t * 512 + l8);
    R.at = *(const bf16x4*)(rec + GAT_OFF + l8); R.u = *(const u32x2*)(rec + GU_OFF + vs * 512 + l8); R.al = *(const float*)(rec + GAL_OFF);
}
__device__ __forceinline__ void gdn_s2c(int chain, int vs, int lane, unsigned char* ws, LAS unsigned char* tb) {
    const int g = lane >> 4;
    const unsigned char* recs = ws + WS_GREC + (size_t)chain * NCHUNK * GREC;
    volatile LAS unsigned* ctl = (volatile LAS unsigned*)(tb + S2_CTL);
    f32x4 S[8]; bf16x8 Sb[4];
#pragma unroll
    for (int t = 0; t < 8; ++t) S[t] = (f32x4){0.f, 0.f, 0.f, 0.f};
#pragma unroll
    for (int s = 0; s < 4; ++s) Sb[s] = mk8(0u, 0u, 0u, 0u);
    GSet A, B;
    gdn_ld(A, recs, vs, lane);
#define GD_STEP(R, Rn, c_) do { const int cn_ = min((c_) + 1, NCHUNK - 1); const unsigned fl_ = ctl[3]; \
        __builtin_amdgcn_s_waitcnt(0x0F70);        \
        gdn_ld(Rn, recs + (size_t)cn_ * GREC, vs, lane); \
        f32x4 WS_ = {0.f, 0.f, 0.f, 0.f}, O = {0.f, 0.f, 0.f, 0.f}; \
        _Pragma("unroll") for (int s = 0; s < 4; ++s) WS_ = MFMA32(R.w[s], Sb[s], WS_); \
        _Pragma("unroll") for (int s = 0; s < 4; ++s) O = MFMA32(R.q[s], Sb[s], O); \
        _Pragma("unroll") for (int t = 0; t < 8; ++t) S[t] = S[t] * R.al; \
        const bf16x4 Vn = mk4(cvtpk(bflo(R.u.x) - WS_[0], bfhi(R.u.x) - WS_[1]), cvtpk(bflo(R.u.y) - WS_[2], bfhi(R.u.y) - WS_[3])); \
        O = MFMA16(R.at, Vn, O); \
        _Pragma("unroll") for (int t = 0; t < 8; ++t) S[t] = MFMA16(R.k[t], Vn, S[t]); \
        if (lane == 0) ctl[1] = (unsigned)((c_) + 1); \
        S2_PACK_SB(); S2_PUBLISH_O(c_, O, fl_); } while (0)
#pragma unroll 1
    for (int c = 0; c < NCHUNK; c += 2) { GD_STEP(A, B, c); GD_STEP(B, A, c + 1); }
#undef GD_STEP
}
__device__ __forceinline__ void ph_even_s2(Frame& F, const Args& a) {
    const int bx = blockIdx.x, vcu = (F.G % 8 == 0) ? (bx % 8) * (F.G / 8) + bx / 8 : bx;
    const int role = F.wave >> 1, ts = F.wave & 1;
    LAS unsigned char* tb = F.lds + RING_OFF + ts * S2_TB;
    for (int tp = vcu; tp < 256; tp += F.G) {
        if (F.tid < 128) ((LAS unsigned*)(F.lds + RING_OFF + (F.tid >> 6) * S2_TB + S2_CTL))[F.tid & 63] = 0u;
        __syncthreads();
        const int task = 2 * tp + ts, mixer = task >> 8, chain = (task >> 3) & 31, vs = task & 7;
        if (role == 0) { if (mixer == 0) gdn_s2c(chain, vs, F.lane, a.ws, tb); else hgrn_s2c(chain, vs, F.lane, a.ws, tb); }
        else if (role == 1) { if (mixer == 0) s2_toucher<0>(chain, vs, F.lane, a.ws, tb); else s2_toucher<1>(chain, vs, F.lane, a.ws, tb); }
        else if (role == 2) s2_flusher(mixer, chain, vs, F.lane, a.ws, tb);
        __syncthreads();
    }
}
constexpr int N_PHASES = 3 + 10 * DEPTH;
__host__ __device__ constexpr bool phase_used(int ph) { return true; }

__global__ void __launch_bounds__(NTHREADS, 2) fwd(Args args) {
    extern __shared__ __attribute__((aligned(16))) unsigned char lds[];
    Frame F;
    F.lds = (LAS unsigned char*)lds; F.tid = threadIdx.x; F.lane = F.tid & 63; F.wave = __builtin_amdgcn_readfirstlane(F.tid >> 6);
    F.G = gridDim.x; F.gw = F.wave * F.G + blockIdx.x; F.NGW = F.G * NWAVES;
    for (int u = F.tid; u < (LDS_BYTES - LDSCTL_OFF) / 4; u += NTHREADS) ((LAS unsigned*)(F.lds + LDSCTL_OFF))[u] = 0u;
    __syncthreads();
    const int lo = args.ph_lo, hi = args.ph_hi; const bool multi = (hi - lo) > 1;
    unsigned char* ws = args.ws;
    XcdBarrier bar; bar.bar = (unsigned*)(ws + WS_CTL) + CW_BAR; bar.x = 0; bar.st = nullptr;
    if (multi) bar = xcd_barrier_post((unsigned*)(ws + WS_CTL) + CW_BAR, (volatile LAS unsigned*)(F.lds + MISC_OFF) + 8);
#ifndef PH_SITES
#define PH_SITES 0x3ffff
#endif
#define SITE(n) ((PH_SITES >> (n)) & 1)
#ifndef PROBE_MASK
#define PROBE_MASK 0
#endif
#define REPS(n) (((PROBE_MASK >> (n)) & 1) ? 2 : 1)
#define IN(k) (lo <= (k) && (k) < hi)
#define LAUNDER() do { asm volatile("" : "+v"(F.tid), "+v"(F.lane)); } while (0)
#define SEAM() do { if (multi) xcd_barrier(bar); } while (0)
    bf16* HX = (bf16*)(ws + WS_HX); bf16* MIX = (bf16*)(ws + WS_MIX); float* XA = (float*)(ws + WS_XA); float* Z = (float*)(ws + WS_Z); bf16* ACT = (bf16*)(ws + WS_ACT);
    LAS unsigned char* ring = F.lds + RING_OFF;

    if (SITE(0) && IN(0)) { _Pragma("unroll 1") for (int rep_ = 0; rep_ < REPS(0); ++rep_) { LAUNDER(); ph_prologue(F, args); } SEAM(); }
    if (SITE(1) && IN(1)) { _Pragma("unroll 1") for (int rep_ = 0; rep_ < REPS(1); ++rep_) { LAUNDER(); ph_modreduce(F, args); } SEAM(); }
    if (SITE(2) && IN(2)) { _Pragma("unroll 1") for (int rep_ = 0; rep_ < REPS(2); ++rep_) { LAUNDER(); ph_mod0(F, args); } SEAM(); }
#pragma unroll 1
    for (int l = 0; l < DEPTH; ++l) {
        const int base = 3 + 10 * l, j = l >> 1; const bool last = (l == DEPTH - 1); const int Mo = last ? MX : M;
        const float* MODL = (const float*)(ws + WS_MOD) + (size_t)l * 3 * 12288;
        if ((l & 1) == 0) {
            if (SITE(3) && IN(base + 0)) { _Pragma("unroll 1") for (int rep_ = 0; rep_ < REPS(3); ++rep_) {
                pg8::Gemm g{HX, (const bf16*)(ws + WS_WINE + j * SZ_WINE), M, NE_INP, D, D, D}; pg8::StaticOrder S; S.init(M, NE_INP, F.G, (int)blockIdx.x);
                EpiEven1 E{(bf16*)(ws + WS_QA), (bf16*)(ws + WS_VA), (bf16*)(ws + WS_GA), (bf16*)(ws + WS_ZB), (bf16*)(ws + WS_QKVB), (float*)(ws + WS_LF), (float*)(ws + WS_GB),
                           (const float*)(ws + WS_LB) + j * AW, args.in[12] + j * 16, args.in[13] + j * 16};
                pg8::gemm_phase<EpiEven1, pg8::StaticOrder, true, true>(ring, g, S, E); } SEAM(); }
            if (SITE(4) && IN(base + 1)) { _Pragma("unroll 1") for (int rep_ = 0; rep_ < REPS(4); ++rep_) { LAUNDER(); ph_conv<0>(F, args, j); } SEAM(); }
            if (SITE(5) && IN(base + 2)) { _Pragma("unroll 1") for (int rep_ = 0; rep_ < REPS(5); ++rep_) { LAUNDER(); ph_even_s1(F, args); } SEAM(); }
            if (SITE(17) && IN(base + 3)) { _Pragma("unroll 1") for (int rep_ = 0; rep_ < REPS(17); ++rep_) { LAUNDER(); ph_even_s2(F, args); } SEAM(); }
            if (SITE(6) && IN(base + 4)) { _Pragma("unroll 1") for (int rep_ = 0; rep_ < REPS(6); ++rep_) { LAUNDER(); ph_merge(F, args, j); } SEAM(); }
        } else {
            if (SITE(7) && IN(base + 0)) { _Pragma("unroll 1") for (int rep_ = 0; rep_ < REPS(7); ++rep_) {
                pg8::Gemm g{HX, (const bf16*)(ws + WS_WINO + j * SZ_WINO), M, 2 * D, D, D, D}; pg8::StaticOrder S; S.init(M, 2 * D, F.G, (int)blockIdx.x);
                EpiOdd1 E{(bf16*)(ws + WS_GY), (bf16*)(ws + WS_XBR)};
                pg8::gemm_phase<EpiOdd1, pg8::StaticOrder, true, true>(ring, g, S, E); } SEAM(); }
            if (SITE(8) && IN(base + 1)) { _Pragma("unroll 1") for (int rep_ = 0; rep_ < REPS(8); ++rep_) { LAUNDER(); ph_conv<1>(F, args, j); } SEAM(); }
            if (SITE(9) && IN(base + 2)) { _Pragma("unroll 1") for (int rep_ = 0; rep_ < REPS(9); ++rep_) {
                pg8::Gemm g{(const bf16*)(ws + WS_XC), (const bf16*)(ws + WS_WGATE + j * SZ_WGATE), M, 8192, 256, D, 256}; pg8::GateOrder S; S.init(M, F.G, (int)blockIdx.x);
                EpiGates E{(const bf16*)(ws + WS_XC), (unsigned*)(ws + WS_AB), args.in[22] + (size_t)j * 4 * D, args.in[23] + (size_t)j * 2 * D};
                pg8::gemm_phase<EpiGates, pg8::GateOrder, true, true>(ring, g, S, E); } SEAM(); }
            if (SITE(10) && IN(base + 3)) { _Pragma("unroll 1") for (int rep_ = 0; rep_ < REPS(10); ++rep_) { LAUNDER(); ph_odd_l1(F, args); } SEAM(); }
            if (SITE(11) && IN(base + 4)) { _Pragma("unroll 1") for (int rep_ = 0; rep_ < REPS(11); ++rep_) { LAUNDER(); ph_odd_l3(F, args); } SEAM(); }
        }
        if (SITE(12) && IN(base + 5)) { _Pragma("unroll 1") for (int rep_ = 0; rep_ < REPS(12); ++rep_) {
            pg8::Gemm g{MIX, (const bf16*)((l & 1) ? ws + WS_WOUTO + j * SZ_WSQ : ws + WS_WOUTE + j * SZ_WSQ), Mo, D, D, D, D}; pg8::StaticOrder S; S.init(Mo, D, F.G, (int)blockIdx.x);
            EpiResid E{l == 0 ? args.in[0] : XA, l == 0 ? args.in[2] : XA + (size_t)MX * D, Z, MODL + 2 * D, l & 1};
            pg8::gemm_phase<EpiResid, pg8::StaticOrder, true, true>(ring, g, S, E); } SEAM(); }
        if (SITE(13) && IN(base + 6)) { _Pragma("unroll 1") for (int rep_ = 0; rep_ < REPS(13); ++rep_) { LAUNDER(); ph_ln(F, Z, Mo, args.in[6] + (size_t)(l * 2) * D, args.in[7] + (size_t)(l * 2) * D, nullptr, HX, MODL + 3 * D, MODL + 4 * D, 0); } SEAM(); }
        if (SITE(14) && IN(base + 7)) { _Pragma("unroll 1") for (int rep_ = 0; rep_ < REPS(14); ++rep_) {
            pg8::Gemm g{HX, (const bf16*)(ws + WS_WGU + l * SZ_WGU), Mo, 2 * FF, D, D, D}; pg8::StaticOrder S; S.init(Mo, 2 * FF, F.G, (int)blockIdx.x);
            EpiSwiGLU E{ACT};
            pg8::gemm_phase<EpiSwiGLU, pg8::StaticOrder, true, true>(ring, g, S, E); } SEAM(); }
        if (SITE(15) && IN(base + 8)) { _Pragma("unroll 1") for (int rep_ = 0; rep_ < REPS(15); ++rep_) {
            pg8::Gemm g{ACT, (const bf16*)(ws + WS_WDN + l * SZ_WDN), Mo, D, FF, FF, FF}; pg8::StaticOrder S; S.init(Mo, D, F.G, (int)blockIdx.x);
            EpiResid E{Z, Z + (size_t)MX * D, XA, MODL + 5 * D, 0};
            pg8::gemm_phase<EpiResid, pg8::StaticOrder, true, true>(ring, g, S, E); } SEAM(); }
        if (SITE(16) && IN(base + 9)) {
            const float* g1 = args.in[6] + (size_t)(l * 2 + 1) * D; const float* b1 = args.in[7] + (size_t)(l * 2 + 1) * D;
            LAUNDER(); if (last) ph_ln(F, XA, MX, g1, b1, args.out, nullptr, nullptr, nullptr, 0);
            else { LAUNDER(); ph_ln(F, XA, M, g1, b1, nullptr, HX, MODL + 3 * 12288, MODL + 3 * 12288 + D, (l + 1) & 1); SEAM(); } }
    }
#undef IN
#undef SEAM
}

extern "C" void kernel_launch(void* const* d_in, const int* in_sizes, int n_in, void* d_out, int out_size, void* d_ws, size_t ws_size, hipStream_t stream) {
    static int grid = 0;
    if (grid == 0) {
        if (n_in != 25 || in_sizes[0] != MX * D || out_size != MX * D || ws_size < WS_END) { fprintf(stderr, "kernel_launch: unexpected shapes (n_in %d, in0 %d, out %d, ws %zu < %zu); nothing launched\n", n_in, n_in > 0 ? in_sizes[0] : -1, out_size, ws_size, (size_t)WS_END); grid = -1; return; }
        int dev = 0, cus = 0, per_cu = 0;
        if (hipGetDevice(&dev) != hipSuccess || hipDeviceGetAttribute(&cus, hipDeviceAttributeMultiprocessorCount, dev) != hipSuccess) { grid = -1; return; }
        if (hipFuncSetAttribute((const void*)fwd, hipFuncAttributeMaxDynamicSharedMemorySize, LDS_BYTES) != hipSuccess) { fprintf(stderr, "kernel_launch: hipFuncSetAttribute failed\n"); grid = -1; return; }
        if (hipOccupancyMaxActiveBlocksPerMultiprocessor(&per_cu, (const void*)fwd, NTHREADS, LDS_BYTES) != hipSuccess || per_cu < 1) { fprintf(stderr, "kernel_launch: occupancy query says %d\n", per_cu); }
        (void)hipGetLastError();
        grid = cus;
    }
    if (grid < 0) return;
    if (hipMemsetAsync((char*)d_ws + WS_CTL, 0, CTL_ZERO_BYTES, stream) != hipSuccess) return;
    Args a{};
    for (int i = 0; i < 25; ++i) a.in[i] = (const float*)d_in[i];
    a.out = (float*)d_out; a.ws = (unsigned char*)d_ws;
#if MK_ONE_LAUNCH
    a.ph_lo = 0; a.ph_hi = N_PHASES;
    hipLaunchKernelGGL(fwd, dim3(grid), dim3(NTHREADS), LDS_BYTES, stream, a);
#else
    for (int ph = 0; ph < N_PHASES; ++ph) { if (!phase_used(ph)) continue; a.ph_lo = ph; a.ph_hi = ph + 1;
        hipLaunchKernelGGL(fwd, dim3(grid), dim3(NTHREADS), LDS_BYTES, stream, a); }
#endif
}
```

```cpp
#include <hip/hip_runtime.h>
#include <cstdio>
#include <cstdint>
#ifndef MK_ONE_LAUNCH
#define MK_ONE_LAUNCH 1
#endif
namespace pg8 {
#define PG8_LAS __attribute__((address_space(3)))
typedef unsigned short bf16_t;
typedef short bf16x8 __attribute__((ext_vector_type(8)));
typedef float f32x4 __attribute__((ext_vector_type(4)));
typedef unsigned u32x4 __attribute__((ext_vector_type(4)));
typedef unsigned u32x2 __attribute__((ext_vector_type(2)));
constexpr int BM = 256, BK = 64, HALF = 128, HTB = HALF * BK * 2  , STAGE_BYTES = 8 * HTB, NXCD = 8, WGM = 8;
__host__ __device__ __forceinline__ int lds_byte(int r, int c) { const int st = (r >> 4) * 2 + (c >> 5), rr = r & 15, cc = c & 31, ob = rr * 64 + cc * 2; return st * 1024 + (ob ^ (((ob >> 9) & 1) << 5)); }
__host__ __device__ __forceinline__ void stage_rc(int b, int& R, int& C) { const int st = b / 1024, sb = b % 1024, swz = sb ^ (((sb >> 9) & 1) << 5); R = (st >> 1) * 16 + swz / 64; C = (st & 1) * 32 + (swz % 64) / 2; }
__host__ __device__ __forceinline__ int perm32(int rho) { const int n = rho >> 4, i = rho & 15; return 8 * (i >> 2) + 4 * n + (i & 3); }

struct Unit { int pm, pn, ka; };
struct Gemm { const bf16_t* A; const bf16_t* Bt; int M, N, K, lda, ldb; };

struct StaticOrder {
    int nM, nN, nwg, G, c;
    __host__ __device__ void init(int M, int N, int G_, int c_) { nM = M / BM; nN = N / BM; nwg = nM * nN; G = G_; c = c_; }
    __host__ __device__ bool next(int i, Unit& u) const {
        const long L = (long)i * G + c; if (L >= nwg) return false;
        int wgid = (int)L; { const int q = nwg / NXCD, r = nwg % NXCD, xcd = wgid % NXCD, off = wgid / NXCD; wgid = (xcd < r ? xcd * (q + 1) : r * (q + 1) + (xcd - r) * q) + off; }
        const int nig = WGM * nN, gid = wgid / nig, fm = gid * WGM, gsz = (nM - fm) < WGM ? (nM - fm) : WGM;
        u.pm = fm + ((wgid % nig) % gsz); u.pn = (wgid % nig) / gsz; u.ka = 0; return true;
    }
    __device__ __forceinline__ void a_ready(const Unit&) const {}
    __device__ __forceinline__ void done(const Unit&) const {}
};
struct GateOrder {
    int nM, nwg, G, c;
    __host__ __device__ void init(int M, int G_, int c_) { nM = M / BM; nwg = nM * 32; G = G_; c = c_; }
    __host__ __device__ bool next(int i, Unit& u) const {
        const long L = (long)i * G + c; if (L >= nwg) return false;
        const int l = (int)L, pn4 = l & 3, pm = (l >> 2) % nM, nb = (l >> 2) / nM;
        u.pm = pm; u.pn = nb * 4 + pn4; u.ka = nb * 256; return true;
    }
    __device__ __forceinline__ void a_ready(const Unit&) const {}
    __device__ __forceinline__ void done(const Unit&) const {}
};
typedef float f32x2c __attribute__((ext_vector_type(2))); typedef __bf16 bf16x2c __attribute__((ext_vector_type(2)));
__device__ __forceinline__ unsigned cvt_pk_bf16(float lo, float hi) { const f32x2c v = {lo, hi}; return __builtin_bit_cast(unsigned, __builtin_convertvector(v, bf16x2c)); }
template <class Epi, class Sched, bool ALIGN_EPI = false, bool SP2 = false>
__device__ __forceinline__ void gemm_phase(PG8_LAS unsigned char* lds, const Gemm g, const Sched& S, const Epi& E) {
    int tid = threadIdx.x; asm volatile("" : "+v"(tid)); const int wid = __builtin_amdgcn_readfirstlane(tid >> 6), lane = tid & 63, wr = wid >> 2, wc = wid & 3, fr = lane & 15, fq = lane >> 4;
    int nt = g.K / BK; asm volatile("" : "+s"(nt));
    unsigned voffA[2], voffB[2];
#pragma unroll
    for (int i = 0; i < 2; ++i) { int R, C; stage_rc(tid * 16 + i * 8192, R, C); const int Rb = Epi::PERM ? ((R & ~31) + perm32(R & 31)) : R;
        voffA[i] = (unsigned)(R * g.lda + C) * 2u; voffB[i] = (unsigned)(Rb * g.ldb + C) * 2u; }
    const size_t kstep = (size_t)(BK * 2);
    const size_t hstepA = (size_t)HALF * g.lda * 2, hstepB = (size_t)HALF * g.ldb * 2;
    const size_t tstepA = 2 * hstepA, tstepB = 2 * hstepB;
    const unsigned ldsw = (unsigned)wid * 1024u;
    const int aoff = lds_byte(wr * 64 + fr, fq * 8), boff = lds_byte(wc * 32 + fr, fq * 8);
#define PG8_SA(b, h) (((b) * 2 + (h)) * HTB)
#define PG8_SB(b, h) ((4 + (b) * 2 + (h)) * HTB)
#define PG8_STAGE(bufoff, gbase, voff) do { _Pragma("unroll") for (int _i = 0; _i < 2; ++_i) \
        __builtin_amdgcn_global_load_lds((const unsigned*)((const char*)(gbase) + (voff)[_i]), (PG8_LAS unsigned*)(lds + (bufoff) + ldsw + _i * 8192), 16, 0, 0); } while (0)
#define PG8_LDA(dst, b, h) do { _Pragma("unroll") for (int m = 0; m < 4; ++m) _Pragma("unroll") for (int k = 0; k < 2; ++k) dst[m][k] = *(const PG8_LAS bf16x8*)(lds + PG8_SA(b, h) + aoff + m * 2048 + k * 1024); } while (0)
#define PG8_LDB(dst, b, h) do { _Pragma("unroll") for (int n = 0; n < 2; ++n) _Pragma("unroll") for (int k = 0; k < 2; ++k) dst[n][k] = *(const PG8_LAS bf16x8*)(lds + PG8_SB(b, h) + boff + n * 2048 + k * 1024); } while (0)
#define PG8_MMA(ai, bj, At, Bt) do { __builtin_amdgcn_s_setprio(1); _Pragma("unroll") for (int m = 0; m < 4; ++m) _Pragma("unroll") for (int n = 0; n < 2; ++n) _Pragma("unroll") for (int k = 0; k < 2; ++k) \
        acc[ai][bj][m][n] = __builtin_amdgcn_mfma_f32_16x16x32_bf16(Bt[n][k], At[m][k], acc[ai][bj][m][n], 0, 0, 0); __builtin_amdgcn_s_setprio(0); } while (0)
#define PG8_WAIT_V(n) asm volatile("s_waitcnt vmcnt(" #n ")" ::: "memory")
#define PG8_WAIT_L(n) asm volatile("s_waitcnt lgkmcnt(" #n ")" ::: "memory")
#define PG8_BAR __builtin_amdgcn_s_barrier()
#define PG8_SCHED __builtin_amdgcn_sched_barrier(0)
    Unit cur, nxt; int ui = 0;
    if (!S.next(0, cur)) return;
    f32x4 acc[2][2][4][2];
#pragma unroll
    for (int a = 0; a < 2; ++a)
#pragma unroll
        for (int b = 0; b < 2; ++b)
#pragma unroll
            for (int m = 0; m < 4; ++m)
#pragma unroll
                for (int n = 0; n < 2; ++n) acc[a][b][m][n] = (f32x4){0.f, 0.f, 0.f, 0.f};
    bf16x8 At[4][2], B0[2][2], B1[2][2];
    const char* cA = (const char*)g.A + (size_t)cur.pm * tstepA + (size_t)cur.ka * 2; const char* cB = (const char*)g.Bt + (size_t)cur.pn * tstepB;
    S.a_ready(cur);
    if constexpr (SP2) {
        PG8_STAGE(PG8_SB(0, 0), cB, voffB); PG8_STAGE(PG8_SB(0, 1), cB + hstepB, voffB); PG8_STAGE(PG8_SA(0, 0), cA, voffA); PG8_STAGE(PG8_SA(0, 1), cA + hstepA, voffA);
        if (wr == 1) PG8_BAR;
        PG8_WAIT_V(2); PG8_BAR;
        PG8_STAGE(PG8_SB(1, 0), cB + kstep, voffB); PG8_STAGE(PG8_SA(1, 0), cA + kstep, voffA); PG8_STAGE(PG8_SB(1, 1), cB + hstepB + kstep, voffB);
        PG8_WAIT_V(6); PG8_BAR;
    } else {
        PG8_STAGE(PG8_SB(0, 0), cB, voffB); PG8_STAGE(PG8_SA(0, 0), cA, voffA); PG8_STAGE(PG8_SB(0, 1), cB + hstepB, voffB); PG8_STAGE(PG8_SA(0, 1), cA + hstepA, voffA);
        if (wr == 1) PG8_BAR;
        PG8_WAIT_V(4); PG8_BAR;
        PG8_STAGE(PG8_SB(1, 0), cB + kstep, voffB); PG8_STAGE(PG8_SA(1, 0), cA + kstep, voffA); PG8_STAGE(PG8_SB(1, 1), cB + hstepB + kstep, voffB);
        PG8_WAIT_V(6); PG8_BAR;
    }
    for (;;) {
        const bool has_next = S.next(ui + 1, nxt);
        const char* nA = has_next ? (const char*)g.A + (size_t)nxt.pm * tstepA + (size_t)nxt.ka * 2 : cA; const char* nB = has_next ? (const char*)g.Bt + (size_t)nxt.pn * tstepB : cB;
        for (int t = 0; t < nt; t += 2) {
            const bool last = (t == nt - 2);
            const char* a1 = cA + (size_t)(t + 1) * kstep;
            const char* a2 = last ? nA : cA + (size_t)(t + 2) * kstep; const char* b2 = last ? nB : cB + (size_t)(t + 2) * kstep;
            const char* a3 = a2 + kstep; const char* b3 = b2 + kstep;
            if (last && has_next) S.a_ready(nxt);
            if constexpr (SP2) {
            PG8_LDB(B0, 0, 0); PG8_LDB(B1, 0, 1); PG8_SCHED; PG8_LDA(At, 0, 0); PG8_STAGE(PG8_SA(1, 1), a1 + hstepA, voffA);
            PG8_WAIT_V(8); PG8_WAIT_L(0); PG8_BAR; PG8_MMA(0, 0, At, B0); PG8_MMA(0, 1, At, B1); PG8_BAR; PG8_SCHED;
            PG8_LDA(At, 0, 1); PG8_STAGE(PG8_SB(0, 0), b2, voffB); PG8_STAGE(PG8_SB(0, 1), b2 + hstepB, voffB); PG8_STAGE(PG8_SA(0, 0), a2, voffA);
            PG8_WAIT_V(8); PG8_WAIT_L(0); PG8_BAR; PG8_MMA(1, 0, At, B0); PG8_MMA(1, 1, At, B1); PG8_BAR; PG8_SCHED;
            PG8_LDB(B0, 1, 0); PG8_LDB(B1, 1, 1); PG8_SCHED; PG8_LDA(At, 1, 0); PG8_STAGE(PG8_SA(0, 1), a2 + hstepA, voffA);
            PG8_WAIT_V(8); PG8_WAIT_L(0); PG8_BAR; PG8_MMA(0, 0, At, B0); PG8_MMA(0, 1, At, B1); PG8_BAR; PG8_SCHED;
            PG8_LDA(At, 1, 1); PG8_STAGE(PG8_SB(1, 0), b3, voffB); PG8_STAGE(PG8_SB(1, 1), b3 + hstepB, voffB); PG8_STAGE(PG8_SA(1, 0), a3, voffA);
            PG8_WAIT_V(8); PG8_WAIT_L(0); PG8_BAR; PG8_MMA(1, 0, At, B0); PG8_MMA(1, 1, At, B1); PG8_BAR; PG8_SCHED;
            } else {
            PG8_LDB(B0, 0, 0); PG8_SCHED; PG8_LDA(At, 0, 0); PG8_STAGE(PG8_SA(1, 1), a1 + hstepA, voffA);
            PG8_WAIT_L(8); PG8_BAR; PG8_WAIT_L(0); PG8_MMA(0, 0, At, B0); PG8_BAR; PG8_SCHED;
            PG8_LDB(B1, 0, 1); PG8_STAGE(PG8_SB(0, 0), b2, voffB);
            PG8_BAR; PG8_WAIT_L(0); PG8_MMA(0, 1, At, B1); PG8_BAR;
            PG8_LDA(At, 0, 1); PG8_STAGE(PG8_SA(0, 0), a2, voffA);
            PG8_BAR; PG8_WAIT_L(0); PG8_MMA(1, 0, At, B0); PG8_BAR; PG8_SCHED;
            PG8_STAGE(PG8_SB(0, 1), b2 + hstepB, voffB);
            PG8_WAIT_V(6); PG8_BAR; PG8_MMA(1, 1, At, B1); PG8_BAR;
            PG8_LDB(B0, 1, 0); PG8_SCHED; PG8_LDA(At, 1, 0); PG8_STAGE(PG8_SA(0, 1), a2 + hstepA, voffA);
            PG8_WAIT_L(8); PG8_BAR; PG8_WAIT_L(0); PG8_MMA(0, 0, At, B0); PG8_BAR; PG8_SCHED;
            PG8_LDB(B1, 1, 1); PG8_STAGE(PG8_SB(1, 0), b3, voffB);
            PG8_BAR; PG8_WAIT_L(0); PG8_MMA(0, 1, At, B1); PG8_BAR;
            PG8_LDA(At, 1, 1); PG8_STAGE(PG8_SA(1, 0), a3, voffA);
            PG8_BAR; PG8_WAIT_L(0); PG8_MMA(1, 0, At, B0); PG8_BAR; PG8_SCHED;
            PG8_STAGE(PG8_SB(1, 1), b3 + hstepB, voffB);
            PG8_WAIT_V(6); PG8_BAR; PG8_MMA(1, 1, At, B1); PG8_BAR;
            }
        }
        if constexpr (ALIGN_EPI) { if (wr == 0) PG8_BAR; }
        if constexpr (!Epi::AFTER_DRAIN) { E(acc, cur, wr, wc, fr, fq); S.done(cur); }
        if (!has_next) break;
#pragma unroll
        for (int a = 0; a < 2; ++a)
#pragma unroll
            for (int b = 0; b < 2; ++b)
#pragma unroll
                for (int m = 0; m < 4; ++m)
#pragma unroll
                    for (int n = 0; n < 2; ++n) acc[a][b][m][n] = (f32x4){0.f, 0.f, 0.f, 0.f};
        cur = nxt; cA = nA; cB = nB; ++ui;
        if constexpr (ALIGN_EPI) { if (wr == 1) PG8_BAR; }
    }
    PG8_WAIT_V(0);
    if constexpr (!ALIGN_EPI) { if (wr == 0) PG8_BAR; }
    PG8_BAR;
    if constexpr (Epi::AFTER_DRAIN) { E.fused(acc, cur, wr, wc, fr, fq, lds, wid, lane); S.done(cur); }
#undef PG8_SA
#undef PG8_SB
#undef PG8_STAGE
#undef PG8_LDA
#undef PG8_LDB
#undef PG8_MMA
#undef PG8_WAIT_V
#undef PG8_WAIT_L
#undef PG8_BAR
#undef PG8_SCHED
}
}
using pg8::bf16_t; using pg8::f32x4; using pg8::u32x4; using pg8::u32x2; using pg8::Unit; using pg8::cvt_pk_bf16;

constexpr int D = 2048, NBATCH = 2, SEQ = 8192, CTXL = 256, DEPTH = 4;
constexpr int MX = NBATCH * SEQ;
constexpr int MC = NBATCH * CTXL;
constexpr int M = MX + MC;
constexpr int NE_IN = 9248, NE_INP = 9472, FF = 5632, AW = 1024;
constexpr int NWAVES = 8, NTHREADS = 512;
constexpr float LN_EPS = 1e-6f, DN_ALPHA = 1.681792830507429f;
constexpr float QSCALE = 0.08838834764831845f;

constexpr size_t MiB = 1u << 20;
constexpr size_t al256(size_t x) { return (x + 255) & ~(size_t)255; }
constexpr size_t WS_CTL = 0, CTL_ZERO_BYTES = 1 * MiB;
constexpr size_t WS_MOD = 1 * MiB;
constexpr size_t WS_LB = 2 * MiB;
constexpr size_t WS_PART = 3 * MiB;
constexpr size_t WS_W0 = 8 * MiB;
constexpr size_t SZ_WINE = (size_t)NE_INP * D * 2, SZ_WSQ = (size_t)D * D * 2, SZ_WINO = (size_t)2 * D * D * 2, SZ_WGATE = (size_t)8192 * 256 * 2, SZ_WGU = (size_t)2 * FF * D * 2, SZ_WDN = (size_t)D * FF * 2;
constexpr size_t WS_WINE = WS_W0;
constexpr size_t WS_WOUTE = WS_WINE + 2 * SZ_WINE;
constexpr size_t WS_WINO = WS_WOUTE + 2 * SZ_WSQ;
constexpr size_t WS_WGATE = WS_WINO + 2 * SZ_WINO;
constexpr size_t WS_WOUTO = WS_WGATE + 2 * SZ_WGATE;
constexpr size_t WS_WGU = WS_WOUTO + 2 * SZ_WSQ;
constexpr size_t WS_WDN = WS_WGU + 4 * SZ_WGU;
constexpr size_t WS_XA = al256(WS_WDN + 4 * SZ_WDN);
constexpr size_t SZ_F32ROW = (size_t)M * D * 4, SZ_BF16ROW = (size_t)M * D * 2, SZ_BF16HALF = (size_t)M * AW * 2;
constexpr size_t WS_Z = WS_XA + SZ_F32ROW;
constexpr size_t WS_HX = WS_Z + SZ_F32ROW;
constexpr size_t WS_MIX = WS_HX + SZ_BF16ROW;
constexpr size_t WS_MR = WS_MIX + SZ_BF16ROW;
constexpr size_t SZ_HRECS = (size_t)16896 * 9216, SZ_GRECS = (size_t)16896 * 17152;
constexpr size_t WS_HREC = WS_HX, WS_GREC = WS_HREC + SZ_HRECS;
constexpr size_t WS_QKVB = WS_MIX;
constexpr size_t WS_QA = al256(WS_GREC + SZ_GRECS), WS_VA = WS_QA + SZ_BF16HALF, WS_GA = WS_VA + SZ_BF16HALF, WS_ZB = WS_GA + SZ_BF16HALF;
constexpr size_t WS_LF = WS_ZB + SZ_BF16HALF;
constexpr size_t WS_GB = WS_LF + 2 * (size_t)M * AW * 4;
constexpr size_t WS_QB = WS_GB + (size_t)M * 32 * 4, WS_KB = WS_QB + SZ_BF16HALF, WS_VB = WS_KB + SZ_BF16HALF;
#ifdef EXP_B
constexpr size_t WS_OA = WS_HREC;
#else
constexpr size_t WS_OA = WS_LF;
#endif
constexpr size_t WS_OB = WS_OA + 2 * SZ_BF16HALF;
constexpr size_t WS_EVEN_END = WS_VB + SZ_BF16HALF;
#ifndef EXP_B
static_assert(WS_QKVB + (size_t)M * 3072 * 2 <= WS_QA && WS_OB + 2 * SZ_BF16HALF <= WS_GB, "even-layer overlays");
#endif
constexpr size_t WS_GY = WS_MR, WS_XBR = WS_GY + SZ_BF16ROW, WS_XC = WS_XBR + SZ_BF16ROW;
constexpr size_t WS_AB = WS_XC + SZ_BF16ROW;
constexpr size_t WS_R = WS_AB + 2 * (size_t)M * D * 4;
constexpr size_t WS_ODD_END = WS_R + 2 * SZ_BF16ROW;
constexpr size_t WS_ACT = WS_MR;
constexpr size_t WS_END = (WS_EVEN_END > WS_ODD_END ? WS_EVEN_END : WS_ODD_END);
static_assert(WS_ACT + (size_t)M * FF * 2 <= WS_END, "ACT fits the mixer region");
static_assert(WS_END <= (size_t)1536 * MiB, "workspace budget: d_ws is at least 4 x the largest input = 1536 MiB");
constexpr int CW_BAR = 4096;

constexpr int RING_OFF = 0, RING_BYTES = 131072;
constexpr int LDSCTL_OFF = RING_BYTES, MISC_OFF = LDSCTL_OFF + 320;
constexpr int LDS_BYTES = 147456;

#define GAS __attribute__((address_space(1)))
#define LAS __attribute__((address_space(3)))
typedef unsigned short bf16;
#define LDS_WAIT() asm volatile("s_waitcnt lgkmcnt(0)" ::: "memory")
#define VM_WAIT() asm volatile("s_waitcnt vmcnt(0)" ::: "memory")
__device__ __forceinline__ unsigned f2bf(float f) { unsigned u = __builtin_bit_cast(unsigned, f); return (u + 0x7fffu + ((u >> 16) & 1u)) >> 16; }
__device__ __forceinline__ unsigned pk2(float lo, float hi) { return f2bf(lo) | (f2bf(hi) << 16); }
__device__ __forceinline__ float bflo(unsigned u) { return __builtin_bit_cast(float, u << 16); }
__device__ __forceinline__ float bfhi(unsigned u) { return __builtin_bit_cast(float, u & 0xffff0000u); }
__device__ __forceinline__ float bf2f(bf16 h) { return __builtin_bit_cast(float, (unsigned)h << 16); }
__device__ __forceinline__ float sigm(float x) { return 1.f / (1.f + __expf(-x)); }
__device__ __forceinline__ float siluf(float x) { return x / (1.f + __expf(-x)); }
__device__ __forceinline__ float log1p_fast(float t) { const float p = t * (1.f + t * (-0.5f + t * (0.33333333f + t * (-0.25f + t * 0.2f)))); return t < 0.03f ? p : __logf(1.f + t); }
__device__ __forceinline__ float softplusf(float x) { return fmaxf(x, 0.f) + log1p_fast(__expf(-fabsf(x))); }
__device__ __forceinline__ float neg_expm1_fast(float x) { const float p = -x * (1.f + x * (0.5f + x * (0.16666667f + x * (0.041666668f + x * 0.0083333338f)))); return x > -0.25f ? p : 1.f - __expf(x); }
__device__ __forceinline__ float gelu_tanh(float x) { const float u = 0.7978845608028654f * (x + 0.044715f * x * x * x); return x / (1.f + __expf(-2.f * u)); }
__device__ __forceinline__ float wave_sum(float v) {
#pragma unroll
    for (int o = 1; o < 64; o <<= 1) v += __shfl_xor(v, o);
    return v;
}
__device__ __forceinline__ int mod_index(int row) { return row < SEQ ? 0 : (row < MX ? 1 : 2); }
__device__ __forceinline__ int perm_row(int r) { if (r >= MX) return r; const int b = r >> 13, t = r & 8191; return (b << 13) + ((t & 63) << 7) + (t >> 6); }
__device__ __forceinline__ int unperm_row(int r) { if (r >= MX) return r; const int b = r >> 13, i = r & 8191; return (b << 13) + ((i & 127) << 6) + (i >> 7); }
__device__ __forceinline__ int seq_row(int b, int dir, int s) {
    if (s < CTXL) { const int pos = dir ? (CTXL - 1 - s) : s; return MX + b * CTXL + pos; }
    const int p = s - CTXL, pos = dir ? (SEQ - 1 - p) : p; return b * SEQ + pos;
}
#define XB_TMO      128
#define XB_XCNT(j)  (256  + 64 * (j))
#define XB_XSUB(j)  (1280 + 64 * (j))
#define XB_XGEN(j)  (2304 + 64 * (j))
#define XB_TOP      3328
#define XB_TOPGEN   3392
#define XCD_BAR_WORDS 3456
#define XB_SPIN_CAP (1u << 18)

__device__ __forceinline__ unsigned xb_ld(unsigned* p)              { return __hip_atomic_load(p, __ATOMIC_RELAXED, __HIP_MEMORY_SCOPE_AGENT); }
__device__ __forceinline__ unsigned xb_add(unsigned* p, unsigned v) { return __hip_atomic_fetch_add(p, v, __ATOMIC_RELAXED, __HIP_MEMORY_SCOPE_AGENT); }
__device__ __forceinline__ unsigned xb_xcc_id() { return (unsigned)__builtin_amdgcn_s_getreg((3 << 11) | 20) & 0xFu; }
#define XB_SPIN(cond, bar) do { unsigned _sp = 0; while (cond) { __builtin_amdgcn_s_sleep(1); \
    if ((++_sp & 255u) == 0u) { if (xb_ld(&(bar)[XB_TMO])) break; if (_sp > XB_SPIN_CAP) { atomicAdd(&(bar)[XB_TMO], 1u); break; } } } } while (0)

struct XcdBarrier {
    unsigned* bar; unsigned x;
    volatile LAS unsigned* st;
};

__device__ __forceinline__ XcdBarrier xcd_barrier_post(unsigned* bar, volatile LAS unsigned* st) {
    XcdBarrier b; b.bar = bar; b.x = xb_xcc_id(); b.st = st;
    if (threadIdx.x == 0) (void)xb_add(&bar[XB_XCNT(b.x)], 1u);
    return b;
}
__device__ __forceinline__ void xcd_barrier_complete(unsigned* bar, unsigned x, unsigned& nloc, unsigned& nx) {
    const unsigned G = gridDim.x * gridDim.y * gridDim.z;
    unsigned sum, cnt, mine, sp = 0u;
    for (;;) {
        sum = 0u; cnt = 0u; mine = 0u;
#pragma unroll
        for (unsigned j = 0; j < 16; ++j) { const unsigned c = xb_ld(&bar[XB_XCNT(j)]); sum += c; cnt += (c > 0u) ? 1u : 0u; mine = (j == x) ? c : mine; }
        if (sum == G) break;
        __builtin_amdgcn_s_sleep(1);
        if ((++sp & 255u) == 0u) { if (xb_ld(&bar[XB_TMO])) break; if (sp > XB_SPIN_CAP) { atomicAdd(&bar[XB_TMO], 1u); break; } }
    }
    nloc = mine > 0u ? mine : 1u; nx = cnt > 0u ? cnt : 1u;
}

__device__ __forceinline__ void xcd_barrier(const XcdBarrier& b) {
    asm volatile("s_waitcnt vmcnt(0)" ::: "memory");
    __syncthreads();
    if (threadIdx.x == 0) {
        unsigned* bar = b.bar;
        __builtin_amdgcn_s_waitcnt(0);
        unsigned nloc = b.st[0], nx = b.st[1];
        if (nloc == 0u) { xcd_barrier_complete(bar, b.x, nloc, nx); b.st[0] = nloc; b.st[1] = nx; }
        const unsigned old = xb_add(&bar[XB_XSUB(b.x)], 1u);
        const unsigned gen = old / nloc;
        if (old + 1u == (gen + 1u) * nloc) {
            __builtin_amdgcn_fence(__ATOMIC_RELEASE, "agent");
            asm volatile("s_waitcnt vmcnt(0)" ::: "memory");
            const unsigned og = xb_add(&bar[XB_TOP], 1u);
            const unsigned tg = og / nx;
            if (og + 1u == (tg + 1u) * nx) xb_add(&bar[XB_TOPGEN], 1u);
            else XB_SPIN(xb_ld(&bar[XB_TOPGEN]) == tg, bar);
            __builtin_amdgcn_fence(__ATOMIC_ACQUIRE, "agent");
            xb_add(&bar[XB_XGEN(b.x)], 1u);
            asm volatile("s_waitcnt vmcnt(0)" ::: "memory");
        } else {
            XB_SPIN(xb_ld(&bar[XB_XGEN(b.x)]) == gen, bar);
            __builtin_amdgcn_fence(__ATOMIC_ACQUIRE, "agent");
            asm volatile("s_waitcnt vmcnt(0)" ::: "memory");
        }
    }
    __syncthreads();
}

struct EpiEven1 {
    static constexpr bool PERM = true, AFTER_DRAIN = false;
    bf16_t *QA, *VA, *GA, *ZB, *QKVB; float *LF, *GB; const float *lb, *a_log, *dt_bias;
    __device__ __forceinline__ void operator()(const f32x4 (&acc)[2][2][4][2], const Unit& u, int wr, int wc, int fr_, int fq_) const {
        int fr = fr_, fq = fq_; asm volatile("" : "+v"(fr), "+v"(fq));
        const int grp = u.pn >> 2, row0 = u.pm * 256 + wr * 64 + fr;
        if (grp == 9) {
            if (wc != 0) return;
            float al[8], db[8];
#pragma unroll
            for (int i = 0; i < 8; ++i) { const int c = (8 * fq + i) & 15; al[i] = -__expf(a_log[c]); db[i] = dt_bias[c]; }
#pragma unroll
            for (int ai = 0; ai < 2; ++ai)
#pragma unroll
                for (int m = 0; m < 4; ++m) { float* rowp = GB + (size_t)(row0 + ai * 128 + m * 16) * 32 + 8 * fq;
#pragma unroll
                    for (int n = 0; n < 2; ++n) { const f32x4 v = acc[ai][0][m][n]; f32x4 o;
#pragma unroll
                        for (int j = 0; j < 4; ++j) o[j] = (fq < 2) ? al[4 * n + j] * softplusf(v[j] + db[4 * n + j]) : sigm(v[j]);
                        *(f32x4*)(rowp + 4 * n) = o; } }
            return;
        }
        const int col0 = (u.pn & 3) * 256 + wc * 32 + 8 * fq;
        int op = 0, ld = 1024; bf16_t* dstb = VA; float* dstf = LF;
        switch (grp) {
            case 0: op = 2; dstb = QA; break;
            case 1: op = 0; dstb = VA; break;
            case 2: op = 3; dstf = LF; break;
            case 3: op = 3; dstf = LF + (size_t)M * 1024; break;
            case 4: op = 1; dstb = GA; break;
            case 5: case 6: case 7: op = 0; dstb = QKVB + (grp - 5) * 1024; ld = 3072; break;
            default: op = 1; dstb = ZB; break;
        }
        if (op == 3) {
#pragma unroll
            for (int bj = 0; bj < 2; ++bj) { float lbv[8];
#pragma unroll
                for (int i = 0; i < 8; ++i) lbv[i] = lb[col0 + bj * 128 + i];
#pragma unroll
                for (int ai = 0; ai < 2; ++ai)
#pragma unroll
                    for (int m = 0; m < 4; ++m) { float* rowp = dstf + (size_t)(row0 + ai * 128 + m * 16) * 1024 + col0 + bj * 128;
#pragma unroll
                        for (int n = 0; n < 2; ++n) { const f32x4 v = acc[ai][bj][m][n]; f32x4 o;
#pragma unroll
                            for (int j = 0; j < 4; ++j) { const float l = lbv[4 * n + j]; o[j] = __logf(l + (1.f - l) * sigm(v[j])); }
                            *(f32x4*)(rowp + 4 * n) = o; } } }
            return;
        }
#pragma unroll
        for (int ai = 0; ai < 2; ++ai)
#pragma unroll
            for (int m = 0; m < 4; ++m) { bf16_t* rowp = dstb + (size_t)(row0 + ai * 128 + m * 16) * ld + col0;
#pragma unroll
                for (int bj = 0; bj < 2; ++bj) { f32x4 v0 = acc[ai][bj][m][0], v1 = acc[ai][bj][m][1];
                    if (op >= 1) {
#pragma unroll
                        for (int j = 0; j < 4; ++j) { v0[j] = siluf(v0[j]); v1[j] = siluf(v1[j]); }
                        if (op == 2) { v0 = v0 * QSCALE; v1 = v1 * QSCALE; } }
                    u32x4 w; w.x = cvt_pk_bf16(v0[0], v0[1]); w.y = cvt_pk_bf16(v0[2], v0[3]); w.z = cvt_pk_bf16(v1[0], v1[1]); w.w = cvt_pk_bf16(v1[2], v1[3]);
                    *(u32x4*)(rowp + bj * 128) = w; } }
    }
};
struct EpiOdd1 {
    static constexpr bool PERM = true, AFTER_DRAIN = false;
    bf16_t *GY, *XBR;
    __device__ __forceinline__ void operator()(const f32x4 (&acc)[2][2][4][2], const Unit& u, int wr, int wc, int fr_, int fq_) const {
        int fr = fr_, fq = fq_; asm volatile("" : "+v"(fr), "+v"(fq));
        const int row0 = u.pm * 256 + wr * 64 + fr; const bool isy = u.pn < 8;
        bf16_t* dst = isy ? GY : XBR; const int col0 = (u.pn & 7) * 256 + wc * 32 + 8 * fq;
#pragma unroll
        for (int ai = 0; ai < 2; ++ai)
#pragma unroll
            for (int m = 0; m < 4; ++m) { bf16_t* rowp = dst + (size_t)(row0 + ai * 128 + m * 16) * D + col0;
#pragma unroll
                for (int bj = 0; bj < 2; ++bj) { f32x4 v0 = acc[ai][bj][m][0], v1 = acc[ai][bj][m][1];
                    if (isy) {
#pragma unroll
                        for (int j = 0; j < 4; ++j) { v0[j] = gelu_tanh(v0[j]); v1[j] = gelu_tanh(v1[j]); } }
                    u32x4 w; w.x = cvt_pk_bf16(v0[0], v0[1]); w.y = cvt_pk_bf16(v0[2], v0[3]); w.z = cvt_pk_bf16(v1[0], v1[1]); w.w = cvt_pk_bf16(v1[2], v1[3]);
                    *(u32x4*)(rowp + bj * 128) = w; } }
    }
};
struct EpiGates {
    static constexpr bool PERM = true, AFTER_DRAIN = false;
    const bf16_t* XC; unsigned* AB; const float *gate_b  , *lam  ;
    __device__ __forceinline__ void operator()(const f32x4 (&acc)[2][2][4][2], const Unit& u, int wr, int wc, int fr_, int fq_) const {
        int fr = fr_, fq = fq_; asm volatile("" : "+v"(fr), "+v"(fq));
        const int nb = u.pn >> 2, pn4 = u.pn & 3, d = pn4 >> 1, half = pn4 & 1;
        const int row0 = u.pm * 256 + wr * 64 + fr, ch0 = nb * 256 + half * 128 + wc * 32 + 8 * fq;
        unsigned* ab = AB + (size_t)d * M * D;
#pragma unroll
        for (int n = 0; n < 2; ++n) {
            const int ch = ch0 + 4 * n;
            const f32x4 gr = *(const f32x4*)(gate_b + (d * 2 + 0) * D + ch), gi = *(const f32x4*)(gate_b + (d * 2 + 1) * D + ch), lm = *(const f32x4*)(lam + d * D + ch);
            f32x4 sp;
#pragma unroll
            for (int j = 0; j < 4; ++j) sp[j] = -8.0f * softplusf(-lm[j]);
#pragma unroll
            for (int ai = 0; ai < 2; ++ai)
#pragma unroll
                for (int m = 0; m < 4; ++m) { const size_t ro = (size_t)(row0 + ai * 128 + m * 16) * D + ch;
                    const u32x2 xr = *(const u32x2*)(XC + ro); const float xc[4] = {bflo(xr.x), bfhi(xr.x), bflo(xr.y), bfhi(xr.y)};
                    u32x4 o;
#pragma unroll
                    for (int j = 0; j < 4; ++j) { const float r = sigm(acc[ai][0][m][n][j] + gr[j]), ig = sigm(acc[ai][1][m][n][j] + gi[j]);
                        const float la = r * sp[j], bb = __builtin_sqrtf(neg_expm1_fast(2.f * la)) * (ig * xc[j]); o[j] = pk2(la, bb); }
                    *(u32x4*)(ab + ro) = o; }
        }
    }
};
struct EpiResid {
    static constexpr bool PERM = false, AFTER_DRAIN = false;
    const float *r0, *r1; float* out; const float* gt; int permute;
    __device__ __forceinline__ void operator()(const f32x4 (&acc)[2][2][4][2], const Unit& u, int wr, int wc, int fr_, int fq_) const {
        int fr = fr_, fq = fq_; asm volatile("" : "+v"(fr), "+v"(fq));
        const int rowt = u.pm * 256, mi = mod_index(rowt), col0 = u.pn * 256 + wc * 32 + 4 * fq;
        f32x4 gv[2][2];
#pragma unroll
        for (int bj = 0; bj < 2; ++bj)
#pragma unroll
            for (int n = 0; n < 2; ++n) gv[bj][n] = *(const f32x4*)(gt + (size_t)mi * 12288 + col0 + bj * 128 + n * 16) + 1.0f;
#pragma unroll
        for (int ai = 0; ai < 2; ++ai)
#pragma unroll
            for (int m = 0; m < 4; ++m) { const int rr = rowt + ai * 128 + wr * 64 + m * 16 + fr, tok = permute ? unperm_row(rr) : rr;
                const float* rp = (tok < MX ? r0 + (size_t)tok * D : r1 + (size_t)(tok - MX) * D) + col0; float* op = out + (size_t)tok * D + col0;
#pragma unroll
                for (int bj = 0; bj < 2; ++bj)
#pragma unroll
                    for (int n = 0; n < 2; ++n) { const f32x4 rs = *(const f32x4*)(rp + bj * 128 + n * 16); *(f32x4*)(op + bj * 128 + n * 16) = rs * DN_ALPHA + gv[bj][n] * acc[ai][bj][m][n]; }
                asm volatile("" ::: "memory"); }
    }
};
struct EpiSwiGLU {
    static constexpr bool PERM = true, AFTER_DRAIN = false;
    bf16_t* ACT;
    __device__ __forceinline__ void operator()(const f32x4 (&acc)[2][2][4][2], const Unit& u, int wr, int wc, int fr_, int fq_) const {
        int fr = fr_, fq = fq_; asm volatile("" : "+v"(fr), "+v"(fq));
        const int row0 = u.pm * 256 + wr * 64 + fr, col0 = u.pn * 128 + wc * 32 + 8 * fq;
#pragma unroll
        for (int ai = 0; ai < 2; ++ai)
#pragma unroll
            for (int m = 0; m < 4; ++m) { f32x4 v0 = acc[ai][0][m][0], v1 = acc[ai][0][m][1]; const f32x4 u0 = acc[ai][1][m][0], u1 = acc[ai][1][m][1];
#pragma unroll
                for (int j = 0; j < 4; ++j) { v0[j] = siluf(v0[j]) * u0[j]; v1[j] = siluf(v1[j]) * u1[j]; }
                u32x4 w; w.x = cvt_pk_bf16(v0[0], v0[1]); w.y = cvt_pk_bf16(v0[2], v0[3]); w.z = cvt_pk_bf16(v1[0], v1[1]); w.w = cvt_pk_bf16(v1[2], v1[3]);
                *(u32x4*)(ACT + (size_t)(row0 + ai * 128 + m * 16) * FF + col0) = w; }
    }
};
struct Frame {
    LAS unsigned char* lds;
    int tid, lane, wave, G, gw, NGW;
};
struct Args { const float* in[25]; float* out; unsigned char* ws; int ph_lo, ph_hi; };

template <int MODE> __device__ __forceinline__ long src_off(int n, int nsrc) {
    if (MODE == 0) return n < nsrc ? (long)n : -1L;
    if (MODE == 1) { const int pn = n >> 8, bj = (n >> 7) & 1, jj = n & 127; return (long)bj * FF + pn * 128 + jj; }
    const int nb = n >> 10, c = n & 1023, pn4 = c >> 8, g = (c >> 7) & 1, jj = c & 127, d = pn4 >> 1, half = pn4 & 1;
    return (long)(((d * 2 + g) * 8 + nb) * 256) * 256 + half * 128 + jj;
}
template <int MODE> __device__ __forceinline__ void tr_item(const float* W, int ldin, int K, bf16* WT, int nout, int nsrc, LAS float* scr, int item, int lane) {
    const int nblk = nout / 32, kb = item / nblk, nb = item % nblk, k0 = 64 * kb, n0 = 32 * nb;
    const long off = src_off<MODE>(n0 + (lane & 31), nsrc);
#pragma unroll 8
    for (int i = 0; i < 32; ++i) { const int kk = 2 * i + (lane >> 5); scr[kk * 33 + (lane & 31)] = off >= 0 ? W[off + (size_t)(k0 + kk) * ldin] : 0.f; }
    LDS_WAIT(); asm volatile("" ::: "memory");
    const int c = lane & 7;
#pragma unroll
    for (int j = 0; j < 4; ++j) { const int n = (lane >> 3) + 8 * j; const LAS float* s = scr + (8 * c) * 33 + n;
        u32x4 o; o.x = pk2(s[0 * 33], s[1 * 33]); o.y = pk2(s[2 * 33], s[3 * 33]); o.z = pk2(s[4 * 33], s[5 * 33]); o.w = pk2(s[6 * 33], s[7 * 33]);
        *(u32x4*)(WT + (size_t)(n0 + n) * K + k0 + 8 * c) = o; }
    LDS_WAIT(); asm volatile("" ::: "memory");
}
__device__ __forceinline__ void gemv_item(const Args& a, int gi, int lane, float* PART) {
    const int l = gi / 384, c48 = (gi >> 3) % 48, kp = gi & 7, col = c48 * 256 + lane * 4;
    const float* W = a.in[4] + ((size_t)l * D + kp * 256) * 12288 + col;
    const float* c0 = a.in[1] + kp * 256; const float* c1 = c0 + D; const float* c2 = a.in[3] + kp * 256;
    f32x4 s0 = {0.f, 0.f, 0.f, 0.f}, s1 = s0, s2 = s0;
#pragma unroll 8
    for (int k = 0; k < 256; ++k) { const f32x4 w = *(const f32x4*)(W + (size_t)k * 12288); s0 += w * siluf(c0[k]); s1 += w * siluf(c1[k]); s2 += w * siluf(c2[k]); }
    float* p = PART + ((size_t)(kp * 4 + l) * 3) * 12288 + col;
    *(f32x4*)p = s0; *(f32x4*)(p + 12288) = s1; *(f32x4*)(p + 2 * 12288) = s2;
}
__device__ __forceinline__ void ph_prologue(Frame& F, const Args& a) {
    LAS float* scr = (LAS float*)(F.lds + RING_OFF + F.wave * 16384);
    unsigned char* ws = a.ws;
    constexpr int I_INE = (D / 64) * (NE_INP / 32), I_SQ = (D / 64) * (D / 32), I_INO = (D / 64) * (2 * D / 32), I_GATE = (256 / 64) * (8192 / 32), I_GU = (D / 64) * (2 * FF / 32), I_DN = (FF / 64) * (D / 32);
    constexpr int NGEMV = 4 * 48 * 8;
    constexpr int NITEMS = NGEMV + 2 * (I_INE + I_SQ + I_INO + I_GATE + I_SQ) + 4 * (I_GU + I_DN);
    for (int it = F.gw; it < NITEMS; it += F.NGW) {
        int r = it;
        if (r < NGEMV) { gemv_item(a, r, F.lane, (float*)(ws + WS_PART)); continue; } r -= NGEMV;
        bool done = false;
#pragma unroll 1
        for (int j = 0; j < 2 && !done; ++j) {
            if (r < I_INE) { tr_item<0>(a.in[10] + (size_t)j * D * NE_IN, NE_IN, D, (bf16*)(ws + WS_WINE + j * SZ_WINE), NE_INP, NE_IN, scr, r, F.lane); done = true; break; } r -= I_INE;
            if (r < I_SQ) { tr_item<0>(a.in[17] + (size_t)j * D * D, D, D, (bf16*)(ws + WS_WOUTE + j * SZ_WSQ), D, D, scr, r, F.lane); done = true; break; } r -= I_SQ;
            if (r < I_INO) { tr_item<0>(a.in[18] + (size_t)j * D * 2 * D, 2 * D, D, (bf16*)(ws + WS_WINO + j * SZ_WINO), 2 * D, 2 * D, scr, r, F.lane); done = true; break; } r -= I_INO;
            if (r < I_GATE) { tr_item<2>(a.in[21] + (size_t)j * 4 * 8 * 256 * 256, 256, 256, (bf16*)(ws + WS_WGATE + j * SZ_WGATE), 8192, 8192, scr, r, F.lane); done = true; break; } r -= I_GATE;
            if (r < I_SQ) { tr_item<0>(a.in[24] + (size_t)j * D * D, D, D, (bf16*)(ws + WS_WOUTO + j * SZ_WSQ), D, D, scr, r, F.lane); done = true; break; } r -= I_SQ;
        }
        if (done) continue;
#pragma unroll 1
        for (int l = 0; l < 4; ++l) {
            if (r < I_GU) { tr_item<1>(a.in[8] + (size_t)l * D * 2 * FF, 2 * FF, D, (bf16*)(ws + WS_WGU + l * SZ_WGU), 2 * FF, 2 * FF, scr, r, F.lane); break; } r -= I_GU;
            if (r < I_DN) { tr_item<0>(a.in[9] + (size_t)l * FF * D, D, FF, (bf16*)(ws + WS_WDN + l * SZ_WDN), D, D, scr, r, F.lane); break; } r -= I_DN;
        }
    }
}
__device__ __forceinline__ void ph_modreduce(Frame& F, const Args& a) {
    float* MOD = (float*)(a.ws + WS_MOD); const float* PART = (const float*)(a.ws + WS_PART); float* LB = (float*)(a.ws + WS_LB);
    const int gt = blockIdx.x * NTHREADS + F.tid, NT = F.G * NTHREADS;
    for (int i = gt; i < 4 * 3 * 12288; i += NT) { const int l = i / 36864, n = i % 12288; float s = a.in[5][l * 12288 + n];
#pragma unroll
        for (int kp = 0; kp < 8; ++kp) s += PART[(size_t)kp * 147456 + i];
        MOD[i] = s; }
    for (int i = gt; i < 2048; i += NT) { const int c = i & 1023; LB[i] = i < 1024 ? 0.f : sigm(a.in[14][1024 + c] - a.in[14][c]); }
}
__device__ __forceinline__ void store_hx(bf16* HX, int orow, const f32x4 (&v)[8], const float* sh, const float* sc, int lane) {
    unsigned long long* o8 = (unsigned long long*)(HX + (size_t)orow * D) + lane;
#pragma unroll
    for (int j = 0; j < 8; ++j) { const f32x4 s = *(const f32x4*)(sc + 4 * (lane + 64 * j)), h = *(const f32x4*)(sh + 4 * (lane + 64 * j)); const f32x4 y = v[j] * (s + 1.0f) + h;
        o8[64 * j] = (unsigned long long)pk2(y[0], y[1]) | ((unsigned long long)pk2(y[2], y[3]) << 32); }
}
__device__ __forceinline__ void ph_mod0(Frame& F, const Args& a) {
    const float* MOD = (const float*)(a.ws + WS_MOD); bf16* HX = (bf16*)(a.ws + WS_HX);
    for (int row = F.gw; row < M; row += F.NGW) {
        const float* p = row < MX ? a.in[0] + (size_t)row * D : a.in[2] + (size_t)(row - MX) * D; f32x4 v[8];
#pragma unroll
        for (int j = 0; j < 8; ++j) v[j] = *(const f32x4*)(p + 4 * (F.lane + 64 * j));
        const float* md = MOD + (size_t)mod_index(row) * 12288;
        store_hx(HX, row, v, md, md + D, F.lane);
    }
}
__device__ __forceinline__ void ph_ln(Frame& F, float* buf, int nrows, const float* g, const float* b, float* dout, bf16* HX, const float* modsh, const float* modsc, int permute) {
    for (int row0 = F.gw; row0 < nrows; row0 += 2 * F.NGW) {
        f32x4 v[2][8]; float s[2] = {0.f, 0.f}, q[2] = {0.f, 0.f};
#pragma unroll
        for (int u = 0; u < 2; ++u) { const int row = row0 + u * F.NGW; if (row < nrows) { const float* p = buf + (size_t)row * D;
#pragma unroll
            for (int jj = 0; jj < 8; ++jj) v[u][jj] = *(const f32x4*)(p + 4 * (F.lane + 64 * jj)); } else {
#pragma unroll
            for (int jj = 0; jj < 8; ++jj) v[u][jj] = (f32x4){0.f, 0.f, 0.f, 0.f}; } }
#pragma unroll
        for (int u = 0; u < 2; ++u)
#pragma unroll
            for (int jj = 0; jj < 8; ++jj) s[u] += (v[u][jj][0] + v[u][jj][1]) + (v[u][jj][2] + v[u][jj][3]);
#pragma unroll
        for (int u = 0; u < 2; ++u) { const float mean = wave_sum(s[u]) * (1.f / D);
#pragma unroll
            for (int jj = 0; jj < 8; ++jj) { v[u][jj] = v[u][jj] - mean; q[u] += (v[u][jj][0] * v[u][jj][0] + v[u][jj][1] * v[u][jj][1]) + (v[u][jj][2] * v[u][jj][2] + v[u][jj][3] * v[u][jj][3]); } }
#pragma unroll
        for (int u = 0; u < 2; ++u) { const int row = row0 + u * F.NGW; if (row >= nrows) continue;
            const float rstd = 1.f / sqrtf(wave_sum(q[u]) * (1.f / D) + LN_EPS);
            float* o = (dout ? dout : buf) + (size_t)row * D;
#pragma unroll
            for (int jj = 0; jj < 8; ++jj) { const f32x4 gg = *(const f32x4*)(g + 4 * (F.lane + 64 * jj)), bb = *(const f32x4*)(b + 4 * (F.lane + 64 * jj)); v[u][jj] = v[u][jj] * rstd * gg + bb; *(f32x4*)(o + 4 * (F.lane + 64 * jj)) = v[u][jj]; }
            if (HX) { const int mi = mod_index(row); store_hx(HX, permute ? perm_row(row) : row, v[u], modsh + (size_t)mi * 12288, modsc + (size_t)mi * 12288, F.lane); } }
    }
}
__device__ __forceinline__ void seg_bounds(int r, int& lo, int& hi) { if (r < MX) { lo = r & ~(SEQ - 1); hi = lo + SEQ; } else { lo = MX + ((r - MX) & ~(CTXL - 1)); hi = lo + CTXL; } }
__device__ __forceinline__ float row16_sum(float v) { v += __shfl_xor(v, 1); v += __shfl_xor(v, 2); v += __shfl_xor(v, 4); v += __shfl_xor(v, 8); return v; }
template <int MODE> __device__ __forceinline__ void ph_conv(Frame& F, const Args& a, int j) {
    constexpr int NG = MODE == 0 ? 6 : 4, LDI = MODE == 0 ? 3072 : D;
    const bf16* X = (const bf16*)(a.ws + (MODE == 0 ? WS_QKVB : WS_XBR));
    const float* cw = MODE == 0 ? a.in[11] + (size_t)j * 4 * 3072 : a.in[19] + (size_t)j * 4 * D;
    for (int it = F.gw; it < (M / 16) * NG; it += F.NGW) {
        const int si = it / NG, kg = it - si * NG, r0 = si * 16, ch = kg * 512 + 8 * F.lane;
        int lo, hi; seg_bounds(r0, lo, hi);
        float w[4][8];
#pragma unroll
        for (int k = 0; k < 4; ++k) { const f32x4 w0 = *(const f32x4*)(cw + k * LDI + ch), w1 = *(const f32x4*)(cw + k * LDI + ch + 4);
#pragma unroll
            for (int c = 0; c < 4; ++c) { w[k][c] = w0[c]; w[k][4 + c] = w1[c]; } }
        float bias[8];
#pragma unroll
        for (int c = 0; c < 8; ++c) bias[c] = 0.f;
        if (MODE == 1) { const float* cb = a.in[20] + (size_t)j * D + ch; const f32x4 b0 = *(const f32x4*)cb, b1 = *(const f32x4*)(cb + 4);
#pragma unroll
            for (int c = 0; c < 4; ++c) { bias[c] = b0[c]; bias[4 + c] = b1[c]; } }
        u32x4 xr[19];
#pragma unroll
        for (int r = 0; r < 19; ++r) { const int rr = r0 + r - 2; xr[r] = (rr >= lo && rr < hi) ? *(const u32x4*)(X + (size_t)rr * LDI + ch) : (u32x4){0u, 0u, 0u, 0u}; }
#pragma unroll
        for (int r = 0; r < 16; ++r) { float y[8];
#pragma unroll
            for (int c = 0; c < 8; ++c) y[c] = bias[c];
#pragma unroll
            for (int k = 0; k < 4; ++k) { const u32x4 x = xr[r + k];
#pragma unroll
                for (int c = 0; c < 4; ++c) { y[2 * c] += w[k][2 * c] * bflo(x[c]); y[2 * c + 1] += w[k][2 * c + 1] * bfhi(x[c]); } }
            const int row = r0 + r;
            if (MODE == 0) {
#pragma unroll
                for (int c = 0; c < 8; ++c) y[c] = siluf(y[c]);
                if (kg < 4) { float ss = 0.f;
#pragma unroll
                    for (int c = 0; c < 8; ++c) ss += y[c] * y[c];
                    const float sc = rsqrtf(row16_sum(ss) + 1e-6f) * (kg < 2 ? QSCALE : 1.f);
#pragma unroll
                    for (int c = 0; c < 8; ++c) y[c] *= sc; }
                bf16* dst = (bf16*)(a.ws + (kg < 2 ? WS_QB : (kg < 4 ? WS_KB : WS_VB))) + (size_t)row * AW + (kg & 1) * 512 + 8 * F.lane;
                *(u32x4*)dst = (u32x4){pk2(y[0], y[1]), pk2(y[2], y[3]), pk2(y[4], y[5]), pk2(y[6], y[7])};
            } else {
                *(u32x4*)((bf16*)(a.ws + WS_XC) + (size_t)row * D + ch) = (u32x4){pk2(y[0], y[1]), pk2(y[2], y[3]), pk2(y[4], y[5]), pk2(y[6], y[7])};
            } }
    }
}
__device__ __forceinline__ void ph_merge(Frame& F, const Args& a, int j) {
    bf16* MIX = (bf16*)(a.ws + WS_MIX);
    for (int row = F.gw; row < M; row += F.NGW) {
        u32x4 o0[4], o1[4], gg[4];
#pragma unroll
        for (int q = 0; q < 4; ++q) { const int part = q >> 1, c = (q & 1) * 512 + 8 * F.lane; const bf16* O = (const bf16*)(a.ws + (part ? WS_OB : WS_OA)); const size_t o = (size_t)row * AW + c;
            o0[q] = *(const u32x4*)(O + o); o1[q] = *(const u32x4*)(O + (size_t)M * AW + o); gg[q] = *(const u32x4*)((const bf16*)(a.ws + (part ? WS_ZB : WS_GA)) + o); }
#pragma unroll
        for (int q = 0; q < 4; ++q) { const int part = q >> 1, c = (q & 1) * 512 + 8 * F.lane; const float* nw = (part ? a.in[16] : a.in[15]) + (size_t)j * AW + c;
            const f32x4 n0 = *(const f32x4*)nw, n1 = *(const f32x4*)(nw + 4); float y[8]; float ss = 0.f;
#pragma unroll
            for (int k = 0; k < 4; ++k) { y[2 * k] = bflo(o0[q][k]) + bflo(o1[q][k]); y[2 * k + 1] = bfhi(o0[q][k]) + bfhi(o1[q][k]); ss += y[2 * k] * y[2 * k] + y[2 * k + 1] * y[2 * k + 1]; }
            const float sc = rsqrtf(row16_sum(ss) * (1.f / 128.f) + 1e-6f);
#pragma unroll
            for (int k = 0; k < 4; ++k) { y[2 * k] *= sc * (k < 2 ? n0[2 * k] : n1[2 * k - 4]) * bflo(gg[q][k]); y[2 * k + 1] *= sc * (k < 2 ? n0[2 * k + 1] : n1[2 * k - 3]) * bfhi(gg[q][k]); }
            *(u32x4*)(MIX + (size_t)row * D + part * AW + c) = (u32x4){pk2(y[0], y[1]), pk2(y[2], y[3]), pk2(y[4], y[5]), pk2(y[6], y[7])}; }
    }
}
__device__ __forceinline__ void ph_odd_l1(Frame& F, const Args& a) {
    const unsigned* AB = (const unsigned*)(a.ws + WS_AB); float2* PH = (float2*)(a.ws + WS_R);
    for (int it = F.gw; it < 128 * 132; it += F.NGW) {
        const int cgp = it & 127, tc = it >> 7, c = cgp * 64 + F.lane, ch = c & 2047, d = (c >> 11) & 1, b = c >> 12;
        const unsigned* ab = AB + (size_t)d * M * D + ch; float P = 1.f, H = 0.f;
        const int row0 = seq_row(b, d, tc * 64), stp = d ? -1 : 1;
#pragma unroll 1
        for (int k0 = 0; k0 < 64; k0 += 16) { unsigned x[16];
#pragma unroll
            for (int k = 0; k < 16; ++k) x[k] = ab[(size_t)(row0 + stp * (k0 + k)) * D];
#pragma unroll
            for (int k = 0; k < 16; ++k) { const float al = __expf(bflo(x[k])); P *= al; H = al * H + bfhi(x[k]); } }
        PH[(size_t)tc * 8192 + c] = make_float2(P, H);
    }
}
__device__ __forceinline__ void ph_odd_l3(Frame& F, const Args& a) {
    const unsigned* AB = (const unsigned*)(a.ws + WS_AB); const float2* PH = (const float2*)(a.ws + WS_R); const bf16* GY = (const bf16*)(a.ws + WS_GY); bf16* MIX = (bf16*)(a.ws + WS_MIX);
    for (int it = F.gw; it < 64 * 132; it += F.NGW) {
        const int g64 = it & 63, jb = it >> 6, b = g64 >> 5, ch = (g64 & 31) * 64 + F.lane;
        const int row0 = jb < 4 ? MX + b * CTXL + jb * 64 : b * SEQ + (jb - 4) * 64;
        const int tcf = jb, tcb = jb < 4 ? 3 - jb : 4 + (131 - jb);
        const int cf = (b << 12) + ch, cb = (b << 12) + 2048 + ch;
        float hf = 0.f, hb = 0.f;
        for (int q = 0; q < tcf; ++q) { const float2 p = PH[(size_t)q * 8192 + cf]; hf = p.x * hf + p.y; }
        for (int q = 0; q < tcb; ++q) { const float2 p = PH[(size_t)q * 8192 + cb]; hb = p.x * hb + p.y; }
        const unsigned* ab0 = AB + (size_t)row0 * D + ch; const unsigned* ab1 = ab0 + (size_t)M * D;
        float hs[64];
#pragma unroll
        for (int k0 = 0; k0 < 64; k0 += 16) { unsigned x[16];
#pragma unroll
            for (int k = 0; k < 16; ++k) x[k] = ab0[(size_t)(k0 + k) * D];
#pragma unroll
            for (int k = 0; k < 16; ++k) { hf = __expf(bflo(x[k])) * hf + bfhi(x[k]); hs[k0 + k] = hf; } }
        const bf16* gy = GY + (size_t)row0 * D + ch; bf16* mx = MIX + (size_t)row0 * D + ch;
#pragma unroll
        for (int k0 = 48; k0 >= 0; k0 -= 16) { unsigned x[16]; bf16 gv[16];
#pragma unroll
            for (int k = 0; k < 16; ++k) { x[k] = ab1[(size_t)(k0 + k) * D]; gv[k] = gy[(size_t)(k0 + k) * D]; }
#pragma unroll
            for (int k = 15; k >= 0; --k) { hb = __expf(bflo(x[k])) * hb + bfhi(x[k]); mx[(size_t)(k0 + k) * D] = (bf16)f2bf(bf2f(gv[k]) * (hs[k0 + k] + hb)); } }
    }
}
__device__ __forceinline__ void hgrn_wave(int wi, int lane, const bf16* QA, const float* LF, const bf16* VA, bf16* OA) {
    const int chain = wi >> 3, cg = wi & 7, b = chain >> 4, h = (chain >> 1) & 7, dir = chain & 1, kq = lane >> 4, col = cg * 16 + (lane & 15);
    const float* lf = LF + (size_t)dir * M * AW + h * 128 + kq * 32; const bf16* qa = QA + h * 128 + kq * 32; const bf16* va = VA + h * 128 + col; bf16* oa = OA + (size_t)dir * M * AW + h * 128 + col;
    float S[32];
#pragma unroll
    for (int i = 0; i < 32; ++i) S[i] = 0.f;
    u32x4 qn[4]; f32x4 fn[8]; float vn; int rown = seq_row(b, dir, 0);
#pragma unroll
    for (int i = 0; i < 4; ++i) qn[i] = *(const u32x4*)(qa + (size_t)rown * AW + 8 * i);
#pragma unroll
    for (int i = 0; i < 8; ++i) fn[i] = *(const f32x4*)(lf + (size_t)rown * AW + 4 * i);
    vn = bf2f(va[(size_t)rown * AW]);
    for (int s = 0; s < CTXL + SEQ; ++s) {
        u32x4 qc[4]; f32x4 fc[8]; const float vc = vn; const int row = rown;
#pragma unroll
        for (int i = 0; i < 4; ++i) qc[i] = qn[i];
#pragma unroll
        for (int i = 0; i < 8; ++i) fc[i] = fn[i];
        if (s + 1 < CTXL + SEQ) { rown = seq_row(b, dir, s + 1);
#pragma unroll
            for (int i = 0; i < 4; ++i) qn[i] = *(const u32x4*)(qa + (size_t)rown * AW + 8 * i);
#pragma unroll
            for (int i = 0; i < 8; ++i) fn[i] = *(const f32x4*)(lf + (size_t)rown * AW + 4 * i);
            vn = bf2f(va[(size_t)rown * AW]); }
        float o = 0.f;
#pragma unroll
        for (int i = 0; i < 32; ++i) { const float f = __expf(fc[i >> 2][i & 3]); const unsigned qw = qc[i >> 3][(i >> 1) & 3]; const float q = (i & 1) ? bfhi(qw) : bflo(qw);
            S[i] = f * (S[i] - vc) + vc; o += S[i] * q; }
        o += __shfl_xor(o, 16); o += __shfl_xor(o, 32);
        if (kq == 0) oa[(size_t)row * AW] = (bf16)f2bf(o);
    }
}
__device__ __forceinline__ void gdn_wave(int wi, int lane, const bf16* QB, const bf16* KB, const bf16* VB, const float* GB, bf16* OB) {
    const int chain = wi >> 3, cg = wi & 7, b = chain >> 4, h = (chain >> 1) & 7, dir = chain & 1, kq = lane >> 4, col = cg * 16 + (lane & 15);
    const bf16* qb = QB + h * 128 + kq * 32; const bf16* kb = KB + h * 128 + kq * 32; const bf16* vb = VB + h * 128 + col; const float* gb = GB + dir * 8 + h; bf16* ob = OB + (size_t)dir * M * AW + h * 128 + col;
    float S[32];
#pragma unroll
    for (int i = 0; i < 32; ++i) S[i] = 0.f;
    u32x4 qn[4], kn[4]; float vn, gn, bn; int rown = seq_row(b, dir, 0);
#pragma unroll
    for (int i = 0; i < 4; ++i) { qn[i] = *(const u32x4*)(qb + (size_t)rown * AW + 8 * i); kn[i] = *(const u32x4*)(kb + (size_t)rown * AW + 8 * i); }
    vn = bf2f(vb[(size_t)rown * AW]); gn = gb[(size_t)rown * 32]; bn = gb[(size_t)rown * 32 + 16];
    for (int s = 0; s < CTXL + SEQ; ++s) {
        u32x4 qc[4], kc[4]; const float vc = vn, gc = gn, bc = bn; const int row = rown;
#pragma unroll
        for (int i = 0; i < 4; ++i) { qc[i] = qn[i]; kc[i] = kn[i]; }
        if (s + 1 < CTXL + SEQ) { rown = seq_row(b, dir, s + 1);
#pragma unroll
            for (int i = 0; i < 4; ++i) { qn[i] = *(const u32x4*)(qb + (size_t)rown * AW + 8 * i); kn[i] = *(const u32x4*)(kb + (size_t)rown * AW + 8 * i); }
            vn = bf2f(vb[(size_t)rown * AW]); gn = gb[(size_t)rown * 32]; bn = gb[(size_t)rown * 32 + 16]; }
        const float al = __expf(gc); float ks = 0.f; float kk[32];
#pragma unroll
        for (int i = 0; i < 32; ++i) { const unsigned kw = kc[i >> 3][(i >> 1) & 3]; kk[i] = (i & 1) ? bfhi(kw) : bflo(kw); ks += kk[i] * S[i]; }
        ks += __shfl_xor(ks, 16); ks += __shfl_xor(ks, 32);
        const float dl = bc * (vc - al * ks); float o = 0.f;
#pragma unroll
        for (int i = 0; i < 32; ++i) { const unsigned qw = qc[i >> 3][(i >> 1) & 3]; const float q = (i & 1) ? bfhi(qw) : bflo(qw); S[i] = al * S[i] + kk[i] * dl; o += S[i] * q; }
        o += __shfl_xor(o, 16); o += __shfl_xor(o, 32);
        if (kq == 0) ob[(size_t)row * AW] = (bf16)f2bf(o);
    }
}
__device__ __forceinline__ void ph_even_scan(Frame& F, const Args& a) {
    unsigned char* ws = a.ws;
    if (F.wave == 0) { for (int wi = blockIdx.x; wi < 256; wi += F.G) hgrn_wave(wi, F.lane, (const bf16*)(ws + WS_QA), (const float*)(ws + WS_LF), (const bf16*)(ws + WS_VA), (bf16*)(ws + WS_OA)); }
    else if (F.wave == 1) { for (int wi = blockIdx.x; wi < 256; wi += F.G) gdn_wave(wi, F.lane, (const bf16*)(ws + WS_QB), (const bf16*)(ws + WS_KB), (const bf16*)(ws + WS_VB), (const float*)(ws + WS_GB), (bf16*)(ws + WS_OB)); }
}
typedef short bf16x8 __attribute__((ext_vector_type(8)));
typedef short bf16x4 __attribute__((ext_vector_type(4)));
constexpr int NCHUNK = (CTXL + SEQ) / 16;
constexpr int NCHH = 32 * NCHUNK;
constexpr int HREC = 9216;
constexpr int HQ_OFF = 0, HK_OFF = 4096, HP_OFF = 8192, HD_OFF = 8704;
constexpr int GREC = 17152;
constexpr int GW_OFF = 0, GQ_OFF = 4096, GK_OFF = 8192, GU_OFF = 12288, GAT_OFF = 16384, GAL_OFF = 16896;
__device__ __forceinline__ unsigned cvtpk(float lo, float hi) { return pg8::cvt_pk_bf16(lo, hi); }
template <int N> __device__ __forceinline__ float row_shr(float x) { return __builtin_bit_cast(float, __builtin_amdgcn_update_dpp(0, __builtin_bit_cast(int, x), 0x110 + N, 0xf, 0xf, true)); }
__device__ __forceinline__ float row_prefix(float x) { x += row_shr<1>(x); x += row_shr<2>(x); x += row_shr<4>(x); x += row_shr<8>(x); return x; }
__device__ __forceinline__ float rdlane(float x, int l) { return __builtin_bit_cast(float, __builtin_amdgcn_readlane(__builtin_bit_cast(int, x), l)); }
__device__ __forceinline__ bf16x8 mk8(unsigned a, unsigned b, unsigned c, unsigned d) { return __builtin_bit_cast(bf16x8, (u32x4){a, b, c, d}); }
__device__ __forceinline__ bf16x4 mk4(unsigned a, unsigned b) { return __builtin_bit_cast(bf16x4, (u32x2){a, b}); }
__device__ __forceinline__ f32x4 mfma32_safe(bf16x8 a, bf16x8 b, f32x4 c) { f32x4 d = __builtin_amdgcn_mfma_f32_16x16x32_bf16(a, b, c, 0, 0, 0); asm volatile("" : "+v"(d) : "v"(a), "v"(b)); return d; }
#define MFMA32(a, b, c) mfma32_safe((a), (b), (c))
#define MFMA16(a, b, c) __builtin_amdgcn_mfma_f32_16x16x16bf16_1k((a), (b), (c), 0, 0, 0)

__device__ __forceinline__ void hgrn_s1(int chh, int lane, unsigned char* ws) {
    const int chain = chh / NCHUNK, ci = chh - chain * NCHUNK, b = chain >> 4, h = (chain >> 1) & 7, dir = chain & 1, i = lane & 15, g = lane >> 4;
    const int row = seq_row(b, dir, ci * 16 + i);
    const bf16* qrow = (const bf16*)(ws + WS_QA) + (size_t)row * AW + h * 128 + 4 * g;
    const float* frow = (const float*)(ws + WS_LF) + (size_t)dir * M * AW + (size_t)row * AW + h * 128 + 4 * g;
    unsigned char* rec = ws + WS_HREC + (size_t)chh * HREC;
    bf16* hk = (bf16*)(rec + HK_OFF) + (16 * (i >> 2)) * 4 + (i & 3);
    f32x4 pacc = {0.f, 0.f, 0.f, 0.f};
#pragma unroll
    for (int s = 0; s < 4; ++s) {
        u32x2 qv[2]; f32x4 fv[2];
#pragma unroll
        for (int hh = 0; hh < 2; ++hh) { qv[hh] = *(const u32x2*)(qrow + 32 * s + 16 * hh); fv[hh] = *(const f32x4*)(frow + 32 * s + 16 * hh); }
        float qt[8], kh[8];
#pragma unroll
        for (int hh = 0; hh < 2; ++hh) { f32x4 ddv;
#pragma unroll
            for (int j = 0; j < 4; ++j) { const int idx = 4 * hh + j; const float lf = fv[hh][j], gc = row_prefix(lf), gl = __shfl(gc, (lane & 48) | 15);
                const float eg = __expf(gc), einv = __builtin_amdgcn_rcpf(eg), f = __expf(lf), dd = __expf(gl);
                const unsigned qw = qv[hh][j >> 1]; const float q = (j & 1) ? bfhi(qw) : bflo(qw);
                qt[idx] = q * eg; kh[idx] = (1.f - f) * einv; ddv[j] = dd;
                hk[((2 * s + hh) * 64 + 4 * g + j) * 4] = (bf16)f2bf(kh[idx] * dd); }
            if (i == 0) *(f32x4*)(rec + HD_OFF + (32 * s + 16 * hh + 4 * g) * 4) = ddv; }
        const bf16x8 Qf = mk8(cvtpk(qt[0], qt[1]), cvtpk(qt[2], qt[3]), cvtpk(qt[4], qt[5]), cvtpk(qt[6], qt[7]));
        const bf16x8 Kf = mk8(cvtpk(kh[0], kh[1]), cvtpk(kh[2], kh[3]), cvtpk(kh[4], kh[5]), cvtpk(kh[6], kh[7]));
        *(bf16x8*)(rec + HQ_OFF + (s * 64 + lane) * 16) = Qf;
        pacc = MFMA32(Kf, Qf, pacc);
    }
    float p[4];
#pragma unroll
    for (int r = 0; r < 4; ++r) p[r] = (4 * g + r <= i) ? pacc[r] : 0.f;
    *(bf16x4*)(rec + HP_OFF + lane * 8) = mk4(cvtpk(p[0], p[1]), cvtpk(p[2], p[3]));
}

__device__ __forceinline__ void gdn_s1(int chh, int lane, unsigned char* ws) {
    const int chain = chh / NCHUNK, ci = chh - chain * NCHUNK, b = chain >> 4, h = (chain >> 1) & 7, dir = chain & 1, i = lane & 15, g = lane >> 4;
    const int row = seq_row(b, dir, ci * 16 + i), row0 = seq_row(b, dir, ci * 16), stp = dir ? -1 : 1;
    const float* GB = (const float*)(ws + WS_GB);
    const float gval = GB[(size_t)row * 32 + dir * 8 + h], beta = GB[(size_t)row * 32 + 16 + dir * 8 + h];
    const float gc = row_prefix(gval), gl = __shfl(gc, (lane & 48) | 15), eg = __expf(gc), ekl = __expf(gl - gc);
    const bf16* qrow = (const bf16*)(ws + WS_QB) + (size_t)row * AW + h * 128 + 4 * g;
    const bf16* krow = (const bf16*)(ws + WS_KB) + (size_t)row * AW + h * 128 + 4 * g;
    unsigned char* rec = ws + WS_GREC + (size_t)chh * GREC;
    f32x4 kkacc = {0.f, 0.f, 0.f, 0.f}, qkacc = {0.f, 0.f, 0.f, 0.f};
#pragma unroll
    for (int s = 0; s < 4; ++s) {
        u32x2 qv[2], kv[2];
#pragma unroll
        for (int hh = 0; hh < 2; ++hh) { qv[hh] = *(const u32x2*)(qrow + 32 * s + 16 * hh); kv[hh] = *(const u32x2*)(krow + 32 * s + 16 * hh); }
        const bf16x8 Kf = mk8(kv[0].x, kv[0].y, kv[1].x, kv[1].y), Qf = mk8(qv[0].x, qv[0].y, qv[1].x, qv[1].y);
        kkacc = MFMA32(Kf, Kf, kkacc);
        qkacc = MFMA32(Kf, Qf, qkacc);
        unsigned qs[4];
#pragma unroll
        for (int w = 0; w < 4; ++w) { const unsigned qw = qv[w >> 1][w & 1]; qs[w] = cvtpk(bflo(qw) * eg, bfhi(qw) * eg); }
        *(bf16x8*)(rec + GQ_OFF + (s * 64 + lane) * 16) = mk8(qs[0], qs[1], qs[2], qs[3]);
    }
    float att[4], Areg[4];
#pragma unroll
    for (int r = 0; r < 4; ++r) { const float gcs = __shfl(gc, 4 * g + r), bts = __shfl(beta, 4 * g + r);
        att[r] = (4 * g + r <= i) ? qkacc[r] * __expf(gc - gcs) : 0.f;
        Areg[r] = (i < 4 * g + r) ? bts * kkacc[r] * __expf(gcs - gc) : 0.f; }
    *(bf16x4*)(rec + GAT_OFF + lane * 8) = mk4(cvtpk(att[0], att[1]), cvtpk(att[2], att[3]));
    if (lane == 0) *(float*)(rec + GAL_OFF) = __expf(gl);
    float xu[16][2], xw[16][2], kt[16][2];
    const bf16* vcol = (const bf16*)(ws + WS_VB) + h * 128 + 2 * lane; const bf16* kcol = (const bf16*)(ws + WS_KB) + h * 128 + 2 * lane;
#pragma unroll
    for (int t = 0; t < 16; ++t) { const size_t ro = (size_t)(row0 + stp * t) * AW; const unsigned vv = *(const unsigned*)(vcol + ro), kv = *(const unsigned*)(kcol + ro);
        const float bt = rdlane(beta, t), egt = rdlane(eg, t), et = rdlane(ekl, t), k0 = bflo(kv), k1 = bfhi(kv);
        xu[t][0] = bt * bflo(vv); xu[t][1] = bt * bfhi(vv); xw[t][0] = bt * egt * k0; xw[t][1] = bt * egt * k1; kt[t][0] = k0 * et; kt[t][1] = k1 * et; }
#pragma unroll
    for (int t = 1; t < 16; ++t)
#pragma unroll
        for (int s = 0; s < t; ++s) { const float a = rdlane(Areg[t & 3], s + 16 * (t >> 2));
            xu[t][0] -= a * xu[s][0]; xu[t][1] -= a * xu[s][1]; xw[t][0] -= a * xw[s][0]; xw[t][1] -= a * xw[s][1]; }
#pragma unroll
    for (int e = 0; e < 2; ++e) { const int c = 2 * lane + e, t16 = c >> 4, m = c & 15;
        const int ks = c >> 5, slot = 4 * ((c >> 4) & 1) + (c & 3), gq = (c >> 2) & 3;
#pragma unroll
        for (int gp = 0; gp < 4; ++gp) {
            *(u32x2*)(rec + GU_OFF + ((t16 * 64 + m + 16 * gp) * 4) * 2) = (u32x2){cvtpk(xu[4 * gp][e], xu[4 * gp + 1][e]), cvtpk(xu[4 * gp + 2][e], xu[4 * gp + 3][e])};
            *(u32x2*)(rec + GK_OFF + ((t16 * 64 + m + 16 * gp) * 4) * 2) = (u32x2){cvtpk(kt[4 * gp][e], kt[4 * gp + 1][e]), cvtpk(kt[4 * gp + 2][e], kt[4 * gp + 3][e])}; }
#pragma unroll
        for (int t = 0; t < 16; ++t) *(bf16*)(rec + GW_OFF + (((ks * 64 + t + 16 * gq) * 8) + slot) * 2) = (bf16)f2bf(xw[t][e]); }
}
__device__ __forceinline__ void ph_even_s1(Frame& F, const Args& a) {
    for (int chh = F.gw; chh < NCHH; chh += F.NGW) {
#ifndef EXP_B
        hgrn_s1(chh, F.lane, a.ws);
#endif
#ifndef EXP_A
        gdn_s1(chh, F.lane, a.ws);
#endif
    }
}

typedef float f32x2v __attribute__((ext_vector_type(2)));
constexpr int S2_NR = 8, S2_SLOT = 14336, S2_ORING = S2_NR * S2_SLOT, S2_CTL = S2_ORING + 2 * 4096;
static_assert(S2_CTL + 256 <= RING_BYTES, "S2 LDS map");
constexpr int GS_ATT = 12288, GS_U = 12800, GS_AL = 13824;
constexpr int HS_V = 9216;
#define S2_SPIN(cond) do { while (cond) __builtin_amdgcn_s_sleep(1); asm volatile("" ::: "memory"); } while (0)
#define DMA16(g, l) __builtin_amdgcn_global_load_lds((const unsigned*)(g), (LAS unsigned*)(l), 16, 0, 0)
#define DMA4(g, l) __builtin_amdgcn_global_load_lds((const unsigned*)(g), (LAS unsigned*)(l), 4, 0, 0)
template <int MIXER, int L> __device__ __forceinline__ void s2_loader(int chain, int vs0, int lane, unsigned char* ws, LAS unsigned char* lds) {
    const int b = chain >> 4, h = (chain >> 1) & 7, dir = chain & 1, stp = dir ? -1 : 1;
    constexpr int RS = MIXER == 0 ? GREC : HREC;
    constexpr int NP = MIXER == 0 ? (L < 2 ? 4 : 3) : (L == 0 ? 3 : (L == 1 ? 2 : 4));
    const unsigned char* recs = ws + (MIXER == 0 ? WS_GREC : WS_HREC) + (size_t)chain * NCHUNK * RS;
    const bf16* va = (const bf16*)(ws + WS_VA) + h * 128 + (vs0 + (L & 1)) * 16;
    volatile LAS unsigned* ctl = (volatile LAS unsigned*)(lds + S2_CTL);
#pragma unroll 1
    for (int c = 0; c < NCHUNK; ++c) {
        S2_SPIN((int)min(ctl[4], ctl[5]) + S2_NR <= c);
        const unsigned char* r = recs + (size_t)c * RS; LAS unsigned char* slot = lds + (c & (S2_NR - 1)) * S2_SLOT;
        if (MIXER == 0) {
#pragma unroll
            for (int p = L; p < 12; p += 4) DMA16(r + p * 1024 + lane * 16, slot + p * 1024);
            if (L == 0) DMA16(lane < 32 ? r + GAT_OFF + lane * 16 : r + GU_OFF + vs0 * 512 + (lane - 32) * 16, slot + GS_ATT);
            if (L == 1) DMA16(lane < 32 ? r + GU_OFF + (vs0 + 1) * 512 + lane * 16 : r + GAL_OFF + (lane & 15) * 16, slot + GS_U + 512);
        } else {
#pragma unroll
            for (int p = L; p < 9; p += 4) DMA16(r + p * 1024 + lane * 16, slot + p * 1024);
            if (L >= 2) { const bf16* vr = va + (size_t)(seq_row(b, dir, c * 16) + stp * (lane >> 2)) * AW + (lane & 3) * 2;
                DMA4(vr, slot + HS_V + (L & 1) * 512); DMA4(vr + 8, slot + HS_V + (L & 1) * 512 + 256); }
        }
        if (c >= 3) { if (NP == 4) asm volatile("s_waitcnt vmcnt(12)" ::: "memory"); else if (NP == 3) asm volatile("s_waitcnt vmcnt(9)" ::: "memory"); else asm volatile("s_waitcnt vmcnt(6)" ::: "memory");
                      if (lane == 0) ctl[L] = (unsigned)(c - 2); }
    }
    asm volatile("s_waitcnt vmcnt(0)" ::: "memory"); if (lane == 0) ctl[L] = (unsigned)NCHUNK;
}
__device__ __forceinline__ void s2_flusher(int mixer, int chain, int vs, int ts, int lane, unsigned char* ws, LAS unsigned char* lds) {
    const int b = chain >> 4, h = (chain >> 1) & 7, dir = chain & 1, stp = dir ? -1 : 1, t = lane >> 2, vq = lane & 3;
    bf16* o = (bf16*)(ws + (mixer == 0 ? WS_OB : WS_OA)) + (size_t)dir * M * AW + h * 128 + vs * 16 + 4 * vq;
    volatile LAS unsigned* ctl = (volatile LAS unsigned*)(lds + S2_CTL);
#pragma unroll 1
    for (int c = 0; c < NCHUNK; ++c) {
        S2_SPIN((int)ctl[6 + ts] <= c);
        const LAS unsigned short* sl = (const LAS unsigned short*)(lds + S2_ORING + ts * 4096 + (c & 7) * 512) + t;
        const unsigned a0 = sl[(4 * vq + 0) * 16], a1 = sl[(4 * vq + 1) * 16], a2 = sl[(4 * vq + 2) * 16], a3 = sl[(4 * vq + 3) * 16];
        *(u32x2*)(o + (size_t)(seq_row(b, dir, c * 16) + stp * t) * AW) = (u32x2){a0 | (a1 << 16), a2 | (a3 << 16)};
        asm volatile("s_waitcnt lgkmcnt(0)" ::: "memory");
        if (lane == 0) ctl[8 + ts] = (unsigned)(c + 1);
    }
}
#define S2_PUBLISH_O(c_, Ov, fl_) do { if ((int)(fl_) < (c_) - 7) S2_SPIN((int)ctl[8 + ts] < (c_) - 7); \
        *(LAS u32x2*)(lds + S2_ORING + ts * 4096 + ((c_) & 7) * 512 + (lane & 15) * 32 + g * 8) = (u32x2){cvtpk((Ov)[0], (Ov)[1]), cvtpk((Ov)[2], (Ov)[3])}; \
        asm volatile("" ::: "memory"); if (lane == 0) ctl[6 + ts] = (unsigned)((c_) + 1); } while (0)
#define S2_PACK_SB() do { _Pragma("unroll") for (int s = 0; s < 4; ++s) Sb[s] = mk8(cvtpk(S[2 * s][0], S[2 * s][1]), cvtpk(S[2 * s][2], S[2 * s][3]), cvtpk(S[2 * s + 1][0], S[2 * s + 1][1]), cvtpk(S[2 * s + 1][2], S[2 * s + 1][3])); } while (0)
#define S2_STAGED() ((int)min(min(ctl[0], ctl[1]), min(ctl[2], ctl[3])))
#define S2_WAIT_STAGED(cn_) do { if (S2_STAGED() <= (cn_)) S2_SPIN(S2_STAGED() <= (cn_)); asm volatile("" ::: "memory"); } while (0)
struct HSet { bf16x8 q[4]; bf16x4 k[8]; bf16x4 p; bf16x4 v; };
__device__ __forceinline__ void hgrn_lds(HSet& R, const LAS unsigned char* sl, int ts, int lane, int g) {
#pragma unroll
    for (int s = 0; s < 4; ++s) R.q[s] = *(const LAS bf16x8*)(sl + HQ_OFF + (s * 64 + lane) * 16);
#pragma unroll
    for (int t = 0; t < 8; ++t) R.k[t] = *(const LAS bf16x4*)(sl + HK_OFF + (t * 64 + lane) * 8);
    R.p = *(const LAS bf16x4*)(sl + HP_OFF + lane * 8);
    const LAS unsigned short* vp = (const LAS unsigned short*)(sl + HS_V + ts * 512 + ((lane & 8) ? 256 : 0) + (lane & 7) * 2);
#pragma unroll
    for (int j = 0; j < 4; ++j) R.v[j] = (short)vp[(4 * g + j) * 8];
}
__device__ __forceinline__ void hgrn_s2c(int ts, int lane, LAS unsigned char* lds) {
    const int g = lane >> 4;
    volatile LAS unsigned* ctl = (volatile LAS unsigned*)(lds + S2_CTL);
    f32x4 S[8]; bf16x8 Sb[4];
#pragma unroll
    for (int t = 0; t < 8; ++t) S[t] = (f32x4){0.f, 0.f, 0.f, 0.f};
#pragma unroll
    for (int s = 0; s < 4; ++s) Sb[s] = mk8(0u, 0u, 0u, 0u);
    HSet A, B;
    S2_WAIT_STAGED(0);
    hgrn_lds(A, lds, ts, lane, g);
#define HG_STEP(R, Rn, c_) do { const int cn_ = (c_) + 1; const unsigned fl_ = ctl[8 + ts]; \
        const LAS unsigned char* sl_ = lds + ((c_) & (S2_NR - 1)) * S2_SLOT; \
        f32x4 dv[8]; _Pragma("unroll") for (int t = 0; t < 8; ++t) dv[t] = *(const LAS f32x4*)(sl_ + HD_OFF + (16 * t + 4 * g) * 4); \
        f32x4 O = {0.f, 0.f, 0.f, 0.f}; \
        _Pragma("unroll") for (int s = 0; s < 4; ++s) O = MFMA32(R.q[s], Sb[s], O); \
        if (cn_ < NCHUNK) { S2_WAIT_STAGED(cn_); hgrn_lds(Rn, lds + (cn_ & (S2_NR - 1)) * S2_SLOT, ts, lane, g); } \
        _Pragma("unroll") for (int t = 0; t < 8; ++t) S[t] = S[t] * dv[t]; \
        O = MFMA16(R.p, R.v, O); \
        _Pragma("unroll") for (int t = 0; t < 8; ++t) S[t] = MFMA16(R.k[t], R.v, S[t]); \
        asm volatile("" ::: "memory"); if (lane == 0) ctl[4 + ts] = (unsigned)cn_;        \
        S2_PACK_SB(); S2_PUBLISH_O(c_, O, fl_); } while (0)
#pragma unroll 1
    for (int c = 0; c < NCHUNK; c += 2) { HG_STEP(A, B, c); HG_STEP(B, A, c + 1); }
#undef HG_STEP
}
struct GSet { bf16x8 w[4], q[4]; bf16x4 k[8]; bf16x4 at; u32x2 u; float al; };
__device__ __forceinline__ void gdn_lds(GSet& R, const LAS unsigned char* sl, int ts, int lane) {
#pragma unroll
    for (int s = 0; s < 4; ++s) { R.w[s] = *(const LAS bf16x8*)(sl + GW_OFF + (s * 64 + lane) * 16); R.q[s] = *(const LAS bf16x8*)(sl + GQ_OFF + (s * 64 + lane) * 16); }
#pragma unroll
    for (int t = 0; t < 8; ++t) R.k[t] = *(const LAS bf16x4*)(sl + GK_OFF + (t * 64 + lane) * 8);
    R.at = *(const LAS bf16x4*)(sl + GS_ATT + lane * 8); R.u = *(const LAS u32x2*)(sl + GS_U + ts * 512 + lane * 8); R.al = *(const LAS float*)(sl + GS_AL);
}
__device__ __forceinline__ void gdn_s2c(int ts, int lane, LAS unsigned char* lds) {
    const int g = lane >> 4;
    volatile LAS unsigned* ctl = (volatile LAS unsigned*)(lds + S2_CTL);
    f32x4 S[8]; bf16x8 Sb[4];
#pragma unroll
    for (int t = 0; t < 8; ++t) S[t] = (f32x4){0.f, 0.f, 0.f, 0.f};
#pragma unroll
    for (int s = 0; s < 4; ++s) Sb[s] = mk8(0u, 0u, 0u, 0u);
    GSet A, B;
    S2_WAIT_STAGED(0);
    gdn_lds(A, lds, ts, lane);
#define GD_STEP(R, Rn, c_) do { const int cn_ = (c_) + 1; const unsigned fl_ = ctl[8 + ts]; \
        f32x4 WS_ = {0.f, 0.f, 0.f, 0.f}, O = {0.f, 0.f, 0.f, 0.f}; \
        _Pragma("unroll") for (int s = 0; s < 4; ++s) WS_ = MFMA32(R.w[s], Sb[s], WS_); \
        _Pragma("unroll") for (int s = 0; s < 4; ++s) O = MFMA32(R.q[s], Sb[s], O); \
        if (cn_ < NCHUNK) { S2_WAIT_STAGED(cn_); gdn_lds(Rn, lds + (cn_ & (S2_NR - 1)) * S2_SLOT, ts, lane); } \
        _Pragma("unroll") for (int t = 0; t < 8; ++t) S[t] = S[t] * R.al; \
        const bf16x4 Vn = mk4(cvtpk(bflo(R.u.x) - WS_[0], bfhi(R.u.x) - WS_[1]), cvtpk(bflo(R.u.y) - WS_[2], bfhi(R.u.y) - WS_[3])); \
        O = MFMA16(R.at, Vn, O); \
        _Pragma("unroll") for (int t = 0; t < 8; ++t) S[t] = MFMA16(R.k[t], Vn, S[t]); \
        asm volatile("" ::: "memory"); if (lane == 0) ctl[4 + ts] = (unsigned)cn_;        \
        S2_PACK_SB(); S2_PUBLISH_O(c_, O, fl_); } while (0)
#pragma unroll 1
    for (int c = 0; c < NCHUNK; c += 2) { GD_STEP(A, B, c); GD_STEP(B, A, c + 1); }
#undef GD_STEP
}
__device__ __forceinline__ void ph_even_s2(Frame& F, const Args& a, int variant) {
    const int bx = blockIdx.x, vcu = (F.G % 8 == 0) ? (bx % 8) * (F.G / 8) + bx / 8 : bx;
    const int ts = F.wave & 1;
    LAS unsigned char* lds = F.lds + RING_OFF;
    for (int tp = vcu; tp < 256; tp += F.G) {
        if (F.tid < 64) ((LAS unsigned*)(lds + S2_CTL))[F.tid] = 0u;
        __syncthreads();
        const int mixer = tp >> 7, chain = (tp >> 2) & 31, vs0 = (tp & 3) * 2;
        switch (F.wave) {
            case 0: case 1: if (mixer == 0) gdn_s2c(ts, F.lane, lds); else hgrn_s2c(ts, F.lane, lds); break;
            case 2: if (mixer == 0) s2_loader<0, 0>(chain, vs0, F.lane, a.ws, lds); else s2_loader<1, 0>(chain, vs0, F.lane, a.ws, lds); break;
            case 3: if (mixer == 0) s2_loader<0, 1>(chain, vs0, F.lane, a.ws, lds); else s2_loader<1, 1>(chain, vs0, F.lane, a.ws, lds); break;
            case 6: if (mixer == 0) s2_loader<0, 2>(chain, vs0, F.lane, a.ws, lds); else s2_loader<1, 2>(chain, vs0, F.lane, a.ws, lds); break;
            case 7: if (mixer == 0) s2_loader<0, 3>(chain, vs0, F.lane, a.ws, lds); else s2_loader<1, 3>(chain, vs0, F.lane, a.ws, lds); break;
            default: s2_flusher(mixer, chain, vs0 + ts, ts, F.lane, a.ws, lds); break;
        }
        __syncthreads();
    }
}
constexpr int N_PHASES = 3 + 10 * DEPTH;
__host__ __device__ constexpr bool phase_used(int ph) { return true; }

__global__ void __launch_bounds__(NTHREADS, 2) fwd(Args args) {
    extern __shared__ __attribute__((aligned(16))) unsigned char lds[];
    Frame F;
    F.lds = (LAS unsigned char*)lds; F.tid = threadIdx.x; F.lane = F.tid & 63; F.wave = __builtin_amdgcn_readfirstlane(F.tid >> 6);
    F.G = gridDim.x; F.gw = F.wave * F.G + blockIdx.x; F.NGW = F.G * NWAVES;
    for (int u = F.tid; u < (LDS_BYTES - LDSCTL_OFF) / 4; u += NTHREADS) ((LAS unsigned*)(F.lds + LDSCTL_OFF))[u] = 0u;
    __syncthreads();
    const int lo = args.ph_lo, hi = args.ph_hi; const bool multi = (hi - lo) > 1;
    unsigned char* ws = args.ws;
    XcdBarrier bar; bar.bar = (unsigned*)(ws + WS_CTL) + CW_BAR; bar.x = 0; bar.st = nullptr;
    if (multi) bar = xcd_barrier_post((unsigned*)(ws + WS_CTL) + CW_BAR, (volatile LAS unsigned*)(F.lds + MISC_OFF) + 8);
#ifndef PH_SITES
#define PH_SITES 0x3ffff
#endif
#define SITE(n) ((PH_SITES >> (n)) & 1)
#ifndef PROBE_MASK
#define PROBE_MASK 0
#endif
#define REPS(n) (((PROBE_MASK >> (n)) & 1) ? 2 : 1)
#define IN(k) (lo <= (k) && (k) < hi)
#define LAUNDER() do { asm volatile("" : "+v"(F.tid), "+v"(F.lane)); } while (0)
#define SEAM() do { if (multi) xcd_barrier(bar); } while (0)
    bf16* HX = (bf16*)(ws + WS_HX); bf16* MIX = (bf16*)(ws + WS_MIX); float* XA = (float*)(ws + WS_XA); float* Z = (float*)(ws + WS_Z); bf16* ACT = (bf16*)(ws + WS_ACT);
    LAS unsigned char* ring = F.lds + RING_OFF;

    if (SITE(0) && IN(0)) { _Pragma("unroll 1") for (int rep_ = 0; rep_ < REPS(0); ++rep_) { LAUNDER(); ph_prologue(F, args); } SEAM(); }
    if (SITE(1) && IN(1)) { _Pragma("unroll 1") for (int rep_ = 0; rep_ < REPS(1); ++rep_) { LAUNDER(); ph_modreduce(F, args); } SEAM(); }
    if (SITE(2) && IN(2)) { _Pragma("unroll 1") for (int rep_ = 0; rep_ < REPS(2); ++rep_) { LAUNDER(); ph_mod0(F, args); } SEAM(); }
#pragma unroll 1
    for (int l = 0; l < DEPTH; ++l) {
        const int base = 3 + 10 * l, j = l >> 1; const bool last = (l == DEPTH - 1); const int Mo = last ? MX : M;
        const float* MODL = (const float*)(ws + WS_MOD) + (size_t)l * 3 * 12288;
        if ((l & 1) == 0) {
            if (SITE(3) && IN(base + 0)) { _Pragma("unroll 1") for (int rep_ = 0; rep_ < REPS(3); ++rep_) {
                pg8::Gemm g{HX, (const bf16*)(ws + WS_WINE + j * SZ_WINE), M, NE_INP, D, D, D}; pg8::StaticOrder S; S.init(M, NE_INP, F.G, (int)blockIdx.x);
                EpiEven1 E{(bf16*)(ws + WS_QA), (bf16*)(ws + WS_VA), (bf16*)(ws + WS_GA), (bf16*)(ws + WS_ZB), (bf16*)(ws + WS_QKVB), (float*)(ws + WS_LF), (float*)(ws + WS_GB),
                           (const float*)(ws + WS_LB) + j * AW, args.in[12] + j * 16, args.in[13] + j * 16};
                pg8::gemm_phase<EpiEven1, pg8::StaticOrder, true, true>(ring, g, S, E); } SEAM(); }
            if (SITE(4) && IN(base + 1)) { _Pragma("unroll 1") for (int rep_ = 0; rep_ < REPS(4); ++rep_) { LAUNDER(); ph_conv<0>(F, args, j); } SEAM(); }
            if (SITE(5) && IN(base + 2)) { _Pragma("unroll 1") for (int rep_ = 0; rep_ < REPS(5); ++rep_) { LAUNDER(); ph_even_s1(F, args); } SEAM(); }
            if (SITE(17) && IN(base + 3)) { _Pragma("unroll 1") for (int rep_ = 0; rep_ < REPS(17); ++rep_) { LAUNDER(); ph_even_s2(F, args, rep_); } SEAM(); }
            if (SITE(6) && IN(base + 4)) { _Pragma("unroll 1") for (int rep_ = 0; rep_ < REPS(6); ++rep_) { LAUNDER(); ph_merge(F, args, j); } SEAM(); }
        } else {
            if (SITE(7) && IN(base + 0)) { _Pragma("unroll 1") for (int rep_ = 0; rep_ < REPS(7); ++rep_) {
                pg8::Gemm g{HX, (const bf16*)(ws + WS_WINO + j * SZ_WINO), M, 2 * D, D, D, D}; pg8::StaticOrder S; S.init(M, 2 * D, F.G, (int)blockIdx.x);
                EpiOdd1 E{(bf16*)(ws + WS_GY), (bf16*)(ws + WS_XBR)};
                pg8::gemm_phase<EpiOdd1, pg8::StaticOrder, true, true>(ring, g, S, E); } SEAM(); }
            if (SITE(8) && IN(base + 1)) { _Pragma("unroll 1") for (int rep_ = 0; rep_ < REPS(8); ++rep_) { LAUNDER(); ph_conv<1>(F, args, j); } SEAM(); }
            if (SITE(9) && IN(base + 2)) { _Pragma("unroll 1") for (int rep_ = 0; rep_ < REPS(9); ++rep_) {
                pg8::Gemm g{(const bf16*)(ws + WS_XC), (const bf16*)(ws + WS_WGATE + j * SZ_WGATE), M, 8192, 256, D, 256}; pg8::GateOrder S; S.init(M, F.G, (int)blockIdx.x);
                EpiGates E{(const bf16*)(ws + WS_XC), (unsigned*)(ws + WS_AB), args.in[22] + (size_t)j * 4 * D, args.in[23] + (size_t)j * 2 * D};
                pg8::gemm_phase<EpiGates, pg8::GateOrder, true, true>(ring, g, S, E); } SEAM(); }
            if (SITE(10) && IN(base + 3)) { _Pragma("unroll 1") for (int rep_ = 0; rep_ < REPS(10); ++rep_) { LAUNDER(); ph_odd_l1(F, args); } SEAM(); }
            if (SITE(11) && IN(base + 4)) { _Pragma("unroll 1") for (int rep_ = 0; rep_ < REPS(11); ++rep_) { LAUNDER(); ph_odd_l3(F, args); } SEAM(); }
        }
        if (SITE(12) && IN(base + 5)) { _Pragma("unroll 1") for (int rep_ = 0; rep_ < REPS(12); ++rep_) {
            pg8::Gemm g{MIX, (const bf16*)((l & 1) ? ws + WS_WOUTO + j * SZ_WSQ : ws + WS_WOUTE + j * SZ_WSQ), Mo, D, D, D, D}; pg8::StaticOrder S; S.init(Mo, D, F.G, (int)blockIdx.x);
            EpiResid E{l == 0 ? args.in[0] : XA, l == 0 ? args.in[2] : XA + (size_t)MX * D, Z, MODL + 2 * D, l & 1};
            pg8::gemm_phase<EpiResid, pg8::StaticOrder, true, true>(ring, g, S, E); } SEAM(); }
        if (SITE(13) && IN(base + 6)) { _Pragma("unroll 1") for (int rep_ = 0; rep_ < REPS(13); ++rep_) { LAUNDER(); ph_ln(F, Z, Mo, args.in[6] + (size_t)(l * 2) * D, args.in[7] + (size_t)(l * 2) * D, nullptr, HX, MODL + 3 * D, MODL + 4 * D, 0); } SEAM(); }
        if (SITE(14) && IN(base + 7)) { _Pragma("unroll 1") for (int rep_ = 0; rep_ < REPS(14); ++rep_) {
            pg8::Gemm g{HX, (const bf16*)(ws + WS_WGU + l * SZ_WGU), Mo, 2 * FF, D, D, D}; pg8::StaticOrder S; S.init(Mo, 2 * FF, F.G, (int)blockIdx.x);
            EpiSwiGLU E{ACT};
            pg8::gemm_phase<EpiSwiGLU, pg8::StaticOrder, true, true>(ring, g, S, E); } SEAM(); }
        if (SITE(15) && IN(base + 8)) { _Pragma("unroll 1") for (int rep_ = 0; rep_ < REPS(15); ++rep_) {
            pg8::Gemm g{ACT, (const bf16*)(ws + WS_WDN + l * SZ_WDN), Mo, D, FF, FF, FF}; pg8::StaticOrder S; S.init(Mo, D, F.G, (int)blockIdx.x);
            EpiResid E{Z, Z + (size_t)MX * D, XA, MODL + 5 * D, 0};
            pg8::gemm_phase<EpiResid, pg8::StaticOrder, true, true>(ring, g, S, E); } SEAM(); }
        if (SITE(16) && IN(base + 9)) {
            const float* g1 = args.in[6] + (size_t)(l * 2 + 1) * D; const float* b1 = args.in[7] + (size_t)(l * 2 + 1) * D;
            LAUNDER(); if (last) ph_ln(F, XA, MX, g1, b1, args.out, nullptr, nullptr, nullptr, 0);
            else { LAUNDER(); ph_ln(F, XA, M, g1, b1, nullptr, HX, MODL + 3 * 12288, MODL + 3 * 12288 + D, (l + 1) & 1); SEAM(); } }
    }
#undef IN
#undef SEAM
}

extern "C" void kernel_launch(void* const* d_in, const int* in_sizes, int n_in, void* d_out, int out_size, void* d_ws, size_t ws_size, hipStream_t stream) {
    static int grid = 0;
    if (grid == 0) {
        if (n_in != 25 || in_sizes[0] != MX * D || out_size != MX * D || ws_size < WS_END) { fprintf(stderr, "kernel_launch: unexpected shapes (n_in %d, in0 %d, out %d, ws %zu < %zu); nothing launched\n", n_in, n_in > 0 ? in_sizes[0] : -1, out_size, ws_size, (size_t)WS_END); grid = -1; return; }
        int dev = 0, cus = 0, per_cu = 0;
        if (hipGetDevice(&dev) != hipSuccess || hipDeviceGetAttribute(&cus, hipDeviceAttributeMultiprocessorCount, dev) != hipSuccess) { grid = -1; return; }
        if (hipFuncSetAttribute((const void*)fwd, hipFuncAttributeMaxDynamicSharedMemorySize, LDS_BYTES) != hipSuccess) { fprintf(stderr, "kernel_launch: hipFuncSetAttribute failed\n"); grid = -1; return; }
        if (hipOccupancyMaxActiveBlocksPerMultiprocessor(&per_cu, (const void*)fwd, NTHREADS, LDS_BYTES) != hipSuccess || per_cu < 1) { fprintf(stderr, "kernel_launch: occupancy query says %d\n", per_cu); }
        (void)hipGetLastError();
        grid = cus;
    }
    if (grid < 0) return;
    if (hipMemsetAsync((char*)d_ws + WS_CTL, 0, CTL_ZERO_BYTES, stream) != hipSuccess) return;
    Args a{};
    for (int i = 0; i < 25; ++i) a.in[i] = (const float*)d_in[i];
    a.out = (float*)d_out; a.ws = (unsigned char*)d_ws;
#if MK_ONE_LAUNCH
    a.ph_lo = 0; a.ph_hi = N_PHASES;
    hipLaunchKernelGGL(fwd, dim3(grid), dim3(NTHREADS), LDS_BYTES, stream, a);
#else
    for (int ph = 0; ph < N_PHASES; ++ph) { if (!phase_used(ph)) continue; a.ph_lo = ph; a.ph_hi = ph + 1;
        hipLaunchKernelGGL(fwd, dim3(grid), dim3(NTHREADS), LDS_BYTES, stream, a); }
#endif
}
```

```cpp
#include <hip/hip_runtime.h>
#include <cstdio>
#include <cstdint>
#ifndef MK_ONE_LAUNCH
#define MK_ONE_LAUNCH 1
#endif
namespace pg8 {
#define PG8_LAS __attribute__((address_space(3)))
typedef unsigned short bf16_t;
typedef short bf16x8 __attribute__((ext_vector_type(8)));
typedef float f32x4 __attribute__((ext_vector_type(4)));
typedef unsigned u32x4 __attribute__((ext_vector_type(4)));
typedef unsigned u32x2 __attribute__((ext_vector_type(2)));
constexpr int BM = 256, BK = 64, HALF = 128, HTB = HALF * BK * 2  , STAGE_BYTES = 8 * HTB, NXCD = 8, WGM = 8;
__host__ __device__ __forceinline__ int lds_byte(int r, int c) { const int st = (r >> 4) * 2 + (c >> 5), rr = r & 15, cc = c & 31, ob = rr * 64 + cc * 2; return st * 1024 + (ob ^ (((ob >> 9) & 1) << 5)); }
__host__ __device__ __forceinline__ void stage_rc(int b, int& R, int& C) { const int st = b / 1024, sb = b % 1024, swz = sb ^ (((sb >> 9) & 1) << 5); R = (st >> 1) * 16 + swz / 64; C = (st & 1) * 32 + (swz % 64) / 2; }
__host__ __device__ __forceinline__ int perm32(int rho) { const int n = rho >> 4, i = rho & 15; return 8 * (i >> 2) + 4 * n + (i & 3); }

struct Unit { int pm, pn, ka, kb; };
struct Gemm { const bf16_t* A; const bf16_t* Bt; int M, N, K, lda, ldb; };

struct StaticOrder {
    int nM, nN, nwg, G, c;
    __host__ __device__ void init(int M, int N, int G_, int c_) { nM = M / BM; nN = N / BM; nwg = nM * nN; G = G_; c = c_; }
    __host__ __device__ bool next(int i, Unit& u) const {
        const long L = (long)i * G + c; if (L >= nwg) return false;
        int wgid = (int)L; { const int q = nwg / NXCD, r = nwg % NXCD, xcd = wgid % NXCD, off = wgid / NXCD; wgid = (xcd < r ? xcd * (q + 1) : r * (q + 1) + (xcd - r) * q) + off; }
        const int nig = WGM * nN, gid = wgid / nig, fm = gid * WGM, gsz = (nM - fm) < WGM ? (nM - fm) : WGM;
        u.pm = fm + ((wgid % nig) % gsz); u.pn = (wgid % nig) / gsz; u.ka = 0; u.kb = 0; return true;
    }
    __device__ __forceinline__ void a_ready(const Unit&) const {}
    __device__ __forceinline__ void done(const Unit&) const {}
};
struct GateOrder {
    int nM, nwg, G, c;
    __host__ __device__ void init(int M, int G_, int c_) { nM = M / BM; nwg = nM * 32; G = G_; c = c_; }
    __host__ __device__ bool next(int i, Unit& u) const {
        const long L = (long)i * G + c; if (L >= nwg) return false;
        const int l = (int)L, pn4 = l & 3, pm = (l >> 2) % nM, nb = (l >> 2) / nM;
        u.pm = pm; u.pn = nb * 4 + pn4; u.ka = nb * 256; u.kb = 0; return true;
    }
    __device__ __forceinline__ void a_ready(const Unit&) const {}
    __device__ __forceinline__ void done(const Unit&) const {}
};
typedef float f32x2c __attribute__((ext_vector_type(2))); typedef __bf16 bf16x2c __attribute__((ext_vector_type(2)));
struct TailOrder {
    int S, ks, c;
    __host__ __device__ bool next(int i, Unit& u) const {
        if (i != 0 || c >= 16 * S) return false;
        const int un = c / S, sl = c - un * S; u.pm = 64 + (un >> 3); u.pn = un & 7; u.ka = sl * ks; u.kb = sl * ks; return true;
    }
    __device__ __forceinline__ void a_ready(const Unit&) const {}
    __device__ __forceinline__ void done(const Unit&) const {}
};
__device__ __forceinline__ unsigned cvt_pk_bf16(float lo, float hi) { const f32x2c v = {lo, hi}; return __builtin_bit_cast(unsigned, __builtin_convertvector(v, bf16x2c)); }
template <class Epi, class Sched, bool ALIGN_EPI = false, bool SP2 = false>
__device__ __forceinline__ void gemm_phase(PG8_LAS unsigned char* lds, const Gemm g, const Sched& S, const Epi& E) {
    int tid = threadIdx.x; asm volatile("" : "+v"(tid)); const int wid = __builtin_amdgcn_readfirstlane(tid >> 6), lane = tid & 63, wr = wid >> 2, wc = wid & 3, fr = lane & 15, fq = lane >> 4;
    int nt = g.K / BK; asm volatile("" : "+s"(nt));
    unsigned voffA[2], voffB[2];
#pragma unroll
    for (int i = 0; i < 2; ++i) { int R, C; stage_rc(tid * 16 + i * 8192, R, C); const int Rb = Epi::PERM ? ((R & ~31) + perm32(R & 31)) : R;
        voffA[i] = (unsigned)(R * g.lda + C) * 2u; voffB[i] = (unsigned)(Rb * g.ldb + C) * 2u; }
    const size_t kstep = (size_t)(BK * 2);
    const size_t hstepA = (size_t)HALF * g.lda * 2, hstepB = (size_t)HALF * g.ldb * 2;
    const size_t tstepA = 2 * hstepA, tstepB = 2 * hstepB;
    const unsigned ldsw = (unsigned)wid * 1024u;
    const int aoff = lds_byte(wr * 64 + fr, fq * 8), boff = lds_byte(wc * 32 + fr, fq * 8);
#define PG8_SA(b, h) (((b) * 2 + (h)) * HTB)
#define PG8_SB(b, h) ((4 + (b) * 2 + (h)) * HTB)
#define PG8_STAGE(bufoff, gbase, voff) do { _Pragma("unroll") for (int _i = 0; _i < 2; ++_i) \
        __builtin_amdgcn_global_load_lds((const unsigned*)((const char*)(gbase) + (voff)[_i]), (PG8_LAS unsigned*)(lds + (bufoff) + ldsw + _i * 8192), 16, 0, 0); } while (0)
#define PG8_LDA(dst, b, h) do { _Pragma("unroll") for (int m = 0; m < 4; ++m) _Pragma("unroll") for (int k = 0; k < 2; ++k) dst[m][k] = *(const PG8_LAS bf16x8*)(lds + PG8_SA(b, h) + aoff + m * 2048 + k * 1024); } while (0)
#define PG8_LDB(dst, b, h) do { _Pragma("unroll") for (int n = 0; n < 2; ++n) _Pragma("unroll") for (int k = 0; k < 2; ++k) dst[n][k] = *(const PG8_LAS bf16x8*)(lds + PG8_SB(b, h) + boff + n * 2048 + k * 1024); } while (0)
#define PG8_MMA(ai, bj, At, Bt) do { __builtin_amdgcn_s_setprio(1); _Pragma("unroll") for (int m = 0; m < 4; ++m) _Pragma("unroll") for (int n = 0; n < 2; ++n) _Pragma("unroll") for (int k = 0; k < 2; ++k) \
        acc[ai][bj][m][n] = __builtin_amdgcn_mfma_f32_16x16x32_bf16(Bt[n][k], At[m][k], acc[ai][bj][m][n], 0, 0, 0); __builtin_amdgcn_s_setprio(0); } while (0)
#define PG8_WAIT_V(n) asm volatile("s_waitcnt vmcnt(" #n ")" ::: "memory")
#define PG8_WAIT_L(n) asm volatile("s_waitcnt lgkmcnt(" #n ")" ::: "memory")
#define PG8_BAR __builtin_amdgcn_s_barrier()
#define PG8_SCHED __builtin_amdgcn_sched_barrier(0)
    Unit cur, nxt; int ui = 0;
    if (!S.next(0, cur)) return;
    f32x4 acc[2][2][4][2];
#pragma unroll
    for (int a = 0; a < 2; ++a)
#pragma unroll
        for (int b = 0; b < 2; ++b)
#pragma unroll
            for (int m = 0; m < 4; ++m)
#pragma unroll
                for (int n = 0; n < 2; ++n) acc[a][b][m][n] = (f32x4){0.f, 0.f, 0.f, 0.f};
    bf16x8 At[4][2], B0[2][2], B1[2][2];
    const char* cA = (const char*)g.A + (size_t)cur.pm * tstepA + (size_t)cur.ka * 2; const char* cB = (const char*)g.Bt + (size_t)cur.pn * tstepB + (size_t)cur.kb * 2;
    S.a_ready(cur);
    if constexpr (SP2) {
        PG8_STAGE(PG8_SB(0, 0), cB, voffB); PG8_STAGE(PG8_SB(0, 1), cB + hstepB, voffB); PG8_STAGE(PG8_SA(0, 0), cA, voffA); PG8_STAGE(PG8_SA(0, 1), cA + hstepA, voffA);
        if (wr == 1) PG8_BAR;
        PG8_WAIT_V(2); PG8_BAR;
        PG8_STAGE(PG8_SB(1, 0), cB + kstep, voffB); PG8_STAGE(PG8_SA(1, 0), cA + kstep, voffA); PG8_STAGE(PG8_SB(1, 1), cB + hstepB + kstep, voffB);
        PG8_WAIT_V(6); PG8_BAR;
    } else {
        PG8_STAGE(PG8_SB(0, 0), cB, voffB); PG8_STAGE(PG8_SA(0, 0), cA, voffA); PG8_STAGE(PG8_SB(0, 1), cB + hstepB, voffB); PG8_STAGE(PG8_SA(0, 1), cA + hstepA, voffA);
        if (wr == 1) PG8_BAR;
        PG8_WAIT_V(4); PG8_BAR;
        PG8_STAGE(PG8_SB(1, 0), cB + kstep, voffB); PG8_STAGE(PG8_SA(1, 0), cA + kstep, voffA); PG8_STAGE(PG8_SB(1, 1), cB + hstepB + kstep, voffB);
        PG8_WAIT_V(6); PG8_BAR;
    }
    for (;;) {
        const bool has_next = S.next(ui + 1, nxt);
        const char* nA = has_next ? (const char*)g.A + (size_t)nxt.pm * tstepA + (size_t)nxt.ka * 2 : cA; const char* nB = has_next ? (const char*)g.Bt + (size_t)nxt.pn * tstepB + (size_t)nxt.kb * 2 : cB;
        for (int t = 0; t < nt; t += 2) {
            const bool last = (t == nt - 2);
            const char* a1 = cA + (size_t)(t + 1) * kstep;
            const char* a2 = last ? nA : cA + (size_t)(t + 2) * kstep; const char* b2 = last ? nB : cB + (size_t)(t + 2) * kstep;
            const char* a3 = a2 + kstep; const char* b3 = b2 + kstep;
            if (last && has_next) S.a_ready(nxt);
            if constexpr (SP2) {
            PG8_LDB(B0, 0, 0); PG8_LDB(B1, 0, 1); PG8_SCHED; PG8_LDA(At, 0, 0); PG8_STAGE(PG8_SA(1, 1), a1 + hstepA, voffA);
            PG8_WAIT_V(8); PG8_WAIT_L(0); PG8_BAR; PG8_MMA(0, 0, At, B0); PG8_MMA(0, 1, At, B1); PG8_BAR; PG8_SCHED;
            PG8_LDA(At, 0, 1); PG8_STAGE(PG8_SB(0, 0), b2, voffB); PG8_STAGE(PG8_SB(0, 1), b2 + hstepB, voffB); PG8_STAGE(PG8_SA(0, 0), a2, voffA);
            PG8_WAIT_V(8); PG8_WAIT_L(0); PG8_BAR; PG8_MMA(1, 0, At, B0); PG8_MMA(1, 1, At, B1); PG8_BAR; PG8_SCHED;
            PG8_LDB(B0, 1, 0); PG8_LDB(B1, 1, 1); PG8_SCHED; PG8_LDA(At, 1, 0); PG8_STAGE(PG8_SA(0, 1), a2 + hstepA, voffA);
            PG8_WAIT_V(8); PG8_WAIT_L(0); PG8_BAR; PG8_MMA(0, 0, At, B0); PG8_MMA(0, 1, At, B1); PG8_BAR; PG8_SCHED;
            PG8_LDA(At, 1, 1); PG8_STAGE(PG8_SB(1, 0), b3, voffB); PG8_STAGE(PG8_SB(1, 1), b3 + hstepB, voffB); PG8_STAGE(PG8_SA(1, 0), a3, voffA);
            PG8_WAIT_V(8); PG8_WAIT_L(0); PG8_BAR; PG8_MMA(1, 0, At, B0); PG8_MMA(1, 1, At, B1); PG8_BAR; PG8_SCHED;
            } else {
            PG8_LDB(B0, 0, 0); PG8_SCHED; PG8_LDA(At, 0, 0); PG8_STAGE(PG8_SA(1, 1), a1 + hstepA, voffA);
            PG8_WAIT_L(8); PG8_BAR; PG8_WAIT_L(0); PG8_MMA(0, 0, At, B0); PG8_BAR; PG8_SCHED;
            PG8_LDB(B1, 0, 1); PG8_STAGE(PG8_SB(0, 0), b2, voffB);
            PG8_BAR; PG8_WAIT_L(0); PG8_MMA(0, 1, At, B1); PG8_BAR;
            PG8_LDA(At, 0, 1); PG8_STAGE(PG8_SA(0, 0), a2, voffA);
            PG8_BAR; PG8_WAIT_L(0); PG8_MMA(1, 0, At, B0); PG8_BAR; PG8_SCHED;
            PG8_STAGE(PG8_SB(0, 1), b2 + hstepB, voffB);
            PG8_WAIT_V(6); PG8_BAR; PG8_MMA(1, 1, At, B1); PG8_BAR;
            PG8_LDB(B0, 1, 0); PG8_SCHED; PG8_LDA(At, 1, 0); PG8_STAGE(PG8_SA(0, 1), a2 + hstepA, voffA);
            PG8_WAIT_L(8); PG8_BAR; PG8_WAIT_L(0); PG8_MMA(0, 0, At, B0); PG8_BAR; PG8_SCHED;
            PG8_LDB(B1, 1, 1); PG8_STAGE(PG8_SB(1, 0), b3, voffB);
            PG8_BAR; PG8_WAIT_L(0); PG8_MMA(0, 1, At, B1); PG8_BAR;
            PG8_LDA(At, 1, 1); PG8_STAGE(PG8_SA(1, 0), a3, voffA);
            PG8_BAR; PG8_WAIT_L(0); PG8_MMA(1, 0, At, B0); PG8_BAR; PG8_SCHED;
            PG8_STAGE(PG8_SB(1, 1), b3 + hstepB, voffB);
            PG8_WAIT_V(6); PG8_BAR; PG8_MMA(1, 1, At, B1); PG8_BAR;
            }
        }
        if constexpr (ALIGN_EPI) { if (wr == 0) PG8_BAR; }
        if constexpr (!Epi::AFTER_DRAIN) { E(acc, cur, wr, wc, fr, fq); S.done(cur); }
        if (!has_next) break;
#pragma unroll
        for (int a = 0; a < 2; ++a)
#pragma unroll
            for (int b = 0; b < 2; ++b)
#pragma unroll
                for (int m = 0; m < 4; ++m)
#pragma unroll
                    for (int n = 0; n < 2; ++n) acc[a][b][m][n] = (f32x4){0.f, 0.f, 0.f, 0.f};
        cur = nxt; cA = nA; cB = nB; ++ui;
        if constexpr (ALIGN_EPI) { if (wr == 1) PG8_BAR; }
    }
    PG8_WAIT_V(0);
    if constexpr (!ALIGN_EPI) { if (wr == 0) PG8_BAR; }
    PG8_BAR;
    if constexpr (Epi::AFTER_DRAIN) { E.fused(acc, cur, wr, wc, fr, fq, lds, wid, lane); S.done(cur); }
#undef PG8_SA
#undef PG8_SB
#undef PG8_STAGE
#undef PG8_LDA
#undef PG8_LDB
#undef PG8_MMA
#undef PG8_WAIT_V
#undef PG8_WAIT_L
#undef PG8_BAR
#undef PG8_SCHED
}
}
using pg8::bf16_t; using pg8::f32x4; using pg8::u32x4; using pg8::u32x2; using pg8::Unit; using pg8::cvt_pk_bf16;

constexpr int D = 2048, NBATCH = 2, SEQ = 8192, CTXL = 256, DEPTH = 4;
constexpr int MX = NBATCH * SEQ;
constexpr int MC = NBATCH * CTXL;
constexpr int M = MX + MC;
constexpr int NE_IN = 9248, NE_INP = 9472, FF = 5632, AW = 1024;
constexpr int NWAVES = 8, NTHREADS = 512;
constexpr float LN_EPS = 1e-6f, DN_ALPHA = 1.681792830507429f;
constexpr float QSCALE = 0.08838834764831845f;

constexpr size_t MiB = 1u << 20;
constexpr size_t al256(size_t x) { return (x + 255) & ~(size_t)255; }
constexpr size_t WS_CTL = 0, CTL_ZERO_BYTES = 1 * MiB;
constexpr size_t WS_MOD = 1 * MiB;
constexpr size_t WS_LB = 2 * MiB;
constexpr size_t WS_PART = 3 * MiB;
constexpr size_t WS_W0 = 8 * MiB;
constexpr size_t SZ_WINE = (size_t)NE_INP * D * 2, SZ_WSQ = (size_t)D * D * 2, SZ_WINO = (size_t)2 * D * D * 2, SZ_WGATE = (size_t)8192 * 256 * 2, SZ_WGU = (size_t)2 * FF * D * 2, SZ_WDN = (size_t)D * FF * 2;
constexpr size_t WS_WINE = WS_W0;
constexpr size_t WS_WOUTE = WS_WINE + 2 * SZ_WINE;
constexpr size_t WS_WINO = WS_WOUTE + 2 * SZ_WSQ;
constexpr size_t WS_WGATE = WS_WINO + 2 * SZ_WINO;
constexpr size_t WS_WOUTO = WS_WGATE + 2 * SZ_WGATE;
constexpr size_t WS_WGU = WS_WOUTO + 2 * SZ_WSQ;
constexpr size_t WS_WDN = WS_WGU + 4 * SZ_WGU;
constexpr size_t WS_XA = al256(WS_WDN + 4 * SZ_WDN);
constexpr size_t SZ_F32ROW = (size_t)M * D * 4, SZ_BF16ROW = (size_t)M * D * 2, SZ_BF16HALF = (size_t)M * AW * 2;
constexpr size_t WS_Z = WS_XA + SZ_F32ROW;
constexpr size_t WS_HX = WS_Z + SZ_F32ROW;
constexpr size_t WS_MIX = WS_HX + SZ_BF16ROW;
constexpr size_t WS_MR = WS_MIX + SZ_BF16ROW;
constexpr size_t SZ_HRECS = (size_t)16896 * 9216, SZ_GRECS = (size_t)16896 * 17152;
constexpr size_t WS_HREC = WS_HX, WS_GREC = WS_HREC + SZ_HRECS;
constexpr size_t WS_QKVB = WS_MIX;
constexpr size_t WS_QA = al256(WS_GREC + SZ_GRECS), WS_VA = WS_QA + SZ_BF16HALF, WS_GA = WS_VA + SZ_BF16HALF, WS_ZB = WS_GA + SZ_BF16HALF;
constexpr size_t WS_LF = WS_ZB + SZ_BF16HALF;
constexpr size_t WS_GB = WS_LF + 2 * (size_t)M * AW * 4;
constexpr size_t WS_QB = WS_GB + (size_t)M * 32 * 4, WS_KB = WS_QB + SZ_BF16HALF, WS_VB = WS_KB + SZ_BF16HALF;
#ifdef EXP_B
constexpr size_t WS_OA = WS_HREC;
#else
constexpr size_t WS_OA = WS_LF;
#endif
constexpr size_t WS_OB = WS_OA + 2 * SZ_BF16HALF;
constexpr size_t WS_EVEN_END = WS_VB + SZ_BF16HALF;
#ifndef EXP_B
static_assert(WS_QKVB + (size_t)M * 3072 * 2 <= WS_QA && WS_OB + 2 * SZ_BF16HALF <= WS_GB, "even-layer overlays");
#endif
constexpr size_t WS_GY = WS_MR, WS_XBR = WS_GY + SZ_BF16ROW, WS_XC = WS_XBR + SZ_BF16ROW;
constexpr size_t WS_AB = WS_XC + SZ_BF16ROW;
constexpr size_t WS_R = WS_AB + 2 * (size_t)M * D * 4;
constexpr size_t WS_ODD_END = WS_R + 2 * SZ_BF16ROW;
constexpr size_t WS_ACT = WS_MR;
constexpr size_t WS_END = (WS_EVEN_END > WS_ODD_END ? WS_EVEN_END : WS_ODD_END);
static_assert(WS_ACT + (size_t)M * FF * 2 <= WS_END, "ACT fits the mixer region");
static_assert(WS_END <= (size_t)1536 * MiB, "workspace budget: d_ws is at least 4 x the largest input = 1536 MiB");
constexpr size_t WS_SLAB = WS_END;
static_assert(WS_SLAB + (size_t)176 * 65536 * 4 <= (size_t)1536 * MiB, "slab fits");
constexpr int CW_BAR = 4096;

constexpr int RING_OFF = 0, RING_BYTES = 131072;
constexpr int LDSCTL_OFF = RING_BYTES, MISC_OFF = LDSCTL_OFF + 320;
constexpr int LDS_BYTES = 147456;

#define GAS __attribute__((address_space(1)))
#define LAS __attribute__((address_space(3)))
typedef unsigned short bf16;
#define LDS_WAIT() asm volatile("s_waitcnt lgkmcnt(0)" ::: "memory")
#define VM_WAIT() asm volatile("s_waitcnt vmcnt(0)" ::: "memory")
__device__ __forceinline__ unsigned f2bf(float f) { unsigned u = __builtin_bit_cast(unsigned, f); return (u + 0x7fffu + ((u >> 16) & 1u)) >> 16; }
__device__ __forceinline__ unsigned pk2(float lo, float hi) { return f2bf(lo) | (f2bf(hi) << 16); }
__device__ __forceinline__ float bflo(unsigned u) { return __builtin_bit_cast(float, u << 16); }
__device__ __forceinline__ float bfhi(unsigned u) { return __builtin_bit_cast(float, u & 0xffff0000u); }
__device__ __forceinline__ float bf2f(bf16 h) { return __builtin_bit_cast(float, (unsigned)h << 16); }
__device__ __forceinline__ float sigm(float x) { return 1.f / (1.f + __expf(-x)); }
__device__ __forceinline__ float siluf(float x) { return x / (1.f + __expf(-x)); }
__device__ __forceinline__ float log1p_fast(float t) { const float p = t * (1.f + t * (-0.5f + t * (0.33333333f + t * (-0.25f + t * 0.2f)))); return t < 0.03f ? p : __logf(1.f + t); }
__device__ __forceinline__ float softplusf(float x) { return fmaxf(x, 0.f) + log1p_fast(__expf(-fabsf(x))); }
__device__ __forceinline__ float neg_expm1_fast(float x) { const float p = -x * (1.f + x * (0.5f + x * (0.16666667f + x * (0.041666668f + x * 0.0083333338f)))); return x > -0.25f ? p : 1.f - __expf(x); }
__device__ __forceinline__ float gelu_tanh(float x) { const float u = 0.7978845608028654f * (x + 0.044715f * x * x * x); return x / (1.f + __expf(-2.f * u)); }
__device__ __forceinline__ float wave_sum(float v) {
#pragma unroll
    for (int o = 1; o < 64; o <<= 1) v += __shfl_xor(v, o);
    return v;
}
__device__ __forceinline__ int mod_index(int row) { return row < SEQ ? 0 : (row < MX ? 1 : 2); }
__device__ __forceinline__ int perm_row(int r) { if (r >= MX) return r; const int b = r >> 13, t = r & 8191; return (b << 13) + ((t & 63) << 7) + (t >> 6); }
__device__ __forceinline__ int unperm_row(int r) { if (r >= MX) return r; const int b = r >> 13, i = r & 8191; return (b << 13) + ((i & 127) << 6) + (i >> 7); }
__device__ __forceinline__ int seq_row(int b, int dir, int s) {
    if (s < CTXL) { const int pos = dir ? (CTXL - 1 - s) : s; return MX + b * CTXL + pos; }
    const int p = s - CTXL, pos = dir ? (SEQ - 1 - p) : p; return b * SEQ + pos;
}
#define XB_TMO      128
#define XB_XCNT(j)  (256  + 64 * (j))
#define XB_XSUB(j)  (1280 + 64 * (j))
#define XB_XGEN(j)  (2304 + 64 * (j))
#define XB_TOP      3328
#define XB_TOPGEN   3392
#define XCD_BAR_WORDS 3456
#define XB_SPIN_CAP (1u << 18)

__device__ __forceinline__ unsigned xb_ld(unsigned* p)              { return __hip_atomic_load(p, __ATOMIC_RELAXED, __HIP_MEMORY_SCOPE_AGENT); }
__device__ __forceinline__ unsigned xb_add(unsigned* p, unsigned v) { return __hip_atomic_fetch_add(p, v, __ATOMIC_RELAXED, __HIP_MEMORY_SCOPE_AGENT); }
__device__ __forceinline__ unsigned xb_xcc_id() { return (unsigned)__builtin_amdgcn_s_getreg((3 << 11) | 20) & 0xFu; }
#define XB_SPIN(cond, bar) do { unsigned _sp = 0; while (cond) { __builtin_amdgcn_s_sleep(1); \
    if ((++_sp & 255u) == 0u) { if (xb_ld(&(bar)[XB_TMO])) break; if (_sp > XB_SPIN_CAP) { atomicAdd(&(bar)[XB_TMO], 1u); break; } } } } while (0)

struct XcdBarrier {
    unsigned* bar; unsigned x;
    volatile LAS unsigned* st;
};

__device__ __forceinline__ XcdBarrier xcd_barrier_post(unsigned* bar, volatile LAS unsigned* st) {
    XcdBarrier b; b.bar = bar; b.x = xb_xcc_id(); b.st = st;
    if (threadIdx.x == 0) (void)xb_add(&bar[XB_XCNT(b.x)], 1u);
    return b;
}
__device__ __forceinline__ void xcd_barrier_complete(unsigned* bar, unsigned x, unsigned& nloc, unsigned& nx) {
    const unsigned G = gridDim.x * gridDim.y * gridDim.z;
    unsigned sum, cnt, mine, sp = 0u;
    for (;;) {
        sum = 0u; cnt = 0u; mine = 0u;
#pragma unroll
        for (unsigned j = 0; j < 16; ++j) { const unsigned c = xb_ld(&bar[XB_XCNT(j)]); sum += c; cnt += (c > 0u) ? 1u : 0u; mine = (j == x) ? c : mine; }
        if (sum == G) break;
        __builtin_amdgcn_s_sleep(1);
        if ((++sp & 255u) == 0u) { if (xb_ld(&bar[XB_TMO])) break; if (sp > XB_SPIN_CAP) { atomicAdd(&bar[XB_TMO], 1u); break; } }
    }
    nloc = mine > 0u ? mine : 1u; nx = cnt > 0u ? cnt : 1u;
}

__device__ __forceinline__ void xcd_barrier(const XcdBarrier& b) {
    asm volatile("s_waitcnt vmcnt(0)" ::: "memory");
    __syncthreads();
    if (threadIdx.x == 0) {
        unsigned* bar = b.bar;
        __builtin_amdgcn_s_waitcnt(0);
        unsigned nloc = b.st[0], nx = b.st[1];
        if (nloc == 0u) { xcd_barrier_complete(bar, b.x, nloc, nx); b.st[0] = nloc; b.st[1] = nx; }
        const unsigned old = xb_add(&bar[XB_XSUB(b.x)], 1u);
        const unsigned gen = old / nloc;
        if (old + 1u == (gen + 1u) * nloc) {
            __builtin_amdgcn_fence(__ATOMIC_RELEASE, "agent");
            asm volatile("s_waitcnt vmcnt(0)" ::: "memory");
            const unsigned og = xb_add(&bar[XB_TOP], 1u);
            const unsigned tg = og / nx;
            if (og + 1u == (tg + 1u) * nx) xb_add(&bar[XB_TOPGEN], 1u);
            else XB_SPIN(xb_ld(&bar[XB_TOPGEN]) == tg, bar);
            __builtin_amdgcn_fence(__ATOMIC_ACQUIRE, "agent");
            xb_add(&bar[XB_XGEN(b.x)], 1u);
            asm volatile("s_waitcnt vmcnt(0)" ::: "memory");
        } else {
            XB_SPIN(xb_ld(&bar[XB_XGEN(b.x)]) == gen, bar);
            __builtin_amdgcn_fence(__ATOMIC_ACQUIRE, "agent");
            asm volatile("s_waitcnt vmcnt(0)" ::: "memory");
        }
    }
    __syncthreads();
}

struct EpiEven1 {
    static constexpr bool PERM = true, AFTER_DRAIN = false;
    bf16_t *QA, *VA, *GA, *ZB, *QKVB; float *LF, *GB; const float *lb, *a_log, *dt_bias;
    __device__ __forceinline__ void operator()(const f32x4 (&acc)[2][2][4][2], const Unit& u, int wr, int wc, int fr_, int fq_) const {
        int fr = fr_, fq = fq_; asm volatile("" : "+v"(fr), "+v"(fq));
        const int grp = u.pn >> 2, row0 = u.pm * 256 + wr * 64 + fr;
        if (grp == 9) {
            if (wc != 0) return;
            float al[8], db[8];
#pragma unroll
            for (int i = 0; i < 8; ++i) { const int c = (8 * fq + i) & 15; al[i] = -__expf(a_log[c]); db[i] = dt_bias[c]; }
#pragma unroll
            for (int ai = 0; ai < 2; ++ai)
#pragma unroll
                for (int m = 0; m < 4; ++m) { float* rowp = GB + (size_t)(row0 + ai * 128 + m * 16) * 32 + 8 * fq;
#pragma unroll
                    for (int n = 0; n < 2; ++n) { const f32x4 v = acc[ai][0][m][n]; f32x4 o;
#pragma unroll
                        for (int j = 0; j < 4; ++j) o[j] = (fq < 2) ? al[4 * n + j] * softplusf(v[j] + db[4 * n + j]) : sigm(v[j]);
                        *(f32x4*)(rowp + 4 * n) = o; } }
            return;
        }
        const int col0 = (u.pn & 3) * 256 + wc * 32 + 8 * fq;
        int op = 0, ld = 1024; bf16_t* dstb = VA; float* dstf = LF;
        switch (grp) {
            case 0: op = 2; dstb = QA; break;
            case 1: op = 0; dstb = VA; break;
            case 2: op = 3; dstf = LF; break;
            case 3: op = 3; dstf = LF + (size_t)M * 1024; break;
            case 4: op = 1; dstb = GA; break;
            case 5: case 6: case 7: op = 0; dstb = QKVB + (grp - 5) * 1024; ld = 3072; break;
            default: op = 1; dstb = ZB; break;
        }
        if (op == 3) {
#pragma unroll
            for (int bj = 0; bj < 2; ++bj) { float lbv[8];
#pragma unroll
                for (int i = 0; i < 8; ++i) lbv[i] = lb[col0 + bj * 128 + i];
#pragma unroll
                for (int ai = 0; ai < 2; ++ai)
#pragma unroll
                    for (int m = 0; m < 4; ++m) { float* rowp = dstf + (size_t)(row0 + ai * 128 + m * 16) * 1024 + col0 + bj * 128;
#pragma unroll
                        for (int n = 0; n < 2; ++n) { const f32x4 v = acc[ai][bj][m][n]; f32x4 o;
#pragma unroll
                            for (int j = 0; j < 4; ++j) { const float l = lbv[4 * n + j]; o[j] = __logf(l + (1.f - l) * sigm(v[j])); }
                            *(f32x4*)(rowp + 4 * n) = o; } } }
            return;
        }
#pragma unroll
        for (int ai = 0; ai < 2; ++ai)
#pragma unroll
            for (int m = 0; m < 4; ++m) { bf16_t* rowp = dstb + (size_t)(row0 + ai * 128 + m * 16) * ld + col0;
#pragma unroll
                for (int bj = 0; bj < 2; ++bj) { f32x4 v0 = acc[ai][bj][m][0], v1 = acc[ai][bj][m][1];
                    if (op >= 1) {
#pragma unroll
                        for (int j = 0; j < 4; ++j) { v0[j] = siluf(v0[j]); v1[j] = siluf(v1[j]); }
                        if (op == 2) { v0 = v0 * QSCALE; v1 = v1 * QSCALE; } }
                    u32x4 w; w.x = cvt_pk_bf16(v0[0], v0[1]); w.y = cvt_pk_bf16(v0[2], v0[3]); w.z = cvt_pk_bf16(v1[0], v1[1]); w.w = cvt_pk_bf16(v1[2], v1[3]);
                    *(u32x4*)(rowp + bj * 128) = w; } }
    }
};
struct EpiOdd1 {
    static constexpr bool PERM = true, AFTER_DRAIN = false;
    bf16_t *GY, *XBR;
    __device__ __forceinline__ void operator()(const f32x4 (&acc)[2][2][4][2], const Unit& u, int wr, int wc, int fr_, int fq_) const {
        int fr = fr_, fq = fq_; asm volatile("" : "+v"(fr), "+v"(fq));
        const int row0 = u.pm * 256 + wr * 64 + fr; const bool isy = u.pn < 8;
        bf16_t* dst = isy ? GY : XBR; const int col0 = (u.pn & 7) * 256 + wc * 32 + 8 * fq;
#pragma unroll
        for (int ai = 0; ai < 2; ++ai)
#pragma unroll
            for (int m = 0; m < 4; ++m) { bf16_t* rowp = dst + (size_t)(row0 + ai * 128 + m * 16) * D + col0;
#pragma unroll
                for (int bj = 0; bj < 2; ++bj) { f32x4 v0 = acc[ai][bj][m][0], v1 = acc[ai][bj][m][1];
                    if (isy) {
#pragma unroll
                        for (int j = 0; j < 4; ++j) { v0[j] = gelu_tanh(v0[j]); v1[j] = gelu_tanh(v1[j]); } }
                    u32x4 w; w.x = cvt_pk_bf16(v0[0], v0[1]); w.y = cvt_pk_bf16(v0[2], v0[3]); w.z = cvt_pk_bf16(v1[0], v1[1]); w.w = cvt_pk_bf16(v1[2], v1[3]);
                    *(u32x4*)(rowp + bj * 128) = w; } }
    }
};
struct EpiGates {
    static constexpr bool PERM = true, AFTER_DRAIN = false;
    const bf16_t* XC; unsigned* AB; const float *gate_b  , *lam  ;
    __device__ __forceinline__ void operator()(const f32x4 (&acc)[2][2][4][2], const Unit& u, int wr, int wc, int fr_, int fq_) const {
        int fr = fr_, fq = fq_; asm volatile("" : "+v"(fr), "+v"(fq));
        const int nb = u.pn >> 2, pn4 = u.pn & 3, d = pn4 >> 1, half = pn4 & 1;
        const int row0 = u.pm * 256 + wr * 64 + fr, ch0 = nb * 256 + half * 128 + wc * 32 + 8 * fq;
        unsigned* ab = AB + (size_t)d * M * D;
#pragma unroll
        for (int n = 0; n < 2; ++n) {
            const int ch = ch0 + 4 * n;
            const f32x4 gr = *(const f32x4*)(gate_b + (d * 2 + 0) * D + ch), gi = *(const f32x4*)(gate_b + (d * 2 + 1) * D + ch), lm = *(const f32x4*)(lam + d * D + ch);
            f32x4 sp;
#pragma unroll
            for (int j = 0; j < 4; ++j) sp[j] = -8.0f * softplusf(-lm[j]);
#pragma unroll
            for (int ai = 0; ai < 2; ++ai)
#pragma unroll
                for (int m = 0; m < 4; ++m) { const size_t ro = (size_t)(row0 + ai * 128 + m * 16) * D + ch;
                    const u32x2 xr = *(const u32x2*)(XC + ro); const float xc[4] = {bflo(xr.x), bfhi(xr.x), bflo(xr.y), bfhi(xr.y)};
                    u32x4 o;
#pragma unroll
                    for (int j = 0; j < 4; ++j) { const float r = sigm(acc[ai][0][m][n][j] + gr[j]), ig = sigm(acc[ai][1][m][n][j] + gi[j]);
                        const float la = r * sp[j], bb = __builtin_sqrtf(neg_expm1_fast(2.f * la)) * (ig * xc[j]); o[j] = pk2(la, bb); }
                    *(u32x4*)(ab + ro) = o; }
        }
    }
};
struct EpiResid {
    static constexpr bool PERM = false, AFTER_DRAIN = false;
    const float *r0, *r1; float* out; const float* gt; int permute;
    __device__ __forceinline__ void operator()(const f32x4 (&acc)[2][2][4][2], const Unit& u, int wr, int wc, int fr_, int fq_) const {
        int fr = fr_, fq = fq_; asm volatile("" : "+v"(fr), "+v"(fq));
        const int rowt = u.pm * 256, mi = mod_index(rowt), col0 = u.pn * 256 + wc * 32 + 4 * fq;
        f32x4 gv[2][2];
#pragma unroll
        for (int bj = 0; bj < 2; ++bj)
#pragma unroll
            for (int n = 0; n < 2; ++n) gv[bj][n] = *(const f32x4*)(gt + (size_t)mi * 12288 + col0 + bj * 128 + n * 16) + 1.0f;
#pragma unroll
        for (int ai = 0; ai < 2; ++ai)
#pragma unroll
            for (int m = 0; m < 4; ++m) { const int rr = rowt + ai * 128 + wr * 64 + m * 16 + fr, tok = permute ? unperm_row(rr) : rr;
                const float* rp = (tok < MX ? r0 + (size_t)tok * D : r1 + (size_t)(tok - MX) * D) + col0; float* op = out + (size_t)tok * D + col0;
#pragma unroll
                for (int bj = 0; bj < 2; ++bj)
#pragma unroll
                    for (int n = 0; n < 2; ++n) { const f32x4 rs = *(const f32x4*)(rp + bj * 128 + n * 16); *(f32x4*)(op + bj * 128 + n * 16) = rs * DN_ALPHA + gv[bj][n] * acc[ai][bj][m][n]; }
                asm volatile("" ::: "memory"); }
    }
};
struct EpiSlab {
    static constexpr bool PERM = false, AFTER_DRAIN = false;
    float* slab; int S, ks;
    __device__ __forceinline__ void operator()(const f32x4 (&acc)[2][2][4][2], const Unit& u, int wr, int wc, int fr_, int fq_) const {
        int fr = fr_, fq = fq_; asm volatile("" : "+v"(fr), "+v"(fq));
        float* base = slab + (size_t)((((u.pm - 64) * 8 + u.pn) * S) + u.ka / ks) * 65536 + (wr * 64 + fr) * 256 + wc * 32 + 4 * fq;
#pragma unroll
        for (int ai = 0; ai < 2; ++ai)
#pragma unroll
            for (int m = 0; m < 4; ++m)
#pragma unroll
                for (int bj = 0; bj < 2; ++bj)
#pragma unroll
                    for (int n = 0; n < 2; ++n) *(f32x4*)(base + (ai * 128 + m * 16) * 256 + bj * 128 + n * 16) = acc[ai][bj][m][n];
    }
};
struct EpiSwiGLU {
    static constexpr bool PERM = true, AFTER_DRAIN = false;
    bf16_t* ACT;
    __device__ __forceinline__ void operator()(const f32x4 (&acc)[2][2][4][2], const Unit& u, int wr, int wc, int fr_, int fq_) const {
        int fr = fr_, fq = fq_; asm volatile("" : "+v"(fr), "+v"(fq));
        const int row0 = u.pm * 256 + wr * 64 + fr, col0 = u.pn * 128 + wc * 32 + 8 * fq;
#pragma unroll
        for (int ai = 0; ai < 2; ++ai)
#pragma unroll
            for (int m = 0; m < 4; ++m) { f32x4 v0 = acc[ai][0][m][0], v1 = acc[ai][0][m][1]; const f32x4 u0 = acc[ai][1][m][0], u1 = acc[ai][1][m][1];
#pragma unroll
                for (int j = 0; j < 4; ++j) { v0[j] = siluf(v0[j]) * u0[j]; v1[j] = siluf(v1[j]) * u1[j]; }
                u32x4 w; w.x = cvt_pk_bf16(v0[0], v0[1]); w.y = cvt_pk_bf16(v0[2], v0[3]); w.z = cvt_pk_bf16(v1[0], v1[1]); w.w = cvt_pk_bf16(v1[2], v1[3]);
                *(u32x4*)(ACT + (size_t)(row0 + ai * 128 + m * 16) * FF + col0) = w; }
    }
};
struct Frame {
    LAS unsigned char* lds;
    int tid, lane, wave, G, gw, NGW;
};
struct Args { const float* in[25]; float* out; unsigned char* ws; int ph_lo, ph_hi; };

template <int MODE> __device__ __forceinline__ long src_off(int n, int nsrc) {
    if (MODE == 0) return n < nsrc ? (long)n : -1L;
    if (MODE == 1) { const int pn = n >> 8, bj = (n >> 7) & 1, jj = n & 127; return (long)bj * FF + pn * 128 + jj; }
    const int nb = n >> 10, c = n & 1023, pn4 = c >> 8, g = (c >> 7) & 1, jj = c & 127, d = pn4 >> 1, half = pn4 & 1;
    return (long)(((d * 2 + g) * 8 + nb) * 256) * 256 + half * 128 + jj;
}
template <int MODE> __device__ __forceinline__ void tr_item(const float* W, int ldin, int K, bf16* WT, int nout, int nsrc, LAS float* scr, int item, int lane) {
    const int nblk = nout / 32, kb = item / nblk, nb = item % nblk, k0 = 64 * kb, n0 = 32 * nb;
    const long off = src_off<MODE>(n0 + (lane & 31), nsrc);
#pragma unroll 8
    for (int i = 0; i < 32; ++i) { const int kk = 2 * i + (lane >> 5); scr[kk * 33 + (lane & 31)] = off >= 0 ? W[off + (size_t)(k0 + kk) * ldin] : 0.f; }
    LDS_WAIT(); asm volatile("" ::: "memory");
    const int c = lane & 7;
#pragma unroll
    for (int j = 0; j < 4; ++j) { const int n = (lane >> 3) + 8 * j; const LAS float* s = scr + (8 * c) * 33 + n;
        u32x4 o; o.x = pk2(s[0 * 33], s[1 * 33]); o.y = pk2(s[2 * 33], s[3 * 33]); o.z = pk2(s[4 * 33], s[5 * 33]); o.w = pk2(s[6 * 33], s[7 * 33]);
        *(u32x4*)(WT + (size_t)(n0 + n) * K + k0 + 8 * c) = o; }
    LDS_WAIT(); asm volatile("" ::: "memory");
}
__device__ __forceinline__ void gemv_item(const Args& a, int gi, int lane, float* PART) {
    const int l = gi / 384, c48 = (gi >> 3) % 48, kp = gi & 7, col = c48 * 256 + lane * 4;
    const float* W = a.in[4] + ((size_t)l * D + kp * 256) * 12288 + col;
    const float* c0 = a.in[1] + kp * 256; const float* c1 = c0 + D; const float* c2 = a.in[3] + kp * 256;
    f32x4 s0 = {0.f, 0.f, 0.f, 0.f}, s1 = s0, s2 = s0;
#pragma unroll 8
    for (int k = 0; k < 256; ++k) { const f32x4 w = *(const f32x4*)(W + (size_t)k * 12288); s0 += w * siluf(c0[k]); s1 += w * siluf(c1[k]); s2 += w * siluf(c2[k]); }
    float* p = PART + ((size_t)(kp * 4 + l) * 3) * 12288 + col;
    *(f32x4*)p = s0; *(f32x4*)(p + 12288) = s1; *(f32x4*)(p + 2 * 12288) = s2;
}
__device__ __forceinline__ void ph_prologue(Frame& F, const Args& a) {
    LAS float* scr = (LAS float*)(F.lds + RING_OFF + F.wave * 16384);
    unsigned char* ws = a.ws;
    constexpr int I_INE = (D / 64) * (NE_INP / 32), I_SQ = (D / 64) * (D / 32), I_INO = (D / 64) * (2 * D / 32), I_GATE = (256 / 64) * (8192 / 32), I_GU = (D / 64) * (2 * FF / 32), I_DN = (FF / 64) * (D / 32);
    constexpr int NGEMV = 4 * 48 * 8;
    constexpr int NITEMS = NGEMV + 2 * (I_INE + I_SQ + I_INO + I_GATE + I_SQ) + 4 * (I_GU + I_DN);
    for (int it = F.gw; it < NITEMS; it += F.NGW) {
        int r = it;
        if (r < NGEMV) { gemv_item(a, r, F.lane, (float*)(ws + WS_PART)); continue; } r -= NGEMV;
        bool done = false;
#pragma unroll 1
        for (int j = 0; j < 2 && !done; ++j) {
            if (r < I_INE) { tr_item<0>(a.in[10] + (size_t)j * D * NE_IN, NE_IN, D, (bf16*)(ws + WS_WINE + j * SZ_WINE), NE_INP, NE_IN, scr, r, F.lane); done = true; break; } r -= I_INE;
            if (r < I_SQ) { tr_item<0>(a.in[17] + (size_t)j * D * D, D, D, (bf16*)(ws + WS_WOUTE + j * SZ_WSQ), D, D, scr, r, F.lane); done = true; break; } r -= I_SQ;
            if (r < I_INO) { tr_item<0>(a.in[18] + (size_t)j * D * 2 * D, 2 * D, D, (bf16*)(ws + WS_WINO + j * SZ_WINO), 2 * D, 2 * D, scr, r, F.lane); done = true; break; } r -= I_INO;
            if (r < I_GATE) { tr_item<2>(a.in[21] + (size_t)j * 4 * 8 * 256 * 256, 256, 256, (bf16*)(ws + WS_WGATE + j * SZ_WGATE), 8192, 8192, scr, r, F.lane); done = true; break; } r -= I_GATE;
            if (r < I_SQ) { tr_item<0>(a.in[24] + (size_t)j * D * D, D, D, (bf16*)(ws + WS_WOUTO + j * SZ_WSQ), D, D, scr, r, F.lane); done = true; break; } r -= I_SQ;
        }
        if (done) continue;
#pragma unroll 1
        for (int l = 0; l < 4; ++l) {
            if (r < I_GU) { tr_item<1>(a.in[8] + (size_t)l * D * 2 * FF, 2 * FF, D, (bf16*)(ws + WS_WGU + l * SZ_WGU), 2 * FF, 2 * FF, scr, r, F.lane); break; } r -= I_GU;
            if (r < I_DN) { tr_item<0>(a.in[9] + (size_t)l * FF * D, D, FF, (bf16*)(ws + WS_WDN + l * SZ_WDN), D, D, scr, r, F.lane); break; } r -= I_DN;
        }
    }
}
__device__ __forceinline__ void ph_modreduce(Frame& F, const Args& a) {
    float* MOD = (float*)(a.ws + WS_MOD); const float* PART = (const float*)(a.ws + WS_PART); float* LB = (float*)(a.ws + WS_LB);
    const int gt = blockIdx.x * NTHREADS + F.tid, NT = F.G * NTHREADS;
    for (int i = gt; i < 4 * 3 * 12288; i += NT) { const int l = i / 36864, n = i % 12288; float s = a.in[5][l * 12288 + n];
#pragma unroll
        for (int kp = 0; kp < 8; ++kp) s += PART[(size_t)kp * 147456 + i];
        MOD[i] = s; }
    for (int i = gt; i < 2048; i += NT) { const int c = i & 1023; LB[i] = i < 1024 ? 0.f : sigm(a.in[14][1024 + c] - a.in[14][c]); }
}
__device__ __forceinline__ void store_hx(bf16* HX, int orow, const f32x4 (&v)[8], const float* sh, const float* sc, int lane) {
    unsigned long long* o8 = (unsigned long long*)(HX + (size_t)orow * D) + lane;
#pragma unroll
    for (int j = 0; j < 8; ++j) { const f32x4 s = *(const f32x4*)(sc + 4 * (lane + 64 * j)), h = *(const f32x4*)(sh + 4 * (lane + 64 * j)); const f32x4 y = v[j] * (s + 1.0f) + h;
        o8[64 * j] = (unsigned long long)pk2(y[0], y[1]) | ((unsigned long long)pk2(y[2], y[3]) << 32); }
}
__device__ __forceinline__ void ph_mod0(Frame& F, const Args& a) {
    const float* MOD = (const float*)(a.ws + WS_MOD); bf16* HX = (bf16*)(a.ws + WS_HX);
    for (int row = F.gw; row < M; row += F.NGW) {
        const float* p = row < MX ? a.in[0] + (size_t)row * D : a.in[2] + (size_t)(row - MX) * D; f32x4 v[8];
#pragma unroll
        for (int j = 0; j < 8; ++j) v[j] = *(const f32x4*)(p + 4 * (F.lane + 64 * j));
        const float* md = MOD + (size_t)mod_index(row) * 12288;
        store_hx(HX, row, v, md, md + D, F.lane);
    }
}
struct TailSrc { const float* slab; int S; const float* resid; const float* gt; };
__device__ __forceinline__ void ph_ln(Frame& F, float* buf, int nrows, const float* g, const float* b, float* dout, bf16* HX, const float* modsh, const float* modsc, int permute, const TailSrc ts) {
    for (int row0 = F.gw; row0 < nrows; row0 += 2 * F.NGW) {
        f32x4 v[2][8]; float s[2] = {0.f, 0.f}, q[2] = {0.f, 0.f};
#pragma unroll
        for (int u = 0; u < 2; ++u) { const int row = row0 + u * F.NGW; if (row < nrows) { const float* p = buf + (size_t)row * D;
            if (ts.slab && row >= MX) { const int rc = row - MX, pmc = rc >> 8, rr = rc & 255;
#pragma unroll
                for (int jj = 0; jj < 8; ++jj) { const int col = 4 * (F.lane + 64 * jj); f32x4 acc = {0.f, 0.f, 0.f, 0.f};
                    const float* sp = ts.slab + (size_t)((pmc * 8 + jj) * ts.S) * 65536 + rr * 256 + 4 * F.lane;
                    for (int s2 = 0; s2 < ts.S; ++s2) acc += *(const f32x4*)(sp + (size_t)s2 * 65536);
                    v[u][jj] = *(const f32x4*)(ts.resid + (size_t)rc * D + col) * DN_ALPHA + (*(const f32x4*)(ts.gt + col) + 1.0f) * acc; }
            } else {
#pragma unroll
            for (int jj = 0; jj < 8; ++jj) v[u][jj] = *(const f32x4*)(p + 4 * (F.lane + 64 * jj)); } } else {
#pragma unroll
            for (int jj = 0; jj < 8; ++jj) v[u][jj] = (f32x4){0.f, 0.f, 0.f, 0.f}; } }
#pragma unroll
        for (int u = 0; u < 2; ++u)
#pragma unroll
            for (int jj = 0; jj < 8; ++jj) s[u] += (v[u][jj][0] + v[u][jj][1]) + (v[u][jj][2] + v[u][jj][3]);
#pragma unroll
        for (int u = 0; u < 2; ++u) { const float mean = wave_sum(s[u]) * (1.f / D);
#pragma unroll
            for (int jj = 0; jj < 8; ++jj) { v[u][jj] = v[u][jj] - mean; q[u] += (v[u][jj][0] * v[u][jj][0] + v[u][jj][1] * v[u][jj][1]) + (v[u][jj][2] * v[u][jj][2] + v[u][jj][3] * v[u][jj][3]); } }
#pragma unroll
        for (int u = 0; u < 2; ++u) { const int row = row0 + u * F.NGW; if (row >= nrows) continue;
            const float rstd = 1.f / sqrtf(wave_sum(q[u]) * (1.f / D) + LN_EPS);
            float* o = (dout ? dout : buf) + (size_t)row * D;
#pragma unroll
            for (int jj = 0; jj < 8; ++jj) { const f32x4 gg = *(const f32x4*)(g + 4 * (F.lane + 64 * jj)), bb = *(const f32x4*)(b + 4 * (F.lane + 64 * jj)); v[u][jj] = v[u][jj] * rstd * gg + bb; *(f32x4*)(o + 4 * (F.lane + 64 * jj)) = v[u][jj]; }
            if (HX) { const int mi = mod_index(row); store_hx(HX, permute ? perm_row(row) : row, v[u], modsh + (size_t)mi * 12288, modsc + (size_t)mi * 12288, F.lane); } }
    }
}
__device__ __forceinline__ void seg_bounds(int r, int& lo, int& hi) { if (r < MX) { lo = r & ~(SEQ - 1); hi = lo + SEQ; } else { lo = MX + ((r - MX) & ~(CTXL - 1)); hi = lo + CTXL; } }
__device__ __forceinline__ float row16_sum(float v) { v += __shfl_xor(v, 1); v += __shfl_xor(v, 2); v += __shfl_xor(v, 4); v += __shfl_xor(v, 8); return v; }
template <int MODE> __device__ __forceinline__ void ph_conv(Frame& F, const Args& a, int j) {
    constexpr int NG = MODE == 0 ? 6 : 4, LDI = MODE == 0 ? 3072 : D;
    const bf16* X = (const bf16*)(a.ws + (MODE == 0 ? WS_QKVB : WS_XBR));
    const float* cw = MODE == 0 ? a.in[11] + (size_t)j * 4 * 3072 : a.in[19] + (size_t)j * 4 * D;
    for (int it = F.gw; it < (M / 16) * NG; it += F.NGW) {
        const int si = it / NG, kg = it - si * NG, r0 = si * 16, ch = kg * 512 + 8 * F.lane;
        int lo, hi; seg_bounds(r0, lo, hi);
        float w[4][8];
#pragma unroll
        for (int k = 0; k < 4; ++k) { const f32x4 w0 = *(const f32x4*)(cw + k * LDI + ch), w1 = *(const f32x4*)(cw + k * LDI + ch + 4);
#pragma unroll
            for (int c = 0; c < 4; ++c) { w[k][c] = w0[c]; w[k][4 + c] = w1[c]; } }
        float bias[8];
#pragma unroll
        for (int c = 0; c < 8; ++c) bias[c] = 0.f;
        if (MODE == 1) { const float* cb = a.in[20] + (size_t)j * D + ch; const f32x4 b0 = *(const f32x4*)cb, b1 = *(const f32x4*)(cb + 4);
#pragma unroll
            for (int c = 0; c < 4; ++c) { bias[c] = b0[c]; bias[4 + c] = b1[c]; } }
        u32x4 xr[19];
#pragma unroll
        for (int r = 0; r < 19; ++r) { const int rr = r0 + r - 2; xr[r] = (rr >= lo && rr < hi) ? *(const u32x4*)(X + (size_t)rr * LDI + ch) : (u32x4){0u, 0u, 0u, 0u}; }
#pragma unroll
        for (int r = 0; r < 16; ++r) { float y[8];
#pragma unroll
            for (int c = 0; c < 8; ++c) y[c] = bias[c];
#pragma unroll
            for (int k = 0; k < 4; ++k) { const u32x4 x = xr[r + k];
#pragma unroll
                for (int c = 0; c < 4; ++c) { y[2 * c] += w[k][2 * c] * bflo(x[c]); y[2 * c + 1] += w[k][2 * c + 1] * bfhi(x[c]); } }
            const int row = r0 + r;
            if (MODE == 0) {
#pragma unroll
                for (int c = 0; c < 8; ++c) y[c] = siluf(y[c]);
                if (kg < 4) { float ss = 0.f;
#pragma unroll
                    for (int c = 0; c < 8; ++c) ss += y[c] * y[c];
                    const float sc = rsqrtf(row16_sum(ss) + 1e-6f) * (kg < 2 ? QSCALE : 1.f);
#pragma unroll
                    for (int c = 0; c < 8; ++c) y[c] *= sc; }
                bf16* dst = (bf16*)(a.ws + (kg < 2 ? WS_QB : (kg < 4 ? WS_KB : WS_VB))) + (size_t)row * AW + (kg & 1) * 512 + 8 * F.lane;
                *(u32x4*)dst = (u32x4){pk2(y[0], y[1]), pk2(y[2], y[3]), pk2(y[4], y[5]), pk2(y[6], y[7])};
            } else {
                *(u32x4*)((bf16*)(a.ws + WS_XC) + (size_t)row * D + ch) = (u32x4){pk2(y[0], y[1]), pk2(y[2], y[3]), pk2(y[4], y[5]), pk2(y[6], y[7])};
            } }
    }
}
__device__ __forceinline__ void ph_merge(Frame& F, const Args& a, int j) {
    bf16* MIX = (bf16*)(a.ws + WS_MIX);
    for (int row = F.gw; row < M; row += F.NGW) {
        u32x4 o0[4], o1[4], gg[4];
#pragma unroll
        for (int q = 0; q < 4; ++q) { const int part = q >> 1, c = (q & 1) * 512 + 8 * F.lane; const bf16* O = (const bf16*)(a.ws + (part ? WS_OB : WS_OA)); const size_t o = (size_t)row * AW + c;
            o0[q] = *(const u32x4*)(O + o); o1[q] = *(const u32x4*)(O + (size_t)M * AW + o); gg[q] = *(const u32x4*)((const bf16*)(a.ws + (part ? WS_ZB : WS_GA)) + o); }
#pragma unroll
        for (int q = 0; q < 4; ++q) { const int part = q >> 1, c = (q & 1) * 512 + 8 * F.lane; const float* nw = (part ? a.in[16] : a.in[15]) + (size_t)j * AW + c;
            const f32x4 n0 = *(const f32x4*)nw, n1 = *(const f32x4*)(nw + 4); float y[8]; float ss = 0.f;
#pragma unroll
            for (int k = 0; k < 4; ++k) { y[2 * k] = bflo(o0[q][k]) + bflo(o1[q][k]); y[2 * k + 1] = bfhi(o0[q][k]) + bfhi(o1[q][k]); ss += y[2 * k] * y[2 * k] + y[2 * k + 1] * y[2 * k + 1]; }
            const float sc = rsqrtf(row16_sum(ss) * (1.f / 128.f) + 1e-6f);
#pragma unroll
            for (int k = 0; k < 4; ++k) { y[2 * k] *= sc * (k < 2 ? n0[2 * k] : n1[2 * k - 4]) * bflo(gg[q][k]); y[2 * k + 1] *= sc * (k < 2 ? n0[2 * k + 1] : n1[2 * k - 3]) * bfhi(gg[q][k]); }
            *(u32x4*)(MIX + (size_t)row * D + part * AW + c) = (u32x4){pk2(y[0], y[1]), pk2(y[2], y[3]), pk2(y[4], y[5]), pk2(y[6], y[7])}; }
    }
}
__device__ __forceinline__ void ph_odd_l1(Frame& F, const Args& a) {
    const unsigned* AB = (const unsigned*)(a.ws + WS_AB); float2* PH = (float2*)(a.ws + WS_R);
    for (int it = F.gw; it < 128 * 132; it += F.NGW) {
        const int cgp = it & 127, tc = it >> 7, c = cgp * 64 + F.lane, ch = c & 2047, d = (c >> 11) & 1, b = c >> 12;
        const unsigned* ab = AB + (size_t)d * M * D + ch; float P = 1.f, H = 0.f;
        const int row0 = seq_row(b, d, tc * 64), stp = d ? -1 : 1;
#pragma unroll 1
        for (int k0 = 0; k0 < 64; k0 += 16) { unsigned x[16];
#pragma unroll
            for (int k = 0; k < 16; ++k) x[k] = ab[(size_t)(row0 + stp * (k0 + k)) * D];
#pragma unroll
            for (int k = 0; k < 16; ++k) { const float al = __expf(bflo(x[k])); P *= al; H = al * H + bfhi(x[k]); } }
        PH[(size_t)tc * 8192 + c] = make_float2(P, H);
    }
}
__device__ __forceinline__ void ph_odd_l3(Frame& F, const Args& a) {
    const unsigned* AB = (const unsigned*)(a.ws + WS_AB); const float2* PH = (const float2*)(a.ws + WS_R); const bf16* GY = (const bf16*)(a.ws + WS_GY); bf16* MIX = (bf16*)(a.ws + WS_MIX);
    for (int it = F.gw; it < 64 * 132; it += F.NGW) {
        const int g64 = it & 63, jb = it >> 6, b = g64 >> 5, ch = (g64 & 31) * 64 + F.lane;
        const int row0 = jb < 4 ? MX + b * CTXL + jb * 64 : b * SEQ + (jb - 4) * 64;
        const int tcf = jb, tcb = jb < 4 ? 3 - jb : 4 + (131 - jb);
        const int cf = (b << 12) + ch, cb = (b << 12) + 2048 + ch;
        float hf = 0.f, hb = 0.f;
        for (int q = 0; q < tcf; ++q) { const float2 p = PH[(size_t)q * 8192 + cf]; hf = p.x * hf + p.y; }
        for (int q = 0; q < tcb; ++q) { const float2 p = PH[(size_t)q * 8192 + cb]; hb = p.x * hb + p.y; }
        const unsigned* ab0 = AB + (size_t)row0 * D + ch; const unsigned* ab1 = ab0 + (size_t)M * D;
        float hs[64];
#pragma unroll
        for (int k0 = 0; k0 < 64; k0 += 16) { unsigned x[16];
#pragma unroll
            for (int k = 0; k < 16; ++k) x[k] = ab0[(size_t)(k0 + k) * D];
#pragma unroll
            for (int k = 0; k < 16; ++k) { hf = __expf(bflo(x[k])) * hf + bfhi(x[k]); hs[k0 + k] = hf; } }
        const bf16* gy = GY + (size_t)row0 * D + ch; bf16* mx = MIX + (size_t)row0 * D + ch;
#pragma unroll
        for (int k0 = 48; k0 >= 0; k0 -= 16) { unsigned x[16]; bf16 gv[16];
#pragma unroll
            for (int k = 0; k < 16; ++k) { x[k] = ab1[(size_t)(k0 + k) * D]; gv[k] = gy[(size_t)(k0 + k) * D]; }
#pragma unroll
            for (int k = 15; k >= 0; --k) { hb = __expf(bflo(x[k])) * hb + bfhi(x[k]); mx[(size_t)(k0 + k) * D] = (bf16)f2bf(bf2f(gv[k]) * (hs[k0 + k] + hb)); } }
    }
}
__device__ __forceinline__ void hgrn_wave(int wi, int lane, const bf16* QA, const float* LF, const bf16* VA, bf16* OA) {
    const int chain = wi >> 3, cg = wi & 7, b = chain >> 4, h = (chain >> 1) & 7, dir = chain & 1, kq = lane >> 4, col = cg * 16 + (lane & 15);
    const float* lf = LF + (size_t)dir * M * AW + h * 128 + kq * 32; const bf16* qa = QA + h * 128 + kq * 32; const bf16* va = VA + h * 128 + col; bf16* oa = OA + (size_t)dir * M * AW + h * 128 + col;
    float S[32];
#pragma unroll
    for (int i = 0; i < 32; ++i) S[i] = 0.f;
    u32x4 qn[4]; f32x4 fn[8]; float vn; int rown = seq_row(b, dir, 0);
#pragma unroll
    for (int i = 0; i < 4; ++i) qn[i] = *(const u32x4*)(qa + (size_t)rown * AW + 8 * i);
#pragma unroll
    for (int i = 0; i < 8; ++i) fn[i] = *(const f32x4*)(lf + (size_t)rown * AW + 4 * i);
    vn = bf2f(va[(size_t)rown * AW]);
    for (int s = 0; s < CTXL + SEQ; ++s) {
        u32x4 qc[4]; f32x4 fc[8]; const float vc = vn; const int row = rown;
#pragma unroll
        for (int i = 0; i < 4; ++i) qc[i] = qn[i];
#pragma unroll
        for (int i = 0; i < 8; ++i) fc[i] = fn[i];
        if (s + 1 < CTXL + SEQ) { rown = seq_row(b, dir, s + 1);
#pragma unroll
            for (int i = 0; i < 4; ++i) qn[i] = *(const u32x4*)(qa + (size_t)rown * AW + 8 * i);
#pragma unroll
            for (int i = 0; i < 8; ++i) fn[i] = *(const f32x4*)(lf + (size_t)rown * AW + 4 * i);
            vn = bf2f(va[(size_t)rown * AW]); }
        float o = 0.f;
#pragma unroll
        for (int i = 0; i < 32; ++i) { const float f = __expf(fc[i >> 2][i & 3]); const unsigned qw = qc[i >> 3][(i >> 1) & 3]; const float q = (i & 1) ? bfhi(qw) : bflo(qw);
            S[i] = f * (S[i] - vc) + vc; o += S[i] * q; }
        o += __shfl_xor(o, 16); o += __shfl_xor(o, 32);
        if (kq == 0) oa[(size_t)row * AW] = (bf16)f2bf(o);
    }
}
__device__ __forceinline__ void gdn_wave(int wi, int lane, const bf16* QB, const bf16* KB, const bf16* VB, const float* GB, bf16* OB) {
    const int chain = wi >> 3, cg = wi & 7, b = chain >> 4, h = (chain >> 1) & 7, dir = chain & 1, kq = lane >> 4, col = cg * 16 + (lane & 15);
    const bf16* qb = QB + h * 128 + kq * 32; const bf16* kb = KB + h * 128 + kq * 32; const bf16* vb = VB + h * 128 + col; const float* gb = GB + dir * 8 + h; bf16* ob = OB + (size_t)dir * M * AW + h * 128 + col;
    float S[32];
#pragma unroll
    for (int i = 0; i < 32; ++i) S[i] = 0.f;
    u32x4 qn[4], kn[4]; float vn, gn, bn; int rown = seq_row(b, dir, 0);
#pragma unroll
    for (int i = 0; i < 4; ++i) { qn[i] = *(const u32x4*)(qb + (size_t)rown * AW + 8 * i); kn[i] = *(const u32x4*)(kb + (size_t)rown * AW + 8 * i); }
    vn = bf2f(vb[(size_t)rown * AW]); gn = gb[(size_t)rown * 32]; bn = gb[(size_t)rown * 32 + 16];
    for (int s = 0; s < CTXL + SEQ; ++s) {
        u32x4 qc[4], kc[4]; const float vc = vn, gc = gn, bc = bn; const int row = rown;
#pragma unroll
        for (int i = 0; i < 4; ++i) { qc[i] = qn[i]; kc[i] = kn[i]; }
        if (s + 1 < CTXL + SEQ) { rown = seq_row(b, dir, s + 1);
#pragma unroll
            for (int i = 0; i < 4; ++i) { qn[i] = *(const u32x4*)(qb + (size_t)rown * AW + 8 * i); kn[i] = *(const u32x4*)(kb + (size_t)rown * AW + 8 * i); }
            vn = bf2f(vb[(size_t)rown * AW]); gn = gb[(size_t)rown * 32]; bn = gb[(size_t)rown * 32 + 16]; }
        const float al = __expf(gc); float ks = 0.f; float kk[32];
#pragma unroll
        for (int i = 0; i < 32; ++i) { const unsigned kw = kc[i >> 3][(i >> 1) & 3]; kk[i] = (i & 1) ? bfhi(kw) : bflo(kw); ks += kk[i] * S[i]; }
        ks += __shfl_xor(ks, 16); ks += __shfl_xor(ks, 32);
        const float dl = bc * (vc - al * ks); float o = 0.f;
#pragma unroll
        for (int i = 0; i < 32; ++i) { const unsigned qw = qc[i >> 3][(i >> 1) & 3]; const float q = (i & 1) ? bfhi(qw) : bflo(qw); S[i] = al * S[i] + kk[i] * dl; o += S[i] * q; }
        o += __shfl_xor(o, 16); o += __shfl_xor(o, 32);
        if (kq == 0) ob[(size_t)row * AW] = (bf16)f2bf(o);
    }
}
__device__ __forceinline__ void ph_even_scan(Frame& F, const Args& a) {
    unsigned char* ws = a.ws;
    if (F.wave == 0) { for (int wi = blockIdx.x; wi < 256; wi += F.G) hgrn_wave(wi, F.lane, (const bf16*)(ws + WS_QA), (const float*)(ws + WS_LF), (const bf16*)(ws + WS_VA), (bf16*)(ws + WS_OA)); }
    else if (F.wave == 1) { for (int wi = blockIdx.x; wi < 256; wi += F.G) gdn_wave(wi, F.lane, (const bf16*)(ws + WS_QB), (const bf16*)(ws + WS_KB), (const bf16*)(ws + WS_VB), (const float*)(ws + WS_GB), (bf16*)(ws + WS_OB)); }
}
typedef short bf16x8 __attribute__((ext_vector_type(8)));
typedef short bf16x4 __attribute__((ext_vector_type(4)));
constexpr int NCHUNK = (CTXL + SEQ) / 16;
constexpr int NCHH = 32 * NCHUNK;
constexpr int HREC = 9216;
constexpr int HQ_OFF = 0, HK_OFF = 4096, HP_OFF = 8192, HD_OFF = 8704;
constexpr int GREC = 17152;
constexpr int GW_OFF = 0, GQ_OFF = 4096, GK_OFF = 8192, GU_OFF = 12288, GAT_OFF = 16384, GAL_OFF = 16896;
__device__ __forceinline__ unsigned cvtpk(float lo, float hi) { return pg8::cvt_pk_bf16(lo, hi); }
template <int N> __device__ __forceinline__ float row_shr(float x) { return __builtin_bit_cast(float, __builtin_amdgcn_update_dpp(0, __builtin_bit_cast(int, x), 0x110 + N, 0xf, 0xf, true)); }
__device__ __forceinline__ float row_prefix(float x) { x += row_shr<1>(x); x += row_shr<2>(x); x += row_shr<4>(x); x += row_shr<8>(x); return x; }
__device__ __forceinline__ float rdlane(float x, int l) { return __builtin_bit_cast(float, __builtin_amdgcn_readlane(__builtin_bit_cast(int, x), l)); }
__device__ __forceinline__ bf16x8 mk8(unsigned a, unsigned b, unsigned c, unsigned d) { return __builtin_bit_cast(bf16x8, (u32x4){a, b, c, d}); }
__device__ __forceinline__ bf16x4 mk4(unsigned a, unsigned b) { return __builtin_bit_cast(bf16x4, (u32x2){a, b}); }
__device__ __forceinline__ f32x4 mfma32_safe(bf16x8 a, bf16x8 b, f32x4 c) { f32x4 d = __builtin_amdgcn_mfma_f32_16x16x32_bf16(a, b, c, 0, 0, 0); asm volatile("" : "+v"(d) : "v"(a), "v"(b)); return d; }
#define MFMA32(a, b, c) mfma32_safe((a), (b), (c))
#define MFMA16(a, b, c) __builtin_amdgcn_mfma_f32_16x16x16bf16_1k((a), (b), (c), 0, 0, 0)

__device__ __forceinline__ void hgrn_s1(int chh, int lane, unsigned char* ws) {
    const int chain = chh / NCHUNK, ci = chh - chain * NCHUNK, b = chain >> 4, h = (chain >> 1) & 7, dir = chain & 1, i = lane & 15, g = lane >> 4;
    const int row = seq_row(b, dir, ci * 16 + i);
    const bf16* qrow = (const bf16*)(ws + WS_QA) + (size_t)row * AW + h * 128 + 4 * g;
    const float* frow = (const float*)(ws + WS_LF) + (size_t)dir * M * AW + (size_t)row * AW + h * 128 + 4 * g;
    unsigned char* rec = ws + WS_HREC + (size_t)chh * HREC;
    bf16* hk = (bf16*)(rec + HK_OFF) + (16 * (i >> 2)) * 4 + (i & 3);
    f32x4 pacc = {0.f, 0.f, 0.f, 0.f};
#pragma unroll
    for (int s = 0; s < 4; ++s) {
        u32x2 qv[2]; f32x4 fv[2];
#pragma unroll
        for (int hh = 0; hh < 2; ++hh) { qv[hh] = *(const u32x2*)(qrow + 32 * s + 16 * hh); fv[hh] = *(const f32x4*)(frow + 32 * s + 16 * hh); }
        float qt[8], kh[8];
#pragma unroll
        for (int hh = 0; hh < 2; ++hh) { f32x4 ddv;
#pragma unroll
            for (int j = 0; j < 4; ++j) { const int idx = 4 * hh + j; const float lf = fv[hh][j], gc = row_prefix(lf), gl = __shfl(gc, (lane & 48) | 15);
                const float eg = __expf(gc), einv = __builtin_amdgcn_rcpf(eg), f = __expf(lf), dd = __expf(gl);
                const unsigned qw = qv[hh][j >> 1]; const float q = (j & 1) ? bfhi(qw) : bflo(qw);
                qt[idx] = q * eg; kh[idx] = (1.f - f) * einv; ddv[j] = dd;
                hk[((2 * s + hh) * 64 + 4 * g + j) * 4] = (bf16)f2bf(kh[idx] * dd); }
            if (i == 0) *(f32x4*)(rec + HD_OFF + (32 * s + 16 * hh + 4 * g) * 4) = ddv; }
        const bf16x8 Qf = mk8(cvtpk(qt[0], qt[1]), cvtpk(qt[2], qt[3]), cvtpk(qt[4], qt[5]), cvtpk(qt[6], qt[7]));
        const bf16x8 Kf = mk8(cvtpk(kh[0], kh[1]), cvtpk(kh[2], kh[3]), cvtpk(kh[4], kh[5]), cvtpk(kh[6], kh[7]));
        *(bf16x8*)(rec + HQ_OFF + (s * 64 + lane) * 16) = Qf;
        pacc = MFMA32(Kf, Qf, pacc);
    }
    float p[4];
#pragma unroll
    for (int r = 0; r < 4; ++r) p[r] = (4 * g + r <= i) ? pacc[r] : 0.f;
    *(bf16x4*)(rec + HP_OFF + lane * 8) = mk4(cvtpk(p[0], p[1]), cvtpk(p[2], p[3]));
}

__device__ __forceinline__ void gdn_s1(int chh, int lane, unsigned char* ws) {
    const int chain = chh / NCHUNK, ci = chh - chain * NCHUNK, b = chain >> 4, h = (chain >> 1) & 7, dir = chain & 1, i = lane & 15, g = lane >> 4;
    const int row = seq_row(b, dir, ci * 16 + i), row0 = seq_row(b, dir, ci * 16), stp = dir ? -1 : 1;
    const float* GB = (const float*)(ws + WS_GB);
    const float gval = GB[(size_t)row * 32 + dir * 8 + h], beta = GB[(size_t)row * 32 + 16 + dir * 8 + h];
    const float gc = row_prefix(gval), gl = __shfl(gc, (lane & 48) | 15), eg = __expf(gc), ekl = __expf(gl - gc);
    const bf16* qrow = (const bf16*)(ws + WS_QB) + (size_t)row * AW + h * 128 + 4 * g;
    const bf16* krow = (const bf16*)(ws + WS_KB) + (size_t)row * AW + h * 128 + 4 * g;
    unsigned char* rec = ws + WS_GREC + (size_t)chh * GREC;
    f32x4 kkacc = {0.f, 0.f, 0.f, 0.f}, qkacc = {0.f, 0.f, 0.f, 0.f};
#pragma unroll
    for (int s = 0; s < 4; ++s) {
        u32x2 qv[2], kv[2];
#pragma unroll
        for (int hh = 0; hh < 2; ++hh) { qv[hh] = *(const u32x2*)(qrow + 32 * s + 16 * hh); kv[hh] = *(const u32x2*)(krow + 32 * s + 16 * hh); }
        const bf16x8 Kf = mk8(kv[0].x, kv[0].y, kv[1].x, kv[1].y), Qf = mk8(qv[0].x, qv[0].y, qv[1].x, qv[1].y);
        kkacc = MFMA32(Kf, Kf, kkacc);
        qkacc = MFMA32(Kf, Qf, qkacc);
        unsigned qs[4];
#pragma unroll
        for (int w = 0; w < 4; ++w) { const unsigned qw = qv[w >> 1][w & 1]; qs[w] = cvtpk(bflo(qw) * eg, bfhi(qw) * eg); }
        *(bf16x8*)(rec + GQ_OFF + (s * 64 + lane) * 16) = mk8(qs[0], qs[1], qs[2], qs[3]);
    }
    float att[4], Areg[4];
#pragma unroll
    for (int r = 0; r < 4; ++r) { const float gcs = __shfl(gc, 4 * g + r), bts = __shfl(beta, 4 * g + r);
        att[r] = (4 * g + r <= i) ? qkacc[r] * __expf(gc - gcs) : 0.f;
        Areg[r] = (i < 4 * g + r) ? bts * kkacc[r] * __expf(gcs - gc) : 0.f; }
    *(bf16x4*)(rec + GAT_OFF + lane * 8) = mk4(cvtpk(att[0], att[1]), cvtpk(att[2], att[3]));
    if (lane == 0) *(float*)(rec + GAL_OFF) = __expf(gl);
    float xu[16][2], xw[16][2], kt[16][2];
    const bf16* vcol = (const bf16*)(ws + WS_VB) + h * 128 + 2 * lane; const bf16* kcol = (const bf16*)(ws + WS_KB) + h * 128 + 2 * lane;
#pragma unroll
    for (int t = 0; t < 16; ++t) { const size_t ro = (size_t)(row0 + stp * t) * AW; const unsigned vv = *(const unsigned*)(vcol + ro), kv = *(const unsigned*)(kcol + ro);
        const float bt = rdlane(beta, t), egt = rdlane(eg, t), et = rdlane(ekl, t), k0 = bflo(kv), k1 = bfhi(kv);
        xu[t][0] = bt * bflo(vv); xu[t][1] = bt * bfhi(vv); xw[t][0] = bt * egt * k0; xw[t][1] = bt * egt * k1; kt[t][0] = k0 * et; kt[t][1] = k1 * et; }
#pragma unroll
    for (int t = 1; t < 16; ++t)
#pragma unroll
        for (int s = 0; s < t; ++s) { const float a = rdlane(Areg[t & 3], s + 16 * (t >> 2));
            xu[t][0] -= a * xu[s][0]; xu[t][1] -= a * xu[s][1]; xw[t][0] -= a * xw[s][0]; xw[t][1] -= a * xw[s][1]; }
#pragma unroll
    for (int e = 0; e < 2; ++e) { const int c = 2 * lane + e, t16 = c >> 4, m = c & 15;
        const int ks = c >> 5, slot = 4 * ((c >> 4) & 1) + (c & 3), gq = (c >> 2) & 3;
#pragma unroll
        for (int gp = 0; gp < 4; ++gp) {
            *(u32x2*)(rec + GU_OFF + ((t16 * 64 + m + 16 * gp) * 4) * 2) = (u32x2){cvtpk(xu[4 * gp][e], xu[4 * gp + 1][e]), cvtpk(xu[4 * gp + 2][e], xu[4 * gp + 3][e])};
            *(u32x2*)(rec + GK_OFF + ((t16 * 64 + m + 16 * gp) * 4) * 2) = (u32x2){cvtpk(kt[4 * gp][e], kt[4 * gp + 1][e]), cvtpk(kt[4 * gp + 2][e], kt[4 * gp + 3][e])}; }
#pragma unroll
        for (int t = 0; t < 16; ++t) *(bf16*)(rec + GW_OFF + (((ks * 64 + t + 16 * gq) * 8) + slot) * 2) = (bf16)f2bf(xw[t][e]); }
}
__device__ __forceinline__ void ph_even_s1(Frame& F, const Args& a) {
    for (int chh = F.gw; chh < NCHH; chh += F.NGW) {
#ifndef EXP_B
        hgrn_s1(chh, F.lane, a.ws);
#endif
#ifndef EXP_A
        gdn_s1(chh, F.lane, a.ws);
#endif
    }
}

typedef float f32x2v __attribute__((ext_vector_type(2)));
constexpr int S2_NR = 8, S2_SLOT = 14336, S2_ORING = S2_NR * S2_SLOT, S2_CTL = S2_ORING + 2 * 4096;
static_assert(S2_CTL + 256 <= RING_BYTES, "S2 LDS map");
constexpr int GS_ATT = 12288, GS_U = 12800, GS_AL = 13824;
constexpr int HS_V = 9216;
#define S2_SPIN(cond) do { while (cond) __builtin_amdgcn_s_sleep(1); asm volatile("" ::: "memory"); } while (0)
#define DMA16(g, l) __builtin_amdgcn_global_load_lds((const unsigned*)(g), (LAS unsigned*)(l), 16, 0, 0)
#define DMA4(g, l) __builtin_amdgcn_global_load_lds((const unsigned*)(g), (LAS unsigned*)(l), 4, 0, 0)
template <int MIXER, int L> __device__ __forceinline__ void s2_loader(int chain, int vs0, int lane, unsigned char* ws, LAS unsigned char* lds) {
    const int b = chain >> 4, h = (chain >> 1) & 7, dir = chain & 1, stp = dir ? -1 : 1;
    constexpr int RS = MIXER == 0 ? GREC : HREC;
    constexpr int NP = MIXER == 0 ? (L < 2 ? 4 : 3) : (L == 0 ? 3 : (L == 1 ? 2 : 4));
    const unsigned char* recs = ws + (MIXER == 0 ? WS_GREC : WS_HREC) + (size_t)chain * NCHUNK * RS;
    const bf16* va = (const bf16*)(ws + WS_VA) + h * 128 + (vs0 + (L & 1)) * 16;
    volatile LAS unsigned* ctl = (volatile LAS unsigned*)(lds + S2_CTL);
#pragma unroll 1
    for (int c = 0; c < NCHUNK; ++c) {
        S2_SPIN((int)min(ctl[4], ctl[5]) + S2_NR <= c);
        const unsigned char* r = recs + (size_t)c * RS; LAS unsigned char* slot = lds + (c & (S2_NR - 1)) * S2_SLOT;
        if (MIXER == 0) {
#pragma unroll
            for (int p = L; p < 12; p += 4) DMA16(r + p * 1024 + lane * 16, slot + p * 1024);
            if (L == 0) DMA16(lane < 32 ? r + GAT_OFF + lane * 16 : r + GU_OFF + vs0 * 512 + (lane - 32) * 16, slot + GS_ATT);
            if (L == 1) DMA16(lane < 32 ? r + GU_OFF + (vs0 + 1) * 512 + lane * 16 : r + GAL_OFF + (lane & 15) * 16, slot + GS_U + 512);
        } else {
#pragma unroll
            for (int p = L; p < 9; p += 4) DMA16(r + p * 1024 + lane * 16, slot + p * 1024);
            if (L >= 2) { const bf16* vr = va + (size_t)(seq_row(b, dir, c * 16) + stp * (lane >> 2)) * AW + (lane & 3) * 2;
                DMA4(vr, slot + HS_V + (L & 1) * 512); DMA4(vr + 8, slot + HS_V + (L & 1) * 512 + 256); }
        }
        if (c >= 3) { if (NP == 4) asm volatile("s_waitcnt vmcnt(12)" ::: "memory"); else if (NP == 3) asm volatile("s_waitcnt vmcnt(9)" ::: "memory"); else asm volatile("s_waitcnt vmcnt(6)" ::: "memory");
                      if (lane == 0) ctl[L] = (unsigned)(c - 2); }
    }
    asm volatile("s_waitcnt vmcnt(0)" ::: "memory"); if (lane == 0) ctl[L] = (unsigned)NCHUNK;
}
__device__ __forceinline__ void s2_flusher(int mixer, int chain, int vs, int ts, int lane, unsigned char* ws, LAS unsigned char* lds) {
    const int b = chain >> 4, h = (chain >> 1) & 7, dir = chain & 1, stp = dir ? -1 : 1, t = lane >> 2, vq = lane & 3;
    bf16* o = (bf16*)(ws + (mixer == 0 ? WS_OB : WS_OA)) + (size_t)dir * M * AW + h * 128 + vs * 16 + 4 * vq;
    volatile LAS unsigned* ctl = (volatile LAS unsigned*)(lds + S2_CTL);
#pragma unroll 1
    for (int c = 0; c < NCHUNK; ++c) {
        S2_SPIN((int)ctl[6 + ts] <= c);
        const LAS unsigned short* sl = (const LAS unsigned short*)(lds + S2_ORING + ts * 4096 + (c & 7) * 512) + t;
        const unsigned a0 = sl[(4 * vq + 0) * 16], a1 = sl[(4 * vq + 1) * 16], a2 = sl[(4 * vq + 2) * 16], a3 = sl[(4 * vq + 3) * 16];
        *(u32x2*)(o + (size_t)(seq_row(b, dir, c * 16) + stp * t) * AW) = (u32x2){a0 | (a1 << 16), a2 | (a3 << 16)};
        asm volatile("s_waitcnt lgkmcnt(0)" ::: "memory");
        if (lane == 0) ctl[8 + ts] = (unsigned)(c + 1);
    }
}
#define S2_PUBLISH_O(c_, Ov, fl_) do { if ((int)(fl_) < (c_) - 7) S2_SPIN((int)ctl[8 + ts] < (c_) - 7); \
        *(LAS u32x2*)(lds + S2_ORING + ts * 4096 + ((c_) & 7) * 512 + (lane & 15) * 32 + g * 8) = (u32x2){cvtpk((Ov)[0], (Ov)[1]), cvtpk((Ov)[2], (Ov)[3])}; \
        asm volatile("" ::: "memory"); if (lane == 0) ctl[6 + ts] = (unsigned)((c_) + 1); } while (0)
#define S2_PACK_SB() do { _Pragma("unroll") for (int s = 0; s < 4; ++s) Sb[s] = mk8(cvtpk(S[2 * s][0], S[2 * s][1]), cvtpk(S[2 * s][2], S[2 * s][3]), cvtpk(S[2 * s + 1][0], S[2 * s + 1][1]), cvtpk(S[2 * s + 1][2], S[2 * s + 1][3])); } while (0)
#define S2_STAGED() ((int)min(min(ctl[0], ctl[1]), min(ctl[2], ctl[3])))
#define S2_WAIT_STAGED(cn_) do { if (S2_STAGED() <= (cn_)) S2_SPIN(S2_STAGED() <= (cn_)); asm volatile("" ::: "memory"); } while (0)
struct HSet { bf16x8 q[4]; bf16x4 k[8]; bf16x4 p; bf16x4 v; };
__device__ __forceinline__ void hgrn_lds(HSet& R, const LAS unsigned char* sl, int ts, int lane, int g) {
#pragma unroll
    for (int s = 0; s < 4; ++s) R.q[s] = *(const LAS bf16x8*)(sl + HQ_OFF + (s * 64 + lane) * 16);
#pragma unroll
    for (int t = 0; t < 8; ++t) R.k[t] = *(const LAS bf16x4*)(sl + HK_OFF + (t * 64 + lane) * 8);
    R.p = *(const LAS bf16x4*)(sl + HP_OFF + lane * 8);
    const LAS unsigned short* vp = (const LAS unsigned short*)(sl + HS_V + ts * 512 + ((lane & 8) ? 256 : 0) + (lane & 7) * 2);
#pragma unroll
    for (int j = 0; j < 4; ++j) R.v[j] = (short)vp[(4 * g + j) * 8];
}
__device__ __forceinline__ void hgrn_s2c(int ts, int lane, LAS unsigned char* lds) {
    const int g = lane >> 4;
    volatile LAS unsigned* ctl = (volatile LAS unsigned*)(lds + S2_CTL);
    f32x4 S[8]; bf16x8 Sb[4];
#pragma unroll
    for (int t = 0; t < 8; ++t) S[t] = (f32x4){0.f, 0.f, 0.f, 0.f};
#pragma unroll
    for (int s = 0; s < 4; ++s) Sb[s] = mk8(0u, 0u, 0u, 0u);
    HSet A, B;
    S2_WAIT_STAGED(0);
    hgrn_lds(A, lds, ts, lane, g);
#define HG_STEP(R, Rn, c_) do { const int cn_ = (c_) + 1; const unsigned fl_ = ctl[8 + ts]; \
        const LAS unsigned char* sl_ = lds + ((c_) & (S2_NR - 1)) * S2_SLOT; \
        f32x4 dv[8]; _Pragma("unroll") for (int t = 0; t < 8; ++t) dv[t] = *(const LAS f32x4*)(sl_ + HD_OFF + (16 * t + 4 * g) * 4); \
        f32x4 O = {0.f, 0.f, 0.f, 0.f}; \
        _Pragma("unroll") for (int s = 0; s < 4; ++s) O = MFMA32(R.q[s], Sb[s], O); \
        if (cn_ < NCHUNK) { S2_WAIT_STAGED(cn_); hgrn_lds(Rn, lds + (cn_ & (S2_NR - 1)) * S2_SLOT, ts, lane, g); } \
        _Pragma("unroll") for (int t = 0; t < 8; ++t) S[t] = S[t] * dv[t]; \
        O = MFMA16(R.p, R.v, O); \
        _Pragma("unroll") for (int t = 0; t < 8; ++t) S[t] = MFMA16(R.k[t], R.v, S[t]); \
        asm volatile("" ::: "memory"); if (lane == 0) ctl[4 + ts] = (unsigned)cn_;        \
        S2_PACK_SB(); S2_PUBLISH_O(c_, O, fl_); } while (0)
#pragma unroll 1
    for (int c = 0; c < NCHUNK; c += 2) { HG_STEP(A, B, c); HG_STEP(B, A, c + 1); }
#undef HG_STEP
}
struct GSet { bf16x8 w[4], q[4]; bf16x4 k[8]; bf16x4 at; u32x2 u; float al; };
__device__ __forceinline__ void gdn_lds(GSet& R, const LAS unsigned char* sl, int ts, int lane) {
#pragma unroll
    for (int s = 0; s < 4; ++s) { R.w[s] = *(const LAS bf16x8*)(sl + GW_OFF + (s * 64 + lane) * 16); R.q[s] = *(const LAS bf16x8*)(sl + GQ_OFF + (s * 64 + lane) * 16); }
#pragma unroll
    for (int t = 0; t < 8; ++t) R.k[t] = *(const LAS bf16x4*)(sl + GK_OFF + (t * 64 + lane) * 8);
    R.at = *(const LAS bf16x4*)(sl + GS_ATT + lane * 8); R.u = *(const LAS u32x2*)(sl + GS_U + ts * 512 + lane * 8); R.al = *(const LAS float*)(sl + GS_AL);
}
__device__ __forceinline__ void gdn_s2c(int ts, int lane, LAS unsigned char* lds) {
    const int g = lane >> 4;
    volatile LAS unsigned* ctl = (volatile LAS unsigned*)(lds + S2_CTL);
    f32x4 S[8]; bf16x8 Sb[4];
#pragma unroll
    for (int t = 0; t < 8; ++t) S[t] = (f32x4){0.f, 0.f, 0.f, 0.f};
#pragma unroll
    for (int s = 0; s < 4; ++s) Sb[s] = mk8(0u, 0u, 0u, 0u);
    GSet A, B;
    S2_WAIT_STAGED(0);
    gdn_lds(A, lds, ts, lane);
#define GD_STEP(R, Rn, c_) do { const int cn_ = (c_) + 1; const unsigned fl_ = ctl[8 + ts]; \
        f32x4 WS_ = {0.f, 0.f, 0.f, 0.f}, O = {0.f, 0.f, 0.f, 0.f}; \
        _Pragma("unroll") for (int s = 0; s < 4; ++s) WS_ = MFMA32(R.w[s], Sb[s], WS_); \
        _Pragma("unroll") for (int s = 0; s < 4; ++s) O = MFMA32(R.q[s], Sb[s], O); \
        if (cn_ < NCHUNK) { S2_WAIT_STAGED(cn_); gdn_lds(Rn, lds + (cn_ & (S2_NR - 1)) * S2_SLOT, ts, lane); } \
        _Pragma("unroll") for (int t = 0; t < 8; ++t) S[t] = S[t] * R.al; \
        const bf16x4 Vn = mk4(cvtpk(bflo(R.u.x) - WS_[0], bfhi(R.u.x) - WS_[1]), cvtpk(bflo(R.u.y) - WS_[2], bfhi(R.u.y) - WS_[3])); \
        O = MFMA16(R.at, Vn, O); \
        _Pragma("unroll") for (int t = 0; t < 8; ++t) S[t] = MFMA16(R.k[t], Vn, S[t]); \
        asm volatile("" ::: "memory"); if (lane == 0) ctl[4 + ts] = (unsigned)cn_;        \
        S2_PACK_SB(); S2_PUBLISH_O(c_, O, fl_); } while (0)
#pragma unroll 1
    for (int c = 0; c < NCHUNK; c += 2) { GD_STEP(A, B, c); GD_STEP(B, A, c + 1); }
#undef GD_STEP
}
__device__ __forceinline__ void ph_even_s2(Frame& F, const Args& a, int variant) {
    const int bx = blockIdx.x, vcu = (F.G % 8 == 0) ? (bx % 8) * (F.G / 8) + bx / 8 : bx;
    const int ts = F.wave & 1;
    LAS unsigned char* lds = F.lds + RING_OFF;
    for (int tp = vcu; tp < 256; tp += F.G) {
        if (F.tid < 64) ((LAS unsigned*)(lds + S2_CTL))[F.tid] = 0u;
        __syncthreads();
        const int mixer = tp >> 7, chain = (tp >> 2) & 31, vs0 = (tp & 3) * 2;
        switch (F.wave) {
            case 0: case 1: if (mixer == 0) gdn_s2c(ts, F.lane, lds); else hgrn_s2c(ts, F.lane, lds); break;
            case 2: if (mixer == 0) s2_loader<0, 0>(chain, vs0, F.lane, a.ws, lds); else s2_loader<1, 0>(chain, vs0, F.lane, a.ws, lds); break;
            case 3: if (mixer == 0) s2_loader<0, 1>(chain, vs0, F.lane, a.ws, lds); else s2_loader<1, 1>(chain, vs0, F.lane, a.ws, lds); break;
            case 6: if (mixer == 0) s2_loader<0, 2>(chain, vs0, F.lane, a.ws, lds); else s2_loader<1, 2>(chain, vs0, F.lane, a.ws, lds); break;
            case 7: if (mixer == 0) s2_loader<0, 3>(chain, vs0, F.lane, a.ws, lds); else s2_loader<1, 3>(chain, vs0, F.lane, a.ws, lds); break;
            default: s2_flusher(mixer, chain, vs0 + ts, ts, F.lane, a.ws, lds); break;
        }
        __syncthreads();
    }
}
constexpr int N_PHASES = 3 + 10 * DEPTH;
__host__ __device__ constexpr bool phase_used(int ph) { return true; }

__global__ void __launch_bounds__(NTHREADS, 2) fwd(Args args) {
    extern __shared__ __attribute__((aligned(16))) unsigned char lds[];
    Frame F;
    F.lds = (LAS unsigned char*)lds; F.tid = threadIdx.x; F.lane = F.tid & 63; F.wave = __builtin_amdgcn_readfirstlane(F.tid >> 6);
    F.G = gridDim.x; F.gw = F.wave * F.G + blockIdx.x; F.NGW = F.G * NWAVES;
    for (int u = F.tid; u < (LDS_BYTES - LDSCTL_OFF) / 4; u += NTHREADS) ((LAS unsigned*)(F.lds + LDSCTL_OFF))[u] = 0u;
    __syncthreads();
    const int lo = args.ph_lo, hi = args.ph_hi; const bool multi = (hi - lo) > 1;
    unsigned char* ws = args.ws;
    XcdBarrier bar; bar.bar = (unsigned*)(ws + WS_CTL) + CW_BAR; bar.x = 0; bar.st = nullptr;
    if (multi) bar = xcd_barrier_post((unsigned*)(ws + WS_CTL) + CW_BAR, (volatile LAS unsigned*)(F.lds + MISC_OFF) + 8);
#ifndef PH_SITES
#define PH_SITES 0x3ffff
#endif
#define SITE(n) ((PH_SITES >> (n)) & 1)
#ifndef PROBE_MASK
#define PROBE_MASK 0
#endif
#define REPS(n) (((PROBE_MASK >> (n)) & 1) ? 2 : 1)
#define IN(k) (lo <= (k) && (k) < hi)
#define LAUNDER() do { asm volatile("" : "+v"(F.tid), "+v"(F.lane)); } while (0)
#define SEAM() do { if (multi) xcd_barrier(bar); } while (0)
    bf16* HX = (bf16*)(ws + WS_HX); bf16* MIX = (bf16*)(ws + WS_MIX); float* XA = (float*)(ws + WS_XA); float* Z = (float*)(ws + WS_Z); bf16* ACT = (bf16*)(ws + WS_ACT);
    LAS unsigned char* ring = F.lds + RING_OFF;

    if (SITE(0) && IN(0)) { _Pragma("unroll 1") for (int rep_ = 0; rep_ < REPS(0); ++rep_) { LAUNDER(); ph_prologue(F, args); } SEAM(); }
    if (SITE(1) && IN(1)) { _Pragma("unroll 1") for (int rep_ = 0; rep_ < REPS(1); ++rep_) { LAUNDER(); ph_modreduce(F, args); } SEAM(); }
    if (SITE(2) && IN(2)) { _Pragma("unroll 1") for (int rep_ = 0; rep_ < REPS(2); ++rep_) { LAUNDER(); ph_mod0(F, args); } SEAM(); }
#pragma unroll 1
    for (int l = 0; l < DEPTH; ++l) {
        const int base = 3 + 10 * l, j = l >> 1; const bool last = (l == DEPTH - 1); const int Mo = last ? MX : M;
        const float* MODL = (const float*)(ws + WS_MOD) + (size_t)l * 3 * 12288;
        if ((l & 1) == 0) {
            if (SITE(3) && IN(base + 0)) { _Pragma("unroll 1") for (int rep_ = 0; rep_ < REPS(3); ++rep_) {
                pg8::Gemm g{HX, (const bf16*)(ws + WS_WINE + j * SZ_WINE), M, NE_INP, D, D, D}; pg8::StaticOrder S; S.init(M, NE_INP, F.G, (int)blockIdx.x);
                EpiEven1 E{(bf16*)(ws + WS_QA), (bf16*)(ws + WS_VA), (bf16*)(ws + WS_GA), (bf16*)(ws + WS_ZB), (bf16*)(ws + WS_QKVB), (float*)(ws + WS_LF), (float*)(ws + WS_GB),
                           (const float*)(ws + WS_LB) + j * AW, args.in[12] + j * 16, args.in[13] + j * 16};
                pg8::gemm_phase<EpiEven1, pg8::StaticOrder, true, true>(ring, g, S, E); } SEAM(); }
            if (SITE(4) && IN(base + 1)) { _Pragma("unroll 1") for (int rep_ = 0; rep_ < REPS(4); ++rep_) { LAUNDER(); ph_conv<0>(F, args, j); } SEAM(); }
            if (SITE(5) && IN(base + 2)) { _Pragma("unroll 1") for (int rep_ = 0; rep_ < REPS(5); ++rep_) { LAUNDER(); ph_even_s1(F, args); } SEAM(); }
            if (SITE(17) && IN(base + 3)) { _Pragma("unroll 1") for (int rep_ = 0; rep_ < REPS(17); ++rep_) { LAUNDER(); ph_even_s2(F, args, rep_); } SEAM(); }
            if (SITE(6) && IN(base + 4)) { _Pragma("unroll 1") for (int rep_ = 0; rep_ < REPS(6); ++rep_) { LAUNDER(); ph_merge(F, args, j); } SEAM(); }
        } else {
            if (SITE(7) && IN(base + 0)) { _Pragma("unroll 1") for (int rep_ = 0; rep_ < REPS(7); ++rep_) {
                pg8::Gemm g{HX, (const bf16*)(ws + WS_WINO + j * SZ_WINO), M, 2 * D, D, D, D}; pg8::StaticOrder S; S.init(M, 2 * D, F.G, (int)blockIdx.x);
                EpiOdd1 E{(bf16*)(ws + WS_GY), (bf16*)(ws + WS_XBR)};
                pg8::gemm_phase<EpiOdd1, pg8::StaticOrder, true, true>(ring, g, S, E); } SEAM(); }
            if (SITE(8) && IN(base + 1)) { _Pragma("unroll 1") for (int rep_ = 0; rep_ < REPS(8); ++rep_) { LAUNDER(); ph_conv<1>(F, args, j); } SEAM(); }
            if (SITE(9) && IN(base + 2)) { _Pragma("unroll 1") for (int rep_ = 0; rep_ < REPS(9); ++rep_) {
                pg8::Gemm g{(const bf16*)(ws + WS_XC), (const bf16*)(ws + WS_WGATE + j * SZ_WGATE), M, 8192, 256, D, 256}; pg8::GateOrder S; S.init(M, F.G, (int)blockIdx.x);
                EpiGates E{(const bf16*)(ws + WS_XC), (unsigned*)(ws + WS_AB), args.in[22] + (size_t)j * 4 * D, args.in[23] + (size_t)j * 2 * D};
                pg8::gemm_phase<EpiGates, pg8::GateOrder, true, true>(ring, g, S, E); } SEAM(); }
            if (SITE(10) && IN(base + 3)) { _Pragma("unroll 1") for (int rep_ = 0; rep_ < REPS(10); ++rep_) { LAUNDER(); ph_odd_l1(F, args); } SEAM(); }
            if (SITE(11) && IN(base + 4)) { _Pragma("unroll 1") for (int rep_ = 0; rep_ < REPS(11); ++rep_) { LAUNDER(); ph_odd_l3(F, args); } SEAM(); }
        }
        if (SITE(12) && IN(base + 5)) { _Pragma("unroll 1") for (int rep_ = 0; rep_ < REPS(12); ++rep_) {
            const bf16* Wt = (const bf16*)((l & 1) ? ws + WS_WOUTO + j * SZ_WSQ : ws + WS_WOUTE + j * SZ_WSQ);
            { pg8::Gemm g{MIX, Wt, MX, D, D, D, D}; pg8::StaticOrder S; S.init(MX, D, F.G, (int)blockIdx.x);
              EpiResid E{l == 0 ? args.in[0] : XA, l == 0 ? args.in[2] : XA + (size_t)MX * D, Z, MODL + 2 * D, l & 1};
              pg8::gemm_phase<EpiResid, pg8::StaticOrder, true, true>(ring, g, S, E); }
            if (!last) { pg8::Gemm g{MIX, Wt, M, D, 256, D, D}; pg8::TailOrder S{8, 256, (int)blockIdx.x};
              EpiSlab E{(float*)(ws + WS_SLAB), 8, 256};
              pg8::gemm_phase<EpiSlab, pg8::TailOrder, true, true>(ring, g, S, E); } } SEAM(); }
        if (SITE(13) && IN(base + 6)) { _Pragma("unroll 1") for (int rep_ = 0; rep_ < REPS(13); ++rep_) { LAUNDER(); ph_ln(F, Z, Mo, args.in[6] + (size_t)(l * 2) * D, args.in[7] + (size_t)(l * 2) * D, nullptr, HX, MODL + 3 * D, MODL + 4 * D, 0, TailSrc{last ? nullptr : (const float*)(ws + WS_SLAB), 8, l == 0 ? args.in[2] : XA + (size_t)MX * D, MODL + 2 * 12288 + 2 * D}); } SEAM(); }
        if (SITE(14) && IN(base + 7)) { _Pragma("unroll 1") for (int rep_ = 0; rep_ < REPS(14); ++rep_) {
            pg8::Gemm g{HX, (const bf16*)(ws + WS_WGU + l * SZ_WGU), Mo, 2 * FF, D, D, D}; pg8::StaticOrder S; S.init(Mo, 2 * FF, F.G, (int)blockIdx.x);
            EpiSwiGLU E{ACT};
            pg8::gemm_phase<EpiSwiGLU, pg8::StaticOrder, true, true>(ring, g, S, E); } SEAM(); }
        if (SITE(15) && IN(base + 8)) { _Pragma("unroll 1") for (int rep_ = 0; rep_ < REPS(15); ++rep_) {
            const bf16* Wt = (const bf16*)(ws + WS_WDN + l * SZ_WDN);
            { pg8::Gemm g{ACT, Wt, MX, D, FF, FF, FF}; pg8::StaticOrder S; S.init(MX, D, F.G, (int)blockIdx.x);
              EpiResid E{Z, Z + (size_t)MX * D, XA, MODL + 5 * D, 0};
              pg8::gemm_phase<EpiResid, pg8::StaticOrder, true, true>(ring, g, S, E); }
            if (!last) { pg8::Gemm g{ACT, Wt, M, D, 512, FF, FF}; pg8::TailOrder S{11, 512, (int)blockIdx.x};
              EpiSlab E{(float*)(ws + WS_SLAB), 11, 512};
              pg8::gemm_phase<EpiSlab, pg8::TailOrder, true, true>(ring, g, S, E); } } SEAM(); }
        if (SITE(16) && IN(base + 9)) {
            const float* g1 = args.in[6] + (size_t)(l * 2 + 1) * D; const float* b1 = args.in[7] + (size_t)(l * 2 + 1) * D;
            LAUNDER(); if (last) ph_ln(F, XA, MX, g1, b1, args.out, nullptr, nullptr, nullptr, 0, TailSrc{nullptr, 0, nullptr, nullptr});
            else { LAUNDER(); ph_ln(F, XA, M, g1, b1, nullptr, HX, MODL + 3 * 12288, MODL + 3 * 12288 + D, (l + 1) & 1, TailSrc{(const float*)(ws + WS_SLAB), 11, Z + (size_t)MX * D, MODL + 2 * 12288 + 5 * D}); SEAM(); } }
    }
#undef IN
#undef SEAM
}

extern "C" void kernel_launch(void* const* d_in, const int* in_sizes, int n_in, void* d_out, int out_size, void* d_ws, size_t ws_size, hipStream_t stream) {
    static int grid = 0;
    if (grid == 0) {
        if (n_in != 25 || in_sizes[0] != MX * D || out_size != MX * D || ws_size < WS_END) { fprintf(stderr, "kernel_launch: unexpected shapes (n_in %d, in0 %d, out %d, ws %zu < %zu); nothing launched\n", n_in, n_in > 0 ? in_sizes[0] : -1, out_size, ws_size, (size_t)WS_END); grid = -1; return; }
        int dev = 0, cus = 0, per_cu = 0;
        if (hipGetDevice(&dev) != hipSuccess || hipDeviceGetAttribute(&cus, hipDeviceAttributeMultiprocessorCount, dev) != hipSuccess) { grid = -1; return; }
        if (hipFuncSetAttribute((const void*)fwd, hipFuncAttributeMaxDynamicSharedMemorySize, LDS_BYTES) != hipSuccess) { fprintf(stderr, "kernel_launch: hipFuncSetAttribute failed\n"); grid = -1; return; }
        if (hipOccupancyMaxActiveBlocksPerMultiprocessor(&per_cu, (const void*)fwd, NTHREADS, LDS_BYTES) != hipSuccess || per_cu < 1) { fprintf(stderr, "kernel_launch: occupancy query says %d\n", per_cu); }
        (void)hipGetLastError();
        grid = cus;
    }
    if (grid < 0) return;
    if (hipMemsetAsync((char*)d_ws + WS_CTL, 0, CTL_ZERO_BYTES, stream) != hipSuccess) return;
    Args a{};
    for (int i = 0; i < 25; ++i) a.in[i] = (const float*)d_in[i];
    a.out = (float*)d_out; a.ws = (unsigned char*)d_ws;
#if MK_ONE_LAUNCH
    a.ph_lo = 0; a.ph_hi = N_PHASES;
    hipLaunchKernelGGL(fwd, dim3(grid), dim3(NTHREADS), LDS_BYTES, stream, a);
#else
    for (int ph = 0; ph < N_PHASES; ++ph) { if (!phase_used(ph)) continue; a.ph_lo = ph; a.ph_hi = ph + 1;
        hipLaunchKernelGGL(fwd, dim3(grid), dim3(NTHREADS), LDS_BYTES, stream, a); }
#endif
}
```
